# Optimizing an MI355X kernel written in HIP

```python
import jax, jax.numpy as jnp
from jax import lax
import numpy as np

D_MODEL = 2048
BATCH = 4
SEQ = 4096
DEPTH = 4

GRID_W = 64
CTX_LEN = 256
N_MIXERS = 2
N_ATT_LAYERS = (DEPTH + N_MIXERS - 1) // N_MIXERS
N_GLA_LAYERS = DEPTH // N_MIXERS
ATT_HEADS = 16
ATT_KV_HEADS = 4
HEAD_DIM = D_MODEL // ATT_HEADS
WINDOW = 128
ATT_BLOCK = 128
ROPE_BASE = 10000.0
ROPE_AXIS_DIM = HEAD_DIM // 2
GLA_HEADS = 4
GLA_DK = D_MODEL // 2
GLA_DV = D_MODEL
GLA_DK_HEAD = GLA_DK // GLA_HEADS
GLA_DV_HEAD = GLA_DV // GLA_HEADS
GLA_GATE_RANK = 16
GLA_GATE_NORM = 16.0
GLA_CHUNK = 16
D_FF = 5632
CONV_W = 3
EPS = 1e-6
N_MOD = 6

kernel_name = "hybrid_swa_gla_convffn_dit"


def rmsnorm(x, g):
    xf = x.astype(jnp.float32)
    y = xf * lax.rsqrt(jnp.mean(xf * xf, axis=-1, keepdims=True) + EPS)
    return (y * g.astype(jnp.float32)).astype(x.dtype)


def modulate(x, g, shift, scale):
    return rmsnorm(x, g) * (1 + scale) + shift


def axial_rope_tables(n):
    rows = n // GRID_W
    row = jnp.repeat(jnp.arange(rows, dtype=jnp.float32), GRID_W)
    col = jnp.tile(jnp.arange(GRID_W, dtype=jnp.float32), rows)
    inv = ROPE_BASE ** (-jnp.arange(0, ROPE_AXIS_DIM, 2, dtype=jnp.float32) / ROPE_AXIS_DIM)
    ang_r = row[:, None] * inv[None, :]
    ang_c = col[:, None] * inv[None, :]
    return (jnp.cos(ang_r), jnp.sin(ang_r), jnp.cos(ang_c), jnp.sin(ang_c))


def rope_1d(x, cos, sin):
    shp = (cos.shape[0],) + (1,) * (x.ndim - 3) + (cos.shape[1],)
    c = cos.reshape(shp)
    s = sin.reshape(shp)
    x1, x2 = jnp.split(x, 2, axis=-1)
    return jnp.concatenate([x1 * c - x2 * s, x2 * c + x1 * s], axis=-1)


def apply_axial_rope(x, rope):
    cos_r, sin_r, cos_c, sin_c = rope
    xr, xc = jnp.split(x.astype(jnp.float32), 2, axis=-1)
    out = jnp.concatenate([rope_1d(xr, cos_r, sin_r), rope_1d(xc, cos_c, sin_c)], axis=-1)
    return out.astype(x.dtype)


def sink_softmax(logits, sink_logit):
    m = jnp.maximum(jnp.max(logits, axis=-1, keepdims=True), sink_logit)
    e = jnp.exp(logits - m)
    return e / (jnp.sum(e, axis=-1, keepdims=True) + jnp.exp(sink_logit - m))


def attn_mixer(h_ctx, h_lat, w_qkv, sink, w_o, rope, ctx_out):
    B, N, _ = h_lat.shape
    G = ATT_HEADS // ATT_KV_HEADS
    nq = ATT_HEADS * HEAD_DIM
    nkv = ATT_KV_HEADS * HEAD_DIM
    scale = HEAD_DIM ** -0.5

    def proj(h):
        n = h.shape[1]
        q, k, v = jnp.split(h @ w_qkv, [nq, nq + nkv], axis=-1)
        return (q.reshape(B, n, ATT_KV_HEADS, G, HEAD_DIM),
                k.reshape(B, n, ATT_KV_HEADS, HEAD_DIM),
                v.reshape(B, n, ATT_KV_HEADS, HEAD_DIM))

    qc, kc, vc = proj(h_ctx)
    ql, kl, vl = proj(h_lat)
    ql = apply_axial_rope(ql, rope)
    kl = apply_axial_rope(kl, rope)
    sink_b = sink.astype(jnp.float32).reshape(ATT_KV_HEADS, G)[None, :, :, None, None]

    oc = None
    if ctx_out:
        s = jnp.einsum('blkgd,bmkd->bkglm', qc, kc, preferred_element_type=jnp.float32) * scale
        p = sink_softmax(s, sink_b).astype(vc.dtype)
        oc = jnp.einsum('bkglm,bmkd->blkgd', p, vc).reshape(B, -1, nq) @ w_o

    nb = N // ATT_BLOCK

    def windows(t):
        tp = jnp.pad(t, ((0, 0), (ATT_BLOCK, ATT_BLOCK), (0, 0), (0, 0)))
        tp = tp.reshape(B, nb + 2, ATT_BLOCK, ATT_KV_HEADS, HEAD_DIM)
        w = jnp.concatenate([tp[:, :-2], tp[:, 1:-1], tp[:, 2:]], axis=2)
        return jnp.moveaxis(w, 1, 0)

    qb = jnp.moveaxis(ql.reshape(B, nb, ATT_BLOCK, ATT_KV_HEADS, G, HEAD_DIM), 1, 0)
    kw = windows(kl)
    vw = windows(vl)
    qi = jnp.arange(ATT_BLOCK)[:, None]
    kj = jnp.arange(3 * ATT_BLOCK)[None, :]
    band = jnp.abs(qi - kj + ATT_BLOCK) <= WINDOW

    def block(args):
        q, k, v, blk = args
        kpos = blk * ATT_BLOCK - ATT_BLOCK + kj
        mask = band & (kpos >= 0) & (kpos < N)
        s_w = jnp.einsum('bqkgd,bjkd->bkgqj', q, k, preferred_element_type=jnp.float32) * scale
        s_w = jnp.where(mask, s_w, -jnp.inf)
        s_c = jnp.einsum('bqkgd,bjkd->bkgqj', q, kc, preferred_element_type=jnp.float32) * scale
        p = sink_softmax(jnp.concatenate([s_w, s_c], axis=-1), sink_b).astype(v.dtype)
        o = (jnp.einsum('bkgqj,bjkd->bqkgd', p[..., :3 * ATT_BLOCK], v)
             + jnp.einsum('bkgqj,bjkd->bqkgd', p[..., 3 * ATT_BLOCK:], vc))
        return o.reshape(B, ATT_BLOCK, nq)

    ol = lax.map(block, (qb, kw, vw, jnp.arange(nb)))
    ol = jnp.moveaxis(ol, 0, 1).reshape(B, N, nq) @ w_o
    return oc, ol


def gla_chunk_scan(q, k, v, g, s0):
    B, H, n, dk = q.shape
    dv = v.shape[-1]
    nc = n // GLA_CHUNK
    f32 = jnp.float32
    qf = q.astype(f32).reshape(B, H, nc, GLA_CHUNK, dk)
    kf = k.astype(f32).reshape(B, H, nc, GLA_CHUNK, dk)
    vf = v.astype(f32).reshape(B, H, nc, GLA_CHUNK, dv)
    b = jnp.cumsum(g.astype(f32).reshape(B, H, nc, GLA_CHUNK, dk), axis=3)
    b_last = b[:, :, :, -1]
    q_in = qf * jnp.exp(b)
    k_in = kf * jnp.exp(-b)
    k_st = kf * jnp.exp(b_last[:, :, :, None, :] - b)
    causal = jnp.tril(jnp.ones((GLA_CHUNK, GLA_CHUNK), dtype=bool))
    a = jnp.where(causal, jnp.einsum('bhcid,bhcjd->bhcij', q_in, k_in), 0.0)
    o_intra = jnp.einsum('bhcij,bhcjv->bhciv', a, vf)

    def step(S, xs):
        qi, ks, vi, dl = xs
        o = jnp.einsum('bhcd,bhdv->bhcv', qi, S)
        S = S * jnp.exp(dl)[..., None] + jnp.einsum('bhcd,bhcv->bhdv', ks, vi)
        return S, o

    xs = (jnp.moveaxis(q_in, 2, 0), jnp.moveaxis(k_st, 2, 0),
          jnp.moveaxis(vf, 2, 0), jnp.moveaxis(b_last, 2, 0))
    S, o_inter = lax.scan(step, s0.astype(f32), xs)
    o = o_intra + jnp.moveaxis(o_inter, 0, 2)
    return o.reshape(B, H, n, dv), S


def gla_mixer(h_ctx, h_lat, w_in, gf_w1, gf_w2, gf_b, gb_w1, gb_w2, gb_b, onorm_g, w_o, ctx_out):
    B = h_lat.shape[0]

    def heads(t, d):
        return t.reshape(B, t.shape[1], GLA_HEADS, d).transpose(0, 2, 1, 3)

    def gate(h, w1, w2, bias):
        z = ((h @ w1) @ w2 + bias).astype(jnp.float32)
        return heads(jax.nn.log_sigmoid(z) / GLA_GATE_NORM, GLA_DK_HEAD)

    def proj(h):
        q, k, v, r = jnp.split(h @ w_in, [GLA_DK, 2 * GLA_DK, 2 * GLA_DK + GLA_DV], axis=-1)
        q = heads(q, GLA_DK_HEAD) * (GLA_DK_HEAD ** -0.5)
        return (q, heads(k, GLA_DK_HEAD), heads(v, GLA_DV_HEAD), r,
                gate(h, gf_w1, gf_w2, gf_b), gate(h, gb_w1, gb_w2, gb_b))

    def flip(t):
        return t[:, :, ::-1]

    def bidir(q, k, v, gf, gb, sf0, sb0):
        of, sf = gla_chunk_scan(q, k, v, gf, sf0)
        ob, sb = gla_chunk_scan(flip(q), flip(k), flip(v), flip(gb), sb0)
        return of + flip(ob), sf, sb

    def out(o, r):
        o = rmsnorm(o, onorm_g)
        o = o.transpose(0, 2, 1, 3).reshape(B, o.shape[2], GLA_DV).astype(r.dtype)
        return (o * jax.nn.silu(r)) @ w_o

    s0 = jnp.zeros((B, GLA_HEADS, GLA_DK_HEAD, GLA_DV_HEAD), jnp.float32)
    qc, kc, vc, rc, gfc, gbc = proj(h_ctx)
    o_c, sf, sb = bidir(qc, kc, vc, gfc, gbc, s0, s0)
    ql, kl, vl, rl, gfl, gbl = proj(h_lat)
    o_l, _, _ = bidir(ql, kl, vl, gfl, gbl, sf, sb)
    oc = out(o_c, rc) if ctx_out else None
    return oc, out(o_l, rl)


def conv_ffn(h, w_up, conv_w, conv_b, w_down):
    u = h @ w_up
    n = u.shape[1]
    up = jnp.pad(u, ((0, 0), (CONV_W // 2, CONV_W // 2), (0, 0)))
    u = conv_b + sum(conv_w[j] * up[:, j:j + n] for j in range(CONV_W))
    gate, val = jnp.split(u, 2, axis=-1)
    return (jax.nn.silu(gate) * val) @ w_down


def setup_inputs(seed: int = 0) -> dict:
    key = jax.random.key(seed)
    ks = jax.random.split(key, 32)
    D = D_MODEL
    nrm = jax.random.normal
    f = jnp.float32
    qkv_w = ATT_HEADS * HEAD_DIM + 2 * ATT_KV_HEADS * HEAD_DIM
    gla_in_w = 2 * GLA_DK + 2 * GLA_DV
    return {
        "x": nrm(ks[0], (BATCH, SEQ, D), f),
        "c": nrm(ks[1], (BATCH, D), f),
        "ctx": nrm(ks[2], (BATCH, CTX_LEN, D), f),
        "c_ctx": nrm(ks[3], (D,), f),
        "ada_w": nrm(ks[4], (DEPTH, D, N_MOD * D), f) * (0.5 * D ** -0.5),
        "ada_b": nrm(ks[5], (DEPTH, N_MOD * D), f) * 0.02,
        "norm_mix_g": 1.0 + 0.02 * nrm(ks[6], (DEPTH, D), f),
        "norm_ffn_g": 1.0 + 0.02 * nrm(ks[7], (DEPTH, D), f),
        "ffn_w_up": nrm(ks[8], (DEPTH, D, 2 * D_FF), f) * D ** -0.5,
        "ffn_conv_w": nrm(ks[9], (DEPTH, CONV_W, 2 * D_FF), f) * CONV_W ** -0.5,
        "ffn_conv_b": nrm(ks[10], (DEPTH, 2 * D_FF), f) * 0.02,
        "ffn_w_down": nrm(ks[11], (DEPTH, D_FF, D), f) * D_FF ** -0.5,
        "attn_w_qkv": nrm(ks[12], (N_ATT_LAYERS, D, qkv_w), f) * D ** -0.5,
        "attn_sink": nrm(ks[13], (N_ATT_LAYERS, ATT_HEADS), f) * 0.5,
        "attn_w_o": nrm(ks[14], (N_ATT_LAYERS, ATT_HEADS * HEAD_DIM, D), f) * (ATT_HEADS * HEAD_DIM) ** -0.5,
        "gla_w_in": nrm(ks[15], (N_GLA_LAYERS, D, gla_in_w), f) * D ** -0.5,
        "gla_gf_w1": nrm(ks[16], (N_GLA_LAYERS, D, GLA_GATE_RANK), f) * D ** -0.5,
        "gla_gf_w2": nrm(ks[17], (N_GLA_LAYERS, GLA_GATE_RANK, GLA_DK), f) * GLA_GATE_RANK ** -0.5,
        "gla_gf_b": nrm(ks[18], (N_GLA_LAYERS, GLA_DK), f) * 0.1,
        "gla_gb_w1": nrm(ks[19], (N_GLA_LAYERS, D, GLA_GATE_RANK), f) * D ** -0.5,
        "gla_gb_w2": nrm(ks[20], (N_GLA_LAYERS, GLA_GATE_RANK, GLA_DK), f) * GLA_GATE_RANK ** -0.5,
        "gla_gb_b": nrm(ks[21], (N_GLA_LAYERS, GLA_DK), f) * 0.1,
        "gla_onorm_g": 1.0 + 0.02 * nrm(ks[22], (N_GLA_LAYERS, GLA_DV_HEAD), f),
        "gla_w_o": nrm(ks[23], (N_GLA_LAYERS, GLA_DV, D), f) * GLA_DV ** -0.5,
        "final_norm_g": 1.0 + 0.02 * nrm(ks[24], (D,), f),
    }


def reference(x, c, ctx, c_ctx, ada_w, ada_b, norm_mix_g, norm_ffn_g, ffn_w_up, ffn_conv_w,
              ffn_conv_b, ffn_w_down, attn_w_qkv, attn_sink, attn_w_o, gla_w_in, gla_gf_w1,
              gla_gf_w2, gla_gf_b, gla_gb_w1, gla_gb_w2, gla_gb_b, gla_onorm_g, gla_w_o,
              final_norm_g):
    n_lat = x.shape[1]
    rope = axial_rope_tables(n_lat)
    sc = jax.nn.silu(c)[:, None, :]
    scc = jax.nn.silu(c_ctx)[None, None, :]
    xc = ctx
    for i in range(DEPTH):
        last = i == DEPTH - 1
        mod_l = jnp.split(sc @ ada_w[i] + ada_b[i], N_MOD, axis=-1)
        mod_c = jnp.split(scc @ ada_w[i] + ada_b[i], N_MOD, axis=-1)
        hl = modulate(x, norm_mix_g[i], mod_l[0], mod_l[1])
        hc = modulate(xc, norm_mix_g[i], mod_c[0], mod_c[1])
        j = i // N_MIXERS
        if i % N_MIXERS == 0:
            oc, ol = attn_mixer(hc, hl, attn_w_qkv[j], attn_sink[j], attn_w_o[j], rope, not last)
        else:
            oc, ol = gla_mixer(hc, hl, gla_w_in[j], gla_gf_w1[j], gla_gf_w2[j], gla_gf_b[j],
                               gla_gb_w1[j], gla_gb_w2[j], gla_gb_b[j], gla_onorm_g[j],
                               gla_w_o[j], not last)
        x = x + mod_l[2] * ol
        x = x + mod_l[5] * conv_ffn(modulate(x, norm_ffn_g[i], mod_l[3], mod_l[4]),
                                    ffn_w_up[i], ffn_conv_w[i], ffn_conv_b[i], ffn_w_down[i])
        if not last:
            xc = xc + mod_c[2] * oc
            xc = xc + mod_c[5] * conv_ffn(modulate(xc, norm_ffn_g[i], mod_c[3], mod_c[4]),
                                          ffn_w_up[i], ffn_conv_w[i], ffn_conv_b[i], ffn_w_down[i])
    return rmsnorm(x, final_norm_g)
```

```cpp
#include <hip/hip_runtime.h>
#include <cstdio>
#include <cstdint>
namespace pg8 {
#define PG8_LAS __attribute__((address_space(3)))
typedef unsigned short bf16_t;
typedef short bf16x8 __attribute__((ext_vector_type(8)));
typedef float f32x4 __attribute__((ext_vector_type(4)));
typedef unsigned u32x4 __attribute__((ext_vector_type(4)));
constexpr int BM = 256, BK = 64, HALF = 128, HTB = HALF * BK * 2  , STAGE_BYTES = 8 * HTB, NXCD = 8, WGM = 8;

__host__ __device__ __forceinline__ int lds_byte(int r, int c) { const int st = (r >> 4) * 2 + (c >> 5), rr = r & 15, cc = c & 31, ob = rr * 64 + cc * 2; return st * 1024 + (ob ^ (((ob >> 9) & 1) << 5)); }
__host__ __device__ __forceinline__ void stage_rc(int b, int& R, int& C) { const int st = b / 1024, sb = b % 1024, swz = sb ^ (((sb >> 9) & 1) << 5); R = (st >> 1) * 16 + swz / 64; C = (st & 1) * 32 + (swz % 64) / 2; }
__host__ __device__ __forceinline__ int perm32(int rho) { const int n = rho >> 4, i = rho & 15; return 8 * (i >> 2) + 4 * n + (i & 3); }

struct Unit { int pm, pn; };
struct Gemm { const bf16_t* A; const bf16_t* Bt; int M, N, K; };

struct StaticOrder {
    int nM, nN, nwg, G, c;
    __host__ __device__ void init(int M, int N, int G_, int c_) { nM = M / BM; nN = N / BM; nwg = nM * nN; G = G_; c = c_; }
    __host__ __device__ bool next(int i, Unit& u) const {
        const long L = (long)i * G + c; if (L >= nwg) return false;
        int wgid = (int)L; { const int q = nwg / NXCD, r = nwg % NXCD, xcd = wgid % NXCD, off = wgid / NXCD; wgid = (xcd < r ? xcd * (q + 1) : r * (q + 1) + (xcd - r) * q) + off; }
        const int nig = WGM * nN, gid = wgid / nig, fm = gid * WGM, gsz = (nM - fm) < WGM ? (nM - fm) : WGM;
        u.pm = fm + ((wgid % nig) % gsz); u.pn = (wgid % nig) / gsz; return true;
    }
    __device__ __forceinline__ void a_ready(const Unit&) const {}
    __device__ __forceinline__ void done(const Unit&) const {}
};

__device__ __forceinline__ unsigned cvt_pk_bf16(float lo, float hi) { unsigned r; asm volatile("v_cvt_pk_bf16_f32 %0, %1, %2" : "=v"(r) : "v"(lo), "v"(hi)); return r; }
typedef float f32x2 __attribute__((ext_vector_type(2)));

struct EpiStoreBf16 {
    static constexpr bool PERM = true, AFTER_DRAIN = false;
    bf16_t* O; int ldc; int zcol0; float* Z;
    __device__ __forceinline__ void operator()(const f32x4 (&acc)[2][2][4][2], const Unit& u, int wr, int wc, int fr, int fq) const {
        const int row0 = u.pm * BM + wr * 64 + fr; const int colt = u.pn * BM;
        if (colt >= zcol0) {
            if (wc == 0) {
#pragma unroll
                for (int ai = 0; ai < 2; ++ai)
#pragma unroll
                    for (int m = 0; m < 4; ++m) { float* zp = Z + (size_t)(row0 + ai * HALF + m * 16) * 32 + 8 * fq;
                        *(f32x4*)(zp) = acc[ai][0][m][0]; *(f32x4*)(zp + 4) = acc[ai][0][m][1]; }
            }
            return;
        }
        const int col0 = colt + wc * 32 + 8 * fq;
#pragma unroll
        for (int ai = 0; ai < 2; ++ai)
#pragma unroll
            for (int m = 0; m < 4; ++m) { bf16_t* rowp = O + (size_t)(row0 + ai * HALF + m * 16) * ldc + col0;
#pragma unroll
                for (int bj = 0; bj < 2; ++bj) { const f32x4 v0 = acc[ai][bj][m][0], v1 = acc[ai][bj][m][1];
                    u32x4 w; w.x = cvt_pk_bf16(v0[0], v0[1]); w.y = cvt_pk_bf16(v0[2], v0[3]); w.z = cvt_pk_bf16(v1[0], v1[1]); w.w = cvt_pk_bf16(v1[2], v1[3]);
                    *(u32x4*)(rowp + bj * HALF) = w; } }
    }
};
struct EpiResid {
    static constexpr bool PERM = false, AFTER_DRAIN = false;
    float* X; int ldc; const float* gate;
    __device__ __forceinline__ void operator()(const f32x4 (&acc)[2][2][4][2], const Unit& u, int wr, int wc, int fr, int fq) const {
        const int row0 = u.pm * BM + wr * 64 + fr, col0 = u.pn * BM + wc * 32 + 4 * fq;
        const int vec = u.pm < 64 ? (u.pm >> 4) : 4;
        const float* g = gate + (size_t)vec * 12288 + col0;
        f32x4 gv[2][2];
#pragma unroll
        for (int bj = 0; bj < 2; ++bj)
#pragma unroll
            for (int n = 0; n < 2; ++n) gv[bj][n] = *(const f32x4*)(g + bj * HALF + n * 16);
#pragma unroll
        for (int ai = 0; ai < 2; ++ai)
#pragma unroll
            for (int m = 0; m < 4; ++m) { float* rowp = X + (size_t)(row0 + ai * HALF + m * 16) * ldc + col0;
#pragma unroll
                for (int bj = 0; bj < 2; ++bj)
#pragma unroll
                    for (int n = 0; n < 2; ++n) { float* p = rowp + bj * HALF + n * 16; *(f32x4*)p = *(const f32x4*)p + gv[bj][n] * acc[ai][bj][m][n]; } }
    }
};
template <class Epi, class Sched, bool ALIGN_EPI = false, bool SP2 = false>
__device__ __forceinline__ void gemm_phase(PG8_LAS unsigned char* lds, const Gemm g, const Sched& S, const Epi& E) {
    int tid_l = threadIdx.x; asm volatile("" : "+v"(tid_l));
    const int tid = tid_l, wid = __builtin_amdgcn_readfirstlane(tid >> 6), lane = tid & 63, wr = wid >> 2, wc = wid & 3, fr = lane & 15, fq = lane >> 4;
    const int K = g.K, nt = K / BK;
    unsigned voffA[2], voffB[2];
#pragma unroll
    for (int i = 0; i < 2; ++i) { int R, C; stage_rc(tid * 16 + i * 8192, R, C); const int Rb = Epi::PERM ? ((R & ~31) + perm32(R & 31)) : R;
        voffA[i] = (unsigned)(R * K + C) * 2u; voffB[i] = (unsigned)(Rb * K + C) * 2u; }
    const size_t kstep = (size_t)(BK * 2);
    const size_t hstep = (size_t)HALF * K * 2;
    const size_t tstep = 2 * hstep;
    const unsigned ldsw = (unsigned)wid * 1024u;
    const int aoff = lds_byte(wr * 64 + fr, fq * 8), boff = lds_byte(wc * 32 + fr, fq * 8);
#define PG8_SA(b, h) (((b) * 2 + (h)) * HTB)
#define PG8_SB(b, h) ((4 + (b) * 2 + (h)) * HTB)
#define PG8_STAGE(bufoff, gbase, voff) do { _Pragma("unroll") for (int _i = 0; _i < 2; ++_i) \
        __builtin_amdgcn_global_load_lds((const unsigned*)((const char*)(gbase) + (voff)[_i]), (PG8_LAS unsigned*)(lds + (bufoff) + ldsw + _i * 8192), 16, 0, 0); } while (0)
#define PG8_LDA(dst, b, h) do { _Pragma("unroll") for (int m = 0; m < 4; ++m) _Pragma("unroll") for (int k = 0; k < 2; ++k) dst[m][k] = *(const PG8_LAS bf16x8*)(lds + PG8_SA(b, h) + aoff + m * 2048 + k * 1024); } while (0)
#define PG8_LDB(dst, b, h) do { _Pragma("unroll") for (int n = 0; n < 2; ++n) _Pragma("unroll") for (int k = 0; k < 2; ++k) dst[n][k] = *(const PG8_LAS bf16x8*)(lds + PG8_SB(b, h) + boff + n * 2048 + k * 1024); } while (0)
#define PG8_MMA(ai, bj, At, Bt) do { __builtin_amdgcn_s_setprio(1); _Pragma("unroll") for (int m = 0; m < 4; ++m) _Pragma("unroll") for (int n = 0; n < 2; ++n) _Pragma("unroll") for (int k = 0; k < 2; ++k) \
        acc[ai][bj][m][n] = __builtin_amdgcn_mfma_f32_16x16x32_bf16(Bt[n][k], At[m][k], acc[ai][bj][m][n], 0, 0, 0); __builtin_amdgcn_s_setprio(0); } while (0)
#define PG8_WAIT_V(n) asm volatile("s_waitcnt vmcnt(" #n ")" ::: "memory")
#define PG8_WAIT_L(n) asm volatile("s_waitcnt lgkmcnt(" #n ")" ::: "memory")
#define PG8_BAR __builtin_amdgcn_s_barrier()
#define PG8_SCHED __builtin_amdgcn_sched_barrier(0)
    Unit cur, nxt; int ui = 0;
    if (!S.next(0, cur)) return;
    f32x4 acc[2][2][4][2];
#pragma unroll
    for (int a = 0; a < 2; ++a)
#pragma unroll
        for (int b = 0; b < 2; ++b)
#pragma unroll
            for (int m = 0; m < 4; ++m)
#pragma unroll
                for (int n = 0; n < 2; ++n) acc[a][b][m][n] = (f32x4){0.f, 0.f, 0.f, 0.f};
    bf16x8 At[4][2], B0[2][2], B1[2][2];
    const char* cA = (const char*)g.A + (size_t)cur.pm * tstep; const char* cB = (const char*)g.Bt + (size_t)cur.pn * tstep;
    S.a_ready(cur);
    if constexpr (SP2) {
        PG8_STAGE(PG8_SB(0, 0), cB, voffB); PG8_STAGE(PG8_SB(0, 1), cB + hstep, voffB); PG8_STAGE(PG8_SA(0, 0), cA, voffA); PG8_STAGE(PG8_SA(0, 1), cA + hstep, voffA);
        if (wr == 1) PG8_BAR;
        PG8_WAIT_V(2); PG8_BAR;
        PG8_STAGE(PG8_SB(1, 0), cB + kstep, voffB); PG8_STAGE(PG8_SA(1, 0), cA + kstep, voffA); PG8_STAGE(PG8_SB(1, 1), cB + hstep + kstep, voffB);
        PG8_WAIT_V(6); PG8_BAR;
    } else {
        PG8_STAGE(PG8_SB(0, 0), cB, voffB); PG8_STAGE(PG8_SA(0, 0), cA, voffA); PG8_STAGE(PG8_SB(0, 1), cB + hstep, voffB); PG8_STAGE(PG8_SA(0, 1), cA + hstep, voffA);
        if (wr == 1) PG8_BAR;
        PG8_WAIT_V(4); PG8_BAR;
        PG8_STAGE(PG8_SB(1, 0), cB + kstep, voffB); PG8_STAGE(PG8_SA(1, 0), cA + kstep, voffA); PG8_STAGE(PG8_SB(1, 1), cB + hstep + kstep, voffB);
        PG8_WAIT_V(6); PG8_BAR;
    }
    for (;;) {
        const bool has_next = S.next(ui + 1, nxt);
        const char* nA = has_next ? (const char*)g.A + (size_t)nxt.pm * tstep : cA; const char* nB = has_next ? (const char*)g.Bt + (size_t)nxt.pn * tstep : cB;
        for (int t = 0; t < nt; t += 2) {
            const bool last = (t == nt - 2);
            const char* a1 = cA + (size_t)(t + 1) * kstep;
            const char* a2 = last ? nA : cA + (size_t)(t + 2) * kstep; const char* b2 = last ? nB : cB + (size_t)(t + 2) * kstep;
            const char* a3 = a2 + kstep; const char* b3 = b2 + kstep;
            if (last && has_next) S.a_ready(nxt);
            if constexpr (SP2) {
            PG8_LDB(B0, 0, 0); PG8_LDB(B1, 0, 1); PG8_SCHED; PG8_LDA(At, 0, 0); PG8_STAGE(PG8_SA(1, 1), a1 + hstep, voffA);
            PG8_WAIT_V(8); PG8_WAIT_L(0); PG8_BAR; PG8_MMA(0, 0, At, B0); PG8_MMA(0, 1, At, B1); PG8_BAR; PG8_SCHED;
            PG8_LDA(At, 0, 1); PG8_STAGE(PG8_SB(0, 0), b2, voffB); PG8_STAGE(PG8_SB(0, 1), b2 + hstep, voffB); PG8_STAGE(PG8_SA(0, 0), a2, voffA);
            PG8_WAIT_V(8); PG8_WAIT_L(0); PG8_BAR; PG8_MMA(1, 0, At, B0); PG8_MMA(1, 1, At, B1); PG8_BAR; PG8_SCHED;
            PG8_LDB(B0, 1, 0); PG8_LDB(B1, 1, 1); PG8_SCHED; PG8_LDA(At, 1, 0); PG8_STAGE(PG8_SA(0, 1), a2 + hstep, voffA);
            PG8_WAIT_V(8); PG8_WAIT_L(0); PG8_BAR; PG8_MMA(0, 0, At, B0); PG8_MMA(0, 1, At, B1); PG8_BAR; PG8_SCHED;
            PG8_LDA(At, 1, 1); PG8_STAGE(PG8_SB(1, 0), b3, voffB); PG8_STAGE(PG8_SB(1, 1), b3 + hstep, voffB); PG8_STAGE(PG8_SA(1, 0), a3, voffA);
            PG8_WAIT_V(8); PG8_WAIT_L(0); PG8_BAR; PG8_MMA(1, 0, At, B0); PG8_MMA(1, 1, At, B1); PG8_BAR; PG8_SCHED;
            } else {
            PG8_LDB(B0, 0, 0); PG8_SCHED; PG8_LDA(At, 0, 0); PG8_STAGE(PG8_SA(1, 1), a1 + hstep, voffA);
            PG8_WAIT_L(8); PG8_BAR; PG8_WAIT_L(0); PG8_MMA(0, 0, At, B0); PG8_BAR; PG8_SCHED;
            PG8_LDB(B1, 0, 1); PG8_STAGE(PG8_SB(0, 0), b2, voffB);
            PG8_BAR; PG8_WAIT_L(0); PG8_MMA(0, 1, At, B1); PG8_BAR;
            PG8_LDA(At, 0, 1); PG8_STAGE(PG8_SA(0, 0), a2, voffA);
            PG8_BAR; PG8_WAIT_L(0); PG8_MMA(1, 0, At, B0); PG8_BAR; PG8_SCHED;
            PG8_STAGE(PG8_SB(0, 1), b2 + hstep, voffB);
            PG8_WAIT_V(6); PG8_BAR; PG8_MMA(1, 1, At, B1); PG8_BAR;
            PG8_LDB(B0, 1, 0); PG8_SCHED; PG8_LDA(At, 1, 0); PG8_STAGE(PG8_SA(0, 1), a2 + hstep, voffA);
            PG8_WAIT_L(8); PG8_BAR; PG8_WAIT_L(0); PG8_MMA(0, 0, At, B0); PG8_BAR; PG8_SCHED;
            PG8_LDB(B1, 1, 1); PG8_STAGE(PG8_SB(1, 0), b3, voffB);
            PG8_BAR; PG8_WAIT_L(0); PG8_MMA(0, 1, At, B1); PG8_BAR;
            PG8_LDA(At, 1, 1); PG8_STAGE(PG8_SA(1, 0), a3, voffA);
            PG8_BAR; PG8_WAIT_L(0); PG8_MMA(1, 0, At, B0); PG8_BAR; PG8_SCHED;
            PG8_STAGE(PG8_SB(1, 1), b3 + hstep, voffB);
            PG8_WAIT_V(6); PG8_BAR; PG8_MMA(1, 1, At, B1); PG8_BAR;
            }
        }
        if constexpr (ALIGN_EPI) { if (wr == 0) PG8_BAR; }
        if constexpr (!Epi::AFTER_DRAIN) { E(acc, cur, wr, wc, fr, fq); S.done(cur); }
        if (!has_next) break;
#pragma unroll
        for (int a = 0; a < 2; ++a)
#pragma unroll
            for (int b = 0; b < 2; ++b)
#pragma unroll
                for (int m = 0; m < 4; ++m)
#pragma unroll
                    for (int n = 0; n < 2; ++n) acc[a][b][m][n] = (f32x4){0.f, 0.f, 0.f, 0.f};
        cur = nxt; cA = nA; cB = nB; ++ui;
        if constexpr (ALIGN_EPI) { if (wr == 1) PG8_BAR; }
    }
    PG8_WAIT_V(0);
    if constexpr (!ALIGN_EPI) { if (wr == 0) PG8_BAR; }
    PG8_BAR;
    if constexpr (Epi::AFTER_DRAIN) { E.fused(acc, cur, wr, wc, fr, fq, lds, wid, lane); S.done(cur); }
#undef PG8_SA
#undef PG8_SB
#undef PG8_STAGE
#undef PG8_LDA
#undef PG8_LDB
#undef PG8_MMA
#undef PG8_WAIT_V
#undef PG8_WAIT_L
#undef PG8_BAR
#undef PG8_SCHED
}
}
#define LAS __attribute__((address_space(3)))
#define XB_TMO      128
#define XB_XCNT(j)  (256  + 64 * (j))
#define XB_XSUB(j)  (1280 + 64 * (j))
#define XB_XGEN(j)  (2304 + 64 * (j))
#define XB_TOP      3328
#define XB_TOPGEN   3392
#define XCD_BAR_WORDS 3456
#define XB_SPIN_CAP (1u << 18)

__device__ __forceinline__ unsigned xb_ld(unsigned* p)              { return __hip_atomic_load(p, __ATOMIC_RELAXED, __HIP_MEMORY_SCOPE_AGENT); }
__device__ __forceinline__ unsigned xb_add(unsigned* p, unsigned v) { return __hip_atomic_fetch_add(p, v, __ATOMIC_RELAXED, __HIP_MEMORY_SCOPE_AGENT); }
__device__ __forceinline__ unsigned xb_xcc_id() { return (unsigned)__builtin_amdgcn_s_getreg((3 << 11) | 20) & 0xFu; }
#define XB_SPIN(cond, bar) do { unsigned _sp = 0; while (cond) { __builtin_amdgcn_s_sleep(1); \
    if ((++_sp & 255u) == 0u) { if (xb_ld(&(bar)[XB_TMO])) break; if (_sp > XB_SPIN_CAP) { atomicAdd(&(bar)[XB_TMO], 1u); break; } } } } while (0)

struct XcdBarrier {
    unsigned* bar; unsigned x;
    volatile LAS unsigned* st;
};

__device__ __forceinline__ XcdBarrier xcd_barrier_post(unsigned* bar, volatile LAS unsigned* st) {
    XcdBarrier b; b.bar = bar; b.x = xb_xcc_id(); b.st = st;
    if (threadIdx.x == 0) (void)xb_add(&bar[XB_XCNT(b.x)], 1u);
    return b;
}
__device__ __forceinline__ void xcd_barrier_complete(unsigned* bar, unsigned x, unsigned& nloc, unsigned& nx) {
    const unsigned G = gridDim.x * gridDim.y * gridDim.z;
    unsigned sum, cnt, mine, sp = 0u;
    for (;;) {
        sum = 0u; cnt = 0u; mine = 0u;
#pragma unroll
        for (unsigned j = 0; j < 16; ++j) { const unsigned c = xb_ld(&bar[XB_XCNT(j)]); sum += c; cnt += (c > 0u) ? 1u : 0u; mine = (j == x) ? c : mine; }
        if (sum == G) break;
        __builtin_amdgcn_s_sleep(1);
        if ((++sp & 255u) == 0u) { if (xb_ld(&bar[XB_TMO])) break; if (sp > XB_SPIN_CAP) { atomicAdd(&bar[XB_TMO], 1u); break; } }
    }
    nloc = mine > 0u ? mine : 1u; nx = cnt > 0u ? cnt : 1u;
}

__device__ __forceinline__ void xcd_barrier(const XcdBarrier& b) {
    asm volatile("s_waitcnt vmcnt(0)" ::: "memory");
    __syncthreads();
    if (threadIdx.x == 0) {
        unsigned* bar = b.bar;
        __builtin_amdgcn_s_waitcnt(0);
        unsigned nloc = b.st[0], nx = b.st[1];
        if (nloc == 0u) { xcd_barrier_complete(bar, b.x, nloc, nx); b.st[0] = nloc; b.st[1] = nx; }
        const unsigned old = xb_add(&bar[XB_XSUB(b.x)], 1u);
        const unsigned gen = old / nloc;
        if (old + 1u == (gen + 1u) * nloc) {
            __builtin_amdgcn_fence(__ATOMIC_RELEASE, "agent");
            asm volatile("s_waitcnt vmcnt(0)" ::: "memory");
            const unsigned og = xb_add(&bar[XB_TOP], 1u);
            const unsigned tg = og / nx;
            if (og + 1u == (tg + 1u) * nx) xb_add(&bar[XB_TOPGEN], 1u);
            else XB_SPIN(xb_ld(&bar[XB_TOPGEN]) == tg, bar);
            __builtin_amdgcn_fence(__ATOMIC_ACQUIRE, "agent");
            xb_add(&bar[XB_XGEN(b.x)], 1u);
            asm volatile("s_waitcnt vmcnt(0)" ::: "memory");
        } else {
            XB_SPIN(xb_ld(&bar[XB_XGEN(b.x)]) == gen, bar);
            __builtin_amdgcn_fence(__ATOMIC_ACQUIRE, "agent");
            asm volatile("s_waitcnt vmcnt(0)" ::: "memory");
        }
    }
    __syncthreads();
}

constexpr int DM = 2048, NB = 4, SEQ = 4096, CTXL = 256, DEPTH = 4;
constexpr int M_LAT = NB * SEQ, M_CTX = NB * CTXL, M_ALL = M_LAT + M_CTX;
constexpr int DFF = 5632, DFF2 = 2 * DFF, NQKV = 3072, NGLA = 6144, NGLA_EXT = 6400, NMOD = 6 * DM;
constexpr float EPS = 1e-6f;
#ifndef MK_ONE_LAUNCH
#define MK_ONE_LAUNCH 1
#endif
#ifndef NAIVE_ATTN
#define NAIVE_ATTN 1
#endif
#ifndef NAIVE_GLA
#define NAIVE_GLA 1
#endif
constexpr int NPH = 42;

constexpr size_t MiB = 1u << 20;
constexpr size_t WS_CTL = 0, CTL_ZERO_BYTES = 1 * MiB;
constexpr size_t WS_MODS = 1 * MiB;
constexpr size_t WS_X = 2 * MiB;
constexpr size_t WS_H = 138 * MiB;
constexpr size_t WS_P = 206 * MiB;
constexpr size_t WS_Z1 = 410 * MiB;
constexpr size_t WS_OMIX = 413 * MiB;
constexpr size_t WS_U = 481 * MiB;
constexpr size_t WS_OF = WS_U, WS_OB = WS_U + 136 * MiB;
constexpr size_t WS_ACT = 855 * MiB;
constexpr size_t WS_WUP = 1042 * MiB, WUP_STRIDE = 44 * MiB;
constexpr size_t WS_WDN = 1218 * MiB, WDN_STRIDE = 22 * MiB;
constexpr size_t WS_WQKV = 1306 * MiB, WQKV_STRIDE = 12 * MiB;
constexpr size_t WS_WAO = 1330 * MiB, WO_STRIDE = 8 * MiB;
constexpr size_t WS_WGIN = 1346 * MiB, WGIN_STRIDE = 25 * MiB;
constexpr size_t WS_WGO = 1396 * MiB;
constexpr size_t WS_END = 1412 * MiB;
constexpr int CW_BAR = 4096;

constexpr int RING_BYTES = 131072, LDSCTL_OFF = RING_BYTES, LDS_BYTES = 147456;

#define GAS __attribute__((address_space(1)))
#define LAS __attribute__((address_space(3)))
typedef unsigned short bf16;
typedef unsigned v4u __attribute__((ext_vector_type(4)));
typedef unsigned v2u __attribute__((ext_vector_type(2)));
typedef float f32x4 __attribute__((ext_vector_type(4)));
#define LDS_WAIT() asm volatile("s_waitcnt lgkmcnt(0)" ::: "memory")
__device__ __forceinline__ unsigned f2bf(float f) { unsigned u = __builtin_bit_cast(unsigned, f); return (u + 0x7fffu + ((u >> 16) & 1u)) >> 16; }
__device__ __forceinline__ unsigned pk2(float lo, float hi) { return f2bf(lo) | (f2bf(hi) << 16); }
__device__ __forceinline__ float bf_lo(unsigned w) { return __builtin_bit_cast(float, w << 16); }
__device__ __forceinline__ float bf_hi(unsigned w) { return __builtin_bit_cast(float, w & 0xffff0000u); }
__device__ __forceinline__ float bf2f(bf16 h) { return __builtin_bit_cast(float, ((unsigned)h) << 16); }
__device__ __forceinline__ float silu_f(float v) { return v / (1.0f + __expf(-v)); }
__device__ __forceinline__ float wave_sum(float v) {
#pragma unroll
    for (int o = 1; o < 64; o <<= 1) v += __shfl_xor(v, o);
    return v;
}

struct Args { const float* in[25]; float* out; unsigned char* ws; int ph_lo, ph_hi; };
struct WV { int tid, lane, wave, G, vcu, gw, NGW; LAS unsigned char* lds; };

__device__ __forceinline__ void p0_transpose_item(const float* W, int K, int N, bf16* WT, int row_off, LAS float* scr, int item, int lane) {
    const int nblk = N / 32, kb = item / nblk, nb = item % nblk, k0 = 64 * kb, n0 = 32 * nb;
#pragma unroll 8
    for (int i = 0; i < 32; ++i) { const int kk = 2 * i + (lane >> 5); scr[kk * 33 + (lane & 31)] = W[(size_t)(k0 + kk) * N + n0 + (lane & 31)]; }
    LDS_WAIT(); asm volatile("" ::: "memory");
    const int c = lane & 7;
#pragma unroll
    for (int j = 0; j < 4; ++j) { const int n = (lane >> 3) + 8 * j; const LAS float* s = scr + (8 * c) * 33 + n;
        v4u o; o.x = pk2(s[0 * 33], s[1 * 33]); o.y = pk2(s[2 * 33], s[3 * 33]); o.z = pk2(s[4 * 33], s[5 * 33]); o.w = pk2(s[6 * 33], s[7 * 33]);
        *(v4u*)(WT + (size_t)(row_off + n0 + n) * K + k0 + 8 * c) = o; }
    LDS_WAIT(); asm volatile("" ::: "memory");
}
__device__ __forceinline__ void transpose_matrix(const WV& w, const float* W, int K, int N, bf16* WT, int row_off) {
    LAS float* scr = (LAS float*)(w.lds + w.wave * 16384);
    const int nitems = (K / 64) * (N / 32);
    for (int it = w.gw; it < nitems; it += w.NGW) p0_transpose_item(W, K, N, WT, row_off, scr, it, w.lane);
}
__device__ __forceinline__ void mods_item(const WV& w, const float* c, const float* c_ctx, const float* ada_w, const float* ada_b, float* mods, int it) {
    const int layer = it / 48, n0 = (it % 48) * 256;
    LAS float* sl = (LAS float*)w.lds;
    LAS float* red = (LAS float*)(w.lds + 40960);
    for (int i = w.tid; i < 5 * DM; i += 512) { const int vec = i >> 11, k = i & 2047; const float v = vec < 4 ? c[vec * DM + k] : c_ctx[k]; sl[i] = silu_f(v); }
    __syncthreads();
    const float* Wp = ada_w + (size_t)layer * DM * NMOD + n0 + 4 * w.lane;
    f32x4 acc[5];
#pragma unroll
    for (int v = 0; v < 5; ++v) acc[v] = (f32x4){0.f, 0.f, 0.f, 0.f};
    const int kbeg = w.wave * 256;
    for (int k = kbeg; k < kbeg + 256; k += 4) {
        f32x4 wv[4];
#pragma unroll
        for (int kk = 0; kk < 4; ++kk) wv[kk] = *(const f32x4*)(Wp + (size_t)(k + kk) * NMOD);
#pragma unroll
        for (int kk = 0; kk < 4; ++kk)
#pragma unroll
            for (int v = 0; v < 5; ++v) acc[v] += wv[kk] * sl[v * DM + k + kk];
    }
#pragma unroll
    for (int v = 0; v < 5; ++v) *(LAS f32x4*)(red + (w.wave * 5 + v) * 256 + 4 * w.lane) = acc[v];
    __syncthreads();
    for (int i = w.tid; i < 5 * 256; i += 512) { const int vec = i >> 8, col = i & 255; float s = 0.f;
#pragma unroll
        for (int ww = 0; ww < 8; ++ww) s += red[(ww * 5 + vec) * 256 + col];
        mods[((size_t)layer * 5 + vec) * NMOD + n0 + col] = s + ada_b[(size_t)layer * NMOD + n0 + col]; }
    __syncthreads();
}

__device__ __forceinline__ void norm_rows(const WV& w, const float* X, bf16* H, const float* g, const float* shift, const float* scale, int nrows) {
    for (int row = w.gw; row < nrows; row += w.NGW) {
        const int vec = row < M_LAT ? (row >> 12) : 4;
        const f32x4* xr = (const f32x4*)(X + (size_t)row * DM) + w.lane;
        f32x4 v[8]; float ss = 0.f;
#pragma unroll
        for (int j = 0; j < 8; ++j) { v[j] = xr[64 * j]; ss += (v[j].x * v[j].x + v[j].y * v[j].y) + (v[j].z * v[j].z + v[j].w * v[j].w); }
        const float r = 1.0f / sqrtf(wave_sum(ss) * (1.0f / DM) + EPS);
        const float* sh = shift + (size_t)vec * NMOD; const float* sc = scale + (size_t)vec * NMOD;
        v2u* o8 = (v2u*)(H + (size_t)row * DM) + w.lane;
#pragma unroll
        for (int j = 0; j < 8; ++j) { const int col = 4 * (64 * j + w.lane);
            const f32x4 gv = *(const f32x4*)(g + col), s = *(const f32x4*)(sc + col), t = *(const f32x4*)(sh + col);
            const f32x4 y = v[j] * r * gv * (s + 1.0f) + t;
            v2u o; o.x = pk2(y.x, y.y); o.y = pk2(y.z, y.w); o8[64 * j] = o; }
    }
}
__device__ __forceinline__ void final_norm(const WV& w, const float* X, float* out, const float* g) {
    for (int row = w.gw; row < M_LAT; row += w.NGW) {
        const f32x4* xr = (const f32x4*)(X + (size_t)row * DM) + w.lane;
        f32x4 v[8]; float ss = 0.f;
#pragma unroll
        for (int j = 0; j < 8; ++j) { v[j] = xr[64 * j]; ss += (v[j].x * v[j].x + v[j].y * v[j].y) + (v[j].z * v[j].z + v[j].w * v[j].w); }
        const float r = 1.0f / sqrtf(wave_sum(ss) * (1.0f / DM) + EPS);
        f32x4* o = (f32x4*)(out + (size_t)row * DM) + w.lane;
#pragma unroll
        for (int j = 0; j < 8; ++j) { const int col = 4 * (64 * j + w.lane); o[64 * j] = v[j] * r * *(const f32x4*)(g + col); }
    }
}

__device__ __forceinline__ void rope_rows(const WV& w, bf16* P) {
    const int half = w.lane >> 5, f = w.lane & 31;
    const float inv = exp2f(-(float)(2 * f) * (13.287712379549449f / 64.0f));
    for (int row = w.gw; row < M_LAT; row += w.NGW) {
        const int t = row & (SEQ - 1); const int pos = half ? (t & 63) : (t >> 6);
        const float ang = (float)pos * inv; const float c = __cosf(ang), s = __sinf(ang);
        bf16* p = P + (size_t)row * NQKV + half * 64 + f;
#pragma unroll 4
        for (int hh = 0; hh < 20; ++hh) { const float x1 = bf2f(p[hh * 128]), x2 = bf2f(p[hh * 128 + 32]);
            p[hh * 128] = (bf16)f2bf(x1 * c - x2 * s); p[hh * 128 + 32] = (bf16)f2bf(x2 * c + x1 * s); }
    }
}

__device__ __forceinline__ void attn_naive(const WV& w, const bf16* P, const float* sink, bf16* O) {
    const int g = w.lane >> 4, li = w.lane & 15;
    const float scale = 0.08838834764831845f;
    for (int task = w.gw; task < M_ALL * 16; task += w.NGW) {
        const int row = task >> 4, hq = task & 15, kvh = hq >> 2;
        float q[8];
        { const v4u qq = *(const v4u*)(P + (size_t)row * NQKV + hq * 128 + 8 * li);
          q[0] = bf_lo(qq.x) * scale; q[1] = bf_hi(qq.x) * scale; q[2] = bf_lo(qq.y) * scale; q[3] = bf_hi(qq.y) * scale;
          q[4] = bf_lo(qq.z) * scale; q[5] = bf_hi(qq.z) * scale; q[6] = bf_lo(qq.w) * scale; q[7] = bf_hi(qq.w) * scale; }
        int b, wbase = 0, nwin = 0;
        if (row < M_LAT) { b = row >> 12; const int t = row & (SEQ - 1); const int j0 = t - 128 < 0 ? 0 : t - 128, j1 = t + 128 > SEQ - 1 ? SEQ - 1 : t + 128; wbase = b * SEQ + j0; nwin = j1 - j0 + 1; }
        else b = (row - M_LAT) >> 8;
        const int cbase = M_LAT + b * CTXL, nk = nwin + CTXL;
        float m = sink[hq], l = (g == 0) ? 1.0f : 0.0f, o[8];
#pragma unroll
        for (int d = 0; d < 8; ++d) o[d] = 0.f;
        for (int i = g; i < nk; i += 4) {
            const int krow = i < nwin ? wbase + i : cbase + (i - nwin);
            const bf16* kp = P + (size_t)krow * NQKV + 2048 + kvh * 128 + 8 * li;
            const v4u kk = *(const v4u*)kp, vv = *(const v4u*)(kp + 512);
            float s = q[0] * bf_lo(kk.x) + q[1] * bf_hi(kk.x) + q[2] * bf_lo(kk.y) + q[3] * bf_hi(kk.y) + q[4] * bf_lo(kk.z) + q[5] * bf_hi(kk.z) + q[6] * bf_lo(kk.w) + q[7] * bf_hi(kk.w);
            s += __shfl_xor(s, 1); s += __shfl_xor(s, 2); s += __shfl_xor(s, 4); s += __shfl_xor(s, 8);
            const float mn = fmaxf(m, s), a = __expf(m - mn), p = __expf(s - mn);
            l = l * a + p; m = mn;
            o[0] = o[0] * a + p * bf_lo(vv.x); o[1] = o[1] * a + p * bf_hi(vv.x); o[2] = o[2] * a + p * bf_lo(vv.y); o[3] = o[3] * a + p * bf_hi(vv.y);
            o[4] = o[4] * a + p * bf_lo(vv.z); o[5] = o[5] * a + p * bf_hi(vv.z); o[6] = o[6] * a + p * bf_lo(vv.w); o[7] = o[7] * a + p * bf_hi(vv.w);
        }
        float ma = fmaxf(m, __shfl_xor(m, 16)); ma = fmaxf(ma, __shfl_xor(ma, 32));
        const float fsc = __expf(m - ma); l *= fsc; l += __shfl_xor(l, 16); l += __shfl_xor(l, 32);
        const float rl = 1.0f / l;
#pragma unroll
        for (int d = 0; d < 8; ++d) { float x = o[d] * fsc; x += __shfl_xor(x, 16); x += __shfl_xor(x, 32); o[d] = x * rl; }
        if (g == 0) { v4u ov; ov.x = pk2(o[0], o[1]); ov.y = pk2(o[2], o[3]); ov.z = pk2(o[4], o[5]); ov.w = pk2(o[6], o[7]);
            *(v4u*)(O + (size_t)row * DM + hq * 128 + 8 * li) = ov; }
    }
}

__device__ __forceinline__ void gla_naive(const WV& w, const bf16* P, const float* Z1, const float* w2f, const float* bf, const float* w2b, const float* bb, float* OF, float* OB) {
    LAS float* buf = (LAS float*)w.lds;
    const int vc = w.tid >> 2, dq = w.tid & 3;
    for (int it = w.vcu; it < 128; it += w.G) {
        const int vs = it & 3, dir = (it >> 2) & 1, h = (it >> 3) & 3, b = it >> 5;
        const float* w2 = dir ? w2b : w2f; const float* bias = dir ? bb : bf; float* OUT = dir ? OB : OF;
        float w2c[16], bz = 0.f;
        if (w.tid < 256) { bz = bias[h * 256 + w.tid];
#pragma unroll
            for (int r = 0; r < 16; ++r) w2c[r] = w2[r * 1024 + h * 256 + w.tid]; }
        else {
#pragma unroll
            for (int r = 0; r < 16; ++r) w2c[r] = 0.f; }
        float S[64];
#pragma unroll
        for (int i = 0; i < 64; ++i) S[i] = 0.f;
        const int cbase = M_LAT + b * CTXL, lbase = b * SEQ;
#define GLA_ROW(step) ((step) < CTXL ? (dir ? cbase + CTXL - 1 - (step) : cbase + (step)) : (dir ? lbase + SEQ - 1 - ((step) - CTXL) : lbase + ((step) - CTXL)))
#define GLA_FILL(step, par) do { if (w.tid < 256) { const int r_ = GLA_ROW(step); const float* z_ = Z1 + (size_t)r_ * 32 + dir * 16; float zz = bz; \
            _Pragma("unroll") for (int r = 0; r < 16; ++r) zz += z_[r] * w2c[r]; \
            const float ls_ = fminf(zz, 0.f) - log1pf(__expf(-fabsf(zz))); \
            LAS float* bp_ = buf + (par) * 768; bp_[w.tid] = __expf(ls_ * (1.0f / 16.0f)); \
            bp_[256 + w.tid] = bf2f(P[(size_t)r_ * NGLA + 1024 + h * 256 + w.tid]); bp_[512 + w.tid] = bf2f(P[(size_t)r_ * NGLA + h * 256 + w.tid]) * 0.0625f; } } while (0)
        __syncthreads();
        GLA_FILL(0, 0);
        __syncthreads();
        for (int step = 0; step < CTXL + SEQ; ++step) {
            const int row = GLA_ROW(step);
            if (step + 1 < CTXL + SEQ) GLA_FILL(step + 1, (step + 1) & 1);
            const float v = bf2f(P[(size_t)row * NGLA + 2048 + h * 512 + vs * 128 + vc]);
            const LAS float* bp = buf + (step & 1) * 768 + 64 * dq;
            float acc = 0.f;
#pragma unroll
            for (int i = 0; i < 64; i += 4) {
                const f32x4 e4 = *(const LAS f32x4*)(bp + i), k4 = *(const LAS f32x4*)(bp + 256 + i), q4 = *(const LAS f32x4*)(bp + 512 + i);
                S[i] = S[i] * e4.x + k4.x * v; acc += q4.x * S[i];
                S[i + 1] = S[i + 1] * e4.y + k4.y * v; acc += q4.y * S[i + 1];
                S[i + 2] = S[i + 2] * e4.z + k4.z * v; acc += q4.z * S[i + 2];
                S[i + 3] = S[i + 3] * e4.w + k4.w * v; acc += q4.w * S[i + 3];
            }
            acc += __shfl_xor(acc, 1); acc += __shfl_xor(acc, 2);
            if (dq == 0) OUT[(size_t)row * DM + h * 512 + vs * 128 + vc] = acc;
            __syncthreads();
        }
#undef GLA_ROW
#undef GLA_FILL
    }
}
__device__ __forceinline__ void gla_combine(const WV& w, const float* OF, const float* OB, const bf16* P, const float* og, bf16* O, int nrows) {
    for (int task = w.gw; task < nrows * 4; task += w.NGW) {
        const int row = task >> 2, h = task & 3; const size_t off = (size_t)row * DM + h * 512 + 8 * w.lane;
        const f32x4 a0 = *(const f32x4*)(OF + off), a1 = *(const f32x4*)(OF + off + 4), b0 = *(const f32x4*)(OB + off), b1 = *(const f32x4*)(OB + off + 4);
        const f32x4 o0 = a0 + b0, o1 = a1 + b1;
        float ss = (o0.x * o0.x + o0.y * o0.y) + (o0.z * o0.z + o0.w * o0.w) + (o1.x * o1.x + o1.y * o1.y) + (o1.z * o1.z + o1.w * o1.w);
        const float r = 1.0f / sqrtf(wave_sum(ss) * (1.0f / 512.0f) + EPS);
        const f32x4 g0 = *(const f32x4*)(og + 8 * w.lane), g1 = *(const f32x4*)(og + 8 * w.lane + 4);
        const v4u rr = *(const v4u*)(P + (size_t)row * NGLA + 4096 + h * 512 + 8 * w.lane);
        v4u ov;
        ov.x = pk2(o0.x * r * g0.x * silu_f(bf_lo(rr.x)), o0.y * r * g0.y * silu_f(bf_hi(rr.x)));
        ov.y = pk2(o0.z * r * g0.z * silu_f(bf_lo(rr.y)), o0.w * r * g0.w * silu_f(bf_hi(rr.y)));
        ov.z = pk2(o1.x * r * g1.x * silu_f(bf_lo(rr.z)), o1.y * r * g1.y * silu_f(bf_hi(rr.z)));
        ov.w = pk2(o1.z * r * g1.z * silu_f(bf_lo(rr.w)), o1.w * r * g1.w * silu_f(bf_hi(rr.w)));
        *(v4u*)(O + off) = ov;
    }
}
__device__ __forceinline__ void unpack8(const v4u a, float (&x)[8]) { x[0] = bf_lo(a.x); x[1] = bf_hi(a.x); x[2] = bf_lo(a.y); x[3] = bf_hi(a.y); x[4] = bf_lo(a.z); x[5] = bf_hi(a.z); x[6] = bf_lo(a.w); x[7] = bf_hi(a.w); }
__device__ __forceinline__ void conv_rows(const WV& w, const bf16* U, const float* cw, const float* cb, bf16* ACT, int nrows) {
    const int nseg = nrows / 32;
    for (int wi = w.gw; wi < nseg * 11; wi += w.NGW) {
        const int seg = wi / 11, cg = wi % 11, r0 = seg * 32, f = (cg * 64 + w.lane) * 8;
        float wg[3][8], wv[3][8], bg[8], bv[8];
#pragma unroll
        for (int j = 0; j < 3; ++j)
#pragma unroll
            for (int e = 0; e < 8; ++e) { wg[j][e] = cw[j * DFF2 + f + e]; wv[j][e] = cw[j * DFF2 + DFF + f + e]; }
#pragma unroll
        for (int e = 0; e < 8; ++e) { bg[e] = cb[f + e]; bv[e] = cb[DFF + f + e]; }
        const bool s_start = r0 < M_LAT ? ((r0 & (SEQ - 1)) == 0) : (((r0 - M_LAT) & (CTXL - 1)) == 0);
        const bool s_end = r0 < M_LAT ? (((r0 + 32) & (SEQ - 1)) == 0) : (((r0 + 32 - M_LAT) & (CTXL - 1)) == 0);
        const v4u zero4 = (v4u){0u, 0u, 0u, 0u};
        v4u pg = s_start ? zero4 : *(const v4u*)(U + (size_t)(r0 - 1) * DFF2 + f), pv = s_start ? zero4 : *(const v4u*)(U + (size_t)(r0 - 1) * DFF2 + DFF + f);
        v4u cg4 = *(const v4u*)(U + (size_t)r0 * DFF2 + f), cv4 = *(const v4u*)(U + (size_t)r0 * DFF2 + DFF + f);
        for (int r = 0; r < 32; ++r) {
            const bool nz = (r == 31) && s_end;
            const v4u ng = nz ? zero4 : *(const v4u*)(U + (size_t)(r0 + r + 1) * DFF2 + f), nv = nz ? zero4 : *(const v4u*)(U + (size_t)(r0 + r + 1) * DFF2 + DFF + f);
            float a[8], c[8], n[8], gate[8], val[8];
            unpack8(pg, a); unpack8(cg4, c); unpack8(ng, n);
#pragma unroll
            for (int e = 0; e < 8; ++e) gate[e] = bg[e] + wg[0][e] * a[e] + wg[1][e] * c[e] + wg[2][e] * n[e];
            unpack8(pv, a); unpack8(cv4, c); unpack8(nv, n);
#pragma unroll
            for (int e = 0; e < 8; ++e) val[e] = bv[e] + wv[0][e] * a[e] + wv[1][e] * c[e] + wv[2][e] * n[e];
            v4u ov; ov.x = pk2(silu_f(gate[0]) * val[0], silu_f(gate[1]) * val[1]); ov.y = pk2(silu_f(gate[2]) * val[2], silu_f(gate[3]) * val[3]);
            ov.z = pk2(silu_f(gate[4]) * val[4], silu_f(gate[5]) * val[5]); ov.w = pk2(silu_f(gate[6]) * val[6], silu_f(gate[7]) * val[7]);
            *(v4u*)(ACT + (size_t)(r0 + r) * DFF + f) = ov;
            pg = cg4; pv = cv4; cg4 = ng; cv4 = nv;
        }
    }
}

__global__ void __launch_bounds__(512, 2) mega(Args args) {
    extern __shared__ __attribute__((aligned(16))) unsigned char lds_raw[];
    LAS unsigned char* const lds0 = (LAS unsigned char*)lds_raw;
    for (int u = threadIdx.x; u < (LDS_BYTES - LDSCTL_OFF) / 4; u += 512) ((LAS unsigned*)(lds0 + LDSCTL_OFF))[u] = 0u;
    __syncthreads();
    XcdBarrier bar; bar.bar = (unsigned*)(args.ws + WS_CTL) + CW_BAR; bar.x = 0; bar.st = nullptr;
    if (MK_ONE_LAUNCH) bar = xcd_barrier_post((unsigned*)(args.ws + WS_CTL) + CW_BAR, (volatile LAS unsigned*)(lds0 + LDSCTL_OFF + 32));
#define PHASE_ENTER() int tid_l = threadIdx.x; asm volatile("" : "+v"(tid_l)); unsigned char* ws = args.ws; asm volatile("" : "+s"(ws)); WV w; w.lds = lds0; w.tid = tid_l; w.lane = tid_l & 63; \
    w.wave = __builtin_amdgcn_readfirstlane(tid_l >> 6); w.G = gridDim.x; { const int bx = blockIdx.x; w.vcu = (w.G % 8 == 0) ? (bx % 8) * (w.G / 8) + bx / 8 : bx; } w.gw = w.vcu * 8 + w.wave; w.NGW = w.G * 8; \
    float* X = (float*)(ws + WS_X); bf16* H = (bf16*)(ws + WS_H); bf16* P = (bf16*)(ws + WS_P); float* Z1 = (float*)(ws + WS_Z1); bf16* OMIX = (bf16*)(ws + WS_OMIX); bf16* U = (bf16*)(ws + WS_U); \
    bf16* ACT = (bf16*)(ws + WS_ACT); float* MODS = (float*)(ws + WS_MODS); float* OF = (float*)(ws + WS_OF); float* OB = (float*)(ws + WS_OB); \
    (void)X; (void)H; (void)P; (void)Z1; (void)OMIX; (void)U; (void)ACT; (void)MODS; (void)OF; (void)OB; (void)w
    const int lo = args.ph_lo, hi = args.ph_hi;
#define RUN(k) (lo <= (k) && (k) < hi)
#define SEAM(k) do { if (MK_ONE_LAUNCH && RUN(k) && RUN((k) + 1)) xcd_barrier(bar); } while (0)

    if (RUN(0)) {
        PHASE_ENTER();
        for (int it = w.vcu; it < 4 * 48; it += w.G) mods_item(w, args.in[1], args.in[3], args.in[4], args.in[5], MODS, it);
        for (int l = 0; l < DEPTH; ++l) {
            transpose_matrix(w, args.in[8] + (size_t)l * DM * DFF2, DM, DFF2, (bf16*)(ws + WS_WUP + l * WUP_STRIDE), 0);
            transpose_matrix(w, args.in[11] + (size_t)l * DFF * DM, DFF, DM, (bf16*)(ws + WS_WDN + l * WDN_STRIDE), 0);
        }
        for (int j = 0; j < 2; ++j) {
            transpose_matrix(w, args.in[12] + (size_t)j * DM * NQKV, DM, NQKV, (bf16*)(ws + WS_WQKV + j * WQKV_STRIDE), 0);
            transpose_matrix(w, args.in[14] + (size_t)j * DM * DM, DM, DM, (bf16*)(ws + WS_WAO + j * WO_STRIDE), 0);
            transpose_matrix(w, args.in[15] + (size_t)j * DM * NGLA, DM, NGLA, (bf16*)(ws + WS_WGIN + j * WGIN_STRIDE), 0);
            transpose_matrix(w, args.in[23] + (size_t)j * DM * DM, DM, DM, (bf16*)(ws + WS_WGO + j * WO_STRIDE), 0);
            bf16* wg = (bf16*)(ws + WS_WGIN + j * WGIN_STRIDE) + (size_t)NGLA * DM;
            const float* f1 = args.in[16] + (size_t)j * DM * 16; const float* b1 = args.in[19] + (size_t)j * DM * 16;
            for (int idx = w.gw * 64 + w.lane; idx < 256 * DM; idx += w.NGW * 64) { const int n = idx >> 11, k = idx & 2047;
                const float v = n < 16 ? f1[k * 16 + n] : (n < 32 ? b1[k * 16 + (n - 16)] : 0.f); wg[idx] = (bf16)f2bf(v); }
        }
        { const f32x4* xs = (const f32x4*)args.in[0]; const f32x4* cs = (const f32x4*)args.in[2]; f32x4* xd = (f32x4*)X;
          const size_t nl = (size_t)M_LAT * DM / 4, nc = (size_t)M_CTX * DM / 4, gt = (size_t)w.gw * 64 + w.lane, gn = (size_t)w.NGW * 64;
          for (size_t i = gt; i < nl; i += gn) xd[i] = xs[i];
          for (size_t i = gt; i < nc; i += gn) xd[nl + i] = cs[i]; }
    }
    SEAM(0);

    for (int l = 0; l < DEPTH; ++l) {
        const int base = 1 + 10 * l, j = l >> 1; const bool gla = (l & 1) != 0, last = (l == DEPTH - 1);
        const size_t mods_off = (size_t)l * 5 * NMOD;
        const int mrows = last ? M_LAT : M_ALL;
        if (RUN(base + 0)) { PHASE_ENTER(); const float* mods_l = MODS + mods_off; norm_rows(w, X, H, args.in[6] + l * DM, mods_l + 0 * DM, mods_l + 1 * DM, M_ALL); }
        SEAM(base + 0);
        if (RUN(base + 1)) {
            PHASE_ENTER();
            pg8::Gemm g{H, gla ? (const bf16*)(ws + WS_WGIN + j * WGIN_STRIDE) : (const bf16*)(ws + WS_WQKV + j * WQKV_STRIDE), M_ALL, gla ? NGLA_EXT : NQKV, DM};
            pg8::StaticOrder S; S.init(g.M, g.N, w.G, (int)blockIdx.x);
            pg8::EpiStoreBf16 E{P, gla ? NGLA : NQKV, gla ? NGLA : (1 << 30), Z1};
            pg8::gemm_phase<pg8::EpiStoreBf16, pg8::StaticOrder, true, true>(w.lds, g, S, E);
        }
        SEAM(base + 1);
        if (RUN(base + 2)) { if (!gla) { PHASE_ENTER(); rope_rows(w, P); } }
        if (!gla) SEAM(base + 2);
        if (RUN(base + 3)) {
            PHASE_ENTER();
            if (!gla) attn_naive(w, P, args.in[13] + j * 16, OMIX);
            else gla_naive(w, P, Z1, args.in[17] + (size_t)j * 16 * 1024, args.in[18] + j * 1024, args.in[20] + (size_t)j * 16 * 1024, args.in[21] + j * 1024, OF, OB);
        }
        SEAM(base + 3);
        if (RUN(base + 4)) { if (gla) { PHASE_ENTER(); gla_combine(w, OF, OB, P, args.in[22] + j * 512, OMIX, mrows); } }
        if (gla) SEAM(base + 4);
        if (RUN(base + 5)) {
            PHASE_ENTER();
            pg8::Gemm g{OMIX, gla ? (const bf16*)(ws + WS_WGO + j * WO_STRIDE) : (const bf16*)(ws + WS_WAO + j * WO_STRIDE), mrows, DM, DM};
            pg8::StaticOrder S; S.init(g.M, g.N, w.G, (int)blockIdx.x);
            pg8::EpiResid E{X, DM, MODS + mods_off + 2 * DM};
            pg8::gemm_phase<pg8::EpiResid, pg8::StaticOrder, true, true>(w.lds, g, S, E);
        }
        SEAM(base + 5);
        if (RUN(base + 6)) { PHASE_ENTER(); const float* mods_l = MODS + mods_off; norm_rows(w, X, H, args.in[7] + l * DM, mods_l + 3 * DM, mods_l + 4 * DM, mrows); }
        SEAM(base + 6);
        if (RUN(base + 7)) {
            PHASE_ENTER();
            pg8::Gemm g{H, (const bf16*)(ws + WS_WUP + l * WUP_STRIDE), mrows, DFF2, DM};
            pg8::StaticOrder S; S.init(g.M, g.N, w.G, (int)blockIdx.x);
            pg8::EpiStoreBf16 E{U, DFF2, 1 << 30, Z1};
            pg8::gemm_phase<pg8::EpiStoreBf16, pg8::StaticOrder, true, true>(w.lds, g, S, E);
        }
        SEAM(base + 7);
        if (RUN(base + 8)) { PHASE_ENTER(); conv_rows(w, U, args.in[9] + (size_t)l * 3 * DFF2, args.in[10] + (size_t)l * DFF2, ACT, mrows); }
        SEAM(base + 8);
        if (RUN(base + 9)) {
            PHASE_ENTER();
            pg8::Gemm g{ACT, (const bf16*)(ws + WS_WDN + l * WDN_STRIDE), mrows, DM, DFF};
            pg8::StaticOrder S; S.init(g.M, g.N, w.G, (int)blockIdx.x);
            pg8::EpiResid E{X, DM, MODS + mods_off + 5 * DM};
            pg8::gemm_phase<pg8::EpiResid, pg8::StaticOrder, true, true>(w.lds, g, S, E);
        }
        SEAM(base + 9);
    }
    if (RUN(41)) { PHASE_ENTER(); final_norm(w, X, args.out, args.in[24]); }
#undef RUN
#undef SEAM
}

extern "C" void kernel_launch(void* const* d_in, const int* in_sizes, int n_in, void* d_out, int out_size, void* d_ws, size_t ws_size, hipStream_t stream) {
    static int grid = 0;
    if (grid == 0) {
        if (n_in != 25 || out_size != M_LAT * DM || ws_size < WS_END) { fprintf(stderr, "kernel_launch: unexpected shapes (n_in %d, out %d, ws %zu < %zu); nothing launched\n", n_in, out_size, ws_size, (size_t)WS_END); grid = -1; return; }
        int dev = 0, cus = 0, per_cu = 0;
        if (hipGetDevice(&dev) != hipSuccess || hipDeviceGetAttribute(&cus, hipDeviceAttributeMultiprocessorCount, dev) != hipSuccess) { grid = -1; return; }
        if (hipFuncSetAttribute((const void*)mega, hipFuncAttributeMaxDynamicSharedMemorySize, LDS_BYTES) != hipSuccess) { fprintf(stderr, "kernel_launch: hipFuncSetAttribute failed\n"); grid = -1; return; }
        if (hipOccupancyMaxActiveBlocksPerMultiprocessor(&per_cu, (const void*)mega, 512, LDS_BYTES) != hipSuccess || per_cu < 1)
            fprintf(stderr, "kernel_launch: occupancy query reports %d workgroups per CU\n", per_cu);
        (void)hipGetLastError();
        grid = cus;
    }
    if (grid < 0) return;
    if (hipMemsetAsync((char*)d_ws + WS_CTL, 0, CTL_ZERO_BYTES, stream) != hipSuccess) return;
    Args a{};
    for (int i = 0; i < 25; ++i) a.in[i] = (const float*)d_in[i];
    a.out = (float*)d_out; a.ws = (unsigned char*)d_ws;
#if MK_ONE_LAUNCH
    a.ph_lo = 0; a.ph_hi = NPH;
    hipLaunchKernelGGL(mega, dim3(grid), dim3(512), LDS_BYTES, stream, a);
#else
    for (int ph = 0; ph < NPH; ++ph) {
        if (ph >= 1 && ph <= 40) { const int l = (ph - 1) / 10, s = (ph - 1) % 10; if ((s == 2 && (l & 1)) || (s == 4 && !(l & 1))) continue; }
        a.ph_lo = ph; a.ph_hi = ph + 1;
        hipLaunchKernelGGL(mega, dim3(grid), dim3(512), LDS_BYTES, stream, a);
    }
#endif
}
```

```cpp
#include <hip/hip_runtime.h>
#include <cstdio>
#include <cstdint>
namespace pg8 {
#define PG8_LAS __attribute__((address_space(3)))
typedef unsigned short bf16_t;
typedef short bf16x8 __attribute__((ext_vector_type(8)));
typedef float f32x4 __attribute__((ext_vector_type(4)));
typedef unsigned u32x4 __attribute__((ext_vector_type(4)));
constexpr int BM = 256, BK = 64, HALF = 128, HTB = HALF * BK * 2  , STAGE_BYTES = 8 * HTB, NXCD = 8, WGM = 8;

__host__ __device__ __forceinline__ int lds_byte(int r, int c) { const int st = (r >> 4) * 2 + (c >> 5), rr = r & 15, cc = c & 31, ob = rr * 64 + cc * 2; return st * 1024 + (ob ^ (((ob >> 9) & 1) << 5)); }
__host__ __device__ __forceinline__ void stage_rc(int b, int& R, int& C) { const int st = b / 1024, sb = b % 1024, swz = sb ^ (((sb >> 9) & 1) << 5); R = (st >> 1) * 16 + swz / 64; C = (st & 1) * 32 + (swz % 64) / 2; }
__host__ __device__ __forceinline__ int perm32(int rho) { const int n = rho >> 4, i = rho & 15; return 8 * (i >> 2) + 4 * n + (i & 3); }

struct Unit { int pm, pn; };
struct Gemm { const bf16_t* A; const bf16_t* Bt; int M, N, K; };

struct StaticOrder {
    int nM, nN, nwg, G, c;
    __host__ __device__ void init(int M, int N, int G_, int c_) { nM = M / BM; nN = N / BM; nwg = nM * nN; G = G_; c = c_; }
    __host__ __device__ bool next(int i, Unit& u) const {
        const long L = (long)i * G + c; if (L >= nwg) return false;
        int wgid = (int)L; { const int q = nwg / NXCD, r = nwg % NXCD, xcd = wgid % NXCD, off = wgid / NXCD; wgid = (xcd < r ? xcd * (q + 1) : r * (q + 1) + (xcd - r) * q) + off; }
        const int nig = WGM * nN, gid = wgid / nig, fm = gid * WGM, gsz = (nM - fm) < WGM ? (nM - fm) : WGM;
        u.pm = fm + ((wgid % nig) % gsz); u.pn = (wgid % nig) / gsz; return true;
    }
    __device__ __forceinline__ void a_ready(const Unit&) const {}
    __device__ __forceinline__ void done(const Unit&) const {}
};

__device__ __forceinline__ unsigned cvt_pk_bf16(float lo, float hi) { unsigned r; asm volatile("v_cvt_pk_bf16_f32 %0, %1, %2" : "=v"(r) : "v"(lo), "v"(hi)); return r; }
typedef float f32x2 __attribute__((ext_vector_type(2)));

struct EpiStoreBf16 {
    static constexpr bool PERM = true, AFTER_DRAIN = false;
    bf16_t* O; int ldc; int zcol0; float* Z;
    __device__ __forceinline__ void operator()(const f32x4 (&acc)[2][2][4][2], const Unit& u, int wr, int wc, int fr, int fq) const {
        const int row0 = u.pm * BM + wr * 64 + fr; const int colt = u.pn * BM;
        if (colt >= zcol0) {
            if (wc == 0) {
#pragma unroll
                for (int ai = 0; ai < 2; ++ai)
#pragma unroll
                    for (int m = 0; m < 4; ++m) { float* zp = Z + (size_t)(row0 + ai * HALF + m * 16) * 32 + 8 * fq;
                        *(f32x4*)(zp) = acc[ai][0][m][0]; *(f32x4*)(zp + 4) = acc[ai][0][m][1]; }
            }
            return;
        }
        const int col0 = colt + wc * 32 + 8 * fq;
#pragma unroll
        for (int ai = 0; ai < 2; ++ai)
#pragma unroll
            for (int m = 0; m < 4; ++m) { bf16_t* rowp = O + (size_t)(row0 + ai * HALF + m * 16) * ldc + col0;
#pragma unroll
                for (int bj = 0; bj < 2; ++bj) { const f32x4 v0 = acc[ai][bj][m][0], v1 = acc[ai][bj][m][1];
                    u32x4 w; w.x = cvt_pk_bf16(v0[0], v0[1]); w.y = cvt_pk_bf16(v0[2], v0[3]); w.z = cvt_pk_bf16(v1[0], v1[1]); w.w = cvt_pk_bf16(v1[2], v1[3]);
                    *(u32x4*)(rowp + bj * HALF) = w; } }
    }
};
struct EpiResid {
    static constexpr bool PERM = false, AFTER_DRAIN = false;
    float* X; int ldc; const float* gate;
    __device__ __forceinline__ void operator()(const f32x4 (&acc)[2][2][4][2], const Unit& u, int wr, int wc, int fr, int fq) const {
        const int row0 = u.pm * BM + wr * 64 + fr, col0 = u.pn * BM + wc * 32 + 4 * fq;
        const int vec = u.pm < 64 ? (u.pm >> 4) : 4;
        const float* g = gate + (size_t)vec * 12288 + col0;
        f32x4 gv[2][2];
#pragma unroll
        for (int bj = 0; bj < 2; ++bj)
#pragma unroll
            for (int n = 0; n < 2; ++n) gv[bj][n] = *(const f32x4*)(g + bj * HALF + n * 16);
#pragma unroll
        for (int ai = 0; ai < 2; ++ai)
#pragma unroll
            for (int m = 0; m < 4; ++m) { float* rowp = X + (size_t)(row0 + ai * HALF + m * 16) * ldc + col0;
#pragma unroll
                for (int bj = 0; bj < 2; ++bj)
#pragma unroll
                    for (int n = 0; n < 2; ++n) { float* p = rowp + bj * HALF + n * 16; *(f32x4*)p = *(const f32x4*)p + gv[bj][n] * acc[ai][bj][m][n]; } }
    }
};
template <class Epi, class Sched, bool ALIGN_EPI = false, bool SP2 = false>
__device__ __forceinline__ void gemm_phase(PG8_LAS unsigned char* lds, const Gemm g, const Sched& S, const Epi& E) {
    int tid_l = threadIdx.x; asm volatile("" : "+v"(tid_l));
    const int tid = tid_l, wid = __builtin_amdgcn_readfirstlane(tid >> 6), lane = tid & 63, wr = wid >> 2, wc = wid & 3, fr = lane & 15, fq = lane >> 4;
    const int K = g.K, nt = K / BK;
    unsigned voffA[2], voffB[2];
#pragma unroll
    for (int i = 0; i < 2; ++i) { int R, C; stage_rc(tid * 16 + i * 8192, R, C); const int Rb = Epi::PERM ? ((R & ~31) + perm32(R & 31)) : R;
        voffA[i] = (unsigned)(R * K + C) * 2u; voffB[i] = (unsigned)(Rb * K + C) * 2u; }
    const size_t kstep = (size_t)(BK * 2);
    const size_t hstep = (size_t)HALF * K * 2;
    const size_t tstep = 2 * hstep;
    const unsigned ldsw = (unsigned)wid * 1024u;
    const int aoff = lds_byte(wr * 64 + fr, fq * 8), boff = lds_byte(wc * 32 + fr, fq * 8);
#define PG8_SA(b, h) (((b) * 2 + (h)) * HTB)
#define PG8_SB(b, h) ((4 + (b) * 2 + (h)) * HTB)
#define PG8_STAGE(bufoff, gbase, voff) do { _Pragma("unroll") for (int _i = 0; _i < 2; ++_i) \
        __builtin_amdgcn_global_load_lds((const unsigned*)((const char*)(gbase) + (voff)[_i]), (PG8_LAS unsigned*)(lds + (bufoff) + ldsw + _i * 8192), 16, 0, 0); } while (0)
#define PG8_LDA(dst, b, h) do { _Pragma("unroll") for (int m = 0; m < 4; ++m) _Pragma("unroll") for (int k = 0; k < 2; ++k) dst[m][k] = *(const PG8_LAS bf16x8*)(lds + PG8_SA(b, h) + aoff + m * 2048 + k * 1024); } while (0)
#define PG8_LDB(dst, b, h) do { _Pragma("unroll") for (int n = 0; n < 2; ++n) _Pragma("unroll") for (int k = 0; k < 2; ++k) dst[n][k] = *(const PG8_LAS bf16x8*)(lds + PG8_SB(b, h) + boff + n * 2048 + k * 1024); } while (0)
#define PG8_MMA(ai, bj, At, Bt) do { __builtin_amdgcn_s_setprio(1); _Pragma("unroll") for (int m = 0; m < 4; ++m) _Pragma("unroll") for (int n = 0; n < 2; ++n) _Pragma("unroll") for (int k = 0; k < 2; ++k) \
        acc[ai][bj][m][n] = __builtin_amdgcn_mfma_f32_16x16x32_bf16(Bt[n][k], At[m][k], acc[ai][bj][m][n], 0, 0, 0); __builtin_amdgcn_s_setprio(0); } while (0)
#define PG8_WAIT_V(n) asm volatile("s_waitcnt vmcnt(" #n ")" ::: "memory")
#define PG8_WAIT_L(n) asm volatile("s_waitcnt lgkmcnt(" #n ")" ::: "memory")
#define PG8_BAR __builtin_amdgcn_s_barrier()
#define PG8_SCHED __builtin_amdgcn_sched_barrier(0)
    Unit cur, nxt; int ui = 0;
    if (!S.next(0, cur)) return;
    f32x4 acc[2][2][4][2];
#pragma unroll
    for (int a = 0; a < 2; ++a)
#pragma unroll
        for (int b = 0; b < 2; ++b)
#pragma unroll
            for (int m = 0; m < 4; ++m)
#pragma unroll
                for (int n = 0; n < 2; ++n) acc[a][b][m][n] = (f32x4){0.f, 0.f, 0.f, 0.f};
    bf16x8 At[4][2], B0[2][2], B1[2][2];
    const char* cA = (const char*)g.A + (size_t)cur.pm * tstep; const char* cB = (const char*)g.Bt + (size_t)cur.pn * tstep;
    S.a_ready(cur);
    if constexpr (SP2) {
        PG8_STAGE(PG8_SB(0, 0), cB, voffB); PG8_STAGE(PG8_SB(0, 1), cB + hstep, voffB); PG8_STAGE(PG8_SA(0, 0), cA, voffA); PG8_STAGE(PG8_SA(0, 1), cA + hstep, voffA);
        if (wr == 1) PG8_BAR;
        PG8_WAIT_V(2); PG8_BAR;
        PG8_STAGE(PG8_SB(1, 0), cB + kstep, voffB); PG8_STAGE(PG8_SA(1, 0), cA + kstep, voffA); PG8_STAGE(PG8_SB(1, 1), cB + hstep + kstep, voffB);
        PG8_WAIT_V(6); PG8_BAR;
    } else {
        PG8_STAGE(PG8_SB(0, 0), cB, voffB); PG8_STAGE(PG8_SA(0, 0), cA, voffA); PG8_STAGE(PG8_SB(0, 1), cB + hstep, voffB); PG8_STAGE(PG8_SA(0, 1), cA + hstep, voffA);
        if (wr == 1) PG8_BAR;
        PG8_WAIT_V(4); PG8_BAR;
        PG8_STAGE(PG8_SB(1, 0), cB + kstep, voffB); PG8_STAGE(PG8_SA(1, 0), cA + kstep, voffA); PG8_STAGE(PG8_SB(1, 1), cB + hstep + kstep, voffB);
        PG8_WAIT_V(6); PG8_BAR;
    }
    for (;;) {
        const bool has_next = S.next(ui + 1, nxt);
        const char* nA = has_next ? (const char*)g.A + (size_t)nxt.pm * tstep : cA; const char* nB = has_next ? (const char*)g.Bt + (size_t)nxt.pn * tstep : cB;
        for (int t = 0; t < nt; t += 2) {
            const bool last = (t == nt - 2);
            const char* a1 = cA + (size_t)(t + 1) * kstep;
            const char* a2 = last ? nA : cA + (size_t)(t + 2) * kstep; const char* b2 = last ? nB : cB + (size_t)(t + 2) * kstep;
            const char* a3 = a2 + kstep; const char* b3 = b2 + kstep;
            if (last && has_next) S.a_ready(nxt);
            if constexpr (SP2) {
            PG8_LDB(B0, 0, 0); PG8_LDB(B1, 0, 1); PG8_SCHED; PG8_LDA(At, 0, 0); PG8_STAGE(PG8_SA(1, 1), a1 + hstep, voffA);
            PG8_WAIT_V(8); PG8_WAIT_L(0); PG8_BAR; PG8_MMA(0, 0, At, B0); PG8_MMA(0, 1, At, B1); PG8_BAR; PG8_SCHED;
            PG8_LDA(At, 0, 1); PG8_STAGE(PG8_SB(0, 0), b2, voffB); PG8_STAGE(PG8_SB(0, 1), b2 + hstep, voffB); PG8_STAGE(PG8_SA(0, 0), a2, voffA);
            PG8_WAIT_V(8); PG8_WAIT_L(0); PG8_BAR; PG8_MMA(1, 0, At, B0); PG8_MMA(1, 1, At, B1); PG8_BAR; PG8_SCHED;
            PG8_LDB(B0, 1, 0); PG8_LDB(B1, 1, 1); PG8_SCHED; PG8_LDA(At, 1, 0); PG8_STAGE(PG8_SA(0, 1), a2 + hstep, voffA);
            PG8_WAIT_V(8); PG8_WAIT_L(0); PG8_BAR; PG8_MMA(0, 0, At, B0); PG8_MMA(0, 1, At, B1); PG8_BAR; PG8_SCHED;
            PG8_LDA(At, 1, 1); PG8_STAGE(PG8_SB(1, 0), b3, voffB); PG8_STAGE(PG8_SB(1, 1), b3 + hstep, voffB); PG8_STAGE(PG8_SA(1, 0), a3, voffA);
            PG8_WAIT_V(8); PG8_WAIT_L(0); PG8_BAR; PG8_MMA(1, 0, At, B0); PG8_MMA(1, 1, At, B1); PG8_BAR; PG8_SCHED;
            } else {
            PG8_LDB(B0, 0, 0); PG8_SCHED; PG8_LDA(At, 0, 0); PG8_STAGE(PG8_SA(1, 1), a1 + hstep, voffA);
            PG8_WAIT_L(8); PG8_BAR; PG8_WAIT_L(0); PG8_MMA(0, 0, At, B0); PG8_BAR; PG8_SCHED;
            PG8_LDB(B1, 0, 1); PG8_STAGE(PG8_SB(0, 0), b2, voffB);
            PG8_BAR; PG8_WAIT_L(0); PG8_MMA(0, 1, At, B1); PG8_BAR;
            PG8_LDA(At, 0, 1); PG8_STAGE(PG8_SA(0, 0), a2, voffA);
            PG8_BAR; PG8_WAIT_L(0); PG8_MMA(1, 0, At, B0); PG8_BAR; PG8_SCHED;
            PG8_STAGE(PG8_SB(0, 1), b2 + hstep, voffB);
            PG8_WAIT_V(6); PG8_BAR; PG8_MMA(1, 1, At, B1); PG8_BAR;
            PG8_LDB(B0, 1, 0); PG8_SCHED; PG8_LDA(At, 1, 0); PG8_STAGE(PG8_SA(0, 1), a2 + hstep, voffA);
            PG8_WAIT_L(8); PG8_BAR; PG8_WAIT_L(0); PG8_MMA(0, 0, At, B0); PG8_BAR; PG8_SCHED;
            PG8_LDB(B1, 1, 1); PG8_STAGE(PG8_SB(1, 0), b3, voffB);
            PG8_BAR; PG8_WAIT_L(0); PG8_MMA(0, 1, At, B1); PG8_BAR;
            PG8_LDA(At, 1, 1); PG8_STAGE(PG8_SA(1, 0), a3, voffA);
            PG8_BAR; PG8_WAIT_L(0); PG8_MMA(1, 0, At, B0); PG8_BAR; PG8_SCHED;
            PG8_STAGE(PG8_SB(1, 1), b3 + hstep, voffB);
            PG8_WAIT_V(6); PG8_BAR; PG8_MMA(1, 1, At, B1); PG8_BAR;
            }
        }
        if constexpr (ALIGN_EPI) { if (wr == 0) PG8_BAR; }
        if constexpr (!Epi::AFTER_DRAIN) { E(acc, cur, wr, wc, fr, fq); S.done(cur); }
        if (!has_next) break;
#pragma unroll
        for (int a = 0; a < 2; ++a)
#pragma unroll
            for (int b = 0; b < 2; ++b)
#pragma unroll
                for (int m = 0; m < 4; ++m)
#pragma unroll
                    for (int n = 0; n < 2; ++n) acc[a][b][m][n] = (f32x4){0.f, 0.f, 0.f, 0.f};
        cur = nxt; cA = nA; cB = nB; ++ui;
        if constexpr (ALIGN_EPI) { if (wr == 1) PG8_BAR; }
    }
    PG8_WAIT_V(0);
    if constexpr (!ALIGN_EPI) { if (wr == 0) PG8_BAR; }
    PG8_BAR;
    if constexpr (Epi::AFTER_DRAIN) { E.fused(acc, cur, wr, wc, fr, fq, lds, wid, lane); S.done(cur); }
#undef PG8_SA
#undef PG8_SB
#undef PG8_STAGE
#undef PG8_LDA
#undef PG8_LDB
#undef PG8_MMA
#undef PG8_WAIT_V
#undef PG8_WAIT_L
#undef PG8_BAR
#undef PG8_SCHED
}
}
#define LAS __attribute__((address_space(3)))
#define XB_TMO      128
#define XB_XCNT(j)  (256  + 64 * (j))
#define XB_XSUB(j)  (1280 + 64 * (j))
#define XB_XGEN(j)  (2304 + 64 * (j))
#define XB_TOP      3328
#define XB_TOPGEN   3392
#define XCD_BAR_WORDS 3456
#define XB_SPIN_CAP (1u << 18)

__device__ __forceinline__ unsigned xb_ld(unsigned* p)              { return __hip_atomic_load(p, __ATOMIC_RELAXED, __HIP_MEMORY_SCOPE_AGENT); }
__device__ __forceinline__ unsigned xb_add(unsigned* p, unsigned v) { return __hip_atomic_fetch_add(p, v, __ATOMIC_RELAXED, __HIP_MEMORY_SCOPE_AGENT); }
__device__ __forceinline__ unsigned xb_xcc_id() { return (unsigned)__builtin_amdgcn_s_getreg((3 << 11) | 20) & 0xFu; }
#define XB_SPIN(cond, bar) do { unsigned _sp = 0; while (cond) { __builtin_amdgcn_s_sleep(1); \
    if ((++_sp & 255u) == 0u) { if (xb_ld(&(bar)[XB_TMO])) break; if (_sp > XB_SPIN_CAP) { atomicAdd(&(bar)[XB_TMO], 1u); break; } } } } while (0)

struct XcdBarrier {
    unsigned* bar; unsigned x;
    volatile LAS unsigned* st;
};

__device__ __forceinline__ XcdBarrier xcd_barrier_post(unsigned* bar, volatile LAS unsigned* st) {
    XcdBarrier b; b.bar = bar; b.x = xb_xcc_id(); b.st = st;
    if (threadIdx.x == 0) (void)xb_add(&bar[XB_XCNT(b.x)], 1u);
    return b;
}
__device__ __forceinline__ void xcd_barrier_complete(unsigned* bar, unsigned x, unsigned& nloc, unsigned& nx) {
    const unsigned G = gridDim.x * gridDim.y * gridDim.z;
    unsigned sum, cnt, mine, sp = 0u;
    for (;;) {
        sum = 0u; cnt = 0u; mine = 0u;
#pragma unroll
        for (unsigned j = 0; j < 16; ++j) { const unsigned c = xb_ld(&bar[XB_XCNT(j)]); sum += c; cnt += (c > 0u) ? 1u : 0u; mine = (j == x) ? c : mine; }
        if (sum == G) break;
        __builtin_amdgcn_s_sleep(1);
        if ((++sp & 255u) == 0u) { if (xb_ld(&bar[XB_TMO])) break; if (sp > XB_SPIN_CAP) { atomicAdd(&bar[XB_TMO], 1u); break; } }
    }
    nloc = mine > 0u ? mine : 1u; nx = cnt > 0u ? cnt : 1u;
}

__device__ __forceinline__ void xcd_barrier(const XcdBarrier& b) {
    asm volatile("s_waitcnt vmcnt(0)" ::: "memory");
    __syncthreads();
    if (threadIdx.x == 0) {
        unsigned* bar = b.bar;
        __builtin_amdgcn_s_waitcnt(0);
        unsigned nloc = b.st[0], nx = b.st[1];
        if (nloc == 0u) { xcd_barrier_complete(bar, b.x, nloc, nx); b.st[0] = nloc; b.st[1] = nx; }
        const unsigned old = xb_add(&bar[XB_XSUB(b.x)], 1u);
        const unsigned gen = old / nloc;
        if (old + 1u == (gen + 1u) * nloc) {
            __builtin_amdgcn_fence(__ATOMIC_RELEASE, "agent");
            asm volatile("s_waitcnt vmcnt(0)" ::: "memory");
            const unsigned og = xb_add(&bar[XB_TOP], 1u);
            const unsigned tg = og / nx;
            if (og + 1u == (tg + 1u) * nx) xb_add(&bar[XB_TOPGEN], 1u);
            else XB_SPIN(xb_ld(&bar[XB_TOPGEN]) == tg, bar);
            __builtin_amdgcn_fence(__ATOMIC_ACQUIRE, "agent");
            xb_add(&bar[XB_XGEN(b.x)], 1u);
            asm volatile("s_waitcnt vmcnt(0)" ::: "memory");
        } else {
            XB_SPIN(xb_ld(&bar[XB_XGEN(b.x)]) == gen, bar);
            __builtin_amdgcn_fence(__ATOMIC_ACQUIRE, "agent");
            asm volatile("s_waitcnt vmcnt(0)" ::: "memory");
        }
    }
    __syncthreads();
}

constexpr int DM = 2048, NB = 4, SEQ = 4096, CTXL = 256, DEPTH = 4;
constexpr int M_LAT = NB * SEQ, M_CTX = NB * CTXL, M_ALL = M_LAT + M_CTX;
constexpr int DFF = 5632, DFF2 = 2 * DFF, NQKV = 3072, NGLA = 6144, NGLA_EXT = 6400, NMOD = 6 * DM;
constexpr float EPS = 1e-6f;
#ifndef MK_ONE_LAUNCH
#define MK_ONE_LAUNCH 1
#endif
#ifndef NAIVE_ATTN
#define NAIVE_ATTN 1
#endif
#ifndef NAIVE_GLA
#define NAIVE_GLA 0
#endif
constexpr int NPH = 42;

constexpr size_t MiB = 1u << 20;
constexpr size_t WS_CTL = 0, CTL_ZERO_BYTES = 1 * MiB;
constexpr size_t WS_MODS = 1 * MiB;
constexpr size_t WS_X = 2 * MiB;
constexpr size_t WS_H = 138 * MiB;
constexpr size_t WS_P = 206 * MiB;
constexpr size_t WS_Z1 = 410 * MiB;
constexpr size_t WS_OMIX = 413 * MiB;
constexpr size_t WS_U = 481 * MiB;
constexpr size_t WS_OF = WS_U, WS_OB = WS_U + 136 * MiB;
constexpr size_t WS_QT = WS_U;
constexpr size_t WS_KHT = WS_U + 68 * MiB;
constexpr size_t WS_AIN = WS_U + 136 * MiB;
constexpr size_t WS_DEC = WS_U + 153 * MiB;
constexpr size_t WS_VT = WS_U + 156 * MiB;
constexpr size_t WS_OFB = WS_U + 224 * MiB, WS_OBB = WS_U + 292 * MiB;
constexpr size_t WS_ACT = 855 * MiB;
constexpr size_t WS_WUP = 1042 * MiB, WUP_STRIDE = 44 * MiB;
constexpr size_t WS_WDN = 1218 * MiB, WDN_STRIDE = 22 * MiB;
constexpr size_t WS_WQKV = 1306 * MiB, WQKV_STRIDE = 12 * MiB;
constexpr size_t WS_WAO = 1330 * MiB, WO_STRIDE = 8 * MiB;
constexpr size_t WS_WGIN = 1346 * MiB, WGIN_STRIDE = 25 * MiB;
constexpr size_t WS_WGO = 1396 * MiB;
constexpr size_t WS_END = 1412 * MiB;
constexpr int CW_BAR = 4096;

constexpr int RING_BYTES = 131072, LDSCTL_OFF = RING_BYTES, LDS_BYTES = 147456;

#define GAS __attribute__((address_space(1)))
#define LAS __attribute__((address_space(3)))
typedef unsigned short bf16;
typedef unsigned v4u __attribute__((ext_vector_type(4)));
typedef unsigned v2u __attribute__((ext_vector_type(2)));
typedef float f32x4 __attribute__((ext_vector_type(4)));
#define LDS_WAIT() asm volatile("s_waitcnt lgkmcnt(0)" ::: "memory")
__device__ __forceinline__ unsigned f2bf(float f) { unsigned u = __builtin_bit_cast(unsigned, f); return (u + 0x7fffu + ((u >> 16) & 1u)) >> 16; }
__device__ __forceinline__ unsigned pk2(float lo, float hi) { return f2bf(lo) | (f2bf(hi) << 16); }
__device__ __forceinline__ float bf_lo(unsigned w) { return __builtin_bit_cast(float, w << 16); }
__device__ __forceinline__ float bf_hi(unsigned w) { return __builtin_bit_cast(float, w & 0xffff0000u); }
__device__ __forceinline__ float bf2f(bf16 h) { return __builtin_bit_cast(float, ((unsigned)h) << 16); }
__device__ __forceinline__ float silu_f(float v) { return v / (1.0f + __expf(-v)); }
__device__ __forceinline__ float wave_sum(float v) {
#pragma unroll
    for (int o = 1; o < 64; o <<= 1) v += __shfl_xor(v, o);
    return v;
}

struct Args { const float* in[25]; float* out; unsigned char* ws; int ph_lo, ph_hi; };
struct WV { int tid, lane, wave, G, vcu, gw, NGW; LAS unsigned char* lds; };

__device__ __forceinline__ void p0_transpose_item(const float* W, int K, int N, bf16* WT, int row_off, LAS float* scr, int item, int lane) {
    const int nblk = N / 32, kb = item / nblk, nb = item % nblk, k0 = 64 * kb, n0 = 32 * nb;
#pragma unroll 8
    for (int i = 0; i < 32; ++i) { const int kk = 2 * i + (lane >> 5); scr[kk * 33 + (lane & 31)] = W[(size_t)(k0 + kk) * N + n0 + (lane & 31)]; }
    LDS_WAIT(); asm volatile("" ::: "memory");
    const int c = lane & 7;
#pragma unroll
    for (int j = 0; j < 4; ++j) { const int n = (lane >> 3) + 8 * j; const LAS float* s = scr + (8 * c) * 33 + n;
        v4u o; o.x = pk2(s[0 * 33], s[1 * 33]); o.y = pk2(s[2 * 33], s[3 * 33]); o.z = pk2(s[4 * 33], s[5 * 33]); o.w = pk2(s[6 * 33], s[7 * 33]);
        *(v4u*)(WT + (size_t)(row_off + n0 + n) * K + k0 + 8 * c) = o; }
    LDS_WAIT(); asm volatile("" ::: "memory");
}
__device__ __forceinline__ void transpose_matrix(const WV& w, const float* W, int K, int N, bf16* WT, int row_off) {
    LAS float* scr = (LAS float*)(w.lds + w.wave * 16384);
    const int nitems = (K / 64) * (N / 32);
    for (int it = w.gw; it < nitems; it += w.NGW) p0_transpose_item(W, K, N, WT, row_off, scr, it, w.lane);
}
__device__ __forceinline__ void mods_item(const WV& w, const float* c, const float* c_ctx, const float* ada_w, const float* ada_b, float* mods, int it) {
    const int layer = it / 48, n0 = (it % 48) * 256;
    LAS float* sl = (LAS float*)w.lds;
    LAS float* red = (LAS float*)(w.lds + 40960);
    for (int i = w.tid; i < 5 * DM; i += 512) { const int vec = i >> 11, k = i & 2047; const float v = vec < 4 ? c[vec * DM + k] : c_ctx[k]; sl[i] = silu_f(v); }
    __syncthreads();
    const float* Wp = ada_w + (size_t)layer * DM * NMOD + n0 + 4 * w.lane;
    f32x4 acc[5];
#pragma unroll
    for (int v = 0; v < 5; ++v) acc[v] = (f32x4){0.f, 0.f, 0.f, 0.f};
    const int kbeg = w.wave * 256;
    for (int k = kbeg; k < kbeg + 256; k += 4) {
        f32x4 wv[4];
#pragma unroll
        for (int kk = 0; kk < 4; ++kk) wv[kk] = *(const f32x4*)(Wp + (size_t)(k + kk) * NMOD);
#pragma unroll
        for (int kk = 0; kk < 4; ++kk)
#pragma unroll
            for (int v = 0; v < 5; ++v) acc[v] += wv[kk] * sl[v * DM + k + kk];
    }
#pragma unroll
    for (int v = 0; v < 5; ++v) *(LAS f32x4*)(red + (w.wave * 5 + v) * 256 + 4 * w.lane) = acc[v];
    __syncthreads();
    for (int i = w.tid; i < 5 * 256; i += 512) { const int vec = i >> 8, col = i & 255; float s = 0.f;
#pragma unroll
        for (int ww = 0; ww < 8; ++ww) s += red[(ww * 5 + vec) * 256 + col];
        mods[((size_t)layer * 5 + vec) * NMOD + n0 + col] = s + ada_b[(size_t)layer * NMOD + n0 + col]; }
    __syncthreads();
}

__device__ __forceinline__ void norm_rows(const WV& w, const float* X, bf16* H, const float* g, const float* shift, const float* scale, int nrows) {
    for (int row = w.gw; row < nrows; row += w.NGW) {
        const int vec = row < M_LAT ? (row >> 12) : 4;
        const f32x4* xr = (const f32x4*)(X + (size_t)row * DM) + w.lane;
        f32x4 v[8]; float ss = 0.f;
#pragma unroll
        for (int j = 0; j < 8; ++j) { v[j] = xr[64 * j]; ss += (v[j].x * v[j].x + v[j].y * v[j].y) + (v[j].z * v[j].z + v[j].w * v[j].w); }
        const float r = 1.0f / sqrtf(wave_sum(ss) * (1.0f / DM) + EPS);
        const float* sh = shift + (size_t)vec * NMOD; const float* sc = scale + (size_t)vec * NMOD;
        v2u* o8 = (v2u*)(H + (size_t)row * DM) + w.lane;
#pragma unroll
        for (int j = 0; j < 8; ++j) { const int col = 4 * (64 * j + w.lane);
            const f32x4 gv = *(const f32x4*)(g + col), s = *(const f32x4*)(sc + col), t = *(const f32x4*)(sh + col);
            const f32x4 y = v[j] * r * gv * (s + 1.0f) + t;
            v2u o; o.x = pk2(y.x, y.y); o.y = pk2(y.z, y.w); o8[64 * j] = o; }
    }
}
__device__ __forceinline__ void final_norm(const WV& w, const float* X, float* out, const float* g) {
    for (int row = w.gw; row < M_LAT; row += w.NGW) {
        const f32x4* xr = (const f32x4*)(X + (size_t)row * DM) + w.lane;
        f32x4 v[8]; float ss = 0.f;
#pragma unroll
        for (int j = 0; j < 8; ++j) { v[j] = xr[64 * j]; ss += (v[j].x * v[j].x + v[j].y * v[j].y) + (v[j].z * v[j].z + v[j].w * v[j].w); }
        const float r = 1.0f / sqrtf(wave_sum(ss) * (1.0f / DM) + EPS);
        f32x4* o = (f32x4*)(out + (size_t)row * DM) + w.lane;
#pragma unroll
        for (int j = 0; j < 8; ++j) { const int col = 4 * (64 * j + w.lane); o[64 * j] = v[j] * r * *(const f32x4*)(g + col); }
    }
}

__device__ __forceinline__ void rope_rows(const WV& w, bf16* P) {
    const int half = w.lane >> 5, f = w.lane & 31;
    const float inv = exp2f(-(float)(2 * f) * (13.287712379549449f / 64.0f));
    for (int row = w.gw; row < M_LAT; row += w.NGW) {
        const int t = row & (SEQ - 1); const int pos = half ? (t & 63) : (t >> 6);
        const float ang = (float)pos * inv; const float c = __cosf(ang), s = __sinf(ang);
        bf16* p = P + (size_t)row * NQKV + half * 64 + f;
#pragma unroll 4
        for (int hh = 0; hh < 20; ++hh) { const float x1 = bf2f(p[hh * 128]), x2 = bf2f(p[hh * 128 + 32]);
            p[hh * 128] = (bf16)f2bf(x1 * c - x2 * s); p[hh * 128 + 32] = (bf16)f2bf(x2 * c + x1 * s); }
    }
}

__device__ __forceinline__ void attn_naive(const WV& w, const bf16* P, const float* sink, bf16* O) {
    const int g = w.lane >> 4, li = w.lane & 15;
    const float scale = 0.08838834764831845f;
    for (int task = w.gw; task < M_ALL * 16; task += w.NGW) {
        const int row = task >> 4, hq = task & 15, kvh = hq >> 2;
        float q[8];
        { const v4u qq = *(const v4u*)(P + (size_t)row * NQKV + hq * 128 + 8 * li);
          q[0] = bf_lo(qq.x) * scale; q[1] = bf_hi(qq.x) * scale; q[2] = bf_lo(qq.y) * scale; q[3] = bf_hi(qq.y) * scale;
          q[4] = bf_lo(qq.z) * scale; q[5] = bf_hi(qq.z) * scale; q[6] = bf_lo(qq.w) * scale; q[7] = bf_hi(qq.w) * scale; }
        int b, wbase = 0, nwin = 0;
        if (row < M_LAT) { b = row >> 12; const int t = row & (SEQ - 1); const int j0 = t - 128 < 0 ? 0 : t - 128, j1 = t + 128 > SEQ - 1 ? SEQ - 1 : t + 128; wbase = b * SEQ + j0; nwin = j1 - j0 + 1; }
        else b = (row - M_LAT) >> 8;
        const int cbase = M_LAT + b * CTXL, nk = nwin + CTXL;
        float m = sink[hq], l = (g == 0) ? 1.0f : 0.0f, o[8];
#pragma unroll
        for (int d = 0; d < 8; ++d) o[d] = 0.f;
        for (int i = g; i < nk; i += 4) {
            const int krow = i < nwin ? wbase + i : cbase + (i - nwin);
            const bf16* kp = P + (size_t)krow * NQKV + 2048 + kvh * 128 + 8 * li;
            const v4u kk = *(const v4u*)kp, vv = *(const v4u*)(kp + 512);
            float s = q[0] * bf_lo(kk.x) + q[1] * bf_hi(kk.x) + q[2] * bf_lo(kk.y) + q[3] * bf_hi(kk.y) + q[4] * bf_lo(kk.z) + q[5] * bf_hi(kk.z) + q[6] * bf_lo(kk.w) + q[7] * bf_hi(kk.w);
            s += __shfl_xor(s, 1); s += __shfl_xor(s, 2); s += __shfl_xor(s, 4); s += __shfl_xor(s, 8);
            const float mn = fmaxf(m, s), a = __expf(m - mn), p = __expf(s - mn);
            l = l * a + p; m = mn;
            o[0] = o[0] * a + p * bf_lo(vv.x); o[1] = o[1] * a + p * bf_hi(vv.x); o[2] = o[2] * a + p * bf_lo(vv.y); o[3] = o[3] * a + p * bf_hi(vv.y);
            o[4] = o[4] * a + p * bf_lo(vv.z); o[5] = o[5] * a + p * bf_hi(vv.z); o[6] = o[6] * a + p * bf_lo(vv.w); o[7] = o[7] * a + p * bf_hi(vv.w);
        }
        float ma = fmaxf(m, __shfl_xor(m, 16)); ma = fmaxf(ma, __shfl_xor(ma, 32));
        const float fsc = __expf(m - ma); l *= fsc; l += __shfl_xor(l, 16); l += __shfl_xor(l, 32);
        const float rl = 1.0f / l;
#pragma unroll
        for (int d = 0; d < 8; ++d) { float x = o[d] * fsc; x += __shfl_xor(x, 16); x += __shfl_xor(x, 32); o[d] = x * rl; }
        if (g == 0) { v4u ov; ov.x = pk2(o[0], o[1]); ov.y = pk2(o[2], o[3]); ov.z = pk2(o[4], o[5]); ov.w = pk2(o[6], o[7]);
            *(v4u*)(O + (size_t)row * DM + hq * 128 + 8 * li) = ov; }
    }
}

__device__ __forceinline__ void gla_naive(const WV& w, const bf16* P, const float* Z1, const float* w2f, const float* bf, const float* w2b, const float* bb, float* OF, float* OB) {
    LAS float* buf = (LAS float*)w.lds;
    const int vc = w.tid >> 2, dq = w.tid & 3;
    for (int it = w.vcu; it < 128; it += w.G) {
        const int vs = it & 3, dir = (it >> 2) & 1, h = (it >> 3) & 3, b = it >> 5;
        const float* w2 = dir ? w2b : w2f; const float* bias = dir ? bb : bf; float* OUT = dir ? OB : OF;
        float w2c[16], bz = 0.f;
        if (w.tid < 256) { bz = bias[h * 256 + w.tid];
#pragma unroll
            for (int r = 0; r < 16; ++r) w2c[r] = w2[r * 1024 + h * 256 + w.tid]; }
        else {
#pragma unroll
            for (int r = 0; r < 16; ++r) w2c[r] = 0.f; }
        float S[64];
#pragma unroll
        for (int i = 0; i < 64; ++i) S[i] = 0.f;
        const int cbase = M_LAT + b * CTXL, lbase = b * SEQ;
#define GLA_ROW(step) ((step) < CTXL ? (dir ? cbase + CTXL - 1 - (step) : cbase + (step)) : (dir ? lbase + SEQ - 1 - ((step) - CTXL) : lbase + ((step) - CTXL)))
#define GLA_FILL(step, par) do { if (w.tid < 256) { const int r_ = GLA_ROW(step); const float* z_ = Z1 + (size_t)r_ * 32 + dir * 16; float zz = bz; \
            _Pragma("unroll") for (int r = 0; r < 16; ++r) zz += z_[r] * w2c[r]; \
            const float ls_ = fminf(zz, 0.f) - log1pf(__expf(-fabsf(zz))); \
            LAS float* bp_ = buf + (par) * 768; bp_[w.tid] = __expf(ls_ * (1.0f / 16.0f)); \
            bp_[256 + w.tid] = bf2f(P[(size_t)r_ * NGLA + 1024 + h * 256 + w.tid]); bp_[512 + w.tid] = bf2f(P[(size_t)r_ * NGLA + h * 256 + w.tid]) * 0.0625f; } } while (0)
        __syncthreads();
        GLA_FILL(0, 0);
        __syncthreads();
        for (int step = 0; step < CTXL + SEQ; ++step) {
            const int row = GLA_ROW(step);
            if (step + 1 < CTXL + SEQ) GLA_FILL(step + 1, (step + 1) & 1);
            const float v = bf2f(P[(size_t)row * NGLA + 2048 + h * 512 + vs * 128 + vc]);
            const LAS float* bp = buf + (step & 1) * 768 + 64 * dq;
            float acc = 0.f;
#pragma unroll
            for (int i = 0; i < 64; i += 4) {
                const f32x4 e4 = *(const LAS f32x4*)(bp + i), k4 = *(const LAS f32x4*)(bp + 256 + i), q4 = *(const LAS f32x4*)(bp + 512 + i);
                S[i] = S[i] * e4.x + k4.x * v; acc += q4.x * S[i];
                S[i + 1] = S[i + 1] * e4.y + k4.y * v; acc += q4.y * S[i + 1];
                S[i + 2] = S[i + 2] * e4.z + k4.z * v; acc += q4.z * S[i + 2];
                S[i + 3] = S[i + 3] * e4.w + k4.w * v; acc += q4.w * S[i + 3];
            }
            acc += __shfl_xor(acc, 1); acc += __shfl_xor(acc, 2);
            if (dq == 0) OUT[(size_t)row * DM + h * 512 + vs * 128 + vc] = acc;
            __syncthreads();
        }
#undef GLA_ROW
#undef GLA_FILL
    }
}
__device__ __forceinline__ void gla_combine(const WV& w, const float* OF, const float* OB, const bf16* P, const float* og, bf16* O, int nrows) {
    for (int task = w.gw; task < nrows * 4; task += w.NGW) {
        const int row = task >> 2, h = task & 3; const size_t off = (size_t)row * DM + h * 512 + 8 * w.lane;
        const f32x4 a0 = *(const f32x4*)(OF + off), a1 = *(const f32x4*)(OF + off + 4), b0 = *(const f32x4*)(OB + off), b1 = *(const f32x4*)(OB + off + 4);
        const f32x4 o0 = a0 + b0, o1 = a1 + b1;
        float ss = (o0.x * o0.x + o0.y * o0.y) + (o0.z * o0.z + o0.w * o0.w) + (o1.x * o1.x + o1.y * o1.y) + (o1.z * o1.z + o1.w * o1.w);
        const float r = 1.0f / sqrtf(wave_sum(ss) * (1.0f / 512.0f) + EPS);
        const f32x4 g0 = *(const f32x4*)(og + 8 * w.lane), g1 = *(const f32x4*)(og + 8 * w.lane + 4);
        const v4u rr = *(const v4u*)(P + (size_t)row * NGLA + 4096 + h * 512 + 8 * w.lane);
        v4u ov;
        ov.x = pk2(o0.x * r * g0.x * silu_f(bf_lo(rr.x)), o0.y * r * g0.y * silu_f(bf_hi(rr.x)));
        ov.y = pk2(o0.z * r * g0.z * silu_f(bf_lo(rr.y)), o0.w * r * g0.w * silu_f(bf_hi(rr.y)));
        ov.z = pk2(o1.x * r * g1.x * silu_f(bf_lo(rr.z)), o1.y * r * g1.y * silu_f(bf_hi(rr.z)));
        ov.w = pk2(o1.z * r * g1.z * silu_f(bf_lo(rr.w)), o1.w * r * g1.w * silu_f(bf_hi(rr.w)));
        *(v4u*)(O + off) = ov;
    }
}
__device__ __forceinline__ void unpack8(const v4u a, float (&x)[8]) { x[0] = bf_lo(a.x); x[1] = bf_hi(a.x); x[2] = bf_lo(a.y); x[3] = bf_hi(a.y); x[4] = bf_lo(a.z); x[5] = bf_hi(a.z); x[6] = bf_lo(a.w); x[7] = bf_hi(a.w); }

typedef short bf16x8 __attribute__((ext_vector_type(8)));
typedef float f32x16 __attribute__((ext_vector_type(16)));
__device__ __forceinline__ int gla_row(int b, int cc, int i) { return cc < 64 ? b * SEQ + cc * 64 + i : M_LAT + b * CTXL + (cc - 64) * 64 + i; }
__device__ __forceinline__ void gla_pre(const WV& w, const bf16* P, const float* Z1, const float* w2f, const float* bf_, const float* w2b, const float* bb_, bf16* QT, bf16* KHT, bf16* AIN, float* DEC) {
    LAS float* z1s = (LAS float*)w.lds;
    LAS float* tot = (LAS float*)(w.lds + 4096);
    LAS bf16* qs = (LAS bf16*)(w.lds + 8192);
    LAS bf16* ks = (LAS bf16*)(w.lds + 8192 + 33792);
    const int d = w.tid & 255, hf = w.tid >> 8;
    for (int it = w.vcu; it < 2 * 4 * 4 * 68; it += w.G) {
        const int dir = it & 1, h = (it >> 1) & 3, b = (it >> 3) & 3, cc = it >> 5;
        const size_t item = ((size_t)(dir * 4 + b) * 4 + h) * 68 + cc;
        const float* w2 = dir ? w2b : w2f; const float bias = (dir ? bb_ : bf_)[h * 256 + d];
        float w2c[16];
#pragma unroll
        for (int r = 0; r < 16; ++r) w2c[r] = w2[r * 1024 + h * 256 + d];
        const int row0 = gla_row(b, cc, 0);
        for (int idx = w.tid; idx < 1024; idx += 512) z1s[idx] = Z1[(size_t)(row0 + (idx >> 4)) * 32 + dir * 16 + (idx & 15)];
        __syncthreads();
        float g[32];
#pragma unroll
        for (int ii = 0; ii < 32; ++ii) { const LAS f32x4* zp = (const LAS f32x4*)(z1s + (32 * hf + ii) * 16); float zz = bias;
#pragma unroll
            for (int q4 = 0; q4 < 4; ++q4) { const f32x4 z = zp[q4]; zz += z.x * w2c[4 * q4] + z.y * w2c[4 * q4 + 1] + z.z * w2c[4 * q4 + 2] + z.w * w2c[4 * q4 + 3]; }
            g[ii] = (fminf(zz, 0.f) - log1pf(__expf(-fabsf(zz)))) * 0.0625f; }
        float run = 0.f;
        if (!dir) {
#pragma unroll
            for (int ii = 0; ii < 32; ++ii) { run += g[ii]; g[ii] = run; } }
        else {
#pragma unroll
            for (int ii = 31; ii >= 0; --ii) { run += g[ii]; g[ii] = run; } }
        tot[hf * 256 + d] = run;
        __syncthreads();
        const float t0 = tot[d], t1 = tot[256 + d], blast = t0 + t1;
        const float off = dir ? (hf == 0 ? t1 : 0.f) : (hf == 1 ? t0 : 0.f);
        unsigned khat[16];
#pragma unroll
        for (int ii = 0; ii < 32; ++ii) { const int i = 32 * hf + ii; const size_t row = (size_t)(row0 + i); const float bbv = g[ii] + off;
            const float qv = bf2f(P[row * NGLA + h * 256 + d]) * 0.0625f, kv = bf2f(P[row * NGLA + 1024 + h * 256 + d]);
            const unsigned qt = f2bf(qv * __expf(bbv)), kt = f2bf(kv * __expf(-bbv)), kh = f2bf(kv * __expf(blast - bbv));
            QT[((size_t)dir * M_ALL + row) * 1024 + h * 256 + d] = (bf16)qt; qs[i * 264 + d] = (bf16)qt; ks[i * 264 + d] = (bf16)kt;
            if (ii & 1) khat[ii >> 1] |= kh << 16; else khat[ii >> 1] = kh; }
        { v4u* kp = (v4u*)(KHT + (item * 256 + d) * 64 + 32 * hf);
#pragma unroll
          for (int q4 = 0; q4 < 4; ++q4) kp[q4] = (v4u){khat[4 * q4], khat[4 * q4 + 1], khat[4 * q4 + 2], khat[4 * q4 + 3]}; }
        if (hf == 0) DEC[item * 256 + d] = __expf(blast);
        __syncthreads();
        { const int rb = w.wave >> 1, ch = w.wave & 1, c16 = w.lane & 15, kg = w.lane >> 4;
          f32x4 acc[2]; acc[0] = (f32x4){0.f, 0.f, 0.f, 0.f}; acc[1] = acc[0];
#pragma unroll
          for (int k8 = 0; k8 < 8; ++k8) { const bf16x8 a = *(const LAS bf16x8*)(qs + (rb * 16 + c16) * 264 + 32 * k8 + 8 * kg);
#pragma unroll
              for (int n = 0; n < 2; ++n) { const bf16x8 bq = *(const LAS bf16x8*)(ks + ((2 * ch + n) * 16 + c16) * 264 + 32 * k8 + 8 * kg); acc[n] = __builtin_amdgcn_mfma_f32_16x16x32_bf16(a, bq, acc[n], 0, 0, 0); } }
#pragma unroll
          for (int n = 0; n < 2; ++n)
#pragma unroll
              for (int r = 0; r < 4; ++r) { const int i = rb * 16 + 4 * kg + r, jj = (2 * ch + n) * 16 + c16; const bool keep = dir ? (jj >= i) : (jj <= i);
                  AIN[(item * 64 + i) * 64 + jj] = (bf16)f2bf(keep ? acc[n][r] : 0.f); } }
        __syncthreads();
    }
}
__device__ __forceinline__ void gla_vt(const WV& w, const bf16* P, bf16* VT) {
    LAS bf16* vt = (LAS bf16*)w.lds;
    for (int it = w.vcu; it < 4 * 4 * 68; it += w.G) {
        const int cc = it % 68, bh = it / 68, h = bh & 3, b = bh >> 2;
        const int row0 = gla_row(b, cc, 0);
#pragma unroll
        for (int rr = 0; rr < 8; ++rr) { const int i = rr * 8 + (w.tid >> 6), piece = w.tid & 63;
            *(LAS v4u*)(vt + i * 520 + 8 * piece) = *(const v4u*)(P + (size_t)(row0 + i) * NGLA + 2048 + h * 512 + 8 * piece); }
        __syncthreads();
        const int dv = w.tid;
#pragma unroll
        for (int grp = 0; grp < 8; ++grp) { unsigned u[8];
#pragma unroll
            for (int e = 0; e < 8; ++e) u[e] = vt[(8 * grp + e) * 520 + dv];
            *(v4u*)(VT + ((size_t)it * 512 + dv) * 64 + 8 * grp) = (v4u){u[0] | (u[1] << 16), u[2] | (u[3] << 16), u[4] | (u[5] << 16), u[6] | (u[7] << 16)}; }
        __syncthreads();
    }
}
__device__ __forceinline__ void gla_scan(const WV& w, const bf16* QT, const bf16* KHT, const bf16* AIN, const float* DEC, const bf16* VT, bf16* OFB, bf16* OBB) {
    LAS bf16* ST = (LAS bf16*)w.lds;
    const int wv = w.wave, r32 = w.lane & 31, hh = w.lane >> 5, c16 = w.lane & 15, kg = w.lane >> 4, tb = wv >> 1, dh = wv & 1;
    for (int it = w.vcu; it < 256; it += w.G) {
        const int vs = it & 7, dir = (it >> 3) & 1, h = (it >> 4) & 3, b = it >> 6;
        bf16* O = dir ? OBB : OFB;
        f32x16 S[2];
#pragma unroll
        for (int n = 0; n < 2; ++n)
#pragma unroll
            for (int r = 0; r < 16; ++r) S[n][r] = 0.f;
        for (int s = 0; s < 68; ++s) {
            const int cc = s < 4 ? (dir ? 67 - s : 64 + s) : (dir ? 67 - s : s - 4);
            const size_t item = ((size_t)(dir * 4 + b) * 4 + h) * 68 + cc, vitem = ((size_t)b * 4 + h) * 68 + cc;
            const int row0 = gla_row(b, cc, 0);
            LAS bf16* st = ST + (s & 1) * (64 * 264);
#pragma unroll
            for (int n = 0; n < 2; ++n)
#pragma unroll
                for (int g4 = 0; g4 < 4; ++g4) { v2u pk; pk.x = pk2(S[n][4 * g4], S[n][4 * g4 + 1]); pk.y = pk2(S[n][4 * g4 + 2], S[n][4 * g4 + 3]);
                    *(LAS v2u*)(st + (32 * n + r32) * 264 + 32 * wv + 8 * g4 + 4 * hh) = pk; }
            bf16x8 qa[8], aa[2], vb16[2][2], ka[4], vb32[2][4]; float dec[16];
            { const bf16* qrow = QT + ((size_t)dir * M_ALL + row0 + tb * 16 + c16) * 1024 + h * 256 + 8 * kg;
#pragma unroll
              for (int k8 = 0; k8 < 8; ++k8) qa[k8] = *(const bf16x8*)(qrow + 32 * k8);
              const bf16* arow = AIN + (item * 64 + tb * 16 + c16) * 64 + 8 * kg; aa[0] = *(const bf16x8*)arow; aa[1] = *(const bf16x8*)(arow + 32);
              const bf16* v16 = VT + (vitem * 512 + vs * 64 + 32 * dh + c16) * 64 + 8 * kg;
#pragma unroll
              for (int n = 0; n < 2; ++n) { vb16[n][0] = *(const bf16x8*)(v16 + n * 16 * 64); vb16[n][1] = *(const bf16x8*)(v16 + n * 16 * 64 + 32); }
              const bf16* krow = KHT + (item * 256 + 32 * wv + r32) * 64 + 8 * hh;
#pragma unroll
              for (int k4 = 0; k4 < 4; ++k4) ka[k4] = *(const bf16x8*)(krow + 16 * k4);
              const bf16* v32 = VT + (vitem * 512 + vs * 64 + r32) * 64 + 8 * hh;
#pragma unroll
              for (int n = 0; n < 2; ++n)
#pragma unroll
                  for (int k4 = 0; k4 < 4; ++k4) vb32[n][k4] = *(const bf16x8*)(v32 + n * 32 * 64 + 16 * k4);
              const float* dp = DEC + item * 256 + 32 * wv + 4 * hh;
#pragma unroll
              for (int r = 0; r < 16; ++r) dec[r] = dp[(r & 3) + 8 * (r >> 2)]; }
            __syncthreads();
            f32x4 oacc[2]; oacc[0] = (f32x4){0.f, 0.f, 0.f, 0.f}; oacc[1] = oacc[0];
#pragma unroll
            for (int k8 = 0; k8 < 8; ++k8)
#pragma unroll
                for (int n = 0; n < 2; ++n) { const bf16x8 sb = *(const LAS bf16x8*)(st + (32 * dh + 16 * n + c16) * 264 + 32 * k8 + 8 * kg); oacc[n] = __builtin_amdgcn_mfma_f32_16x16x32_bf16(qa[k8], sb, oacc[n], 0, 0, 0); }
#pragma unroll
            for (int k2 = 0; k2 < 2; ++k2)
#pragma unroll
                for (int n = 0; n < 2; ++n) oacc[n] = __builtin_amdgcn_mfma_f32_16x16x32_bf16(aa[k2], vb16[n][k2], oacc[n], 0, 0, 0);
#pragma unroll
            for (int n = 0; n < 2; ++n)
#pragma unroll
                for (int r = 0; r < 4; ++r) O[(size_t)(row0 + tb * 16 + 4 * kg + r) * DM + h * 512 + vs * 64 + 32 * dh + 16 * n + c16] = (bf16)f2bf(oacc[n][r]);
#pragma unroll
            for (int n = 0; n < 2; ++n) {
#pragma unroll
                for (int r = 0; r < 16; ++r) S[n][r] *= dec[r];
#pragma unroll
                for (int k4 = 0; k4 < 4; ++k4) S[n] = __builtin_amdgcn_mfma_f32_32x32x16_bf16(ka[k4], vb32[n][k4], S[n], 0, 0, 0); }
        }
        __syncthreads();
    }
}
__device__ __forceinline__ void gla_combine_bf(const WV& w, const bf16* OFB, const bf16* OBB, const bf16* P, const float* og, bf16* O, int nrows) {
    for (int task = w.gw; task < nrows * 4; task += w.NGW) {
        const int row = task >> 2, h = task & 3; const size_t off = (size_t)row * DM + h * 512 + 8 * w.lane;
        float a[8], c[8], o[8], rv[8]; unpack8(*(const v4u*)(OFB + off), a); unpack8(*(const v4u*)(OBB + off), c);
        float ss = 0.f;
#pragma unroll
        for (int e = 0; e < 8; ++e) { o[e] = a[e] + c[e]; ss += o[e] * o[e]; }
        const float r = 1.0f / sqrtf(wave_sum(ss) * (1.0f / 512.0f) + EPS);
        const f32x4 g0 = *(const f32x4*)(og + 8 * w.lane), g1 = *(const f32x4*)(og + 8 * w.lane + 4);
        const float gg[8] = {g0.x, g0.y, g0.z, g0.w, g1.x, g1.y, g1.z, g1.w};
        unpack8(*(const v4u*)(P + (size_t)row * NGLA + 4096 + h * 512 + 8 * w.lane), rv);
#pragma unroll
        for (int e = 0; e < 8; ++e) o[e] = o[e] * r * gg[e] * silu_f(rv[e]);
        *(v4u*)(O + off) = (v4u){pk2(o[0], o[1]), pk2(o[2], o[3]), pk2(o[4], o[5]), pk2(o[6], o[7])};
    }
}

__device__ __forceinline__ void conv_rows(const WV& w, const bf16* U, const float* cw, const float* cb, bf16* ACT, int nrows) {
    const int nseg = nrows / 32;
    for (int wi = w.gw; wi < nseg * 11; wi += w.NGW) {
        const int seg = wi / 11, cg = wi % 11, r0 = seg * 32, f = (cg * 64 + w.lane) * 8;
        float wg[3][8], wv[3][8], bg[8], bv[8];
#pragma unroll
        for (int j = 0; j < 3; ++j)
#pragma unroll
            for (int e = 0; e < 8; ++e) { wg[j][e] = cw[j * DFF2 + f + e]; wv[j][e] = cw[j * DFF2 + DFF + f + e]; }
#pragma unroll
        for (int e = 0; e < 8; ++e) { bg[e] = cb[f + e]; bv[e] = cb[DFF + f + e]; }
        const bool s_start = r0 < M_LAT ? ((r0 & (SEQ - 1)) == 0) : (((r0 - M_LAT) & (CTXL - 1)) == 0);
        const bool s_end = r0 < M_LAT ? (((r0 + 32) & (SEQ - 1)) == 0) : (((r0 + 32 - M_LAT) & (CTXL - 1)) == 0);
        const v4u zero4 = (v4u){0u, 0u, 0u, 0u};
        v4u pg = s_start ? zero4 : *(const v4u*)(U + (size_t)(r0 - 1) * DFF2 + f), pv = s_start ? zero4 : *(const v4u*)(U + (size_t)(r0 - 1) * DFF2 + DFF + f);
        v4u cg4 = *(const v4u*)(U + (size_t)r0 * DFF2 + f), cv4 = *(const v4u*)(U + (size_t)r0 * DFF2 + DFF + f);
        for (int r = 0; r < 32; ++r) {
            const bool nz = (r == 31) && s_end;
            const v4u ng = nz ? zero4 : *(const v4u*)(U + (size_t)(r0 + r + 1) * DFF2 + f), nv = nz ? zero4 : *(const v4u*)(U + (size_t)(r0 + r + 1) * DFF2 + DFF + f);
            float a[8], c[8], n[8], gate[8], val[8];
            unpack8(pg, a); unpack8(cg4, c); unpack8(ng, n);
#pragma unroll
            for (int e = 0; e < 8; ++e) gate[e] = bg[e] + wg[0][e] * a[e] + wg[1][e] * c[e] + wg[2][e] * n[e];
            unpack8(pv, a); unpack8(cv4, c); unpack8(nv, n);
#pragma unroll
            for (int e = 0; e < 8; ++e) val[e] = bv[e] + wv[0][e] * a[e] + wv[1][e] * c[e] + wv[2][e] * n[e];
            v4u ov; ov.x = pk2(silu_f(gate[0]) * val[0], silu_f(gate[1]) * val[1]); ov.y = pk2(silu_f(gate[2]) * val[2], silu_f(gate[3]) * val[3]);
            ov.z = pk2(silu_f(gate[4]) * val[4], silu_f(gate[5]) * val[5]); ov.w = pk2(silu_f(gate[6]) * val[6], silu_f(gate[7]) * val[7]);
            *(v4u*)(ACT + (size_t)(r0 + r) * DFF + f) = ov;
            pg = cg4; pv = cv4; cg4 = ng; cv4 = nv;
        }
    }
}

__global__ void __launch_bounds__(512, 2) mega(Args args) {
    extern __shared__ __attribute__((aligned(16))) unsigned char lds_raw[];
    LAS unsigned char* const lds0 = (LAS unsigned char*)lds_raw;
    for (int u = threadIdx.x; u < (LDS_BYTES - LDSCTL_OFF) / 4; u += 512) ((LAS unsigned*)(lds0 + LDSCTL_OFF))[u] = 0u;
    __syncthreads();
    XcdBarrier bar; bar.bar = (unsigned*)(args.ws + WS_CTL) + CW_BAR; bar.x = 0; bar.st = nullptr;
    if (MK_ONE_LAUNCH) bar = xcd_barrier_post((unsigned*)(args.ws + WS_CTL) + CW_BAR, (volatile LAS unsigned*)(lds0 + LDSCTL_OFF + 32));
#define PHASE_ENTER() int tid_l = threadIdx.x; asm volatile("" : "+v"(tid_l)); unsigned char* ws = args.ws; asm volatile("" : "+s"(ws)); WV w; w.lds = lds0; w.tid = tid_l; w.lane = tid_l & 63; \
    w.wave = __builtin_amdgcn_readfirstlane(tid_l >> 6); w.G = gridDim.x; { const int bx = blockIdx.x; w.vcu = (w.G % 8 == 0) ? (bx % 8) * (w.G / 8) + bx / 8 : bx; } w.gw = w.vcu * 8 + w.wave; w.NGW = w.G * 8; \
    float* X = (float*)(ws + WS_X); bf16* H = (bf16*)(ws + WS_H); bf16* P = (bf16*)(ws + WS_P); float* Z1 = (float*)(ws + WS_Z1); bf16* OMIX = (bf16*)(ws + WS_OMIX); bf16* U = (bf16*)(ws + WS_U); \
    bf16* ACT = (bf16*)(ws + WS_ACT); float* MODS = (float*)(ws + WS_MODS); float* OF = (float*)(ws + WS_OF); float* OB = (float*)(ws + WS_OB); \
    (void)X; (void)H; (void)P; (void)Z1; (void)OMIX; (void)U; (void)ACT; (void)MODS; (void)OF; (void)OB; (void)w
    const int lo = args.ph_lo, hi = args.ph_hi;
#define RUN(k) (lo <= (k) && (k) < hi)
#define SEAM(k) do { if (MK_ONE_LAUNCH && RUN(k) && RUN((k) + 1)) xcd_barrier(bar); } while (0)

    if (RUN(0)) {
        PHASE_ENTER();
        for (int it = w.vcu; it < 4 * 48; it += w.G) mods_item(w, args.in[1], args.in[3], args.in[4], args.in[5], MODS, it);
        for (int l = 0; l < DEPTH; ++l) {
            transpose_matrix(w, args.in[8] + (size_t)l * DM * DFF2, DM, DFF2, (bf16*)(ws + WS_WUP + l * WUP_STRIDE), 0);
            transpose_matrix(w, args.in[11] + (size_t)l * DFF * DM, DFF, DM, (bf16*)(ws + WS_WDN + l * WDN_STRIDE), 0);
        }
        for (int j = 0; j < 2; ++j) {
            transpose_matrix(w, args.in[12] + (size_t)j * DM * NQKV, DM, NQKV, (bf16*)(ws + WS_WQKV + j * WQKV_STRIDE), 0);
            transpose_matrix(w, args.in[14] + (size_t)j * DM * DM, DM, DM, (bf16*)(ws + WS_WAO + j * WO_STRIDE), 0);
            transpose_matrix(w, args.in[15] + (size_t)j * DM * NGLA, DM, NGLA, (bf16*)(ws + WS_WGIN + j * WGIN_STRIDE), 0);
            transpose_matrix(w, args.in[23] + (size_t)j * DM * DM, DM, DM, (bf16*)(ws + WS_WGO + j * WO_STRIDE), 0);
            bf16* wg = (bf16*)(ws + WS_WGIN + j * WGIN_STRIDE) + (size_t)NGLA * DM;
            const float* f1 = args.in[16] + (size_t)j * DM * 16; const float* b1 = args.in[19] + (size_t)j * DM * 16;
            for (int idx = w.gw * 64 + w.lane; idx < 256 * DM; idx += w.NGW * 64) { const int n = idx >> 11, k = idx & 2047;
                const float v = n < 16 ? f1[k * 16 + n] : (n < 32 ? b1[k * 16 + (n - 16)] : 0.f); wg[idx] = (bf16)f2bf(v); }
        }
        { const f32x4* xs = (const f32x4*)args.in[0]; const f32x4* cs = (const f32x4*)args.in[2]; f32x4* xd = (f32x4*)X;
          const size_t nl = (size_t)M_LAT * DM / 4, nc = (size_t)M_CTX * DM / 4, gt = (size_t)w.gw * 64 + w.lane, gn = (size_t)w.NGW * 64;
          for (size_t i = gt; i < nl; i += gn) xd[i] = xs[i];
          for (size_t i = gt; i < nc; i += gn) xd[nl + i] = cs[i]; }
    }
    SEAM(0);

    for (int l = 0; l < DEPTH; ++l) {
        const int base = 1 + 10 * l, j = l >> 1; const bool gla = (l & 1) != 0, last = (l == DEPTH - 1);
        const size_t mods_off = (size_t)l * 5 * NMOD;
        const int mrows = last ? M_LAT : M_ALL;
        if (RUN(base + 0)) { PHASE_ENTER(); const float* mods_l = MODS + mods_off; norm_rows(w, X, H, args.in[6] + l * DM, mods_l + 0 * DM, mods_l + 1 * DM, M_ALL); }
        SEAM(base + 0);
        if (RUN(base + 1)) {
            PHASE_ENTER();
            pg8::Gemm g{H, gla ? (const bf16*)(ws + WS_WGIN + j * WGIN_STRIDE) : (const bf16*)(ws + WS_WQKV + j * WQKV_STRIDE), M_ALL, gla ? NGLA_EXT : NQKV, DM};
            pg8::StaticOrder S; S.init(g.M, g.N, w.G, (int)blockIdx.x);
            pg8::EpiStoreBf16 E{P, gla ? NGLA : NQKV, gla ? NGLA : (1 << 30), Z1};
            pg8::gemm_phase<pg8::EpiStoreBf16, pg8::StaticOrder, true, true>(w.lds, g, S, E);
        }
        SEAM(base + 1);
        if (RUN(base + 2)) {
            PHASE_ENTER();
            if (!gla) rope_rows(w, P);
#if !NAIVE_GLA
            else { gla_pre(w, P, Z1, args.in[17] + (size_t)j * 16 * 1024, args.in[18] + j * 1024, args.in[20] + (size_t)j * 16 * 1024, args.in[21] + j * 1024,
                           (bf16*)(ws + WS_QT), (bf16*)(ws + WS_KHT), (bf16*)(ws + WS_AIN), (float*)(ws + WS_DEC));
                   gla_vt(w, P, (bf16*)(ws + WS_VT)); }
#endif
        }
        if (!gla || !NAIVE_GLA) SEAM(base + 2);
        if (RUN(base + 3)) {
            PHASE_ENTER();
            if (!gla) attn_naive(w, P, args.in[13] + j * 16, OMIX);
#if NAIVE_GLA
            else gla_naive(w, P, Z1, args.in[17] + (size_t)j * 16 * 1024, args.in[18] + j * 1024, args.in[20] + (size_t)j * 16 * 1024, args.in[21] + j * 1024, OF, OB);
#else
            else gla_scan(w, (const bf16*)(ws + WS_QT), (const bf16*)(ws + WS_KHT), (const bf16*)(ws + WS_AIN), (const float*)(ws + WS_DEC), (const bf16*)(ws + WS_VT), (bf16*)(ws + WS_OFB), (bf16*)(ws + WS_OBB));
#endif
        }
        SEAM(base + 3);
#if NAIVE_GLA
        if (RUN(base + 4)) { if (gla) { PHASE_ENTER(); gla_combine(w, OF, OB, P, args.in[22] + j * 512, OMIX, mrows); } }
#else
        if (RUN(base + 4)) { if (gla) { PHASE_ENTER(); gla_combine_bf(w, (const bf16*)(ws + WS_OFB), (const bf16*)(ws + WS_OBB), P, args.in[22] + j * 512, OMIX, mrows); } }
#endif
        if (gla) SEAM(base + 4);
        if (RUN(base + 5)) {
            PHASE_ENTER();
            pg8::Gemm g{OMIX, gla ? (const bf16*)(ws + WS_WGO + j * WO_STRIDE) : (const bf16*)(ws + WS_WAO + j * WO_STRIDE), mrows, DM, DM};
            pg8::StaticOrder S; S.init(g.M, g.N, w.G, (int)blockIdx.x);
            pg8::EpiResid E{X, DM, MODS + mods_off + 2 * DM};
            pg8::gemm_phase<pg8::EpiResid, pg8::StaticOrder, true, true>(w.lds, g, S, E);
        }
        SEAM(base + 5);
        if (RUN(base + 6)) { PHASE_ENTER(); const float* mods_l = MODS + mods_off; norm_rows(w, X, H, args.in[7] + l * DM, mods_l + 3 * DM, mods_l + 4 * DM, mrows); }
        SEAM(base + 6);
        if (RUN(base + 7)) {
            PHASE_ENTER();
            pg8::Gemm g{H, (const bf16*)(ws + WS_WUP + l * WUP_STRIDE), mrows, DFF2, DM};
            pg8::StaticOrder S; S.init(g.M, g.N, w.G, (int)blockIdx.x);
            pg8::EpiStoreBf16 E{U, DFF2, 1 << 30, Z1};
            pg8::gemm_phase<pg8::EpiStoreBf16, pg8::StaticOrder, true, true>(w.lds, g, S, E);
        }
        SEAM(base + 7);
        if (RUN(base + 8)) { PHASE_ENTER(); conv_rows(w, U, args.in[9] + (size_t)l * 3 * DFF2, args.in[10] + (size_t)l * DFF2, ACT, mrows); }
        SEAM(base + 8);
        if (RUN(base + 9)) {
            PHASE_ENTER();
            pg8::Gemm g{ACT, (const bf16*)(ws + WS_WDN + l * WDN_STRIDE), mrows, DM, DFF};
            pg8::StaticOrder S; S.init(g.M, g.N, w.G, (int)blockIdx.x);
            pg8::EpiResid E{X, DM, MODS + mods_off + 5 * DM};
            pg8::gemm_phase<pg8::EpiResid, pg8::StaticOrder, true, true>(w.lds, g, S, E);
        }
        SEAM(base + 9);
    }
    if (RUN(41)) { PHASE_ENTER(); final_norm(w, X, args.out, args.in[24]); }
#undef RUN
#undef SEAM
}

extern "C" void kernel_launch(void* const* d_in, const int* in_sizes, int n_in, void* d_out, int out_size, void* d_ws, size_t ws_size, hipStream_t stream) {
    static int grid = 0;
    if (grid == 0) {
        if (n_in != 25 || out_size != M_LAT * DM || ws_size < WS_END) { fprintf(stderr, "kernel_launch: unexpected shapes (n_in %d, out %d, ws %zu < %zu); nothing launched\n", n_in, out_size, ws_size, (size_t)WS_END); grid = -1; return; }
        int dev = 0, cus = 0, per_cu = 0;
        if (hipGetDevice(&dev) != hipSuccess || hipDeviceGetAttribute(&cus, hipDeviceAttributeMultiprocessorCount, dev) != hipSuccess) { grid = -1; return; }
        if (hipFuncSetAttribute((const void*)mega, hipFuncAttributeMaxDynamicSharedMemorySize, LDS_BYTES) != hipSuccess) { fprintf(stderr, "kernel_launch: hipFuncSetAttribute failed\n"); grid = -1; return; }
        if (hipOccupancyMaxActiveBlocksPerMultiprocessor(&per_cu, (const void*)mega, 512, LDS_BYTES) != hipSuccess || per_cu < 1)
            fprintf(stderr, "kernel_launch: occupancy query reports %d workgroups per CU\n", per_cu);
        (void)hipGetLastError();
        grid = cus;
    }
    if (grid < 0) return;
    if (hipMemsetAsync((char*)d_ws + WS_CTL, 0, CTL_ZERO_BYTES, stream) != hipSuccess) return;
    Args a{};
    for (int i = 0; i < 25; ++i) a.in[i] = (const float*)d_in[i];
    a.out = (float*)d_out; a.ws = (unsigned char*)d_ws;
#if MK_ONE_LAUNCH
    a.ph_lo = 0; a.ph_hi = NPH;
    hipLaunchKernelGGL(mega, dim3(grid), dim3(512), LDS_BYTES, stream, a);
#else
    for (int ph = 0; ph < NPH; ++ph) {
        if (ph >= 1 && ph <= 40) { const int l = (ph - 1) / 10, s = (ph - 1) % 10; if ((s == 2 && (l & 1) && NAIVE_GLA) || (s == 4 && !(l & 1))) continue; }
        a.ph_lo = ph; a.ph_hi = ph + 1;
        hipLaunchKernelGGL(mega, dim3(grid), dim3(512), LDS_BYTES, stream, a);
    }
#endif
}
```

```cpp
#include <hip/hip_runtime.h>
#include <cstdio>
#include <cstdint>
namespace pg8 {
#define PG8_LAS __attribute__((address_space(3)))
typedef unsigned short bf16_t;
typedef short bf16x8 __attribute__((ext_vector_type(8)));
typedef float f32x4 __attribute__((ext_vector_type(4)));
typedef unsigned u32x4 __attribute__((ext_vector_type(4)));
constexpr int BM = 256, BK = 64, HALF = 128, HTB = HALF * BK * 2  , STAGE_BYTES = 8 * HTB, NXCD = 8, WGM = 8;

__host__ __device__ __forceinline__ int lds_byte(int r, int c) { const int st = (r >> 4) * 2 + (c >> 5), rr = r & 15, cc = c & 31, ob = rr * 64 + cc * 2; return st * 1024 + (ob ^ (((ob >> 9) & 1) << 5)); }
__host__ __device__ __forceinline__ void stage_rc(int b, int& R, int& C) { const int st = b / 1024, sb = b % 1024, swz = sb ^ (((sb >> 9) & 1) << 5); R = (st >> 1) * 16 + swz / 64; C = (st & 1) * 32 + (swz % 64) / 2; }
__host__ __device__ __forceinline__ int perm32(int rho) { const int n = rho >> 4, i = rho & 15; return 8 * (i >> 2) + 4 * n + (i & 3); }

struct Unit { int pm, pn; };
struct Gemm { const bf16_t* A; const bf16_t* Bt; int M, N, K; };

struct StaticOrder {
    int nM, nN, nwg, G, c;
    __host__ __device__ void init(int M, int N, int G_, int c_) { nM = M / BM; nN = N / BM; nwg = nM * nN; G = G_; c = c_; }
    __host__ __device__ bool next(int i, Unit& u) const {
        const long L = (long)i * G + c; if (L >= nwg) return false;
        int wgid = (int)L; { const int q = nwg / NXCD, r = nwg % NXCD, xcd = wgid % NXCD, off = wgid / NXCD; wgid = (xcd < r ? xcd * (q + 1) : r * (q + 1) + (xcd - r) * q) + off; }
        const int nig = WGM * nN, gid = wgid / nig, fm = gid * WGM, gsz = (nM - fm) < WGM ? (nM - fm) : WGM;
        u.pm = fm + ((wgid % nig) % gsz); u.pn = (wgid % nig) / gsz; return true;
    }
    __device__ __forceinline__ void a_ready(const Unit&) const {}
    __device__ __forceinline__ void done(const Unit&) const {}
};

__device__ __forceinline__ unsigned cvt_pk_bf16(float lo, float hi) { unsigned r; asm volatile("v_cvt_pk_bf16_f32 %0, %1, %2" : "=v"(r) : "v"(lo), "v"(hi)); return r; }
typedef float f32x2 __attribute__((ext_vector_type(2)));

struct EpiStoreBf16 {
    static constexpr bool PERM = true, AFTER_DRAIN = false;
    bf16_t* O; int ldc; int zcol0; float* Z;
    __device__ __forceinline__ void operator()(const f32x4 (&acc)[2][2][4][2], const Unit& u, int wr, int wc, int fr, int fq) const {
        const int row0 = u.pm * BM + wr * 64 + fr; const int colt = u.pn * BM;
        if (colt >= zcol0) {
            if (wc == 0) {
#pragma unroll
                for (int ai = 0; ai < 2; ++ai)
#pragma unroll
                    for (int m = 0; m < 4; ++m) { float* zp = Z + (size_t)(row0 + ai * HALF + m * 16) * 32 + 8 * fq;
                        *(f32x4*)(zp) = acc[ai][0][m][0]; *(f32x4*)(zp + 4) = acc[ai][0][m][1]; }
            }
            return;
        }
        const int col0 = colt + wc * 32 + 8 * fq;
#pragma unroll
        for (int ai = 0; ai < 2; ++ai)
#pragma unroll
            for (int m = 0; m < 4; ++m) { bf16_t* rowp = O + (size_t)(row0 + ai * HALF + m * 16) * ldc + col0;
#pragma unroll
                for (int bj = 0; bj < 2; ++bj) { const f32x4 v0 = acc[ai][bj][m][0], v1 = acc[ai][bj][m][1];
                    u32x4 w; w.x = cvt_pk_bf16(v0[0], v0[1]); w.y = cvt_pk_bf16(v0[2], v0[3]); w.z = cvt_pk_bf16(v1[0], v1[1]); w.w = cvt_pk_bf16(v1[2], v1[3]);
                    *(u32x4*)(rowp + bj * HALF) = w; } }
    }
};
struct EpiResid {
    static constexpr bool PERM = false, AFTER_DRAIN = false;
    float* X; int ldc; const float* gate;
    __device__ __forceinline__ void operator()(const f32x4 (&acc)[2][2][4][2], const Unit& u, int wr, int wc, int fr, int fq) const {
        const int row0 = u.pm * BM + wr * 64 + fr, col0 = u.pn * BM + wc * 32 + 4 * fq;
        const int vec = u.pm < 64 ? (u.pm >> 4) : 4;
        const float* g = gate + (size_t)vec * 12288 + col0;
        f32x4 gv[2][2];
#pragma unroll
        for (int bj = 0; bj < 2; ++bj)
#pragma unroll
            for (int n = 0; n < 2; ++n) gv[bj][n] = *(const f32x4*)(g + bj * HALF + n * 16);
#pragma unroll
        for (int ai = 0; ai < 2; ++ai)
#pragma unroll
            for (int m = 0; m < 4; ++m) { float* rowp = X + (size_t)(row0 + ai * HALF + m * 16) * ldc + col0;
#pragma unroll
                for (int bj = 0; bj < 2; ++bj)
#pragma unroll
                    for (int n = 0; n < 2; ++n) { float* p = rowp + bj * HALF + n * 16; *(f32x4*)p = *(const f32x4*)p + gv[bj][n] * acc[ai][bj][m][n]; } }
    }
};
template <class Epi, class Sched, bool ALIGN_EPI = false, bool SP2 = false>
__device__ __forceinline__ void gemm_phase(PG8_LAS unsigned char* lds, const Gemm g, const Sched& S, const Epi& E) {
    int tid_l = threadIdx.x; asm volatile("" : "+v"(tid_l));
    const int tid = tid_l, wid = __builtin_amdgcn_readfirstlane(tid >> 6), lane = tid & 63, wr = wid >> 2, wc = wid & 3, fr = lane & 15, fq = lane >> 4;
    const int K = g.K, nt = K / BK;
    unsigned voffA[2], voffB[2];
#pragma unroll
    for (int i = 0; i < 2; ++i) { int R, C; stage_rc(tid * 16 + i * 8192, R, C); const int Rb = Epi::PERM ? ((R & ~31) + perm32(R & 31)) : R;
        voffA[i] = (unsigned)(R * K + C) * 2u; voffB[i] = (unsigned)(Rb * K + C) * 2u; }
    const size_t kstep = (size_t)(BK * 2);
    const size_t hstep = (size_t)HALF * K * 2;
    const size_t tstep = 2 * hstep;
    const unsigned ldsw = (unsigned)wid * 1024u;
    const int aoff = lds_byte(wr * 64 + fr, fq * 8), boff = lds_byte(wc * 32 + fr, fq * 8);
#define PG8_SA(b, h) (((b) * 2 + (h)) * HTB)
#define PG8_SB(b, h) ((4 + (b) * 2 + (h)) * HTB)
#define PG8_STAGE(bufoff, gbase, voff) do { _Pragma("unroll") for (int _i = 0; _i < 2; ++_i) \
        __builtin_amdgcn_global_load_lds((const unsigned*)((const char*)(gbase) + (voff)[_i]), (PG8_LAS unsigned*)(lds + (bufoff) + ldsw + _i * 8192), 16, 0, 0); } while (0)
#define PG8_LDA(dst, b, h) do { _Pragma("unroll") for (int m = 0; m < 4; ++m) _Pragma("unroll") for (int k = 0; k < 2; ++k) dst[m][k] = *(const PG8_LAS bf16x8*)(lds + PG8_SA(b, h) + aoff + m * 2048 + k * 1024); } while (0)
#define PG8_LDB(dst, b, h) do { _Pragma("unroll") for (int n = 0; n < 2; ++n) _Pragma("unroll") for (int k = 0; k < 2; ++k) dst[n][k] = *(const PG8_LAS bf16x8*)(lds + PG8_SB(b, h) + boff + n * 2048 + k * 1024); } while (0)
#define PG8_MMA(ai, bj, At, Bt) do { __builtin_amdgcn_s_setprio(1); _Pragma("unroll") for (int m = 0; m < 4; ++m) _Pragma("unroll") for (int n = 0; n < 2; ++n) _Pragma("unroll") for (int k = 0; k < 2; ++k) \
        acc[ai][bj][m][n] = __builtin_amdgcn_mfma_f32_16x16x32_bf16(Bt[n][k], At[m][k], acc[ai][bj][m][n], 0, 0, 0); __builtin_amdgcn_s_setprio(0); } while (0)
#define PG8_WAIT_V(n) asm volatile("s_waitcnt vmcnt(" #n ")" ::: "memory")
#define PG8_WAIT_L(n) asm volatile("s_waitcnt lgkmcnt(" #n ")" ::: "memory")
#define PG8_BAR __builtin_amdgcn_s_barrier()
#define PG8_SCHED __builtin_amdgcn_sched_barrier(0)
    Unit cur, nxt; int ui = 0;
    if (!S.next(0, cur)) return;
    f32x4 acc[2][2][4][2];
#pragma unroll
    for (int a = 0; a < 2; ++a)
#pragma unroll
        for (int b = 0; b < 2; ++b)
#pragma unroll
            for (int m = 0; m < 4; ++m)
#pragma unroll
                for (int n = 0; n < 2; ++n) acc[a][b][m][n] = (f32x4){0.f, 0.f, 0.f, 0.f};
    bf16x8 At[4][2], B0[2][2], B1[2][2];
    const char* cA = (const char*)g.A + (size_t)cur.pm * tstep; const char* cB = (const char*)g.Bt + (size_t)cur.pn * tstep;
    S.a_ready(cur);
    if constexpr (SP2) {
        PG8_STAGE(PG8_SB(0, 0), cB, voffB); PG8_STAGE(PG8_SB(0, 1), cB + hstep, voffB); PG8_STAGE(PG8_SA(0, 0), cA, voffA); PG8_STAGE(PG8_SA(0, 1), cA + hstep, voffA);
        if (wr == 1) PG8_BAR;
        PG8_WAIT_V(2); PG8_BAR;
        PG8_STAGE(PG8_SB(1, 0), cB + kstep, voffB); PG8_STAGE(PG8_SA(1, 0), cA + kstep, voffA); PG8_STAGE(PG8_SB(1, 1), cB + hstep + kstep, voffB);
        PG8_WAIT_V(6); PG8_BAR;
    } else {
        PG8_STAGE(PG8_SB(0, 0), cB, voffB); PG8_STAGE(PG8_SA(0, 0), cA, voffA); PG8_STAGE(PG8_SB(0, 1), cB + hstep, voffB); PG8_STAGE(PG8_SA(0, 1), cA + hstep, voffA);
        if (wr == 1) PG8_BAR;
        PG8_WAIT_V(4); PG8_BAR;
        PG8_STAGE(PG8_SB(1, 0), cB + kstep, voffB); PG8_STAGE(PG8_SA(1, 0), cA + kstep, voffA); PG8_STAGE(PG8_SB(1, 1), cB + hstep + kstep, voffB);
        PG8_WAIT_V(6); PG8_BAR;
    }
    for (;;) {
        const bool has_next = S.next(ui + 1, nxt);
        const char* nA = has_next ? (const char*)g.A + (size_t)nxt.pm * tstep : cA; const char* nB = has_next ? (const char*)g.Bt + (size_t)nxt.pn * tstep : cB;
        for (int t = 0; t < nt; t += 2) {
            const bool last = (t == nt - 2);
            const char* a1 = cA + (size_t)(t + 1) * kstep;
            const char* a2 = last ? nA : cA + (size_t)(t + 2) * kstep; const char* b2 = last ? nB : cB + (size_t)(t + 2) * kstep;
            const char* a3 = a2 + kstep; const char* b3 = b2 + kstep;
            if (last && has_next) S.a_ready(nxt);
            if constexpr (SP2) {
            PG8_LDB(B0, 0, 0); PG8_LDB(B1, 0, 1); PG8_SCHED; PG8_LDA(At, 0, 0); PG8_STAGE(PG8_SA(1, 1), a1 + hstep, voffA);
            PG8_WAIT_V(8); PG8_WAIT_L(0); PG8_BAR; PG8_MMA(0, 0, At, B0); PG8_MMA(0, 1, At, B1); PG8_BAR; PG8_SCHED;
            PG8_LDA(At, 0, 1); PG8_STAGE(PG8_SB(0, 0), b2, voffB); PG8_STAGE(PG8_SB(0, 1), b2 + hstep, voffB); PG8_STAGE(PG8_SA(0, 0), a2, voffA);
            PG8_WAIT_V(8); PG8_WAIT_L(0); PG8_BAR; PG8_MMA(1, 0, At, B0); PG8_MMA(1, 1, At, B1); PG8_BAR; PG8_SCHED;
            PG8_LDB(B0, 1, 0); PG8_LDB(B1, 1, 1); PG8_SCHED; PG8_LDA(At, 1, 0); PG8_STAGE(PG8_SA(0, 1), a2 + hstep, voffA);
            PG8_WAIT_V(8); PG8_WAIT_L(0); PG8_BAR; PG8_MMA(0, 0, At, B0); PG8_MMA(0, 1, At, B1); PG8_BAR; PG8_SCHED;
            PG8_LDA(At, 1, 1); PG8_STAGE(PG8_SB(1, 0), b3, voffB); PG8_STAGE(PG8_SB(1, 1), b3 + hstep, voffB); PG8_STAGE(PG8_SA(1, 0), a3, voffA);
            PG8_WAIT_V(8); PG8_WAIT_L(0); PG8_BAR; PG8_MMA(1, 0, At, B0); PG8_MMA(1, 1, At, B1); PG8_BAR; PG8_SCHED;
            } else {
            PG8_LDB(B0, 0, 0); PG8_SCHED; PG8_LDA(At, 0, 0); PG8_STAGE(PG8_SA(1, 1), a1 + hstep, voffA);
            PG8_WAIT_L(8); PG8_BAR; PG8_WAIT_L(0); PG8_MMA(0, 0, At, B0); PG8_BAR; PG8_SCHED;
            PG8_LDB(B1, 0, 1); PG8_STAGE(PG8_SB(0, 0), b2, voffB);
            PG8_BAR; PG8_WAIT_L(0); PG8_MMA(0, 1, At, B1); PG8_BAR;
            PG8_LDA(At, 0, 1); PG8_STAGE(PG8_SA(0, 0), a2, voffA);
            PG8_BAR; PG8_WAIT_L(0); PG8_MMA(1, 0, At, B0); PG8_BAR; PG8_SCHED;
            PG8_STAGE(PG8_SB(0, 1), b2 + hstep, voffB);
            PG8_WAIT_V(6); PG8_BAR; PG8_MMA(1, 1, At, B1); PG8_BAR;
            PG8_LDB(B0, 1, 0); PG8_SCHED; PG8_LDA(At, 1, 0); PG8_STAGE(PG8_SA(0, 1), a2 + hstep, voffA);
            PG8_WAIT_L(8); PG8_BAR; PG8_WAIT_L(0); PG8_MMA(0, 0, At, B0); PG8_BAR; PG8_SCHED;
            PG8_LDB(B1, 1, 1); PG8_STAGE(PG8_SB(1, 0), b3, voffB);
            PG8_BAR; PG8_WAIT_L(0); PG8_MMA(0, 1, At, B1); PG8_BAR;
            PG8_LDA(At, 1, 1); PG8_STAGE(PG8_SA(1, 0), a3, voffA);
            PG8_BAR; PG8_WAIT_L(0); PG8_MMA(1, 0, At, B0); PG8_BAR; PG8_SCHED;
            PG8_STAGE(PG8_SB(1, 1), b3 + hstep, voffB);
            PG8_WAIT_V(6); PG8_BAR; PG8_MMA(1, 1, At, B1); PG8_BAR;
            }
        }
        if constexpr (ALIGN_EPI) { if (wr == 0) PG8_BAR; }
        if constexpr (!Epi::AFTER_DRAIN) { E(acc, cur, wr, wc, fr, fq); S.done(cur); }
        if (!has_next) break;
#pragma unroll
        for (int a = 0; a < 2; ++a)
#pragma unroll
            for (int b = 0; b < 2; ++b)
#pragma unroll
                for (int m = 0; m < 4; ++m)
#pragma unroll
                    for (int n = 0; n < 2; ++n) acc[a][b][m][n] = (f32x4){0.f, 0.f, 0.f, 0.f};
        cur = nxt; cA = nA; cB = nB; ++ui;
        if constexpr (ALIGN_EPI) { if (wr == 1) PG8_BAR; }
    }
    PG8_WAIT_V(0);
    if constexpr (!ALIGN_EPI) { if (wr == 0) PG8_BAR; }
    PG8_BAR;
    if constexpr (Epi::AFTER_DRAIN) { E.fused(acc, cur, wr, wc, fr, fq, lds, wid, lane); S.done(cur); }
#undef PG8_SA
#undef PG8_SB
#undef PG8_STAGE
#undef PG8_LDA
#undef PG8_LDB
#undef PG8_MMA
#undef PG8_WAIT_V
#undef PG8_WAIT_L
#undef PG8_BAR
#undef PG8_SCHED
}
}
#define LAS __attribute__((address_space(3)))
#define XB_TMO      128
#define XB_XCNT(j)  (256  + 64 * (j))
#define XB_XSUB(j)  (1280 + 64 * (j))
#define XB_XGEN(j)  (2304 + 64 * (j))
#define XB_TOP      3328
#define XB_TOPGEN   3392
#define XCD_BAR_WORDS 3456
#define XB_SPIN_CAP (1u << 18)

__device__ __forceinline__ unsigned xb_ld(unsigned* p)              { return __hip_atomic_load(p, __ATOMIC_RELAXED, __HIP_MEMORY_SCOPE_AGENT); }
__device__ __forceinline__ unsigned xb_add(unsigned* p, unsigned v) { return __hip_atomic_fetch_add(p, v, __ATOMIC_RELAXED, __HIP_MEMORY_SCOPE_AGENT); }
__device__ __forceinline__ unsigned xb_xcc_id() { return (unsigned)__builtin_amdgcn_s_getreg((3 << 11) | 20) & 0xFu; }
#define XB_SPIN(cond, bar) do { unsigned _sp = 0; while (cond) { __builtin_amdgcn_s_sleep(1); \
    if ((++_sp & 255u) == 0u) { if (xb_ld(&(bar)[XB_TMO])) break; if (_sp > XB_SPIN_CAP) { atomicAdd(&(bar)[XB_TMO], 1u); break; } } } } while (0)

struct XcdBarrier {
    unsigned* bar; unsigned x;
    volatile LAS unsigned* st;
};

__device__ __forceinline__ XcdBarrier xcd_barrier_post(unsigned* bar, volatile LAS unsigned* st) {
    XcdBarrier b; b.bar = bar; b.x = xb_xcc_id(); b.st = st;
    if (threadIdx.x == 0) (void)xb_add(&bar[XB_XCNT(b.x)], 1u);
    return b;
}
__device__ __forceinline__ void xcd_barrier_complete(unsigned* bar, unsigned x, unsigned& nloc, unsigned& nx) {
    const unsigned G = gridDim.x * gridDim.y * gridDim.z;
    unsigned sum, cnt, mine, sp = 0u;
    for (;;) {
        sum = 0u; cnt = 0u; mine = 0u;
#pragma unroll
        for (unsigned j = 0; j < 16; ++j) { const unsigned c = xb_ld(&bar[XB_XCNT(j)]); sum += c; cnt += (c > 0u) ? 1u : 0u; mine = (j == x) ? c : mine; }
        if (sum == G) break;
        __builtin_amdgcn_s_sleep(1);
        if ((++sp & 255u) == 0u) { if (xb_ld(&bar[XB_TMO])) break; if (sp > XB_SPIN_CAP) { atomicAdd(&bar[XB_TMO], 1u); break; } }
    }
    nloc = mine > 0u ? mine : 1u; nx = cnt > 0u ? cnt : 1u;
}

__device__ __forceinline__ void xcd_barrier(const XcdBarrier& b) {
    asm volatile("s_waitcnt vmcnt(0)" ::: "memory");
    __syncthreads();
    if (threadIdx.x == 0) {
        unsigned* bar = b.bar;
        __builtin_amdgcn_s_waitcnt(0);
        unsigned nloc = b.st[0], nx = b.st[1];
        if (nloc == 0u) { xcd_barrier_complete(bar, b.x, nloc, nx); b.st[0] = nloc; b.st[1] = nx; }
        const unsigned old = xb_add(&bar[XB_XSUB(b.x)], 1u);
        const unsigned gen = old / nloc;
        if (old + 1u == (gen + 1u) * nloc) {
            __builtin_amdgcn_fence(__ATOMIC_RELEASE, "agent");
            asm volatile("s_waitcnt vmcnt(0)" ::: "memory");
            const unsigned og = xb_add(&bar[XB_TOP], 1u);
            const unsigned tg = og / nx;
            if (og + 1u == (tg + 1u) * nx) xb_add(&bar[XB_TOPGEN], 1u);
            else XB_SPIN(xb_ld(&bar[XB_TOPGEN]) == tg, bar);
            __builtin_amdgcn_fence(__ATOMIC_ACQUIRE, "agent");
            xb_add(&bar[XB_XGEN(b.x)], 1u);
            asm volatile("s_waitcnt vmcnt(0)" ::: "memory");
        } else {
            XB_SPIN(xb_ld(&bar[XB_XGEN(b.x)]) == gen, bar);
            __builtin_amdgcn_fence(__ATOMIC_ACQUIRE, "agent");
            asm volatile("s_waitcnt vmcnt(0)" ::: "memory");
        }
    }
    __syncthreads();
}

constexpr int DM = 2048, NB = 4, SEQ = 4096, CTXL = 256, DEPTH = 4;
constexpr int M_LAT = NB * SEQ, M_CTX = NB * CTXL, M_ALL = M_LAT + M_CTX;
constexpr int DFF = 5632, DFF2 = 2 * DFF, NQKV = 3072, NGLA = 6144, NGLA_EXT = 6400, NMOD = 6 * DM;
constexpr float EPS = 1e-6f;
#ifndef MK_ONE_LAUNCH
#define MK_ONE_LAUNCH 1
#endif
#ifndef NAIVE_ATTN
#define NAIVE_ATTN 0
#endif
#ifndef NAIVE_GLA
#define NAIVE_GLA 0
#endif
constexpr int NPH = 42;

constexpr size_t MiB = 1u << 20;
constexpr size_t WS_CTL = 0, CTL_ZERO_BYTES = 1 * MiB;
constexpr size_t WS_MODS = 1 * MiB;
constexpr size_t WS_X = 2 * MiB;
constexpr size_t WS_H = 138 * MiB;
constexpr size_t WS_P = 206 * MiB;
constexpr size_t WS_Z1 = 410 * MiB;
constexpr size_t WS_OMIX = 413 * MiB;
constexpr size_t WS_U = 481 * MiB;
constexpr size_t WS_OF = WS_U, WS_OB = WS_U + 136 * MiB;
constexpr size_t WS_VTA = WS_U;
constexpr size_t WS_QT = WS_U;
constexpr size_t WS_KHT = WS_U + 68 * MiB;
constexpr size_t WS_AIN = WS_U + 136 * MiB;
constexpr size_t WS_DEC = WS_U + 153 * MiB;
constexpr size_t WS_VT = WS_U + 156 * MiB;
constexpr size_t WS_OFB = WS_U + 224 * MiB, WS_OBB = WS_U + 292 * MiB;
constexpr size_t WS_ACT = 855 * MiB;
constexpr size_t WS_WUP = 1042 * MiB, WUP_STRIDE = 44 * MiB;
constexpr size_t WS_WDN = 1218 * MiB, WDN_STRIDE = 22 * MiB;
constexpr size_t WS_WQKV = 1306 * MiB, WQKV_STRIDE = 12 * MiB;
constexpr size_t WS_WAO = 1330 * MiB, WO_STRIDE = 8 * MiB;
constexpr size_t WS_WGIN = 1346 * MiB, WGIN_STRIDE = 25 * MiB;
constexpr size_t WS_WGO = 1396 * MiB;
constexpr size_t WS_END = 1412 * MiB;
constexpr int CW_BAR = 4096;

constexpr int RING_BYTES = 131072, LDSCTL_OFF = RING_BYTES, LDS_BYTES = 147456;

#define GAS __attribute__((address_space(1)))
#define LAS __attribute__((address_space(3)))
typedef unsigned short bf16;
typedef unsigned v4u __attribute__((ext_vector_type(4)));
typedef unsigned v2u __attribute__((ext_vector_type(2)));
typedef float f32x4 __attribute__((ext_vector_type(4)));
#define LDS_WAIT() asm volatile("s_waitcnt lgkmcnt(0)" ::: "memory")
__device__ __forceinline__ unsigned f2bf(float f) { unsigned u = __builtin_bit_cast(unsigned, f); return (u + 0x7fffu + ((u >> 16) & 1u)) >> 16; }
__device__ __forceinline__ unsigned pk2(float lo, float hi) { return f2bf(lo) | (f2bf(hi) << 16); }
__device__ __forceinline__ float bf_lo(unsigned w) { return __builtin_bit_cast(float, w << 16); }
__device__ __forceinline__ float bf_hi(unsigned w) { return __builtin_bit_cast(float, w & 0xffff0000u); }
__device__ __forceinline__ float bf2f(bf16 h) { return __builtin_bit_cast(float, ((unsigned)h) << 16); }
__device__ __forceinline__ float silu_f(float v) { return v / (1.0f + __expf(-v)); }
__device__ __forceinline__ float wave_sum(float v) {
#pragma unroll
    for (int o = 1; o < 64; o <<= 1) v += __shfl_xor(v, o);
    return v;
}

struct Args { const float* in[25]; float* out; unsigned char* ws; int ph_lo, ph_hi; };
struct WV { int tid, lane, wave, G, vcu, gw, NGW; LAS unsigned char* lds; };

__device__ __forceinline__ void p0_transpose_item(const float* W, int K, int N, bf16* WT, int row_off, LAS float* scr, int item, int lane) {
    const int nblk = N / 32, kb = item / nblk, nb = item % nblk, k0 = 64 * kb, n0 = 32 * nb;
#pragma unroll 8
    for (int i = 0; i < 32; ++i) { const int kk = 2 * i + (lane >> 5); scr[kk * 33 + (lane & 31)] = W[(size_t)(k0 + kk) * N + n0 + (lane & 31)]; }
    LDS_WAIT(); asm volatile("" ::: "memory");
    const int c = lane & 7;
#pragma unroll
    for (int j = 0; j < 4; ++j) { const int n = (lane >> 3) + 8 * j; const LAS float* s = scr + (8 * c) * 33 + n;
        v4u o; o.x = pk2(s[0 * 33], s[1 * 33]); o.y = pk2(s[2 * 33], s[3 * 33]); o.z = pk2(s[4 * 33], s[5 * 33]); o.w = pk2(s[6 * 33], s[7 * 33]);
        *(v4u*)(WT + (size_t)(row_off + n0 + n) * K + k0 + 8 * c) = o; }
    LDS_WAIT(); asm volatile("" ::: "memory");
}
__device__ __forceinline__ void transpose_matrix(const WV& w, const float* W, int K, int N, bf16* WT, int row_off) {
    LAS float* scr = (LAS float*)(w.lds + w.wave * 16384);
    const int nitems = (K / 64) * (N / 32);
    for (int it = w.gw; it < nitems; it += w.NGW) p0_transpose_item(W, K, N, WT, row_off, scr, it, w.lane);
}
__device__ __forceinline__ void mods_item(const WV& w, const float* c, const float* c_ctx, const float* ada_w, const float* ada_b, float* mods, int it) {
    const int layer = it / 48, n0 = (it % 48) * 256;
    LAS float* sl = (LAS float*)w.lds;
    LAS float* red = (LAS float*)(w.lds + 40960);
    for (int i = w.tid; i < 5 * DM; i += 512) { const int vec = i >> 11, k = i & 2047; const float v = vec < 4 ? c[vec * DM + k] : c_ctx[k]; sl[i] = silu_f(v); }
    __syncthreads();
    const float* Wp = ada_w + (size_t)layer * DM * NMOD + n0 + 4 * w.lane;
    f32x4 acc[5];
#pragma unroll
    for (int v = 0; v < 5; ++v) acc[v] = (f32x4){0.f, 0.f, 0.f, 0.f};
    const int kbeg = w.wave * 256;
    for (int k = kbeg; k < kbeg + 256; k += 4) {
        f32x4 wv[4];
#pragma unroll
        for (int kk = 0; kk < 4; ++kk) wv[kk] = *(const f32x4*)(Wp + (size_t)(k + kk) * NMOD);
#pragma unroll
        for (int kk = 0; kk < 4; ++kk)
#pragma unroll
            for (int v = 0; v < 5; ++v) acc[v] += wv[kk] * sl[v * DM + k + kk];
    }
#pragma unroll
    for (int v = 0; v < 5; ++v) *(LAS f32x4*)(red + (w.wave * 5 + v) * 256 + 4 * w.lane) = acc[v];
    __syncthreads();
    for (int i = w.tid; i < 5 * 256; i += 512) { const int vec = i >> 8, col = i & 255; float s = 0.f;
#pragma unroll
        for (int ww = 0; ww < 8; ++ww) s += red[(ww * 5 + vec) * 256 + col];
        mods[((size_t)layer * 5 + vec) * NMOD + n0 + col] = s + ada_b[(size_t)layer * NMOD + n0 + col]; }
    __syncthreads();
}

__device__ __forceinline__ void norm_rows(const WV& w, const float* X, bf16* H, const float* g, const float* shift, const float* scale, int nrows) {
    for (int row = w.gw; row < nrows; row += w.NGW) {
        const int vec = row < M_LAT ? (row >> 12) : 4;
        const f32x4* xr = (const f32x4*)(X + (size_t)row * DM) + w.lane;
        f32x4 v[8]; float ss = 0.f;
#pragma unroll
        for (int j = 0; j < 8; ++j) { v[j] = xr[64 * j]; ss += (v[j].x * v[j].x + v[j].y * v[j].y) + (v[j].z * v[j].z + v[j].w * v[j].w); }
        const float r = 1.0f / sqrtf(wave_sum(ss) * (1.0f / DM) + EPS);
        const float* sh = shift + (size_t)vec * NMOD; const float* sc = scale + (size_t)vec * NMOD;
        v2u* o8 = (v2u*)(H + (size_t)row * DM) + w.lane;
#pragma unroll
        for (int j = 0; j < 8; ++j) { const int col = 4 * (64 * j + w.lane);
            const f32x4 gv = *(const f32x4*)(g + col), s = *(const f32x4*)(sc + col), t = *(const f32x4*)(sh + col);
            const f32x4 y = v[j] * r * gv * (s + 1.0f) + t;
            v2u o; o.x = pk2(y.x, y.y); o.y = pk2(y.z, y.w); o8[64 * j] = o; }
    }
}
__device__ __forceinline__ void final_norm(const WV& w, const float* X, float* out, const float* g) {
    for (int row = w.gw; row < M_LAT; row += w.NGW) {
        const f32x4* xr = (const f32x4*)(X + (size_t)row * DM) + w.lane;
        f32x4 v[8]; float ss = 0.f;
#pragma unroll
        for (int j = 0; j < 8; ++j) { v[j] = xr[64 * j]; ss += (v[j].x * v[j].x + v[j].y * v[j].y) + (v[j].z * v[j].z + v[j].w * v[j].w); }
        const float r = 1.0f / sqrtf(wave_sum(ss) * (1.0f / DM) + EPS);
        f32x4* o = (f32x4*)(out + (size_t)row * DM) + w.lane;
#pragma unroll
        for (int j = 0; j < 8; ++j) { const int col = 4 * (64 * j + w.lane); o[64 * j] = v[j] * r * *(const f32x4*)(g + col); }
    }
}

__device__ __forceinline__ void rope_rows(const WV& w, bf16* P) {
    const int half = w.lane >> 5, f = w.lane & 31;
    const float inv = exp2f(-(float)(2 * f) * (13.287712379549449f / 64.0f));
    for (int row = w.gw; row < M_LAT; row += w.NGW) {
        const int t = row & (SEQ - 1); const int pos = half ? (t & 63) : (t >> 6);
        const float ang = (float)pos * inv; const float c = __cosf(ang), s = __sinf(ang);
        bf16* p = P + (size_t)row * NQKV + half * 64 + f;
#pragma unroll 4
        for (int hh = 0; hh < 20; ++hh) { const float x1 = bf2f(p[hh * 128]), x2 = bf2f(p[hh * 128 + 32]);
            p[hh * 128] = (bf16)f2bf(x1 * c - x2 * s); p[hh * 128 + 32] = (bf16)f2bf(x2 * c + x1 * s); }
    }
}

__device__ __forceinline__ void attn_naive(const WV& w, const bf16* P, const float* sink, bf16* O) {
    const int g = w.lane >> 4, li = w.lane & 15;
    const float scale = 0.08838834764831845f;
    for (int task = w.gw; task < M_ALL * 16; task += w.NGW) {
        const int row = task >> 4, hq = task & 15, kvh = hq >> 2;
        float q[8];
        { const v4u qq = *(const v4u*)(P + (size_t)row * NQKV + hq * 128 + 8 * li);
          q[0] = bf_lo(qq.x) * scale; q[1] = bf_hi(qq.x) * scale; q[2] = bf_lo(qq.y) * scale; q[3] = bf_hi(qq.y) * scale;
          q[4] = bf_lo(qq.z) * scale; q[5] = bf_hi(qq.z) * scale; q[6] = bf_lo(qq.w) * scale; q[7] = bf_hi(qq.w) * scale; }
        int b, wbase = 0, nwin = 0;
        if (row < M_LAT) { b = row >> 12; const int t = row & (SEQ - 1); const int j0 = t - 128 < 0 ? 0 : t - 128, j1 = t + 128 > SEQ - 1 ? SEQ - 1 : t + 128; wbase = b * SEQ + j0; nwin = j1 - j0 + 1; }
        else b = (row - M_LAT) >> 8;
        const int cbase = M_LAT + b * CTXL, nk = nwin + CTXL;
        float m = sink[hq], l = (g == 0) ? 1.0f : 0.0f, o[8];
#pragma unroll
        for (int d = 0; d < 8; ++d) o[d] = 0.f;
        for (int i = g; i < nk; i += 4) {
            const int krow = i < nwin ? wbase + i : cbase + (i - nwin);
            const bf16* kp = P + (size_t)krow * NQKV + 2048 + kvh * 128 + 8 * li;
            const v4u kk = *(const v4u*)kp, vv = *(const v4u*)(kp + 512);
            float s = q[0] * bf_lo(kk.x) + q[1] * bf_hi(kk.x) + q[2] * bf_lo(kk.y) + q[3] * bf_hi(kk.y) + q[4] * bf_lo(kk.z) + q[5] * bf_hi(kk.z) + q[6] * bf_lo(kk.w) + q[7] * bf_hi(kk.w);
            s += __shfl_xor(s, 1); s += __shfl_xor(s, 2); s += __shfl_xor(s, 4); s += __shfl_xor(s, 8);
            const float mn = fmaxf(m, s), a = __expf(m - mn), p = __expf(s - mn);
            l = l * a + p; m = mn;
            o[0] = o[0] * a + p * bf_lo(vv.x); o[1] = o[1] * a + p * bf_hi(vv.x); o[2] = o[2] * a + p * bf_lo(vv.y); o[3] = o[3] * a + p * bf_hi(vv.y);
            o[4] = o[4] * a + p * bf_lo(vv.z); o[5] = o[5] * a + p * bf_hi(vv.z); o[6] = o[6] * a + p * bf_lo(vv.w); o[7] = o[7] * a + p * bf_hi(vv.w);
        }
        float ma = fmaxf(m, __shfl_xor(m, 16)); ma = fmaxf(ma, __shfl_xor(ma, 32));
        const float fsc = __expf(m - ma); l *= fsc; l += __shfl_xor(l, 16); l += __shfl_xor(l, 32);
        const float rl = 1.0f / l;
#pragma unroll
        for (int d = 0; d < 8; ++d) { float x = o[d] * fsc; x += __shfl_xor(x, 16); x += __shfl_xor(x, 32); o[d] = x * rl; }
        if (g == 0) { v4u ov; ov.x = pk2(o[0], o[1]); ov.y = pk2(o[2], o[3]); ov.z = pk2(o[4], o[5]); ov.w = pk2(o[6], o[7]);
            *(v4u*)(O + (size_t)row * DM + hq * 128 + 8 * li) = ov; }
    }
}

__device__ __forceinline__ void gla_naive(const WV& w, const bf16* P, const float* Z1, const float* w2f, const float* bf, const float* w2b, const float* bb, float* OF, float* OB) {
    LAS float* buf = (LAS float*)w.lds;
    const int vc = w.tid >> 2, dq = w.tid & 3;
    for (int it = w.vcu; it < 128; it += w.G) {
        const int vs = it & 3, dir = (it >> 2) & 1, h = (it >> 3) & 3, b = it >> 5;
        const float* w2 = dir ? w2b : w2f; const float* bias = dir ? bb : bf; float* OUT = dir ? OB : OF;
        float w2c[16], bz = 0.f;
        if (w.tid < 256) { bz = bias[h * 256 + w.tid];
#pragma unroll
            for (int r = 0; r < 16; ++r) w2c[r] = w2[r * 1024 + h * 256 + w.tid]; }
        else {
#pragma unroll
            for (int r = 0; r < 16; ++r) w2c[r] = 0.f; }
        float S[64];
#pragma unroll
        for (int i = 0; i < 64; ++i) S[i] = 0.f;
        const int cbase = M_LAT + b * CTXL, lbase = b * SEQ;
#define GLA_ROW(step) ((step) < CTXL ? (dir ? cbase + CTXL - 1 - (step) : cbase + (step)) : (dir ? lbase + SEQ - 1 - ((step) - CTXL) : lbase + ((step) - CTXL)))
#define GLA_FILL(step, par) do { if (w.tid < 256) { const int r_ = GLA_ROW(step); const float* z_ = Z1 + (size_t)r_ * 32 + dir * 16; float zz = bz; \
            _Pragma("unroll") for (int r = 0; r < 16; ++r) zz += z_[r] * w2c[r]; \
            const float ls_ = fminf(zz, 0.f) - log1pf(__expf(-fabsf(zz))); \
            LAS float* bp_ = buf + (par) * 768; bp_[w.tid] = __expf(ls_ * (1.0f / 16.0f)); \
            bp_[256 + w.tid] = bf2f(P[(size_t)r_ * NGLA + 1024 + h * 256 + w.tid]); bp_[512 + w.tid] = bf2f(P[(size_t)r_ * NGLA + h * 256 + w.tid]) * 0.0625f; } } while (0)
        __syncthreads();
        GLA_FILL(0, 0);
        __syncthreads();
        for (int step = 0; step < CTXL + SEQ; ++step) {
            const int row = GLA_ROW(step);
            if (step + 1 < CTXL + SEQ) GLA_FILL(step + 1, (step + 1) & 1);
            const float v = bf2f(P[(size_t)row * NGLA + 2048 + h * 512 + vs * 128 + vc]);
            const LAS float* bp = buf + (step & 1) * 768 + 64 * dq;
            float acc = 0.f;
#pragma unroll
            for (int i = 0; i < 64; i += 4) {
                const f32x4 e4 = *(const LAS f32x4*)(bp + i), k4 = *(const LAS f32x4*)(bp + 256 + i), q4 = *(const LAS f32x4*)(bp + 512 + i);
                S[i] = S[i] * e4.x + k4.x * v; acc += q4.x * S[i];
                S[i + 1] = S[i + 1] * e4.y + k4.y * v; acc += q4.y * S[i + 1];
                S[i + 2] = S[i + 2] * e4.z + k4.z * v; acc += q4.z * S[i + 2];
                S[i + 3] = S[i + 3] * e4.w + k4.w * v; acc += q4.w * S[i + 3];
            }
            acc += __shfl_xor(acc, 1); acc += __shfl_xor(acc, 2);
            if (dq == 0) OUT[(size_t)row * DM + h * 512 + vs * 128 + vc] = acc;
            __syncthreads();
        }
#undef GLA_ROW
#undef GLA_FILL
    }
}
__device__ __forceinline__ void gla_combine(const WV& w, const float* OF, const float* OB, const bf16* P, const float* og, bf16* O, int nrows) {
    for (int task = w.gw; task < nrows * 4; task += w.NGW) {
        const int row = task >> 2, h = task & 3; const size_t off = (size_t)row * DM + h * 512 + 8 * w.lane;
        const f32x4 a0 = *(const f32x4*)(OF + off), a1 = *(const f32x4*)(OF + off + 4), b0 = *(const f32x4*)(OB + off), b1 = *(const f32x4*)(OB + off + 4);
        const f32x4 o0 = a0 + b0, o1 = a1 + b1;
        float ss = (o0.x * o0.x + o0.y * o0.y) + (o0.z * o0.z + o0.w * o0.w) + (o1.x * o1.x + o1.y * o1.y) + (o1.z * o1.z + o1.w * o1.w);
        const float r = 1.0f / sqrtf(wave_sum(ss) * (1.0f / 512.0f) + EPS);
        const f32x4 g0 = *(const f32x4*)(og + 8 * w.lane), g1 = *(const f32x4*)(og + 8 * w.lane + 4);
        const v4u rr = *(const v4u*)(P + (size_t)row * NGLA + 4096 + h * 512 + 8 * w.lane);
        v4u ov;
        ov.x = pk2(o0.x * r * g0.x * silu_f(bf_lo(rr.x)), o0.y * r * g0.y * silu_f(bf_hi(rr.x)));
        ov.y = pk2(o0.z * r * g0.z * silu_f(bf_lo(rr.y)), o0.w * r * g0.w * silu_f(bf_hi(rr.y)));
        ov.z = pk2(o1.x * r * g1.x * silu_f(bf_lo(rr.z)), o1.y * r * g1.y * silu_f(bf_hi(rr.z)));
        ov.w = pk2(o1.z * r * g1.z * silu_f(bf_lo(rr.w)), o1.w * r * g1.w * silu_f(bf_hi(rr.w)));
        *(v4u*)(O + off) = ov;
    }
}
__device__ __forceinline__ void unpack8(const v4u a, float (&x)[8]) { x[0] = bf_lo(a.x); x[1] = bf_hi(a.x); x[2] = bf_lo(a.y); x[3] = bf_hi(a.y); x[4] = bf_lo(a.z); x[5] = bf_hi(a.z); x[6] = bf_lo(a.w); x[7] = bf_hi(a.w); }

typedef short bf16x8 __attribute__((ext_vector_type(8)));
typedef float f32x16 __attribute__((ext_vector_type(16)));
__device__ __forceinline__ int gla_row(int b, int cc, int i) { return cc < 64 ? b * SEQ + cc * 64 + i : M_LAT + b * CTXL + (cc - 64) * 64 + i; }
__device__ __forceinline__ void gla_pre(const WV& w, const bf16* P, const float* Z1, const float* w2f, const float* bf_, const float* w2b, const float* bb_, bf16* QT, bf16* KHT, bf16* AIN, float* DEC) {
    LAS float* z1s = (LAS float*)w.lds;
    LAS float* tot = (LAS float*)(w.lds + 4096);
    LAS bf16* qs = (LAS bf16*)(w.lds + 8192);
    LAS bf16* ks = (LAS bf16*)(w.lds + 8192 + 33792);
    const int d = w.tid & 255, hf = w.tid >> 8;
    for (int it = w.vcu; it < 2 * 4 * 4 * 68; it += w.G) {
        const int dir = it & 1, h = (it >> 1) & 3, b = (it >> 3) & 3, cc = it >> 5;
        const size_t item = ((size_t)(dir * 4 + b) * 4 + h) * 68 + cc;
        const float* w2 = dir ? w2b : w2f; const float bias = (dir ? bb_ : bf_)[h * 256 + d];
        float w2c[16];
#pragma unroll
        for (int r = 0; r < 16; ++r) w2c[r] = w2[r * 1024 + h * 256 + d];
        const int row0 = gla_row(b, cc, 0);
        for (int idx = w.tid; idx < 1024; idx += 512) z1s[idx] = Z1[(size_t)(row0 + (idx >> 4)) * 32 + dir * 16 + (idx & 15)];
        __syncthreads();
        float g[32];
#pragma unroll
        for (int ii = 0; ii < 32; ++ii) { const LAS f32x4* zp = (const LAS f32x4*)(z1s + (32 * hf + ii) * 16); float zz = bias;
#pragma unroll
            for (int q4 = 0; q4 < 4; ++q4) { const f32x4 z = zp[q4]; zz += z.x * w2c[4 * q4] + z.y * w2c[4 * q4 + 1] + z.z * w2c[4 * q4 + 2] + z.w * w2c[4 * q4 + 3]; }
            g[ii] = (fminf(zz, 0.f) - log1pf(__expf(-fabsf(zz)))) * 0.0625f; }
        float run = 0.f;
        if (!dir) {
#pragma unroll
            for (int ii = 0; ii < 32; ++ii) { run += g[ii]; g[ii] = run; } }
        else {
#pragma unroll
            for (int ii = 31; ii >= 0; --ii) { run += g[ii]; g[ii] = run; } }
        tot[hf * 256 + d] = run;
        __syncthreads();
        const float t0 = tot[d], t1 = tot[256 + d], blast = t0 + t1;
        const float off = dir ? (hf == 0 ? t1 : 0.f) : (hf == 1 ? t0 : 0.f);
        unsigned khat[16];
#pragma unroll
        for (int ii = 0; ii < 32; ++ii) { const int i = 32 * hf + ii; const size_t row = (size_t)(row0 + i); const float bbv = g[ii] + off;
            const float qv = bf2f(P[row * NGLA + h * 256 + d]) * 0.0625f, kv = bf2f(P[row * NGLA + 1024 + h * 256 + d]);
            const unsigned qt = f2bf(qv * __expf(bbv)), kt = f2bf(kv * __expf(-bbv)), kh = f2bf(kv * __expf(blast - bbv));
            QT[((size_t)dir * M_ALL + row) * 1024 + h * 256 + d] = (bf16)qt; qs[i * 264 + d] = (bf16)qt; ks[i * 264 + d] = (bf16)kt;
            if (ii & 1) khat[ii >> 1] |= kh << 16; else khat[ii >> 1] = kh; }
        { v4u* kp = (v4u*)(KHT + (item * 256 + d) * 64 + 32 * hf);
#pragma unroll
          for (int q4 = 0; q4 < 4; ++q4) kp[q4] = (v4u){khat[4 * q4], khat[4 * q4 + 1], khat[4 * q4 + 2], khat[4 * q4 + 3]}; }
        if (hf == 0) DEC[item * 256 + d] = __expf(blast);
        __syncthreads();
        { const int rb = w.wave >> 1, ch = w.wave & 1, c16 = w.lane & 15, kg = w.lane >> 4;
          f32x4 acc[2]; acc[0] = (f32x4){0.f, 0.f, 0.f, 0.f}; acc[1] = acc[0];
#pragma unroll
          for (int k8 = 0; k8 < 8; ++k8) { const bf16x8 a = *(const LAS bf16x8*)(qs + (rb * 16 + c16) * 264 + 32 * k8 + 8 * kg);
#pragma unroll
              for (int n = 0; n < 2; ++n) { const bf16x8 bq = *(const LAS bf16x8*)(ks + ((2 * ch + n) * 16 + c16) * 264 + 32 * k8 + 8 * kg); acc[n] = __builtin_amdgcn_mfma_f32_16x16x32_bf16(a, bq, acc[n], 0, 0, 0); } }
#pragma unroll
          for (int n = 0; n < 2; ++n)
#pragma unroll
              for (int r = 0; r < 4; ++r) { const int i = rb * 16 + 4 * kg + r, jj = (2 * ch + n) * 16 + c16; const bool keep = dir ? (jj >= i) : (jj <= i);
                  AIN[(item * 64 + i) * 64 + jj] = (bf16)f2bf(keep ? acc[n][r] : 0.f); } }
        __syncthreads();
    }
}
__device__ __forceinline__ void gla_vt(const WV& w, const bf16* P, bf16* VT) {
    LAS bf16* vt = (LAS bf16*)w.lds;
    for (int it = w.vcu; it < 4 * 4 * 68; it += w.G) {
        const int cc = it % 68, bh = it / 68, h = bh & 3, b = bh >> 2;
        const int row0 = gla_row(b, cc, 0);
#pragma unroll
        for (int rr = 0; rr < 8; ++rr) { const int i = rr * 8 + (w.tid >> 6), piece = w.tid & 63;
            *(LAS v4u*)(vt + i * 520 + 8 * piece) = *(const v4u*)(P + (size_t)(row0 + i) * NGLA + 2048 + h * 512 + 8 * piece); }
        __syncthreads();
        const int dv = w.tid;
#pragma unroll
        for (int grp = 0; grp < 8; ++grp) { unsigned u[8];
#pragma unroll
            for (int e = 0; e < 8; ++e) u[e] = vt[(8 * grp + e) * 520 + dv];
            *(v4u*)(VT + ((size_t)it * 512 + dv) * 64 + 8 * grp) = (v4u){u[0] | (u[1] << 16), u[2] | (u[3] << 16), u[4] | (u[5] << 16), u[6] | (u[7] << 16)}; }
        __syncthreads();
    }
}
__device__ __forceinline__ void gla_scan(const WV& w, const bf16* QT, const bf16* KHT, const bf16* AIN, const float* DEC, const bf16* VT, bf16* OFB, bf16* OBB) {
    LAS bf16* ST = (LAS bf16*)w.lds;
    const int wv = w.wave, r32 = w.lane & 31, hh = w.lane >> 5, c16 = w.lane & 15, kg = w.lane >> 4, tb = wv >> 1, dh = wv & 1;
    for (int it = w.vcu; it < 256; it += w.G) {
        const int vs = it & 7, dir = (it >> 3) & 1, h = (it >> 4) & 3, b = it >> 6;
        bf16* O = dir ? OBB : OFB;
        f32x16 S[2];
#pragma unroll
        for (int n = 0; n < 2; ++n)
#pragma unroll
            for (int r = 0; r < 16; ++r) S[n][r] = 0.f;
        for (int s = 0; s < 68; ++s) {
            const int cc = s < 4 ? (dir ? 67 - s : 64 + s) : (dir ? 67 - s : s - 4);
            const size_t item = ((size_t)(dir * 4 + b) * 4 + h) * 68 + cc, vitem = ((size_t)b * 4 + h) * 68 + cc;
            const int row0 = gla_row(b, cc, 0);
            LAS bf16* st = ST + (s & 1) * (64 * 264);
#pragma unroll
            for (int n = 0; n < 2; ++n)
#pragma unroll
                for (int g4 = 0; g4 < 4; ++g4) { v2u pk; pk.x = pk2(S[n][4 * g4], S[n][4 * g4 + 1]); pk.y = pk2(S[n][4 * g4 + 2], S[n][4 * g4 + 3]);
                    *(LAS v2u*)(st + (32 * n + r32) * 264 + 32 * wv + 8 * g4 + 4 * hh) = pk; }
            bf16x8 qa[8], aa[2], vb16[2][2], ka[4], vb32[2][4]; float dec[16];
            { const bf16* qrow = QT + ((size_t)dir * M_ALL + row0 + tb * 16 + c16) * 1024 + h * 256 + 8 * kg;
#pragma unroll
              for (int k8 = 0; k8 < 8; ++k8) qa[k8] = *(const bf16x8*)(qrow + 32 * k8);
              const bf16* arow = AIN + (item * 64 + tb * 16 + c16) * 64 + 8 * kg; aa[0] = *(const bf16x8*)arow; aa[1] = *(const bf16x8*)(arow + 32);
              const bf16* v16 = VT + (vitem * 512 + vs * 64 + 32 * dh + c16) * 64 + 8 * kg;
#pragma unroll
              for (int n = 0; n < 2; ++n) { vb16[n][0] = *(const bf16x8*)(v16 + n * 16 * 64); vb16[n][1] = *(const bf16x8*)(v16 + n * 16 * 64 + 32); }
              const bf16* krow = KHT + (item * 256 + 32 * wv + r32) * 64 + 8 * hh;
#pragma unroll
              for (int k4 = 0; k4 < 4; ++k4) ka[k4] = *(const bf16x8*)(krow + 16 * k4);
              const bf16* v32 = VT + (vitem * 512 + vs * 64 + r32) * 64 + 8 * hh;
#pragma unroll
              for (int n = 0; n < 2; ++n)
#pragma unroll
                  for (int k4 = 0; k4 < 4; ++k4) vb32[n][k4] = *(const bf16x8*)(v32 + n * 32 * 64 + 16 * k4);
              const float* dp = DEC + item * 256 + 32 * wv + 4 * hh;
#pragma unroll
              for (int r = 0; r < 16; ++r) dec[r] = dp[(r & 3) + 8 * (r >> 2)]; }
            __syncthreads();
            f32x4 oacc[2]; oacc[0] = (f32x4){0.f, 0.f, 0.f, 0.f}; oacc[1] = oacc[0];
#pragma unroll
            for (int k8 = 0; k8 < 8; ++k8)
#pragma unroll
                for (int n = 0; n < 2; ++n) { const bf16x8 sb = *(const LAS bf16x8*)(st + (32 * dh + 16 * n + c16) * 264 + 32 * k8 + 8 * kg); oacc[n] = __builtin_amdgcn_mfma_f32_16x16x32_bf16(qa[k8], sb, oacc[n], 0, 0, 0); }
#pragma unroll
            for (int k2 = 0; k2 < 2; ++k2)
#pragma unroll
                for (int n = 0; n < 2; ++n) oacc[n] = __builtin_amdgcn_mfma_f32_16x16x32_bf16(aa[k2], vb16[n][k2], oacc[n], 0, 0, 0);
#pragma unroll
            for (int n = 0; n < 2; ++n)
#pragma unroll
                for (int r = 0; r < 4; ++r) O[(size_t)(row0 + tb * 16 + 4 * kg + r) * DM + h * 512 + vs * 64 + 32 * dh + 16 * n + c16] = (bf16)f2bf(oacc[n][r]);
#pragma unroll
            for (int n = 0; n < 2; ++n) {
#pragma unroll
                for (int r = 0; r < 16; ++r) S[n][r] *= dec[r];
#pragma unroll
                for (int k4 = 0; k4 < 4; ++k4) S[n] = __builtin_amdgcn_mfma_f32_32x32x16_bf16(ka[k4], vb32[n][k4], S[n], 0, 0, 0); }
        }
        __syncthreads();
    }
}
__device__ __forceinline__ void gla_combine_bf(const WV& w, const bf16* OFB, const bf16* OBB, const bf16* P, const float* og, bf16* O, int nrows) {
    for (int task = w.gw; task < nrows * 4; task += w.NGW) {
        const int row = task >> 2, h = task & 3; const size_t off = (size_t)row * DM + h * 512 + 8 * w.lane;
        float a[8], c[8], o[8], rv[8]; unpack8(*(const v4u*)(OFB + off), a); unpack8(*(const v4u*)(OBB + off), c);
        float ss = 0.f;
#pragma unroll
        for (int e = 0; e < 8; ++e) { o[e] = a[e] + c[e]; ss += o[e] * o[e]; }
        const float r = 1.0f / sqrtf(wave_sum(ss) * (1.0f / 512.0f) + EPS);
        const f32x4 g0 = *(const f32x4*)(og + 8 * w.lane), g1 = *(const f32x4*)(og + 8 * w.lane + 4);
        const float gg[8] = {g0.x, g0.y, g0.z, g0.w, g1.x, g1.y, g1.z, g1.w};
        unpack8(*(const v4u*)(P + (size_t)row * NGLA + 4096 + h * 512 + 8 * w.lane), rv);
#pragma unroll
        for (int e = 0; e < 8; ++e) o[e] = o[e] * r * gg[e] * silu_f(rv[e]);
        *(v4u*)(O + off) = (v4u){pk2(o[0], o[1]), pk2(o[2], o[3]), pk2(o[4], o[5]), pk2(o[6], o[7])};
    }
}


__device__ __forceinline__ void attn_vt(const WV& w, const bf16* P, bf16* VTA) {
    LAS bf16* tl = (LAS bf16*)w.lds;
    for (int it = w.vcu; it < 16 * 68; it += w.G) {
        const int blk = it % 68, bk = it / 68, b = bk >> 2, kvh = bk & 3;
        const size_t row0 = blk < 64 ? (size_t)b * SEQ + 64 * blk : (size_t)M_LAT + b * CTXL + 64 * (blk - 64);
        const int col0 = blk < 64 ? 64 * blk : SEQ + 64 * (blk - 64);
#pragma unroll
        for (int i = 0; i < 2; ++i) { const int p = w.tid + 512 * i, r = p >> 4, c8 = p & 15;
            *(LAS v4u*)(tl + r * 136 + 8 * c8) = *(const v4u*)(P + (row0 + r) * NQKV + 2560 + kvh * 128 + 8 * c8); }
        __syncthreads();
        const int d = w.tid & 127, tg = w.tid >> 7;
        unsigned u[16];
#pragma unroll
        for (int e = 0; e < 16; ++e) u[e] = tl[(16 * tg + e) * 136 + d];
        v4u* dst = (v4u*)(VTA + ((size_t)bk * 128 + d) * 4352 + col0 + 16 * tg);
        dst[0] = (v4u){u[0] | (u[1] << 16), u[2] | (u[3] << 16), u[4] | (u[5] << 16), u[6] | (u[7] << 16)};
        dst[1] = (v4u){u[8] | (u[9] << 16), u[10] | (u[11] << 16), u[12] | (u[13] << 16), u[14] | (u[15] << 16)};
        __syncthreads();
    }
}
__device__ __forceinline__ void attn_fast(const WV& w, const bf16* P, const bf16* VTA, const float* sink, bf16* O) {
    LAS bf16* KL = (LAS bf16*)w.lds;
    LAS bf16* VL = (LAS bf16*)(w.lds + 2 * 17408);
    const int wv = w.wave, r32 = w.lane & 31, hh = w.lane >> 5, g = wv >> 1, th = wv & 1;
    const float C2 = 0.08838834764831845f * 1.4426950408889634f, L2E = 1.4426950408889634f;
    for (int u = w.vcu; u < 1088; u += w.G) {
        int b, kvh, qb; bool isctx;
        if (u < 1024) { b = u >> 8; kvh = (u >> 6) & 3; qb = u & 63; isctx = false; } else { const int v = u - 1024; b = v >> 4; kvh = (v >> 2) & 3; qb = v & 3; isctx = true; }
        const int hq = kvh * 4 + g, tq = qb * 64 + 32 * th + r32;
        const size_t qrow = isctx ? (size_t)M_LAT + b * CTXL + tq : (size_t)b * SEQ + tq;
        int i_lo = 0, nwin = 0;
        if (!isctx) { i_lo = 2 - qb > 0 ? 2 - qb : 0; const int i_hi = 65 - qb < 4 ? 65 - qb : 4; nwin = i_hi - i_lo + 1; }
        const int T = nwin + 4;
        bf16x8 qf[8];
#pragma unroll
        for (int k8 = 0; k8 < 8; ++k8) qf[k8] = *(const bf16x8*)(P + qrow * NQKV + hq * 128 + 16 * k8 + 8 * hh);
        f32x16 OT[4];
#pragma unroll
        for (int db = 0; db < 4; ++db)
#pragma unroll
            for (int r = 0; r < 16; ++r) OT[db][r] = 0.f;
        float m = sink[hq] * L2E, lsum = hh == 0 ? 1.0f : 0.0f;
        v4u kreg[2], vreg[2];
#define ATT_LOAD(t_) do { const int t__ = (t_); const bool wt_ = t__ < nwin; const int kp0_ = qb * 64 - 128 + 64 * (i_lo + t__), ct_ = t__ - nwin; \
            const size_t krow0_ = wt_ ? (size_t)b * SEQ + kp0_ : (size_t)M_LAT + b * CTXL + 64 * ct_; const int vcol0_ = wt_ ? kp0_ : SEQ + 64 * ct_; \
            _Pragma("unroll") for (int i_ = 0; i_ < 2; ++i_) { const int p_ = w.tid + 512 * i_; \
                kreg[i_] = *(const v4u*)(P + (krow0_ + (p_ >> 4)) * NQKV + 2048 + kvh * 128 + 8 * (p_ & 15)); \
                vreg[i_] = *(const v4u*)(VTA + ((size_t)(b * 4 + kvh) * 128 + (p_ >> 3)) * 4352 + vcol0_ + 8 * (p_ & 7)); } } while (0)
#define ATT_STORE(buf_) do { _Pragma("unroll") for (int i_ = 0; i_ < 2; ++i_) { const int p_ = w.tid + 512 * i_; \
                *(LAS v4u*)(KL + (buf_) * (64 * 136) + (p_ >> 4) * 136 + 8 * (p_ & 15)) = kreg[i_]; \
                LAS v2u* vp_ = (LAS v2u*)(VL + (buf_) * (128 * 68) + (p_ >> 3) * 68 + 8 * (p_ & 7)); vp_[0] = (v2u){vreg[i_].x, vreg[i_].y}; vp_[1] = (v2u){vreg[i_].z, vreg[i_].w}; } } while (0)
        __syncthreads();
        ATT_LOAD(0); ATT_STORE(0);
        __syncthreads();
        for (int t = 0; t < T; ++t) {
            if (t + 1 < T) ATT_LOAD(t + 1);
            const LAS bf16* kl = KL + (t & 1) * (64 * 136); const LAS bf16* vl = VL + (t & 1) * (128 * 68);
            f32x16 sacc[2];
#pragma unroll
            for (int kb = 0; kb < 2; ++kb) {
#pragma unroll
                for (int r = 0; r < 16; ++r) sacc[kb][r] = 0.f;
#pragma unroll
                for (int k8 = 0; k8 < 8; ++k8) { const bf16x8 a = *(const LAS bf16x8*)(kl + (32 * kb + r32) * 136 + 16 * k8 + 8 * hh); sacc[kb] = __builtin_amdgcn_mfma_f32_32x32x16_bf16(a, qf[k8], sacc[kb], 0, 0, 0); } }
            const bool wt = t < nwin; const int kp0 = qb * 64 - 128 + 64 * (i_lo + t);
            float mx = -INFINITY;
#pragma unroll
            for (int kb = 0; kb < 2; ++kb)
#pragma unroll
                for (int r = 0; r < 16; ++r) { float sv = sacc[kb][r] * C2;
                    if (wt) { const int dlt = kp0 + 32 * kb + (r & 3) + 8 * (r >> 2) + 4 * hh - tq; if (dlt > 128 || dlt < -128) sv = -INFINITY; }
                    sacc[kb][r] = sv; mx = fmaxf(mx, sv); }
            mx = fmaxf(mx, __shfl_xor(mx, 32));
            const float mn = fmaxf(m, mx), alpha = __builtin_amdgcn_exp2f(m - mn); m = mn;
            float ps = 0.f;
#pragma unroll
            for (int kb = 0; kb < 2; ++kb)
#pragma unroll
                for (int r = 0; r < 16; ++r) { const float pv = __builtin_amdgcn_exp2f(sacc[kb][r] - mn); ps += pv; sacc[kb][r] = pv; }
            lsum = lsum * alpha + ps;
#pragma unroll
            for (int db = 0; db < 4; ++db)
#pragma unroll
                for (int r = 0; r < 16; ++r) OT[db][r] *= alpha;
#pragma unroll
            for (int kb = 0; kb < 2; ++kb)
#pragma unroll
                for (int sh = 0; sh < 2; ++sh) {
                    v4u pw; pw.x = pg8::cvt_pk_bf16(sacc[kb][8 * sh], sacc[kb][8 * sh + 1]); pw.y = pg8::cvt_pk_bf16(sacc[kb][8 * sh + 2], sacc[kb][8 * sh + 3]);
                    pw.z = pg8::cvt_pk_bf16(sacc[kb][8 * sh + 4], sacc[kb][8 * sh + 5]); pw.w = pg8::cvt_pk_bf16(sacc[kb][8 * sh + 6], sacc[kb][8 * sh + 7]);
                    const bf16x8 pf = __builtin_bit_cast(bf16x8, pw);
#pragma unroll
                    for (int db = 0; db < 4; ++db) { const LAS bf16* vp = vl + (32 * db + r32) * 68 + 32 * kb + 16 * sh + 4 * hh;
                        const v2u lo = *(const LAS v2u*)vp, hi = *(const LAS v2u*)(vp + 8);
                        const bf16x8 vf = __builtin_bit_cast(bf16x8, ((v4u){lo.x, lo.y, hi.x, hi.y}));
                        OT[db] = __builtin_amdgcn_mfma_f32_32x32x16_bf16(vf, pf, OT[db], 0, 0, 0); } }
            if (t + 1 < T) ATT_STORE((t + 1) & 1);
            __syncthreads();
        }
#undef ATT_LOAD
#undef ATT_STORE
        const float l = lsum + __shfl_xor(lsum, 32), rl = 1.0f / l;
        bf16* op = O + qrow * DM + hq * 128 + 4 * hh;
#pragma unroll
        for (int db = 0; db < 4; ++db)
#pragma unroll
            for (int g4 = 0; g4 < 4; ++g4) { v2u o; o.x = pk2(OT[db][4 * g4] * rl, OT[db][4 * g4 + 1] * rl); o.y = pk2(OT[db][4 * g4 + 2] * rl, OT[db][4 * g4 + 3] * rl);
                *(v2u*)(op + 32 * db + 8 * g4) = o; }
    }
}

__device__ __forceinline__ void conv_rows(const WV& w, const bf16* U, const float* cw, const float* cb, bf16* ACT, int nrows) {
    const int nseg = nrows / 32;
    for (int wi = w.gw; wi < nseg * 11; wi += w.NGW) {
        const int seg = wi / 11, cg = wi % 11, r0 = seg * 32, f = (cg * 64 + w.lane) * 8;
        float wg[3][8], wv[3][8], bg[8], bv[8];
#pragma unroll
        for (int j = 0; j < 3; ++j)
#pragma unroll
            for (int e = 0; e < 8; ++e) { wg[j][e] = cw[j * DFF2 + f + e]; wv[j][e] = cw[j * DFF2 + DFF + f + e]; }
#pragma unroll
        for (int e = 0; e < 8; ++e) { bg[e] = cb[f + e]; bv[e] = cb[DFF + f + e]; }
        const bool s_start = r0 < M_LAT ? ((r0 & (SEQ - 1)) == 0) : (((r0 - M_LAT) & (CTXL - 1)) == 0);
        const bool s_end = r0 < M_LAT ? (((r0 + 32) & (SEQ - 1)) == 0) : (((r0 + 32 - M_LAT) & (CTXL - 1)) == 0);
        const v4u zero4 = (v4u){0u, 0u, 0u, 0u};
        v4u pg = s_start ? zero4 : *(const v4u*)(U + (size_t)(r0 - 1) * DFF2 + f), pv = s_start ? zero4 : *(const v4u*)(U + (size_t)(r0 - 1) * DFF2 + DFF + f);
        v4u cg4 = *(const v4u*)(U + (size_t)r0 * DFF2 + f), cv4 = *(const v4u*)(U + (size_t)r0 * DFF2 + DFF + f);
        for (int r = 0; r < 32; ++r) {
            const bool nz = (r == 31) && s_end;
            const v4u ng = nz ? zero4 : *(const v4u*)(U + (size_t)(r0 + r + 1) * DFF2 + f), nv = nz ? zero4 : *(const v4u*)(U + (size_t)(r0 + r + 1) * DFF2 + DFF + f);
            float a[8], c[8], n[8], gate[8], val[8];
            unpack8(pg, a); unpack8(cg4, c); unpack8(ng, n);
#pragma unroll
            for (int e = 0; e < 8; ++e) gate[e] = bg[e] + wg[0][e] * a[e] + wg[1][e] * c[e] + wg[2][e] * n[e];
            unpack8(pv, a); unpack8(cv4, c); unpack8(nv, n);
#pragma unroll
            for (int e = 0; e < 8; ++e) val[e] = bv[e] + wv[0][e] * a[e] + wv[1][e] * c[e] + wv[2][e] * n[e];
            v4u ov; ov.x = pk2(silu_f(gate[0]) * val[0], silu_f(gate[1]) * val[1]); ov.y = pk2(silu_f(gate[2]) * val[2], silu_f(gate[3]) * val[3]);
            ov.z = pk2(silu_f(gate[4]) * val[4], silu_f(gate[5]) * val[5]); ov.w = pk2(silu_f(gate[6]) * val[6], silu_f(gate[7]) * val[7]);
            *(v4u*)(ACT + (size_t)(r0 + r) * DFF + f) = ov;
            pg = cg4; pv = cv4; cg4 = ng; cv4 = nv;
        }
    }
}

__global__ void __launch_bounds__(512, 2) mega(Args args) {
    extern __shared__ __attribute__((aligned(16))) unsigned char lds_raw[];
    LAS unsigned char* const lds0 = (LAS unsigned char*)lds_raw;
    for (int u = threadIdx.x; u < (LDS_BYTES - LDSCTL_OFF) / 4; u += 512) ((LAS unsigned*)(lds0 + LDSCTL_OFF))[u] = 0u;
    __syncthreads();
    XcdBarrier bar; bar.bar = (unsigned*)(args.ws + WS_CTL) + CW_BAR; bar.x = 0; bar.st = nullptr;
    if (MK_ONE_LAUNCH) bar = xcd_barrier_post((unsigned*)(args.ws + WS_CTL) + CW_BAR, (volatile LAS unsigned*)(lds0 + LDSCTL_OFF + 32));
#define PHASE_ENTER() int tid_l = threadIdx.x; asm volatile("" : "+v"(tid_l)); unsigned char* ws = args.ws; asm volatile("" : "+s"(ws)); WV w; w.lds = lds0; w.tid = tid_l; w.lane = tid_l & 63; \
    w.wave = __builtin_amdgcn_readfirstlane(tid_l >> 6); w.G = gridDim.x; { const int bx = blockIdx.x; w.vcu = (w.G % 8 == 0) ? (bx % 8) * (w.G / 8) + bx / 8 : bx; } w.gw = w.vcu * 8 + w.wave; w.NGW = w.G * 8; \
    float* X = (float*)(ws + WS_X); bf16* H = (bf16*)(ws + WS_H); bf16* P = (bf16*)(ws + WS_P); float* Z1 = (float*)(ws + WS_Z1); bf16* OMIX = (bf16*)(ws + WS_OMIX); bf16* U = (bf16*)(ws + WS_U); \
    bf16* ACT = (bf16*)(ws + WS_ACT); float* MODS = (float*)(ws + WS_MODS); float* OF = (float*)(ws + WS_OF); float* OB = (float*)(ws + WS_OB); \
    (void)X; (void)H; (void)P; (void)Z1; (void)OMIX; (void)U; (void)ACT; (void)MODS; (void)OF; (void)OB; (void)w
    const int lo = args.ph_lo, hi = args.ph_hi;
#define RUN(k) (lo <= (k) && (k) < hi)
#define SEAM(k) do { if (MK_ONE_LAUNCH && RUN(k) && RUN((k) + 1)) xcd_barrier(bar); } while (0)

    if (RUN(0)) {
        PHASE_ENTER();
        for (int it = w.vcu; it < 4 * 48; it += w.G) mods_item(w, args.in[1], args.in[3], args.in[4], args.in[5], MODS, it);
        for (int l = 0; l < DEPTH; ++l) {
            transpose_matrix(w, args.in[8] + (size_t)l * DM * DFF2, DM, DFF2, (bf16*)(ws + WS_WUP + l * WUP_STRIDE), 0);
            transpose_matrix(w, args.in[11] + (size_t)l * DFF * DM, DFF, DM, (bf16*)(ws + WS_WDN + l * WDN_STRIDE), 0);
        }
        for (int j = 0; j < 2; ++j) {
            transpose_matrix(w, args.in[12] + (size_t)j * DM * NQKV, DM, NQKV, (bf16*)(ws + WS_WQKV + j * WQKV_STRIDE), 0);
            transpose_matrix(w, args.in[14] + (size_t)j * DM * DM, DM, DM, (bf16*)(ws + WS_WAO + j * WO_STRIDE), 0);
            transpose_matrix(w, args.in[15] + (size_t)j * DM * NGLA, DM, NGLA, (bf16*)(ws + WS_WGIN + j * WGIN_STRIDE), 0);
            transpose_matrix(w, args.in[23] + (size_t)j * DM * DM, DM, DM, (bf16*)(ws + WS_WGO + j * WO_STRIDE), 0);
            bf16* wg = (bf16*)(ws + WS_WGIN + j * WGIN_STRIDE) + (size_t)NGLA * DM;
            const float* f1 = args.in[16] + (size_t)j * DM * 16; const float* b1 = args.in[19] + (size_t)j * DM * 16;
            for (int idx = w.gw * 64 + w.lane; idx < 256 * DM; idx += w.NGW * 64) { const int n = idx >> 11, k = idx & 2047;
                const float v = n < 16 ? f1[k * 16 + n] : (n < 32 ? b1[k * 16 + (n - 16)] : 0.f); wg[idx] = (bf16)f2bf(v); }
        }
        { const f32x4* xs = (const f32x4*)args.in[0]; const f32x4* cs = (const f32x4*)args.in[2]; f32x4* xd = (f32x4*)X;
          const size_t nl = (size_t)M_LAT * DM / 4, nc = (size_t)M_CTX * DM / 4, gt = (size_t)w.gw * 64 + w.lane, gn = (size_t)w.NGW * 64;
          for (size_t i = gt; i < nl; i += gn) xd[i] = xs[i];
          for (size_t i = gt; i < nc; i += gn) xd[nl + i] = cs[i]; }
    }
    SEAM(0);

    for (int l = 0; l < DEPTH; ++l) {
        const int base = 1 + 10 * l, j = l >> 1; const bool gla = (l & 1) != 0, last = (l == DEPTH - 1);
        const size_t mods_off = (size_t)l * 5 * NMOD;
        const int mrows = last ? M_LAT : M_ALL;
        if (RUN(base + 0)) { PHASE_ENTER(); const float* mods_l = MODS + mods_off; norm_rows(w, X, H, args.in[6] + l * DM, mods_l + 0 * DM, mods_l + 1 * DM, M_ALL); }
        SEAM(base + 0);
        if (RUN(base + 1)) {
            PHASE_ENTER();
            pg8::Gemm g{H, gla ? (const bf16*)(ws + WS_WGIN + j * WGIN_STRIDE) : (const bf16*)(ws + WS_WQKV + j * WQKV_STRIDE), M_ALL, gla ? NGLA_EXT : NQKV, DM};
            pg8::StaticOrder S; S.init(g.M, g.N, w.G, (int)blockIdx.x);
            pg8::EpiStoreBf16 E{P, gla ? NGLA : NQKV, gla ? NGLA : (1 << 30), Z1};
            pg8::gemm_phase<pg8::EpiStoreBf16, pg8::StaticOrder, true, true>(w.lds, g, S, E);
        }
        SEAM(base + 1);
        if (RUN(base + 2)) {
            PHASE_ENTER();
            if (!gla) { rope_rows(w, P);
#if !NAIVE_ATTN
                attn_vt(w, P, (bf16*)(ws + WS_VTA));
#endif
            }
#if !NAIVE_GLA
            else { gla_pre(w, P, Z1, args.in[17] + (size_t)j * 16 * 1024, args.in[18] + j * 1024, args.in[20] + (size_t)j * 16 * 1024, args.in[21] + j * 1024,
                           (bf16*)(ws + WS_QT), (bf16*)(ws + WS_KHT), (bf16*)(ws + WS_AIN), (float*)(ws + WS_DEC));
                   gla_vt(w, P, (bf16*)(ws + WS_VT)); }
#endif
        }
        if (!gla || !NAIVE_GLA) SEAM(base + 2);
        if (RUN(base + 3)) {
            PHASE_ENTER();
#if NAIVE_ATTN
            if (!gla) attn_naive(w, P, args.in[13] + j * 16, OMIX);
#else
            if (!gla) attn_fast(w, P, (const bf16*)(ws + WS_VTA), args.in[13] + j * 16, OMIX);
#endif
#if NAIVE_GLA
            else gla_naive(w, P, Z1, args.in[17] + (size_t)j * 16 * 1024, args.in[18] + j * 1024, args.in[20] + (size_t)j * 16 * 1024, args.in[21] + j * 1024, OF, OB);
#else
            else gla_scan(w, (const bf16*)(ws + WS_QT), (const bf16*)(ws + WS_KHT), (const bf16*)(ws + WS_AIN), (const float*)(ws + WS_DEC), (const bf16*)(ws + WS_VT), (bf16*)(ws + WS_OFB), (bf16*)(ws + WS_OBB));
#endif
        }
        SEAM(base + 3);
#if NAIVE_GLA
        if (RUN(base + 4)) { if (gla) { PHASE_ENTER(); gla_combine(w, OF, OB, P, args.in[22] + j * 512, OMIX, mrows); } }
#else
        if (RUN(base + 4)) { if (gla) { PHASE_ENTER(); gla_combine_bf(w, (const bf16*)(ws + WS_OFB), (const bf16*)(ws + WS_OBB), P, args.in[22] + j * 512, OMIX, mrows); } }
#endif
        if (gla) SEAM(base + 4);
        if (RUN(base + 5)) {
            PHASE_ENTER();
            pg8::Gemm g{OMIX, gla ? (const bf16*)(ws + WS_WGO + j * WO_STRIDE) : (const bf16*)(ws + WS_WAO + j * WO_STRIDE), mrows, DM, DM};
            pg8::StaticOrder S; S.init(g.M, g.N, w.G, (int)blockIdx.x);
            pg8::EpiResid E{X, DM, MODS + mods_off + 2 * DM};
            pg8::gemm_phase<pg8::EpiResid, pg8::StaticOrder, true, true>(w.lds, g, S, E);
        }
        SEAM(base + 5);
        if (RUN(base + 6)) { PHASE_ENTER(); const float* mods_l = MODS + mods_off; norm_rows(w, X, H, args.in[7] + l * DM, mods_l + 3 * DM, mods_l + 4 * DM, mrows); }
        SEAM(base + 6);
        if (RUN(base + 7)) {
            PHASE_ENTER();
            pg8::Gemm g{H, (const bf16*)(ws + WS_WUP + l * WUP_STRIDE), mrows, DFF2, DM};
            pg8::StaticOrder S; S.init(g.M, g.N, w.G, (int)blockIdx.x);
            pg8::EpiStoreBf16 E{U, DFF2, 1 << 30, Z1};
            pg8::gemm_phase<pg8::EpiStoreBf16, pg8::StaticOrder, true, true>(w.lds, g, S, E);
        }
        SEAM(base + 7);
        if (RUN(base + 8)) { PHASE_ENTER(); conv_rows(w, U, args.in[9] + (size_t)l * 3 * DFF2, args.in[10] + (size_t)l * DFF2, ACT, mrows); }
        SEAM(base + 8);
        if (RUN(base + 9)) {
            PHASE_ENTER();
            pg8::Gemm g{ACT, (const bf16*)(ws + WS_WDN + l * WDN_STRIDE), mrows, DM, DFF};
            pg8::StaticOrder S; S.init(g.M, g.N, w.G, (int)blockIdx.x);
            pg8::EpiResid E{X, DM, MODS + mods_off + 5 * DM};
            pg8::gemm_phase<pg8::EpiResid, pg8::StaticOrder, true, true>(w.lds, g, S, E);
        }
        SEAM(base + 9);
    }
    if (RUN(41)) { PHASE_ENTER(); final_norm(w, X, args.out, args.in[24]); }
#undef RUN
#undef SEAM
}

extern "C" void kernel_launch(void* const* d_in, const int* in_sizes, int n_in, void* d_out, int out_size, void* d_ws, size_t ws_size, hipStream_t stream) {
    static int grid = 0;
    if (grid == 0) {
        if (n_in != 25 || out_size != M_LAT * DM || ws_size < WS_END) { fprintf(stderr, "kernel_launch: unexpected shapes (n_in %d, out %d, ws %zu < %zu); nothing launched\n", n_in, out_size, ws_size, (size_t)WS_END); grid = -1; return; }
        int dev = 0, cus = 0, per_cu = 0;
        if (hipGetDevice(&dev) != hipSuccess || hipDeviceGetAttribute(&cus, hipDeviceAttributeMultiprocessorCount, dev) != hipSuccess) { grid = -1; return; }
        if (hipFuncSetAttribute((const void*)mega, hipFuncAttributeMaxDynamicSharedMemorySize, LDS_BYTES) != hipSuccess) { fprintf(stderr, "kernel_launch: hipFuncSetAttribute failed\n"); grid = -1; return; }
        if (hipOccupancyMaxActiveBlocksPerMultiprocessor(&per_cu, (const void*)mega, 512, LDS_BYTES) != hipSuccess || per_cu < 1)
            fprintf(stderr, "kernel_launch: occupancy query reports %d workgroups per CU\n", per_cu);
        (void)hipGetLastError();
        grid = cus;
    }
    if (grid < 0) return;
    if (hipMemsetAsync((char*)d_ws + WS_CTL, 0, CTL_ZERO_BYTES, stream) != hipSuccess) return;
    Args a{};
    for (int i = 0; i < 25; ++i) a.in[i] = (const float*)d_in[i];
    a.out = (float*)d_out; a.ws = (unsigned char*)d_ws;
#if MK_ONE_LAUNCH
    a.ph_lo = 0; a.ph_hi = NPH;
    hipLaunchKernelGGL(mega, dim3(grid), dim3(512), LDS_BYTES, stream, a);
#else
    for (int ph = 0; ph < NPH; ++ph) {
        if (ph >= 1 && ph <= 40) { const int l = (ph - 1) / 10, s = (ph - 1) % 10; if ((s == 2 && (l & 1) && NAIVE_GLA) || (s == 4 && !(l & 1))) continue; }
        a.ph_lo = ph; a.ph_hi = ph + 1;
        hipLaunchKernelGGL(mega, dim3(grid), dim3(512), LDS_BYTES, stream, a);
    }
#endif
}
```

```cpp
#include <hip/hip_runtime.h>
#include <cstdio>
#include <cstdint>
namespace pg8 {
#define PG8_LAS __attribute__((address_space(3)))
typedef unsigned short bf16_t;
typedef short bf16x8 __attribute__((ext_vector_type(8)));
typedef float f32x4 __attribute__((ext_vector_type(4)));
typedef unsigned u32x4 __attribute__((ext_vector_type(4)));
constexpr int BM = 256, BK = 64, HALF = 128, HTB = HALF * BK * 2  , STAGE_BYTES = 8 * HTB, NXCD = 8, WGM = 8;

__host__ __device__ __forceinline__ int lds_byte(int r, int c) { const int st = (r >> 4) * 2 + (c >> 5), rr = r & 15, cc = c & 31, ob = rr * 64 + cc * 2; return st * 1024 + (ob ^ (((ob >> 9) & 1) << 5)); }
__host__ __device__ __forceinline__ void stage_rc(int b, int& R, int& C) { const int st = b / 1024, sb = b % 1024, swz = sb ^ (((sb >> 9) & 1) << 5); R = (st >> 1) * 16 + swz / 64; C = (st & 1) * 32 + (swz % 64) / 2; }
__host__ __device__ __forceinline__ int perm32(int rho) { const int n = rho >> 4, i = rho & 15; return 8 * (i >> 2) + 4 * n + (i & 3); }

struct Unit { int pm, pn, kofs; };
struct Gemm { const bf16_t* A; const bf16_t* Bt; int M, N, K, kloop; };

struct StaticOrder {
    int nM, nN, nwg, G, c;
    __host__ __device__ void init(int M, int N, int G_, int c_) { nM = M / BM; nN = N / BM; nwg = nM * nN; G = G_; c = c_; }
    __host__ __device__ bool next(int i, Unit& u) const {
        const long L = (long)i * G + c; if (L >= nwg) return false;
        int wgid = (int)L; { const int q = nwg / NXCD, r = nwg % NXCD, xcd = wgid % NXCD, off = wgid / NXCD; wgid = (xcd < r ? xcd * (q + 1) : r * (q + 1) + (xcd - r) * q) + off; }
        const int nig = WGM * nN, gid = wgid / nig, fm = gid * WGM, gsz = (nM - fm) < WGM ? (nM - fm) : WGM;
        u.pm = fm + ((wgid % nig) % gsz); u.pn = (wgid % nig) / gsz; u.kofs = 0; return true;
    }
    __device__ __forceinline__ void a_ready(const Unit&) const {}
    __device__ __forceinline__ void done(const Unit&) const {}
};

struct SplitKOrder {
    int nN, nunits, nsplit, kloop, G, c;
    __host__ __device__ void init(int M, int N, int nsplit_, int kloop_, int G_, int c_) { nN = N / BM; nunits = (M / BM) * nN * nsplit_; nsplit = nsplit_; kloop = kloop_; G = G_; c = c_; }
    __host__ __device__ bool next(int i, Unit& u) const { const long L = (long)i * G + c; if (L >= nunits) return false; const int t = (int)L / nsplit, ks = (int)L % nsplit; u.pm = t / nN; u.pn = t % nN; u.kofs = ks * kloop; return true; }
    __device__ __forceinline__ void a_ready(const Unit&) const {}
    __device__ __forceinline__ void done(const Unit&) const {}
};
typedef __bf16 bf16x2_hw __attribute__((ext_vector_type(2)));
typedef float f32x2_hw __attribute__((ext_vector_type(2)));
__device__ __forceinline__ unsigned cvt_pk_bf16(float lo, float hi) { const f32x2_hw v = {lo, hi}; return __builtin_bit_cast(unsigned, __builtin_convertvector(v, bf16x2_hw)); }
typedef float f32x2 __attribute__((ext_vector_type(2)));

struct EpiStoreBf16 {
    static constexpr bool PERM = true, AFTER_DRAIN = false;
    bf16_t* O; int ldc; int zcol0; float* Z;
    __device__ __forceinline__ void operator()(const f32x4 (&acc)[2][2][4][2], const Unit& u, int wr, int wc, int fr, int fq) const {
        const int row0 = u.pm * BM + wr * 64 + fr; const int colt = u.pn * BM;
        if (colt >= zcol0) {
            if (wc == 0) {
#pragma unroll
                for (int ai = 0; ai < 2; ++ai)
#pragma unroll
                    for (int m = 0; m < 4; ++m) { float* zp = Z + (size_t)(row0 + ai * HALF + m * 16) * 32 + 8 * fq;
                        *(f32x4*)(zp) = acc[ai][0][m][0]; *(f32x4*)(zp + 4) = acc[ai][0][m][1]; }
            }
            return;
        }
        const int col0 = colt + wc * 32 + 8 * fq;
#pragma unroll
        for (int ai = 0; ai < 2; ++ai)
#pragma unroll
            for (int m = 0; m < 4; ++m) { bf16_t* rowp = O + (size_t)(row0 + ai * HALF + m * 16) * ldc + col0;
#pragma unroll
                for (int bj = 0; bj < 2; ++bj) { const f32x4 v0 = acc[ai][bj][m][0], v1 = acc[ai][bj][m][1];
                    u32x4 w; w.x = cvt_pk_bf16(v0[0], v0[1]); w.y = cvt_pk_bf16(v0[2], v0[3]); w.z = cvt_pk_bf16(v1[0], v1[1]); w.w = cvt_pk_bf16(v1[2], v1[3]);
                    *(u32x4*)(rowp + bj * HALF) = w; } }
    }
};
struct EpiResid {
    static constexpr bool PERM = false, AFTER_DRAIN = false;
    float* X; int ldc; const float* gate;
    __device__ __forceinline__ void operator()(const f32x4 (&acc)[2][2][4][2], const Unit& u, int wr, int wc, int fr, int fq) const {
        const int row0 = u.pm * BM + wr * 64 + fr, col0 = u.pn * BM + wc * 32 + 4 * fq;
        const int vec = u.pm < 64 ? (u.pm >> 4) : 4;
        const float* g = gate + (size_t)vec * 12288 + col0;
        f32x4 gv[2][2];
#pragma unroll
        for (int bj = 0; bj < 2; ++bj)
#pragma unroll
            for (int n = 0; n < 2; ++n) gv[bj][n] = *(const f32x4*)(g + bj * HALF + n * 16);
#pragma unroll
        for (int ai = 0; ai < 2; ++ai)
#pragma unroll
            for (int m = 0; m < 4; ++m) { float* rowp = X + (size_t)(row0 + ai * HALF + m * 16) * ldc + col0;
#pragma unroll
                for (int bj = 0; bj < 2; ++bj)
#pragma unroll
                    for (int n = 0; n < 2; ++n) { float* p = rowp + bj * HALF + n * 16; *(f32x4*)p = *(const f32x4*)p + gv[bj][n] * acc[ai][bj][m][n]; } }
    }
};
struct EpiPartial {
    static constexpr bool PERM = false, AFTER_DRAIN = false;
    float* PART; int ldc; int kloop; size_t slab;
    __device__ __forceinline__ void operator()(const f32x4 (&acc)[2][2][4][2], const Unit& u, int wr, int wc, int fr, int fq) const {
        const int row0 = u.pm * BM + wr * 64 + fr, col0 = u.pn * BM + wc * 32 + 4 * fq;
        float* base = PART + (size_t)(u.kofs / kloop) * slab;
#pragma unroll
        for (int ai = 0; ai < 2; ++ai)
#pragma unroll
            for (int m = 0; m < 4; ++m) { float* rowp = base + (size_t)(row0 + ai * HALF + m * 16) * ldc + col0;
#pragma unroll
                for (int bj = 0; bj < 2; ++bj)
#pragma unroll
                    for (int n = 0; n < 2; ++n) *(f32x4*)(rowp + bj * HALF + n * 16) = acc[ai][bj][m][n]; }
    }
};
template <class Epi, class Sched, bool ALIGN_EPI = false, bool SP2 = false>
__device__ __forceinline__ void gemm_phase(PG8_LAS unsigned char* lds, const Gemm g, const Sched& S, const Epi& E) {
    int tid_l = threadIdx.x; asm volatile("" : "+v"(tid_l));
    const int tid = tid_l, wid = __builtin_amdgcn_readfirstlane(tid >> 6), lane = tid & 63, wr = wid >> 2, wc = wid & 3, fr = lane & 15, fq = lane >> 4;
    const int K = g.K, nt = g.kloop / BK;
    unsigned voffA[2], voffB[2];
#pragma unroll
    for (int i = 0; i < 2; ++i) { int R, C; stage_rc(tid * 16 + i * 8192, R, C); const int Rb = Epi::PERM ? ((R & ~31) + perm32(R & 31)) : R;
        voffA[i] = (unsigned)(R * K + C) * 2u; voffB[i] = (unsigned)(Rb * K + C) * 2u; }
    const size_t kstep = (size_t)(BK * 2);
    const size_t hstep = (size_t)HALF * K * 2;
    const size_t tstep = 2 * hstep;
    const unsigned ldsw = (unsigned)wid * 1024u;
    const int aoff = lds_byte(wr * 64 + fr, fq * 8), boff = lds_byte(wc * 32 + fr, fq * 8);
#define PG8_SA(b, h) (((b) * 2 + (h)) * HTB)
#define PG8_SB(b, h) ((4 + (b) * 2 + (h)) * HTB)
#define PG8_STAGE(bufoff, gbase, voff) do { _Pragma("unroll") for (int _i = 0; _i < 2; ++_i) \
        __builtin_amdgcn_global_load_lds((const unsigned*)((const char*)(gbase) + (voff)[_i]), (PG8_LAS unsigned*)(lds + (bufoff) + ldsw + _i * 8192), 16, 0, 0); } while (0)
#define PG8_LDA(dst, b, h) do { _Pragma("unroll") for (int m = 0; m < 4; ++m) _Pragma("unroll") for (int k = 0; k < 2; ++k) dst[m][k] = *(const PG8_LAS bf16x8*)(lds + PG8_SA(b, h) + aoff + m * 2048 + k * 1024); } while (0)
#define PG8_LDB(dst, b, h) do { _Pragma("unroll") for (int n = 0; n < 2; ++n) _Pragma("unroll") for (int k = 0; k < 2; ++k) dst[n][k] = *(const PG8_LAS bf16x8*)(lds + PG8_SB(b, h) + boff + n * 2048 + k * 1024); } while (0)
#define PG8_MMA(ai, bj, At, Bt) do { __builtin_amdgcn_s_setprio(1); _Pragma("unroll") for (int m = 0; m < 4; ++m) _Pragma("unroll") for (int n = 0; n < 2; ++n) _Pragma("unroll") for (int k = 0; k < 2; ++k) \
        acc[ai][bj][m][n] = __builtin_amdgcn_mfma_f32_16x16x32_bf16(Bt[n][k], At[m][k], acc[ai][bj][m][n], 0, 0, 0); __builtin_amdgcn_s_setprio(0); } while (0)
#define PG8_WAIT_V(n) asm volatile("s_waitcnt vmcnt(" #n ")" ::: "memory")
#define PG8_WAIT_L(n) asm volatile("s_waitcnt lgkmcnt(" #n ")" ::: "memory")
#define PG8_BAR __builtin_amdgcn_s_barrier()
#define PG8_SCHED __builtin_amdgcn_sched_barrier(0)
    Unit cur, nxt; int ui = 0;
    if (!S.next(0, cur)) return;
    f32x4 acc[2][2][4][2];
#pragma unroll
    for (int a = 0; a < 2; ++a)
#pragma unroll
        for (int b = 0; b < 2; ++b)
#pragma unroll
            for (int m = 0; m < 4; ++m)
#pragma unroll
                for (int n = 0; n < 2; ++n) acc[a][b][m][n] = (f32x4){0.f, 0.f, 0.f, 0.f};
    bf16x8 At[4][2], B0[2][2], B1[2][2];
    const char* cA = (const char*)g.A + (size_t)cur.pm * tstep + (size_t)cur.kofs * 2; const char* cB = (const char*)g.Bt + (size_t)cur.pn * tstep + (size_t)cur.kofs * 2;
    S.a_ready(cur);
    if constexpr (SP2) {
        PG8_STAGE(PG8_SB(0, 0), cB, voffB); PG8_STAGE(PG8_SB(0, 1), cB + hstep, voffB); PG8_STAGE(PG8_SA(0, 0), cA, voffA); PG8_STAGE(PG8_SA(0, 1), cA + hstep, voffA);
        if (wr == 1) PG8_BAR;
        PG8_WAIT_V(2); PG8_BAR;
        PG8_STAGE(PG8_SB(1, 0), cB + kstep, voffB); PG8_STAGE(PG8_SA(1, 0), cA + kstep, voffA); PG8_STAGE(PG8_SB(1, 1), cB + hstep + kstep, voffB);
        PG8_WAIT_V(6); PG8_BAR;
    } else {
        PG8_STAGE(PG8_SB(0, 0), cB, voffB); PG8_STAGE(PG8_SA(0, 0), cA, voffA); PG8_STAGE(PG8_SB(0, 1), cB + hstep, voffB); PG8_STAGE(PG8_SA(0, 1), cA + hstep, voffA);
        if (wr == 1) PG8_BAR;
        PG8_WAIT_V(4); PG8_BAR;
        PG8_STAGE(PG8_SB(1, 0), cB + kstep, voffB); PG8_STAGE(PG8_SA(1, 0), cA + kstep, voffA); PG8_STAGE(PG8_SB(1, 1), cB + hstep + kstep, voffB);
        PG8_WAIT_V(6); PG8_BAR;
    }
    for (;;) {
        const bool has_next = S.next(ui + 1, nxt);
        const char* nA = has_next ? (const char*)g.A + (size_t)nxt.pm * tstep + (size_t)nxt.kofs * 2 : cA; const char* nB = has_next ? (const char*)g.Bt + (size_t)nxt.pn * tstep + (size_t)nxt.kofs * 2 : cB;
        for (int t = 0; t < nt; t += 2) {
            const bool last = (t == nt - 2);
            const char* a1 = cA + (size_t)(t + 1) * kstep;
            const char* a2 = last ? nA : cA + (size_t)(t + 2) * kstep; const char* b2 = last ? nB : cB + (size_t)(t + 2) * kstep;
            const char* a3 = a2 + kstep; const char* b3 = b2 + kstep;
            if (last && has_next) S.a_ready(nxt);
            if constexpr (SP2) {
            PG8_LDB(B0, 0, 0); PG8_LDB(B1, 0, 1); PG8_SCHED; PG8_LDA(At, 0, 0); PG8_STAGE(PG8_SA(1, 1), a1 + hstep, voffA);
            PG8_WAIT_V(8); PG8_WAIT_L(0); PG8_BAR; PG8_MMA(0, 0, At, B0); PG8_MMA(0, 1, At, B1); PG8_BAR; PG8_SCHED;
            PG8_LDA(At, 0, 1); PG8_STAGE(PG8_SB(0, 0), b2, voffB); PG8_STAGE(PG8_SB(0, 1), b2 + hstep, voffB); PG8_STAGE(PG8_SA(0, 0), a2, voffA);
            PG8_WAIT_V(8); PG8_WAIT_L(0); PG8_BAR; PG8_MMA(1, 0, At, B0); PG8_MMA(1, 1, At, B1); PG8_BAR; PG8_SCHED;
            PG8_LDB(B0, 1, 0); PG8_LDB(B1, 1, 1); PG8_SCHED; PG8_LDA(At, 1, 0); PG8_STAGE(PG8_SA(0, 1), a2 + hstep, voffA);
            PG8_WAIT_V(8); PG8_WAIT_L(0); PG8_BAR; PG8_MMA(0, 0, At, B0); PG8_MMA(0, 1, At, B1); PG8_BAR; PG8_SCHED;
            PG8_LDA(At, 1, 1); PG8_STAGE(PG8_SB(1, 0), b3, voffB); PG8_STAGE(PG8_SB(1, 1), b3 + hstep, voffB); PG8_STAGE(PG8_SA(1, 0), a3, voffA);
            PG8_WAIT_V(8); PG8_WAIT_L(0); PG8_BAR; PG8_MMA(1, 0, At, B0); PG8_MMA(1, 1, At, B1); PG8_BAR; PG8_SCHED;
            } else {
            PG8_LDB(B0, 0, 0); PG8_SCHED; PG8_LDA(At, 0, 0); PG8_STAGE(PG8_SA(1, 1), a1 + hstep, voffA);
            PG8_WAIT_L(8); PG8_BAR; PG8_WAIT_L(0); PG8_MMA(0, 0, At, B0); PG8_BAR; PG8_SCHED;
            PG8_LDB(B1, 0, 1); PG8_STAGE(PG8_SB(0, 0), b2, voffB);
            PG8_BAR; PG8_WAIT_L(0); PG8_MMA(0, 1, At, B1); PG8_BAR;
            PG8_LDA(At, 0, 1); PG8_STAGE(PG8_SA(0, 0), a2, voffA);
            PG8_BAR; PG8_WAIT_L(0); PG8_MMA(1, 0, At, B0); PG8_BAR; PG8_SCHED;
            PG8_STAGE(PG8_SB(0, 1), b2 + hstep, voffB);
            PG8_WAIT_V(6); PG8_BAR; PG8_MMA(1, 1, At, B1); PG8_BAR;
            PG8_LDB(B0, 1, 0); PG8_SCHED; PG8_LDA(At, 1, 0); PG8_STAGE(PG8_SA(0, 1), a2 + hstep, voffA);
            PG8_WAIT_L(8); PG8_BAR; PG8_WAIT_L(0); PG8_MMA(0, 0, At, B0); PG8_BAR; PG8_SCHED;
            PG8_LDB(B1, 1, 1); PG8_STAGE(PG8_SB(1, 0), b3, voffB);
            PG8_BAR; PG8_WAIT_L(0); PG8_MMA(0, 1, At, B1); PG8_BAR;
            PG8_LDA(At, 1, 1); PG8_STAGE(PG8_SA(1, 0), a3, voffA);
            PG8_BAR; PG8_WAIT_L(0); PG8_MMA(1, 0, At, B0); PG8_BAR; PG8_SCHED;
            PG8_STAGE(PG8_SB(1, 1), b3 + hstep, voffB);
            PG8_WAIT_V(6); PG8_BAR; PG8_MMA(1, 1, At, B1); PG8_BAR;
            }
        }
        if constexpr (ALIGN_EPI) { if (wr == 0) PG8_BAR; }
        if constexpr (!Epi::AFTER_DRAIN) { E(acc, cur, wr, wc, fr, fq); S.done(cur); }
        if (!has_next) break;
#pragma unroll
        for (int a = 0; a < 2; ++a)
#pragma unroll
            for (int b = 0; b < 2; ++b)
#pragma unroll
                for (int m = 0; m < 4; ++m)
#pragma unroll
                    for (int n = 0; n < 2; ++n) acc[a][b][m][n] = (f32x4){0.f, 0.f, 0.f, 0.f};
        cur = nxt; cA = nA; cB = nB; ++ui;
        if constexpr (ALIGN_EPI) { if (wr == 1) PG8_BAR; }
    }
    PG8_WAIT_V(0);
    if constexpr (!ALIGN_EPI) { if (wr == 0) PG8_BAR; }
    PG8_BAR;
    if constexpr (Epi::AFTER_DRAIN) { E.fused(acc, cur, wr, wc, fr, fq, lds, wid, lane); S.done(cur); }
#undef PG8_SA
#undef PG8_SB
#undef PG8_STAGE
#undef PG8_LDA
#undef PG8_LDB
#undef PG8_MMA
#undef PG8_WAIT_V
#undef PG8_WAIT_L
#undef PG8_BAR
#undef PG8_SCHED
}
}
#define LAS __attribute__((address_space(3)))
#define XB_TMO      128
#define XB_XCNT(j)  (256  + 64 * (j))
#define XB_XSUB(j)  (1280 + 64 * (j))
#define XB_XGEN(j)  (2304 + 64 * (j))
#define XB_TOP      3328
#define XB_TOPGEN   3392
#define XCD_BAR_WORDS 3456
#define XB_SPIN_CAP (1u << 18)

__device__ __forceinline__ unsigned xb_ld(unsigned* p)              { return __hip_atomic_load(p, __ATOMIC_RELAXED, __HIP_MEMORY_SCOPE_AGENT); }
__device__ __forceinline__ unsigned xb_add(unsigned* p, unsigned v) { return __hip_atomic_fetch_add(p, v, __ATOMIC_RELAXED, __HIP_MEMORY_SCOPE_AGENT); }
__device__ __forceinline__ unsigned xb_xcc_id() { return (unsigned)__builtin_amdgcn_s_getreg((3 << 11) | 20) & 0xFu; }
#define XB_SPIN(cond, bar) do { unsigned _sp = 0; while (cond) { __builtin_amdgcn_s_sleep(1); \
    if ((++_sp & 255u) == 0u) { if (xb_ld(&(bar)[XB_TMO])) break; if (_sp > XB_SPIN_CAP) { atomicAdd(&(bar)[XB_TMO], 1u); break; } } } } while (0)

struct XcdBarrier {
    unsigned* bar; unsigned x;
    volatile LAS unsigned* st;
};

__device__ __forceinline__ XcdBarrier xcd_barrier_post(unsigned* bar, volatile LAS unsigned* st) {
    XcdBarrier b; b.bar = bar; b.x = xb_xcc_id(); b.st = st;
    if (threadIdx.x == 0) (void)xb_add(&bar[XB_XCNT(b.x)], 1u);
    return b;
}
__device__ __forceinline__ void xcd_barrier_complete(unsigned* bar, unsigned x, unsigned& nloc, unsigned& nx) {
    const unsigned G = gridDim.x * gridDim.y * gridDim.z;
    unsigned sum, cnt, mine, sp = 0u;
    for (;;) {
        sum = 0u; cnt = 0u; mine = 0u;
#pragma unroll
        for (unsigned j = 0; j < 16; ++j) { const unsigned c = xb_ld(&bar[XB_XCNT(j)]); sum += c; cnt += (c > 0u) ? 1u : 0u; mine = (j == x) ? c : mine; }
        if (sum == G) break;
        __builtin_amdgcn_s_sleep(1);
        if ((++sp & 255u) == 0u) { if (xb_ld(&bar[XB_TMO])) break; if (sp > XB_SPIN_CAP) { atomicAdd(&bar[XB_TMO], 1u); break; } }
    }
    nloc = mine > 0u ? mine : 1u; nx = cnt > 0u ? cnt : 1u;
}

__device__ __forceinline__ void xcd_barrier(const XcdBarrier& b) {
    asm volatile("s_waitcnt vmcnt(0)" ::: "memory");
    __syncthreads();
    if (threadIdx.x == 0) {
        unsigned* bar = b.bar;
        __builtin_amdgcn_s_waitcnt(0);
        unsigned nloc = b.st[0], nx = b.st[1];
        if (nloc == 0u) { xcd_barrier_complete(bar, b.x, nloc, nx); b.st[0] = nloc; b.st[1] = nx; }
        const unsigned old = xb_add(&bar[XB_XSUB(b.x)], 1u);
        const unsigned gen = old / nloc;
        if (old + 1u == (gen + 1u) * nloc) {
            __builtin_amdgcn_fence(__ATOMIC_RELEASE, "agent");
            asm volatile("s_waitcnt vmcnt(0)" ::: "memory");
            const unsigned og = xb_add(&bar[XB_TOP], 1u);
            const unsigned tg = og / nx;
            if (og + 1u == (tg + 1u) * nx) xb_add(&bar[XB_TOPGEN], 1u);
            else XB_SPIN(xb_ld(&bar[XB_TOPGEN]) == tg, bar);
            __builtin_amdgcn_fence(__ATOMIC_ACQUIRE, "agent");
            xb_add(&bar[XB_XGEN(b.x)], 1u);
            asm volatile("s_waitcnt vmcnt(0)" ::: "memory");
        } else {
            XB_SPIN(xb_ld(&bar[XB_XGEN(b.x)]) == gen, bar);
            __builtin_amdgcn_fence(__ATOMIC_ACQUIRE, "agent");
            asm volatile("s_waitcnt vmcnt(0)" ::: "memory");
        }
    }
    __syncthreads();
}

constexpr int DM = 2048, NB = 4, SEQ = 4096, CTXL = 256, DEPTH = 4;
constexpr int M_LAT = NB * SEQ, M_CTX = NB * CTXL, M_ALL = M_LAT + M_CTX;
constexpr int DFF = 5632, DFF2 = 2 * DFF, NQKV = 3072, NGLA = 6144, NGLA_EXT = 6400, NMOD = 6 * DM;
constexpr float EPS = 1e-6f;
#ifndef MK_ONE_LAUNCH
#define MK_ONE_LAUNCH 1
#endif
#ifndef NAIVE_ATTN
#define NAIVE_ATTN 0
#endif
#ifndef NAIVE_GLA
#define NAIVE_GLA 0
#endif
#ifndef RPT_PRO
#define RPT_PRO 1
#endif
#ifndef RPT_NORM
#define RPT_NORM 1
#endif
#ifndef RPT_ATT
#define RPT_ATT 1
#endif
#ifndef RPT_GPRE
#define RPT_GPRE 1
#endif
#ifndef RPT_SCAN
#define RPT_SCAN 1
#endif
#ifndef RPT_COMB
#define RPT_COMB 1
#endif
#ifndef RPT_UP
#define RPT_UP 1
#endif
#ifndef RPT_CONV
#define RPT_CONV 1
#endif
#ifndef RPT_PROJ
#define RPT_PROJ 1
#endif
#ifndef RPT_WO
#define RPT_WO 0
#endif
#ifndef RPT_DN
#define RPT_DN 0
#endif
#ifndef DIAG_SCAN
#define DIAG_SCAN 0
#endif
#ifndef SPLITK_CTX
#define SPLITK_CTX 0
#endif
constexpr int NPH = 42;

constexpr size_t MiB = 1u << 20;
constexpr size_t WS_CTL = 0, CTL_ZERO_BYTES = 1 * MiB;
constexpr size_t WS_MODS = 1 * MiB;
constexpr size_t WS_X = 2 * MiB;
constexpr size_t WS_H = 138 * MiB;
constexpr size_t WS_P = 206 * MiB;
constexpr size_t WS_Z1 = 410 * MiB;
constexpr size_t WS_OMIX = 413 * MiB;
constexpr size_t WS_U = 481 * MiB;
constexpr size_t WS_OF = WS_U, WS_OB = WS_U + 136 * MiB;
constexpr size_t WS_PART = WS_U;
constexpr size_t WS_VTA = WS_U;
constexpr size_t WS_QT = WS_U;
constexpr size_t WS_KHT = WS_U + 68 * MiB;
constexpr size_t WS_AIN = WS_U + 136 * MiB;
constexpr size_t WS_DEC = WS_U + 153 * MiB;
constexpr size_t WS_VT = WS_U + 156 * MiB;
constexpr size_t WS_OFB = WS_U + 224 * MiB, WS_OBB = WS_U + 292 * MiB;
constexpr size_t WS_ACT = 855 * MiB;
constexpr size_t WS_WUP = 1042 * MiB, WUP_STRIDE = 44 * MiB;
constexpr size_t WS_WDN = 1218 * MiB, WDN_STRIDE = 22 * MiB;
constexpr size_t WS_WQKV = 1306 * MiB, WQKV_STRIDE = 12 * MiB;
constexpr size_t WS_WAO = 1330 * MiB, WO_STRIDE = 8 * MiB;
constexpr size_t WS_WGIN = 1346 * MiB, WGIN_STRIDE = 25 * MiB;
constexpr size_t WS_WGO = 1396 * MiB;
constexpr size_t WS_END = 1412 * MiB;
constexpr int CW_BAR = 4096;

constexpr int RING_BYTES = 131072, LDSCTL_OFF = RING_BYTES, LDS_BYTES = 147456;

#define GAS __attribute__((address_space(1)))
#define LAS __attribute__((address_space(3)))
typedef unsigned short bf16;
typedef unsigned v4u __attribute__((ext_vector_type(4)));
typedef unsigned v2u __attribute__((ext_vector_type(2)));
typedef float f32x4 __attribute__((ext_vector_type(4)));
#define LDS_WAIT() asm volatile("s_waitcnt lgkmcnt(0)" ::: "memory")
__device__ __forceinline__ unsigned pk2(float lo, float hi) { return pg8::cvt_pk_bf16(lo, hi); }
__device__ __forceinline__ unsigned f2bf(float f) { return pk2(f, 0.f) & 0xffffu; }
__device__ __forceinline__ float bf_lo(unsigned w) { return __builtin_bit_cast(float, w << 16); }
__device__ __forceinline__ float bf_hi(unsigned w) { return __builtin_bit_cast(float, w & 0xffff0000u); }
__device__ __forceinline__ float bf2f(bf16 h) { return __builtin_bit_cast(float, ((unsigned)h) << 16); }
__device__ __forceinline__ float silu_f(float v) { return v / (1.0f + __expf(-v)); }
__device__ __forceinline__ float wave_sum(float v) {
#pragma unroll
    for (int o = 1; o < 64; o <<= 1) v += __shfl_xor(v, o);
    return v;
}

struct Args { const float* in[25]; float* out; unsigned char* ws; int ph_lo, ph_hi; };
struct WV { int tid, lane, wave, G, vcu, gw, NGW; LAS unsigned char* lds; };

__device__ __forceinline__ void p0_transpose_item(const float* W, int K, int N, bf16* WT, int row_off, LAS float* scr, int item, int lane) {
    const int nblk = N / 32, kb = item / nblk, nb = item % nblk, k0 = 64 * kb, n0 = 32 * nb;
#pragma unroll 8
    for (int i = 0; i < 32; ++i) { const int kk = 2 * i + (lane >> 5); scr[kk * 33 + (lane & 31)] = W[(size_t)(k0 + kk) * N + n0 + (lane & 31)]; }
    LDS_WAIT(); asm volatile("" ::: "memory");
    const int c = lane & 7;
#pragma unroll
    for (int j = 0; j < 4; ++j) { const int n = (lane >> 3) + 8 * j; const LAS float* s = scr + (8 * c) * 33 + n;
        v4u o; o.x = pk2(s[0 * 33], s[1 * 33]); o.y = pk2(s[2 * 33], s[3 * 33]); o.z = pk2(s[4 * 33], s[5 * 33]); o.w = pk2(s[6 * 33], s[7 * 33]);
        *(v4u*)(WT + (size_t)(row_off + n0 + n) * K + k0 + 8 * c) = o; }
    LDS_WAIT(); asm volatile("" ::: "memory");
}
__device__ __forceinline__ void transpose_matrix(const WV& w, const float* W, int K, int N, bf16* WT, int row_off) {
    LAS float* scr = (LAS float*)(w.lds + w.wave * 16384);
    const int nitems = (K / 64) * (N / 32);
    for (int it = w.gw; it < nitems; it += w.NGW) p0_transpose_item(W, K, N, WT, row_off, scr, it, w.lane);
}
__device__ __forceinline__ void mods_item(const WV& w, const float* c, const float* c_ctx, const float* ada_w, const float* ada_b, float* mods, int it) {
    const int layer = it / 48, n0 = (it % 48) * 256;
    LAS float* sl = (LAS float*)w.lds;
    LAS float* red = (LAS float*)(w.lds + 40960);
    for (int i = w.tid; i < 5 * DM; i += 512) { const int vec = i >> 11, k = i & 2047; const float v = vec < 4 ? c[vec * DM + k] : c_ctx[k]; sl[i] = silu_f(v); }
    __syncthreads();
    const float* Wp = ada_w + (size_t)layer * DM * NMOD + n0 + 4 * w.lane;
    f32x4 acc[5];
#pragma unroll
    for (int v = 0; v < 5; ++v) acc[v] = (f32x4){0.f, 0.f, 0.f, 0.f};
    const int kbeg = w.wave * 256;
    for (int k = kbeg; k < kbeg + 256; k += 4) {
        f32x4 wv[4];
#pragma unroll
        for (int kk = 0; kk < 4; ++kk) wv[kk] = *(const f32x4*)(Wp + (size_t)(k + kk) * NMOD);
#pragma unroll
        for (int kk = 0; kk < 4; ++kk)
#pragma unroll
            for (int v = 0; v < 5; ++v) acc[v] += wv[kk] * sl[v * DM + k + kk];
    }
#pragma unroll
    for (int v = 0; v < 5; ++v) *(LAS f32x4*)(red + (w.wave * 5 + v) * 256 + 4 * w.lane) = acc[v];
    __syncthreads();
    for (int i = w.tid; i < 5 * 256; i += 512) { const int vec = i >> 8, col = i & 255; float s = 0.f;
#pragma unroll
        for (int ww = 0; ww < 8; ++ww) s += red[(ww * 5 + vec) * 256 + col];
        mods[((size_t)layer * 5 + vec) * NMOD + n0 + col] = s + ada_b[(size_t)layer * NMOD + n0 + col]; }
    __syncthreads();
}

__device__ __forceinline__ void norm_rows(const WV& w, float* X, bf16* H, const float* g, const float* shift, const float* scale, int nrows, const float* part, int nsplit, const float* pgate) {
    for (int row = w.gw; row < nrows; row += w.NGW) {
        const int vec = row < M_LAT ? (row >> 12) : 4;
        f32x4* xr = (f32x4*)(X + (size_t)row * DM) + w.lane;
        f32x4 v[8]; float ss = 0.f;
#pragma unroll
        for (int j = 0; j < 8; ++j) v[j] = xr[64 * j];
        if (nsplit > 0 && row >= M_LAT) {
            const f32x4* pr = (const f32x4*)(part + (size_t)(row - M_LAT) * DM) + w.lane;
#pragma unroll
            for (int j = 0; j < 8; ++j) { f32x4 sum = pr[64 * j];
                for (int sl = 1; sl < nsplit; ++sl) sum += pr[(size_t)sl * (M_CTX * DM / 4) + 64 * j];
                v[j] += *(const f32x4*)(pgate + 4 * (64 * j + w.lane)) * sum; xr[64 * j] = v[j]; }
        }
#pragma unroll
        for (int j = 0; j < 8; ++j) ss += (v[j].x * v[j].x + v[j].y * v[j].y) + (v[j].z * v[j].z + v[j].w * v[j].w);
        const float r = 1.0f / sqrtf(wave_sum(ss) * (1.0f / DM) + EPS);
        const float* sh = shift + (size_t)vec * NMOD; const float* sc = scale + (size_t)vec * NMOD;
        v2u* o8 = (v2u*)(H + (size_t)row * DM) + w.lane;
#pragma unroll
        for (int j = 0; j < 8; ++j) { const int col = 4 * (64 * j + w.lane);
            const f32x4 gv = *(const f32x4*)(g + col), s = *(const f32x4*)(sc + col), t = *(const f32x4*)(sh + col);
            const f32x4 y = v[j] * r * gv * (s + 1.0f) + t;
            v2u o; o.x = pk2(y.x, y.y); o.y = pk2(y.z, y.w); o8[64 * j] = o; }
    }
}
__device__ __forceinline__ void final_norm(const WV& w, const float* X, float* out, const float* g) {
    for (int row = w.gw; row < M_LAT; row += w.NGW) {
        const f32x4* xr = (const f32x4*)(X + (size_t)row * DM) + w.lane;
        f32x4 v[8]; float ss = 0.f;
#pragma unroll
        for (int j = 0; j < 8; ++j) { v[j] = xr[64 * j]; ss += (v[j].x * v[j].x + v[j].y * v[j].y) + (v[j].z * v[j].z + v[j].w * v[j].w); }
        const float r = 1.0f / sqrtf(wave_sum(ss) * (1.0f / DM) + EPS);
        f32x4* o = (f32x4*)(out + (size_t)row * DM) + w.lane;
#pragma unroll
        for (int j = 0; j < 8; ++j) { const int col = 4 * (64 * j + w.lane); o[64 * j] = v[j] * r * *(const f32x4*)(g + col); }
    }
}

__device__ __forceinline__ void rope_rows(const WV& w, bf16* P) {
    const int half = w.lane >> 5, f = w.lane & 31;
    const float inv = exp2f(-(float)(2 * f) * (13.287712379549449f / 64.0f));
    for (int row = w.gw; row < M_LAT; row += w.NGW) {
        const int t = row & (SEQ - 1); const int pos = half ? (t & 63) : (t >> 6);
        const float ang = (float)pos * inv; const float c = __cosf(ang), s = __sinf(ang);
        bf16* p = P + (size_t)row * NQKV + half * 64 + f;
#pragma unroll 4
        for (int hh = 0; hh < 20; ++hh) { const float x1 = bf2f(p[hh * 128]), x2 = bf2f(p[hh * 128 + 32]);
            p[hh * 128] = (bf16)f2bf(x1 * c - x2 * s); p[hh * 128 + 32] = (bf16)f2bf(x2 * c + x1 * s); }
    }
}

__device__ __forceinline__ void attn_naive(const WV& w, const bf16* P, const float* sink, bf16* O) {
    const int g = w.lane >> 4, li = w.lane & 15;
    const float scale = 0.08838834764831845f;
    for (int task = w.gw; task < M_ALL * 16; task += w.NGW) {
        const int row = task >> 4, hq = task & 15, kvh = hq >> 2;
        float q[8];
        { const v4u qq = *(const v4u*)(P + (size_t)row * NQKV + hq * 128 + 8 * li);
          q[0] = bf_lo(qq.x) * scale; q[1] = bf_hi(qq.x) * scale; q[2] = bf_lo(qq.y) * scale; q[3] = bf_hi(qq.y) * scale;
          q[4] = bf_lo(qq.z) * scale; q[5] = bf_hi(qq.z) * scale; q[6] = bf_lo(qq.w) * scale; q[7] = bf_hi(qq.w) * scale; }
        int b, wbase = 0, nwin = 0;
        if (row < M_LAT) { b = row >> 12; const int t = row & (SEQ - 1); const int j0 = t - 128 < 0 ? 0 : t - 128, j1 = t + 128 > SEQ - 1 ? SEQ - 1 : t + 128; wbase = b * SEQ + j0; nwin = j1 - j0 + 1; }
        else b = (row - M_LAT) >> 8;
        const int cbase = M_LAT + b * CTXL, nk = nwin + CTXL;
        float m = sink[hq], l = (g == 0) ? 1.0f : 0.0f, o[8];
#pragma unroll
        for (int d = 0; d < 8; ++d) o[d] = 0.f;
        for (int i = g; i < nk; i += 4) {
            const int krow = i < nwin ? wbase + i : cbase + (i - nwin);
            const bf16* kp = P + (size_t)krow * NQKV + 2048 + kvh * 128 + 8 * li;
            const v4u kk = *(const v4u*)kp, vv = *(const v4u*)(kp + 512);
            float s = q[0] * bf_lo(kk.x) + q[1] * bf_hi(kk.x) + q[2] * bf_lo(kk.y) + q[3] * bf_hi(kk.y) + q[4] * bf_lo(kk.z) + q[5] * bf_hi(kk.z) + q[6] * bf_lo(kk.w) + q[7] * bf_hi(kk.w);
            s += __shfl_xor(s, 1); s += __shfl_xor(s, 2); s += __shfl_xor(s, 4); s += __shfl_xor(s, 8);
            const float mn = fmaxf(m, s), a = __expf(m - mn), p = __expf(s - mn);
            l = l * a + p; m = mn;
            o[0] = o[0] * a + p * bf_lo(vv.x); o[1] = o[1] * a + p * bf_hi(vv.x); o[2] = o[2] * a + p * bf_lo(vv.y); o[3] = o[3] * a + p * bf_hi(vv.y);
            o[4] = o[4] * a + p * bf_lo(vv.z); o[5] = o[5] * a + p * bf_hi(vv.z); o[6] = o[6] * a + p * bf_lo(vv.w); o[7] = o[7] * a + p * bf_hi(vv.w);
        }
        float ma = fmaxf(m, __shfl_xor(m, 16)); ma = fmaxf(ma, __shfl_xor(ma, 32));
        const float fsc = __expf(m - ma); l *= fsc; l += __shfl_xor(l, 16); l += __shfl_xor(l, 32);
        const float rl = 1.0f / l;
#pragma unroll
        for (int d = 0; d < 8; ++d) { float x = o[d] * fsc; x += __shfl_xor(x, 16); x += __shfl_xor(x, 32); o[d] = x * rl; }
        if (g == 0) { v4u ov; ov.x = pk2(o[0], o[1]); ov.y = pk2(o[2], o[3]); ov.z = pk2(o[4], o[5]); ov.w = pk2(o[6], o[7]);
            *(v4u*)(O + (size_t)row * DM + hq * 128 + 8 * li) = ov; }
    }
}

__device__ __forceinline__ void gla_naive(const WV& w, const bf16* P, const float* Z1, const float* w2f, const float* bf, const float* w2b, const float* bb, float* OF, float* OB) {
    LAS float* buf = (LAS float*)w.lds;
    const int vc = w.tid >> 2, dq = w.tid & 3;
    for (int it = w.vcu; it < 128; it += w.G) {
        const int vs = it & 3, dir = (it >> 2) & 1, h = (it >> 3) & 3, b = it >> 5;
        const float* w2 = dir ? w2b : w2f; const float* bias = dir ? bb : bf; float* OUT = dir ? OB : OF;
        float w2c[16], bz = 0.f;
        if (w.tid < 256) { bz = bias[h * 256 + w.tid];
#pragma unroll
            for (int r = 0; r < 16; ++r) w2c[r] = w2[r * 1024 + h * 256 + w.tid]; }
        else {
#pragma unroll
            for (int r = 0; r < 16; ++r) w2c[r] = 0.f; }
        float S[64];
#pragma unroll
        for (int i = 0; i < 64; ++i) S[i] = 0.f;
        const int cbase = M_LAT + b * CTXL, lbase = b * SEQ;
#define GLA_ROW(step) ((step) < CTXL ? (dir ? cbase + CTXL - 1 - (step) : cbase + (step)) : (dir ? lbase + SEQ - 1 - ((step) - CTXL) : lbase + ((step) - CTXL)))
#define GLA_FILL(step, par) do { if (w.tid < 256) { const int r_ = GLA_ROW(step); const float* z_ = Z1 + (size_t)r_ * 32 + dir * 16; float zz = bz; \
            _Pragma("unroll") for (int r = 0; r < 16; ++r) zz += z_[r] * w2c[r]; \
            const float ls_ = fminf(zz, 0.f) - log1pf(__expf(-fabsf(zz))); \
            LAS float* bp_ = buf + (par) * 768; bp_[w.tid] = __expf(ls_ * (1.0f / 16.0f)); \
            bp_[256 + w.tid] = bf2f(P[(size_t)r_ * NGLA + 1024 + h * 256 + w.tid]); bp_[512 + w.tid] = bf2f(P[(size_t)r_ * NGLA + h * 256 + w.tid]) * 0.0625f; } } while (0)
        __syncthreads();
        GLA_FILL(0, 0);
        __syncthreads();
        for (int step = 0; step < CTXL + SEQ; ++step) {
            const int row = GLA_ROW(step);
            if (step + 1 < CTXL + SEQ) GLA_FILL(step + 1, (step + 1) & 1);
            const float v = bf2f(P[(size_t)row * NGLA + 2048 + h * 512 + vs * 128 + vc]);
            const LAS float* bp = buf + (step & 1) * 768 + 64 * dq;
            float acc = 0.f;
#pragma unroll
            for (int i = 0; i < 64; i += 4) {
                const f32x4 e4 = *(const LAS f32x4*)(bp + i), k4 = *(const LAS f32x4*)(bp + 256 + i), q4 = *(const LAS f32x4*)(bp + 512 + i);
                S[i] = S[i] * e4.x + k4.x * v; acc += q4.x * S[i];
                S[i + 1] = S[i + 1] * e4.y + k4.y * v; acc += q4.y * S[i + 1];
                S[i + 2] = S[i + 2] * e4.z + k4.z * v; acc += q4.z * S[i + 2];
                S[i + 3] = S[i + 3] * e4.w + k4.w * v; acc += q4.w * S[i + 3];
            }
            acc += __shfl_xor(acc, 1); acc += __shfl_xor(acc, 2);
            if (dq == 0) OUT[(size_t)row * DM + h * 512 + vs * 128 + vc] = acc;
            __syncthreads();
        }
#undef GLA_ROW
#undef GLA_FILL
    }
}
__device__ __forceinline__ void gla_combine(const WV& w, const float* OF, const float* OB, const bf16* P, const float* og, bf16* O, int nrows) {
    for (int task = w.gw; task < nrows * 4; task += w.NGW) {
        const int row = task >> 2, h = task & 3; const size_t off = (size_t)row * DM + h * 512 + 8 * w.lane;
        const f32x4 a0 = *(const f32x4*)(OF + off), a1 = *(const f32x4*)(OF + off + 4), b0 = *(const f32x4*)(OB + off), b1 = *(const f32x4*)(OB + off + 4);
        const f32x4 o0 = a0 + b0, o1 = a1 + b1;
        float ss = (o0.x * o0.x + o0.y * o0.y) + (o0.z * o0.z + o0.w * o0.w) + (o1.x * o1.x + o1.y * o1.y) + (o1.z * o1.z + o1.w * o1.w);
        const float r = 1.0f / sqrtf(wave_sum(ss) * (1.0f / 512.0f) + EPS);
        const f32x4 g0 = *(const f32x4*)(og + 8 * w.lane), g1 = *(const f32x4*)(og + 8 * w.lane + 4);
        const v4u rr = *(const v4u*)(P + (size_t)row * NGLA + 4096 + h * 512 + 8 * w.lane);
        v4u ov;
        ov.x = pk2(o0.x * r * g0.x * silu_f(bf_lo(rr.x)), o0.y * r * g0.y * silu_f(bf_hi(rr.x)));
        ov.y = pk2(o0.z * r * g0.z * silu_f(bf_lo(rr.y)), o0.w * r * g0.w * silu_f(bf_hi(rr.y)));
        ov.z = pk2(o1.x * r * g1.x * silu_f(bf_lo(rr.z)), o1.y * r * g1.y * silu_f(bf_hi(rr.z)));
        ov.w = pk2(o1.z * r * g1.z * silu_f(bf_lo(rr.w)), o1.w * r * g1.w * silu_f(bf_hi(rr.w)));
        *(v4u*)(O + off) = ov;
    }
}
__device__ __forceinline__ void unpack8(const v4u a, float (&x)[8]) { x[0] = bf_lo(a.x); x[1] = bf_hi(a.x); x[2] = bf_lo(a.y); x[3] = bf_hi(a.y); x[4] = bf_lo(a.z); x[5] = bf_hi(a.z); x[6] = bf_lo(a.w); x[7] = bf_hi(a.w); }

typedef short bf16x8 __attribute__((ext_vector_type(8)));
typedef float f32x16 __attribute__((ext_vector_type(16)));
__device__ __forceinline__ int gla_row(int b, int cc, int i) { return cc < 64 ? b * SEQ + cc * 64 + i : M_LAT + b * CTXL + (cc - 64) * 64 + i; }
__device__ __forceinline__ void gla_pre(const WV& w, const bf16* P, const float* Z1, const float* w2f, const float* bf_, const float* w2b, const float* bb_, bf16* QT, bf16* KHT, bf16* AIN, float* DEC) {
    LAS bf16* QS = (LAS bf16*)w.lds;
    LAS bf16* KS = (LAS bf16*)(w.lds + 33792);
    LAS bf16* KH = (LAS bf16*)(w.lds + 67584);
    LAS float* z1s = (LAS float*)(w.lds + 104448);
    LAS float* tot = (LAS float*)(w.lds + 108544);
    LAS bf16* AS = (LAS bf16*)(w.lds + 110592);
    const int d = w.tid & 255, hf = w.tid >> 8;
    float w2c[16], bias = 0.f; int cur_dh = -1;
    for (int it = w.vcu; it < 2 * 4 * 4 * 68; it += w.G) {
        const int dir = it & 1, h = (it >> 1) & 3, b = (it >> 3) & 3, cc = it >> 5;
        const size_t item = ((size_t)(dir * 4 + b) * 4 + h) * 68 + cc;
        if (cur_dh != (dir * 4 + h)) { cur_dh = dir * 4 + h; const float* w2 = dir ? w2b : w2f; bias = (dir ? bb_ : bf_)[h * 256 + d];
#pragma unroll
            for (int r = 0; r < 16; ++r) w2c[r] = w2[r * 1024 + h * 256 + d]; }
        const int row0 = gla_row(b, cc, 0);
#pragma unroll
        for (int i = 0; i < 4; ++i) { const int p = w.tid + 512 * i, r = p >> 5, c = p & 31; const bf16* src = P + (size_t)(row0 + r) * NGLA + h * 256 + 8 * c;
            *(LAS v4u*)(QS + r * 264 + 8 * c) = *(const v4u*)src; *(LAS v4u*)(KS + r * 264 + 8 * c) = *(const v4u*)(src + 1024); }
        if (w.tid < 256) *(LAS f32x4*)(z1s + 4 * w.tid) = *(const f32x4*)(Z1 + (size_t)(row0 + (w.tid >> 2)) * 32 + dir * 16 + 4 * (w.tid & 3));
        __syncthreads();
        float g[32];
#pragma unroll
        for (int ii = 0; ii < 32; ++ii) { const LAS f32x4* zp = (const LAS f32x4*)(z1s + (32 * hf + ii) * 16); float zz = bias;
#pragma unroll
            for (int q4 = 0; q4 < 4; ++q4) { const f32x4 z = zp[q4]; zz += z.x * w2c[4 * q4] + z.y * w2c[4 * q4 + 1] + z.z * w2c[4 * q4 + 2] + z.w * w2c[4 * q4 + 3]; }
            g[ii] = (fminf(zz, 0.f) * 1.4426950408889634f - __builtin_amdgcn_logf(1.0f + __builtin_amdgcn_exp2f(-fabsf(zz) * 1.4426950408889634f))) * 0.0625f; }
        float run = 0.f;
        if (!dir) {
#pragma unroll
            for (int ii = 0; ii < 32; ++ii) { run += g[ii]; g[ii] = run; } }
        else {
#pragma unroll
            for (int ii = 31; ii >= 0; --ii) { run += g[ii]; g[ii] = run; } }
        tot[hf * 256 + d] = run;
        __syncthreads();
        const float t0 = tot[d], t1 = tot[256 + d], blast = t0 + t1;
        const float off = dir ? (hf == 0 ? t1 : 0.f) : (hf == 1 ? t0 : 0.f);
        unsigned khat[16];
#pragma unroll
        for (int ii = 0; ii < 32; ++ii) { const int i = 32 * hf + ii; const float bbv = g[ii] + off;
            const float qv = bf2f(QS[i * 264 + d]) * 0.0625f, kv = bf2f(KS[i * 264 + d]);
            const unsigned qk = pk2(qv * __builtin_amdgcn_exp2f(bbv), kv * __builtin_amdgcn_exp2f(-bbv)); const unsigned kh = f2bf(kv * __builtin_amdgcn_exp2f(blast - bbv));
            QS[i * 264 + d] = (bf16)(qk & 0xffffu); KS[i * 264 + d] = (bf16)(qk >> 16);
            if (ii & 1) khat[ii >> 1] |= kh << 16; else khat[ii >> 1] = kh; }
        { LAS v4u* kp = (LAS v4u*)(KH + d * 72 + 32 * hf);
#pragma unroll
          for (int q4 = 0; q4 < 4; ++q4) kp[q4] = (v4u){khat[4 * q4], khat[4 * q4 + 1], khat[4 * q4 + 2], khat[4 * q4 + 3]}; }
        if (hf == 0) DEC[item * 256 + d] = __builtin_amdgcn_exp2f(blast);
        __syncthreads();
#pragma unroll
        for (int i = 0; i < 4; ++i) { const int p = w.tid + 512 * i, r = p >> 5, c = p & 31;
            *(v4u*)(QT + ((size_t)dir * M_ALL + row0 + r) * 1024 + h * 256 + 8 * c) = *(const LAS v4u*)(QS + r * 264 + 8 * c); }
#pragma unroll
        for (int i = 0; i < 4; ++i) { const int p = w.tid + 512 * i, dd = p >> 3, c = p & 7;
            *(v4u*)(KHT + (item * 256 + dd) * 64 + 8 * c) = *(const LAS v4u*)(KH + dd * 72 + 8 * c); }
        { const int rb = w.wave >> 1, ch = w.wave & 1, c16 = w.lane & 15, kg = w.lane >> 4;
          f32x4 acc[2]; acc[0] = (f32x4){0.f, 0.f, 0.f, 0.f}; acc[1] = acc[0];
#pragma unroll
          for (int k8 = 0; k8 < 8; ++k8) { const bf16x8 a = *(const LAS bf16x8*)(QS + (rb * 16 + c16) * 264 + 32 * k8 + 8 * kg);
#pragma unroll
              for (int n = 0; n < 2; ++n) { const bf16x8 bq = *(const LAS bf16x8*)(KS + ((2 * ch + n) * 16 + c16) * 264 + 32 * k8 + 8 * kg); acc[n] = __builtin_amdgcn_mfma_f32_16x16x32_bf16(a, bq, acc[n], 0, 0, 0); } }
#pragma unroll
          for (int n = 0; n < 2; ++n)
#pragma unroll
              for (int r = 0; r < 4; ++r) { const int i = rb * 16 + 4 * kg + r, jj = (2 * ch + n) * 16 + c16; const bool keep = dir ? (jj >= i) : (jj <= i);
                  AS[i * 72 + jj] = (bf16)f2bf(keep ? acc[n][r] : 0.f); } }
        __syncthreads();
        { const int r = w.tid >> 3, c = w.tid & 7; *(v4u*)(AIN + (item * 64 + r) * 64 + 8 * c) = *(const LAS v4u*)(AS + r * 72 + 8 * c); }
        __syncthreads();
    }
}
__device__ __forceinline__ void gla_vt(const WV& w, const bf16* P, bf16* VT) {
    LAS bf16* vt = (LAS bf16*)w.lds;
    for (int it = w.vcu; it < 4 * 4 * 68; it += w.G) {
        const int cc = it % 68, bh = it / 68, h = bh & 3, b = bh >> 2;
        const int row0 = gla_row(b, cc, 0);
#pragma unroll
        for (int rr = 0; rr < 8; ++rr) { const int i = rr * 8 + (w.tid >> 6), piece = w.tid & 63;
            *(LAS v4u*)(vt + i * 520 + 8 * (piece ^ (i >> 3))) = *(const v4u*)(P + (size_t)(row0 + i) * NGLA + 2048 + h * 512 + 8 * piece); }
        __syncthreads();
#pragma unroll
        for (int i = 0; i < 8; ++i) { const int p = w.tid + 512 * i, dv = p >> 3, c = p & 7; unsigned u[8];
#pragma unroll
            for (int e = 0; e < 8; ++e) u[e] = vt[(8 * c + e) * 520 + 8 * ((dv >> 3) ^ c) + (dv & 7)];
            *(v4u*)(VT + ((size_t)it * 512 + dv) * 64 + 8 * c) = (v4u){u[0] | (u[1] << 16), u[2] | (u[3] << 16), u[4] | (u[5] << 16), u[6] | (u[7] << 16)}; }
        __syncthreads();
    }
}
__device__ __forceinline__ void gla_scan(const WV& w, const bf16* QT, const bf16* KHT, const bf16* AIN, const float* DEC, const bf16* VT, bf16* OFB, bf16* OBB) {
    LAS bf16* ST = (LAS bf16*)w.lds;
    LAS bf16* QS = (LAS bf16*)(w.lds + 33792);
    LAS bf16* VS = (LAS bf16*)(w.lds + 67584);
    LAS bf16* AS = (LAS bf16*)(w.lds + 76800);
    LAS float* DS = (LAS float*)(w.lds + 86016);
    LAS bf16* OS = (LAS bf16*)(w.lds + 87040);
    const int wv = w.wave, r32 = w.lane & 31, hh = w.lane >> 5, c16 = w.lane & 15, kg = w.lane >> 4, tb = wv >> 1, dh = wv & 1;
    for (int it = w.vcu; it < 256; it += w.G) {
        const int vs = it & 7, dir = (it >> 3) & 1, h = (it >> 4) & 3, b = it >> 6;
        bf16* O = dir ? OBB : OFB;
        f32x16 S[2];
#pragma unroll
        for (int n = 0; n < 2; ++n)
#pragma unroll
            for (int r = 0; r < 16; ++r) S[n][r] = 0.f;
        v4u sq[4], sv, sa; f32x4 sd = (f32x4){0.f, 0.f, 0.f, 0.f}; bf16x8 kn[4];
#define SC_CC(s_) ((s_) < 4 ? (dir ? 67 - (s_) : 64 + (s_)) : (dir ? 67 - (s_) : (s_) - 4))
#define SC_LOAD(s_) do { const int cc_ = SC_CC(s_); const size_t item_ = ((size_t)(dir * 4 + b) * 4 + h) * 68 + cc_, vitem_ = ((size_t)b * 4 + h) * 68 + cc_; const int row0_ = gla_row(b, cc_, 0); \
            _Pragma("unroll") for (int i_ = 0; i_ < 4; ++i_) { const int p_ = w.tid + 512 * i_; sq[i_] = *(const v4u*)(QT + ((size_t)dir * M_ALL + row0_ + (p_ >> 5)) * 1024 + h * 256 + 8 * (p_ & 31)); } \
            sv = *(const v4u*)(VT + (vitem_ * 512 + vs * 64 + (w.tid >> 3)) * 64 + 8 * (w.tid & 7)); \
            sa = *(const v4u*)(AIN + (item_ * 64 + (w.tid >> 3)) * 64 + 8 * (w.tid & 7)); \
            if (w.tid < 64) sd = *(const f32x4*)(DEC + item_ * 256 + 4 * w.tid); \
            const bf16* krow_ = KHT + (item_ * 256 + 32 * wv + r32) * 64 + 8 * hh; \
            _Pragma("unroll") for (int k4 = 0; k4 < 4; ++k4) kn[k4] = *(const bf16x8*)(krow_ + 16 * k4); } while (0)
        SC_LOAD(0);
        for (int s = 0; s < 68; ++s) {
            const int row0 = gla_row(b, SC_CC(s), 0);
#pragma unroll
            for (int n = 0; n < 2; ++n)
#pragma unroll
                for (int g4 = 0; g4 < 4; ++g4) { v2u pk; pk.x = pk2(S[n][4 * g4], S[n][4 * g4 + 1]); pk.y = pk2(S[n][4 * g4 + 2], S[n][4 * g4 + 3]);
                    *(LAS v2u*)(ST + (32 * n + r32) * 264 + 32 * wv + 8 * g4 + 4 * hh) = pk; }
#pragma unroll
            for (int i = 0; i < 4; ++i) { const int p = w.tid + 512 * i; *(LAS v4u*)(QS + (p >> 5) * 264 + 8 * (p & 31)) = sq[i]; }
            *(LAS v4u*)(VS + (w.tid >> 3) * 72 + 8 * (w.tid & 7)) = sv;
            *(LAS v4u*)(AS + (w.tid >> 3) * 72 + 8 * (w.tid & 7)) = sa;
            if (w.tid < 64) *(LAS f32x4*)(DS + 4 * w.tid) = sd;
            bf16x8 ka[4];
#pragma unroll
            for (int k4 = 0; k4 < 4; ++k4) ka[k4] = kn[k4];
            if (s + 1 < 68) SC_LOAD(s + 1);
            asm volatile("s_waitcnt lgkmcnt(0)" ::: "memory"); __builtin_amdgcn_s_barrier(); asm volatile("" ::: "memory");
            f32x4 oacc[2]; oacc[0] = (f32x4){0.f, 0.f, 0.f, 0.f}; oacc[1] = oacc[0];
#pragma unroll
            for (int k8 = 0; k8 < 8; ++k8) { const bf16x8 qa = *(const LAS bf16x8*)(QS + (tb * 16 + c16) * 264 + 32 * k8 + 8 * kg);
#pragma unroll
                for (int n = 0; n < 2; ++n) { const bf16x8 sb = *(const LAS bf16x8*)(ST + (32 * dh + 16 * n + c16) * 264 + 32 * k8 + 8 * kg); oacc[n] = __builtin_amdgcn_mfma_f32_16x16x32_bf16(qa, sb, oacc[n], 0, 0, 0); } }
#pragma unroll
            for (int k2 = 0; k2 < 2; ++k2) { const bf16x8 aa = *(const LAS bf16x8*)(AS + (tb * 16 + c16) * 72 + 32 * k2 + 8 * kg);
#pragma unroll
                for (int n = 0; n < 2; ++n) { const bf16x8 vb = *(const LAS bf16x8*)(VS + (32 * dh + 16 * n + c16) * 72 + 32 * k2 + 8 * kg); oacc[n] = __builtin_amdgcn_mfma_f32_16x16x32_bf16(aa, vb, oacc[n], 0, 0, 0); } }
#pragma unroll
            for (int n = 0; n < 2; ++n)
#pragma unroll
                for (int r = 0; r < 4; ++r) OS[(tb * 16 + 4 * kg + r) * 72 + 32 * dh + 16 * n + c16] = (bf16)f2bf(oacc[n][r]);
            { float dec[16];
#pragma unroll
              for (int q4 = 0; q4 < 4; ++q4) { const f32x4 dq = *(const LAS f32x4*)(DS + 32 * wv + 4 * hh + 8 * q4); dec[4 * q4] = dq.x; dec[4 * q4 + 1] = dq.y; dec[4 * q4 + 2] = dq.z; dec[4 * q4 + 3] = dq.w; }
#pragma unroll
              for (int n = 0; n < 2; ++n) {
#pragma unroll
                  for (int r = 0; r < 16; ++r) S[n][r] *= dec[r];
#pragma unroll
                  for (int k4 = 0; k4 < 4; ++k4) { const bf16x8 vb = *(const LAS bf16x8*)(VS + (32 * n + r32) * 72 + 16 * k4 + 8 * hh); S[n] = __builtin_amdgcn_mfma_f32_32x32x16_bf16(ka[k4], vb, S[n], 0, 0, 0); } } }
            asm volatile("s_waitcnt lgkmcnt(0)" ::: "memory"); __builtin_amdgcn_s_barrier(); asm volatile("" ::: "memory");
            *(v4u*)(O + (size_t)(row0 + (w.tid >> 3)) * DM + h * 512 + vs * 64 + 8 * (w.tid & 7)) = *(const LAS v4u*)(OS + (w.tid >> 3) * 72 + 8 * (w.tid & 7));
        }
#undef SC_CC
#undef SC_LOAD
        __syncthreads();
    }
}
__device__ __forceinline__ void gla_combine_bf(const WV& w, const bf16* OFB, const bf16* OBB, const bf16* P, const float* og, bf16* O, int nrows) {
    for (int task = w.gw; task < nrows * 4; task += w.NGW) {
        const int row = task >> 2, h = task & 3; const size_t off = (size_t)row * DM + h * 512 + 8 * w.lane;
        float a[8], c[8], o[8], rv[8]; unpack8(*(const v4u*)(OFB + off), a); unpack8(*(const v4u*)(OBB + off), c);
        float ss = 0.f;
#pragma unroll
        for (int e = 0; e < 8; ++e) { o[e] = a[e] + c[e]; ss += o[e] * o[e]; }
        const float r = 1.0f / sqrtf(wave_sum(ss) * (1.0f / 512.0f) + EPS);
        const f32x4 g0 = *(const f32x4*)(og + 8 * w.lane), g1 = *(const f32x4*)(og + 8 * w.lane + 4);
        const float gg[8] = {g0.x, g0.y, g0.z, g0.w, g1.x, g1.y, g1.z, g1.w};
        unpack8(*(const v4u*)(P + (size_t)row * NGLA + 4096 + h * 512 + 8 * w.lane), rv);
#pragma unroll
        for (int e = 0; e < 8; ++e) o[e] = o[e] * r * gg[e] * silu_f(rv[e]);
        *(v4u*)(O + off) = (v4u){pk2(o[0], o[1]), pk2(o[2], o[3]), pk2(o[4], o[5]), pk2(o[6], o[7])};
    }
}


__device__ __forceinline__ void attn_vt(const WV& w, const bf16* P, bf16* VTA) {
    LAS bf16* tl = (LAS bf16*)w.lds;
    for (int it = w.vcu; it < 16 * 68; it += w.G) {
        const int blk = it % 68, bk = it / 68, b = bk >> 2, kvh = bk & 3;
        const size_t row0 = blk < 64 ? (size_t)b * SEQ + 64 * blk : (size_t)M_LAT + b * CTXL + 64 * (blk - 64);
        const int col0 = blk < 64 ? 64 * blk : SEQ + 64 * (blk - 64);
#pragma unroll
        for (int i = 0; i < 2; ++i) { const int p = w.tid + 512 * i, r = p >> 4, c8 = p & 15;
            *(LAS v4u*)(tl + r * 136 + 8 * c8) = *(const v4u*)(P + (row0 + r) * NQKV + 2560 + kvh * 128 + 8 * c8); }
        __syncthreads();
        const int d = w.tid & 127, tg = w.tid >> 7;
        unsigned u[16];
#pragma unroll
        for (int e = 0; e < 16; ++e) u[e] = tl[(16 * tg + e) * 136 + d];
        v4u* dst = (v4u*)(VTA + ((size_t)bk * 128 + d) * 4352 + col0 + 16 * tg);
        dst[0] = (v4u){u[0] | (u[1] << 16), u[2] | (u[3] << 16), u[4] | (u[5] << 16), u[6] | (u[7] << 16)};
        dst[1] = (v4u){u[8] | (u[9] << 16), u[10] | (u[11] << 16), u[12] | (u[13] << 16), u[14] | (u[15] << 16)};
        __syncthreads();
    }
}
__device__ __forceinline__ void attn_fast(const WV& w, const bf16* P, const bf16* VTA, const float* sink, bf16* O) {
    LAS bf16* KL = (LAS bf16*)w.lds;
    LAS bf16* VL = (LAS bf16*)(w.lds + 2 * 17408);
    const int wv = w.wave, r32 = w.lane & 31, hh = w.lane >> 5, g = wv >> 1, th = wv & 1;
    const float C2 = 0.08838834764831845f * 1.4426950408889634f, L2E = 1.4426950408889634f;
    for (int u = w.vcu; u < 1088; u += w.G) {
        int b, kvh, qb; bool isctx;
        if (u < 1024) { b = u >> 8; kvh = (u >> 6) & 3; qb = u & 63; isctx = false; } else { const int v = u - 1024; b = v >> 4; kvh = (v >> 2) & 3; qb = v & 3; isctx = true; }
        const int hq = kvh * 4 + g, tq = qb * 64 + 32 * th + r32;
        const size_t qrow = isctx ? (size_t)M_LAT + b * CTXL + tq : (size_t)b * SEQ + tq;
        int i_lo = 0, nwin = 0;
        if (!isctx) { i_lo = 2 - qb > 0 ? 2 - qb : 0; const int i_hi = 65 - qb < 4 ? 65 - qb : 4; nwin = i_hi - i_lo + 1; }
        const int T = nwin + 4;
        bf16x8 qf[8];
#pragma unroll
        for (int k8 = 0; k8 < 8; ++k8) qf[k8] = *(const bf16x8*)(P + qrow * NQKV + hq * 128 + 16 * k8 + 8 * hh);
        f32x16 OT[4];
#pragma unroll
        for (int db = 0; db < 4; ++db)
#pragma unroll
            for (int r = 0; r < 16; ++r) OT[db][r] = 0.f;
        float m = sink[hq] * L2E, lsum = hh == 0 ? 1.0f : 0.0f;
        v4u kreg[2], vreg[2];
#define ATT_LOAD(t_) do { const int t__ = (t_); const bool wt_ = t__ < nwin; const int kp0_ = qb * 64 - 128 + 64 * (i_lo + t__), ct_ = t__ - nwin; \
            const size_t krow0_ = wt_ ? (size_t)b * SEQ + kp0_ : (size_t)M_LAT + b * CTXL + 64 * ct_; const int vcol0_ = wt_ ? kp0_ : SEQ + 64 * ct_; \
            _Pragma("unroll") for (int i_ = 0; i_ < 2; ++i_) { const int p_ = w.tid + 512 * i_; \
                kreg[i_] = *(const v4u*)(P + (krow0_ + (p_ >> 4)) * NQKV + 2048 + kvh * 128 + 8 * (p_ & 15)); \
                vreg[i_] = *(const v4u*)(VTA + ((size_t)(b * 4 + kvh) * 128 + (p_ >> 3)) * 4352 + vcol0_ + 8 * (p_ & 7)); } } while (0)
#define ATT_STORE(buf_) do { _Pragma("unroll") for (int i_ = 0; i_ < 2; ++i_) { const int p_ = w.tid + 512 * i_; \
                *(LAS v4u*)(KL + (buf_) * (64 * 136) + (p_ >> 4) * 136 + 8 * (p_ & 15)) = kreg[i_]; \
                LAS v2u* vp_ = (LAS v2u*)(VL + (buf_) * (128 * 68) + (p_ >> 3) * 68 + 8 * (p_ & 7)); vp_[0] = (v2u){vreg[i_].x, vreg[i_].y}; vp_[1] = (v2u){vreg[i_].z, vreg[i_].w}; } } while (0)
        __syncthreads();
        ATT_LOAD(0); ATT_STORE(0);
        __syncthreads();
        for (int t = 0; t < T; ++t) {
            if (t + 1 < T) ATT_LOAD(t + 1);
            const LAS bf16* kl = KL + (t & 1) * (64 * 136); const LAS bf16* vl = VL + (t & 1) * (128 * 68);
            f32x16 sacc[2];
#pragma unroll
            for (int kb = 0; kb < 2; ++kb) {
#pragma unroll
                for (int r = 0; r < 16; ++r) sacc[kb][r] = 0.f;
#pragma unroll
                for (int k8 = 0; k8 < 8; ++k8) { const bf16x8 a = *(const LAS bf16x8*)(kl + (32 * kb + r32) * 136 + 16 * k8 + 8 * hh); sacc[kb] = __builtin_amdgcn_mfma_f32_32x32x16_bf16(a, qf[k8], sacc[kb], 0, 0, 0); } }
            const bool wt = t < nwin; const int kp0 = qb * 64 - 128 + 64 * (i_lo + t);
            float mx = -INFINITY;
#pragma unroll
            for (int kb = 0; kb < 2; ++kb)
#pragma unroll
                for (int r = 0; r < 16; ++r) { float sv = sacc[kb][r] * C2;
                    if (wt) { const int dlt = kp0 + 32 * kb + (r & 3) + 8 * (r >> 2) + 4 * hh - tq; if (dlt > 128 || dlt < -128) sv = -INFINITY; }
                    sacc[kb][r] = sv; mx = fmaxf(mx, sv); }
            mx = fmaxf(mx, __shfl_xor(mx, 32));
            const float mn = fmaxf(m, mx), alpha = __builtin_amdgcn_exp2f(m - mn); m = mn;
            float ps = 0.f;
#pragma unroll
            for (int kb = 0; kb < 2; ++kb)
#pragma unroll
                for (int r = 0; r < 16; ++r) { const float pv = __builtin_amdgcn_exp2f(sacc[kb][r] - mn); ps += pv; sacc[kb][r] = pv; }
            lsum = lsum * alpha + ps;
#pragma unroll
            for (int db = 0; db < 4; ++db)
#pragma unroll
                for (int r = 0; r < 16; ++r) OT[db][r] *= alpha;
#pragma unroll
            for (int kb = 0; kb < 2; ++kb)
#pragma unroll
                for (int sh = 0; sh < 2; ++sh) {
                    v4u pw; pw.x = pk2(sacc[kb][8 * sh], sacc[kb][8 * sh + 1]); pw.y = pk2(sacc[kb][8 * sh + 2], sacc[kb][8 * sh + 3]);
                    pw.z = pk2(sacc[kb][8 * sh + 4], sacc[kb][8 * sh + 5]); pw.w = pk2(sacc[kb][8 * sh + 6], sacc[kb][8 * sh + 7]);
                    const bf16x8 pf = __builtin_bit_cast(bf16x8, pw);
#pragma unroll
                    for (int db = 0; db < 4; ++db) { const LAS bf16* vp = vl + (32 * db + r32) * 68 + 32 * kb + 16 * sh + 4 * hh;
                        const v2u lo = *(const LAS v2u*)vp, hi = *(const LAS v2u*)(vp + 8);
                        const bf16x8 vf = __builtin_bit_cast(bf16x8, ((v4u){lo.x, lo.y, hi.x, hi.y}));
                        OT[db] = __builtin_amdgcn_mfma_f32_32x32x16_bf16(vf, pf, OT[db], 0, 0, 0); } }
            if (t + 1 < T) ATT_STORE((t + 1) & 1);
            __syncthreads();
        }
#undef ATT_LOAD
#undef ATT_STORE
        const float l = lsum + __shfl_xor(lsum, 32), rl = 1.0f / l;
        bf16* op = O + qrow * DM + hq * 128 + 4 * hh;
#pragma unroll
        for (int db = 0; db < 4; ++db)
#pragma unroll
            for (int g4 = 0; g4 < 4; ++g4) { v2u o; o.x = pk2(OT[db][4 * g4] * rl, OT[db][4 * g4 + 1] * rl); o.y = pk2(OT[db][4 * g4 + 2] * rl, OT[db][4 * g4 + 3] * rl);
                *(v2u*)(op + 32 * db + 8 * g4) = o; }
    }
}

__device__ __forceinline__ void conv_rows(const WV& w, const bf16* U, const float* cw, const float* cb, bf16* ACT, int nrows) {
    const int nseg = nrows / 32;
    for (int wi = w.gw; wi < nseg * 11; wi += w.NGW) {
        const int seg = wi / 11, cg = wi % 11, r0 = seg * 32, f = (cg * 64 + w.lane) * 8;
        float wg[3][8], wv[3][8], bg[8], bv[8];
#pragma unroll
        for (int j = 0; j < 3; ++j)
#pragma unroll
            for (int e = 0; e < 8; ++e) { wg[j][e] = cw[j * DFF2 + f + e]; wv[j][e] = cw[j * DFF2 + DFF + f + e]; }
#pragma unroll
        for (int e = 0; e < 8; ++e) { bg[e] = cb[f + e]; bv[e] = cb[DFF + f + e]; }
        const bool s_start = r0 < M_LAT ? ((r0 & (SEQ - 1)) == 0) : (((r0 - M_LAT) & (CTXL - 1)) == 0);
        const bool s_end = r0 < M_LAT ? (((r0 + 32) & (SEQ - 1)) == 0) : (((r0 + 32 - M_LAT) & (CTXL - 1)) == 0);
        const v4u zero4 = (v4u){0u, 0u, 0u, 0u};
        v4u pg = s_start ? zero4 : *(const v4u*)(U + (size_t)(r0 - 1) * DFF2 + f), pv = s_start ? zero4 : *(const v4u*)(U + (size_t)(r0 - 1) * DFF2 + DFF + f);
        v4u cg4 = *(const v4u*)(U + (size_t)r0 * DFF2 + f), cv4 = *(const v4u*)(U + (size_t)r0 * DFF2 + DFF + f);
        for (int r = 0; r < 32; ++r) {
            const bool nz = (r == 31) && s_end;
            const v4u ng = nz ? zero4 : *(const v4u*)(U + (size_t)(r0 + r + 1) * DFF2 + f), nv = nz ? zero4 : *(const v4u*)(U + (size_t)(r0 + r + 1) * DFF2 + DFF + f);
            float a[8], c[8], n[8], gate[8], val[8];
            unpack8(pg, a); unpack8(cg4, c); unpack8(ng, n);
#pragma unroll
            for (int e = 0; e < 8; ++e) gate[e] = bg[e] + wg[0][e] * a[e] + wg[1][e] * c[e] + wg[2][e] * n[e];
            unpack8(pv, a); unpack8(cv4, c); unpack8(nv, n);
#pragma unroll
            for (int e = 0; e < 8; ++e) val[e] = bv[e] + wv[0][e] * a[e] + wv[1][e] * c[e] + wv[2][e] * n[e];
            v4u ov; ov.x = pk2(silu_f(gate[0]) * val[0], silu_f(gate[1]) * val[1]); ov.y = pk2(silu_f(gate[2]) * val[2], silu_f(gate[3]) * val[3]);
            ov.z = pk2(silu_f(gate[4]) * val[4], silu_f(gate[5]) * val[5]); ov.w = pk2(silu_f(gate[6]) * val[6], silu_f(gate[7]) * val[7]);
            *(v4u*)(ACT + (size_t)(r0 + r) * DFF + f) = ov;
            pg = cg4; pv = cv4; cg4 = ng; cv4 = nv;
        }
    }
}

__global__ void __launch_bounds__(512, 2) mega(Args args) {
    extern __shared__ __attribute__((aligned(16))) unsigned char lds_raw[];
    LAS unsigned char* const lds0 = (LAS unsigned char*)lds_raw;
    for (int u = threadIdx.x; u < (LDS_BYTES - LDSCTL_OFF) / 4; u += 512) ((LAS unsigned*)(lds0 + LDSCTL_OFF))[u] = 0u;
    __syncthreads();
    XcdBarrier bar; bar.bar = (unsigned*)(args.ws + WS_CTL) + CW_BAR; bar.x = 0; bar.st = nullptr;
    if (MK_ONE_LAUNCH) bar = xcd_barrier_post((unsigned*)(args.ws + WS_CTL) + CW_BAR, (volatile LAS unsigned*)(lds0 + LDSCTL_OFF + 32));
#define PHASE_ENTER() int tid_l = threadIdx.x; asm volatile("" : "+v"(tid_l)); unsigned char* ws = args.ws; asm volatile("" : "+s"(ws)); WV w; w.lds = lds0; w.tid = tid_l; w.lane = tid_l & 63; \
    w.wave = __builtin_amdgcn_readfirstlane(tid_l >> 6); w.G = gridDim.x; { const int bx = blockIdx.x; w.vcu = (w.G % 8 == 0) ? (bx % 8) * (w.G / 8) + bx / 8 : bx; } w.gw = w.vcu * 8 + w.wave; w.NGW = w.G * 8; \
    float* X = (float*)(ws + WS_X); bf16* H = (bf16*)(ws + WS_H); bf16* P = (bf16*)(ws + WS_P); float* Z1 = (float*)(ws + WS_Z1); bf16* OMIX = (bf16*)(ws + WS_OMIX); bf16* U = (bf16*)(ws + WS_U); \
    bf16* ACT = (bf16*)(ws + WS_ACT); float* MODS = (float*)(ws + WS_MODS); float* OF = (float*)(ws + WS_OF); float* OB = (float*)(ws + WS_OB); \
    (void)X; (void)H; (void)P; (void)Z1; (void)OMIX; (void)U; (void)ACT; (void)MODS; (void)OF; (void)OB; (void)w
    const int lo = args.ph_lo, hi = args.ph_hi;
#define RUN(k) (lo <= (k) && (k) < hi)
#define SEAM(k) do { if (MK_ONE_LAUNCH && RUN(k) && RUN((k) + 1)) xcd_barrier(bar); } while (0)

    for (int rep = 0; rep < RPT_PRO; ++rep) if (RUN(0)) {
        PHASE_ENTER();
        for (int it = w.vcu; it < 4 * 48; it += w.G) mods_item(w, args.in[1], args.in[3], args.in[4], args.in[5], MODS, it);
        for (int l = 0; l < DEPTH; ++l) {
            transpose_matrix(w, args.in[8] + (size_t)l * DM * DFF2, DM, DFF2, (bf16*)(ws + WS_WUP + l * WUP_STRIDE), 0);
            transpose_matrix(w, args.in[11] + (size_t)l * DFF * DM, DFF, DM, (bf16*)(ws + WS_WDN + l * WDN_STRIDE), 0);
        }
        for (int j = 0; j < 2; ++j) {
            transpose_matrix(w, args.in[12] + (size_t)j * DM * NQKV, DM, NQKV, (bf16*)(ws + WS_WQKV + j * WQKV_STRIDE), 0);
            transpose_matrix(w, args.in[14] + (size_t)j * DM * DM, DM, DM, (bf16*)(ws + WS_WAO + j * WO_STRIDE), 0);
            transpose_matrix(w, args.in[15] + (size_t)j * DM * NGLA, DM, NGLA, (bf16*)(ws + WS_WGIN + j * WGIN_STRIDE), 0);
            transpose_matrix(w, args.in[23] + (size_t)j * DM * DM, DM, DM, (bf16*)(ws + WS_WGO + j * WO_STRIDE), 0);
            bf16* wg = (bf16*)(ws + WS_WGIN + j * WGIN_STRIDE) + (size_t)NGLA * DM;
            const float* f1 = args.in[16] + (size_t)j * DM * 16; const float* b1 = args.in[19] + (size_t)j * DM * 16;
            for (int idx = w.gw * 64 + w.lane; idx < 256 * DM; idx += w.NGW * 64) { const int n = idx >> 11, k = idx & 2047;
                const float v = n < 16 ? f1[k * 16 + n] : (n < 32 ? b1[k * 16 + (n - 16)] : 0.f); wg[idx] = (bf16)f2bf(v); }
        }
        { const f32x4* xs = (const f32x4*)args.in[0]; const f32x4* cs = (const f32x4*)args.in[2]; f32x4* xd = (f32x4*)X;
          const size_t nl = (size_t)M_LAT * DM / 4, nc = (size_t)M_CTX * DM / 4, gt = (size_t)w.gw * 64 + w.lane, gn = (size_t)w.NGW * 64;
          for (size_t i = gt; i < nl; i += gn) xd[i] = xs[i];
          for (size_t i = gt; i < nc; i += gn) xd[nl + i] = cs[i]; }
    }
    SEAM(0);

    for (int l = 0; l < DEPTH; ++l) {
        const int base = 1 + 10 * l, j = l >> 1; const bool gla = (l & 1) != 0, last = (l == DEPTH - 1);
        const size_t mods_off = (size_t)l * 5 * NMOD;
        const int mrows = last ? M_LAT : M_ALL;
        for (int rep = 0; rep < RPT_NORM; ++rep) if (RUN(base + 0)) { PHASE_ENTER(); const float* mods_l = MODS + mods_off; norm_rows(w, X, H, args.in[6] + l * DM, mods_l + 0 * DM, mods_l + 1 * DM, M_ALL, (const float*)(ws + WS_PART), (SPLITK_CTX && l > 0) ? 4 : 0, MODS + (mods_off - 5 * NMOD) + 4 * NMOD + 5 * DM); }
        SEAM(base + 0);
        for (int rep = 0; rep < RPT_PROJ; ++rep) if (RUN(base + 1)) {
            PHASE_ENTER();
            pg8::Gemm g{H, gla ? (const bf16*)(ws + WS_WGIN + j * WGIN_STRIDE) : (const bf16*)(ws + WS_WQKV + j * WQKV_STRIDE), M_ALL, gla ? NGLA_EXT : NQKV, DM, DM};
            pg8::StaticOrder S; S.init(g.M, g.N, w.G, (int)blockIdx.x);
            pg8::EpiStoreBf16 E{P, gla ? NGLA : NQKV, gla ? NGLA : (1 << 30), Z1};
            pg8::gemm_phase<pg8::EpiStoreBf16, pg8::StaticOrder, true, true>(w.lds, g, S, E);
        }
        SEAM(base + 1);
        if (RUN(base + 2)) {
            PHASE_ENTER();
            if (!gla) { rope_rows(w, P);
#if !NAIVE_ATTN
                attn_vt(w, P, (bf16*)(ws + WS_VTA));
#endif
            }
#if !NAIVE_GLA
            else for (int rep2 = 0; rep2 < RPT_GPRE; ++rep2) { gla_pre(w, P, Z1, args.in[17] + (size_t)j * 16 * 1024, args.in[18] + j * 1024, args.in[20] + (size_t)j * 16 * 1024, args.in[21] + j * 1024,
                           (bf16*)(ws + WS_QT), (bf16*)(ws + WS_KHT), (bf16*)(ws + WS_AIN), (float*)(ws + WS_DEC));
                   gla_vt(w, P, (bf16*)(ws + WS_VT)); }
#endif
        }
        if (!gla || !NAIVE_GLA) SEAM(base + 2);
        for (int rep = 0; rep < (gla ? RPT_SCAN : RPT_ATT); ++rep) if (RUN(base + 3)) {
            PHASE_ENTER();
#if NAIVE_ATTN
            if (!gla) attn_naive(w, P, args.in[13] + j * 16, OMIX);
#else
            if (!gla) attn_fast(w, P, (const bf16*)(ws + WS_VTA), args.in[13] + j * 16, OMIX);
#endif
#if NAIVE_GLA
            else gla_naive(w, P, Z1, args.in[17] + (size_t)j * 16 * 1024, args.in[18] + j * 1024, args.in[20] + (size_t)j * 16 * 1024, args.in[21] + j * 1024, OF, OB);
#else
            else gla_scan(w, (const bf16*)(ws + WS_QT), (const bf16*)(ws + WS_KHT), (const bf16*)(ws + WS_AIN), (const float*)(ws + WS_DEC), (const bf16*)(ws + WS_VT), (bf16*)(ws + WS_OFB), (bf16*)(ws + WS_OBB));
#endif
        }
        SEAM(base + 3);
#if NAIVE_GLA
        if (RUN(base + 4)) { if (gla) { PHASE_ENTER(); gla_combine(w, OF, OB, P, args.in[22] + j * 512, OMIX, mrows); } }
#else
        for (int rep = 0; rep < RPT_COMB; ++rep) if (RUN(base + 4)) { if (gla) { PHASE_ENTER(); gla_combine_bf(w, (const bf16*)(ws + WS_OFB), (const bf16*)(ws + WS_OBB), P, args.in[22] + j * 512, OMIX, mrows); } }
#endif
        if (gla) SEAM(base + 4);
        if (RUN(base + 5)) {
            PHASE_ENTER();
            pg8::Gemm g{OMIX, gla ? (const bf16*)(ws + WS_WGO + j * WO_STRIDE) : (const bf16*)(ws + WS_WAO + j * WO_STRIDE), SPLITK_CTX ? M_LAT : mrows, DM, DM, DM};
            pg8::StaticOrder S; S.init(g.M, g.N, w.G, (int)blockIdx.x);
            pg8::EpiResid E{X, DM, MODS + mods_off + 2 * DM};
            if (RPT_WO) { pg8::EpiResid Ed{(float*)(ws + WS_U), DM, MODS + mods_off + 2 * DM}; pg8::gemm_phase<pg8::EpiResid, pg8::StaticOrder, true, true>(w.lds, g, S, Ed); }
            pg8::gemm_phase<pg8::EpiResid, pg8::StaticOrder, true, true>(w.lds, g, S, E);
            if (SPLITK_CTX && !last) {
                pg8::Gemm g2{OMIX + (size_t)M_LAT * DM, g.Bt, M_CTX, DM, DM, 256};
                pg8::SplitKOrder S2; S2.init(M_CTX, DM, 8, 256, w.G, (int)blockIdx.x);
                pg8::EpiPartial E2{(float*)(ws + WS_PART), DM, 256, (size_t)M_CTX * DM};
                pg8::gemm_phase<pg8::EpiPartial, pg8::SplitKOrder, true, true>(w.lds, g2, S2, E2);
            }
        }
        SEAM(base + 5);
        for (int rep = 0; rep < RPT_NORM; ++rep) if (RUN(base + 6)) { PHASE_ENTER(); const float* mods_l = MODS + mods_off; norm_rows(w, X, H, args.in[7] + l * DM, mods_l + 3 * DM, mods_l + 4 * DM, mrows, (const float*)(ws + WS_PART), (!SPLITK_CTX || last) ? 0 : 8, mods_l + 4 * NMOD + 2 * DM); }
        SEAM(base + 6);
        for (int rep = 0; rep < RPT_UP; ++rep) if (RUN(base + 7)) {
            PHASE_ENTER();
            pg8::Gemm g{H, (const bf16*)(ws + WS_WUP + l * WUP_STRIDE), mrows, DFF2, DM, DM};
            pg8::StaticOrder S; S.init(g.M, g.N, w.G, (int)blockIdx.x);
            pg8::EpiStoreBf16 E{U, DFF2, 1 << 30, Z1};
            pg8::gemm_phase<pg8::EpiStoreBf16, pg8::StaticOrder, true, true>(w.lds, g, S, E);
        }
        SEAM(base + 7);
        for (int rep = 0; rep < RPT_CONV; ++rep) if (RUN(base + 8)) { PHASE_ENTER(); conv_rows(w, U, args.in[9] + (size_t)l * 3 * DFF2, args.in[10] + (size_t)l * DFF2, ACT, mrows); }
        SEAM(base + 8);
        if (RUN(base + 9)) {
            PHASE_ENTER();
            pg8::Gemm g{ACT, (const bf16*)(ws + WS_WDN + l * WDN_STRIDE), SPLITK_CTX ? M_LAT : mrows, DM, DFF, DFF};
            pg8::StaticOrder S; S.init(g.M, g.N, w.G, (int)blockIdx.x);
            pg8::EpiResid E{X, DM, MODS + mods_off + 5 * DM};
            if (RPT_DN) { pg8::EpiResid Ed{(float*)(ws + WS_U), DM, MODS + mods_off + 5 * DM}; pg8::gemm_phase<pg8::EpiResid, pg8::StaticOrder, true, true>(w.lds, g, S, Ed); }
            pg8::gemm_phase<pg8::EpiResid, pg8::StaticOrder, true, true>(w.lds, g, S, E);
            if (SPLITK_CTX && !last) {
                pg8::Gemm g2{ACT + (size_t)M_LAT * DFF, g.Bt, M_CTX, DM, DFF, 1408};
                pg8::SplitKOrder S2; S2.init(M_CTX, DM, 4, 1408, w.G, (int)blockIdx.x);
                pg8::EpiPartial E2{(float*)(ws + WS_PART), DM, 1408, (size_t)M_CTX * DM};
                pg8::gemm_phase<pg8::EpiPartial, pg8::SplitKOrder, true, true>(w.lds, g2, S2, E2);
            }
        }
        SEAM(base + 9);
    }
    if (RUN(41)) { PHASE_ENTER(); final_norm(w, X, args.out, args.in[24]);
        if (DIAG_SCAN && blockIdx.x == 0 && w.tid == 0) { asm volatile("s_waitcnt vmcnt(0)" ::: "memory"); const unsigned long long* dg = (const unsigned long long*)(ws + WS_CTL + 65536);
            const double a = (double)dg[0], b = (double)dg[1], c = (double)dg[2], tot = a + b + c; int d1 = (int)(10.0 * a / tot), d2 = (int)(10.0 * b / tot); if (d1 < 1) d1 = 1; if (d2 < 0) d2 = 0;
            args.out[0] = (float)(DIAG_SCAN == 1 ? 10 * d1 + d2 : (DIAG_SCAN == 2 ? tot / 68.0 / 2.0 / 10.0 : 0)); } }
#undef RUN
#undef SEAM
}

extern "C" void kernel_launch(void* const* d_in, const int* in_sizes, int n_in, void* d_out, int out_size, void* d_ws, size_t ws_size, hipStream_t stream) {
    static int grid = 0;
    if (grid == 0) {
        if (n_in != 25 || out_size != M_LAT * DM || ws_size < WS_END) { fprintf(stderr, "kernel_launch: unexpected shapes (n_in %d, out %d, ws %zu < %zu); nothing launched\n", n_in, out_size, ws_size, (size_t)WS_END); grid = -1; return; }
        int dev = 0, cus = 0, per_cu = 0;
        if (hipGetDevice(&dev) != hipSuccess || hipDeviceGetAttribute(&cus, hipDeviceAttributeMultiprocessorCount, dev) != hipSuccess) { grid = -1; return; }
        if (hipFuncSetAttribute((const void*)mega, hipFuncAttributeMaxDynamicSharedMemorySize, LDS_BYTES) != hipSuccess) { fprintf(stderr, "kernel_launch: hipFuncSetAttribute failed\n"); grid = -1; return; }
        if (hipOccupancyMaxActiveBlocksPerMultiprocessor(&per_cu, (const void*)mega, 512, LDS_BYTES) != hipSuccess || per_cu < 1)
            fprintf(stderr, "kernel_launch: occupancy query reports %d workgroups per CU\n", per_cu);
        (void)hipGetLastError();
        grid = cus;
    }
    if (grid < 0) return;
    if (hipMemsetAsync((char*)d_ws + WS_CTL, 0, CTL_ZERO_BYTES, stream) != hipSuccess) return;
    Args a{};
    for (int i = 0; i < 25; ++i) a.in[i] = (const float*)d_in[i];
    a.out = (float*)d_out; a.ws = (unsigned char*)d_ws;
#if MK_ONE_LAUNCH
    a.ph_lo = 0; a.ph_hi = NPH;
    hipLaunchKernelGGL(mega, dim3(grid), dim3(512), LDS_BYTES, stream, a);
#else
    for (int ph = 0; ph < NPH; ++ph) {
        if (ph >= 1 && ph <= 40) { const int l = (ph - 1) / 10, s = (ph - 1) % 10; if ((s == 2 && (l & 1) && NAIVE_GLA) || (s == 4 && !(l & 1))) continue; }
        a.ph_lo = ph; a.ph_hi = ph + 1;
        hipLaunchKernelGGL(mega, dim3(grid), dim3(512), LDS_BYTES, stream, a);
    }
#endif
}
```

```cpp
#include <hip/hip_runtime.h>
#include <cstdio>
#include <cstdint>
namespace pg8 {
#define PG8_LAS __attribute__((address_space(3)))
typedef unsigned short bf16_t;
typedef short bf16x8 __attribute__((ext_vector_type(8)));
typedef float f32x4 __attribute__((ext_vector_type(4)));
typedef unsigned u32x4 __attribute__((ext_vector_type(4)));
constexpr int BM = 256, BK = 64, HALF = 128, HTB = HALF * BK * 2  , STAGE_BYTES = 8 * HTB, NXCD = 8, WGM = 8;

__host__ __device__ __forceinline__ int lds_byte(int r, int c) { const int st = (r >> 4) * 2 + (c >> 5), rr = r & 15, cc = c & 31, ob = rr * 64 + cc * 2; return st * 1024 + (ob ^ (((ob >> 9) & 1) << 5)); }
__host__ __device__ __forceinline__ void stage_rc(int b, int& R, int& C) { const int st = b / 1024, sb = b % 1024, swz = sb ^ (((sb >> 9) & 1) << 5); R = (st >> 1) * 16 + swz / 64; C = (st & 1) * 32 + (swz % 64) / 2; }
__host__ __device__ __forceinline__ int perm32(int rho) { const int n = rho >> 4, i = rho & 15; return 8 * (i >> 2) + 4 * n + (i & 3); }

struct Unit { int pm, pn, kofs; };
struct Gemm { const bf16_t* A; const bf16_t* Bt; int M, N, K, kloop; };

struct StaticOrder {
    int nM, nN, nwg, G, c;
    __host__ __device__ void init(int M, int N, int G_, int c_) { nM = M / BM; nN = N / BM; nwg = nM * nN; G = G_; c = c_; }
    __host__ __device__ bool next(int i, Unit& u) const {
        const long L = (long)i * G + c; if (L >= nwg) return false;
        int wgid = (int)L; { const int q = nwg / NXCD, r = nwg % NXCD, xcd = wgid % NXCD, off = wgid / NXCD; wgid = (xcd < r ? xcd * (q + 1) : r * (q + 1) + (xcd - r) * q) + off; }
        const int nig = WGM * nN, gid = wgid / nig, fm = gid * WGM, gsz = (nM - fm) < WGM ? (nM - fm) : WGM;
        u.pm = fm + ((wgid % nig) % gsz); u.pn = (wgid % nig) / gsz; u.kofs = 0; return true;
    }
    __device__ __forceinline__ void a_ready(const Unit&) const {}
    __device__ __forceinline__ void done(const Unit&) const {}
};

struct SplitKOrder {
    int nN, nunits, nsplit, kloop, G, c;
    __host__ __device__ void init(int M, int N, int nsplit_, int kloop_, int G_, int c_) { nN = N / BM; nunits = (M / BM) * nN * nsplit_; nsplit = nsplit_; kloop = kloop_; G = G_; c = c_; }
    __host__ __device__ bool next(int i, Unit& u) const { const long L = (long)i * G + c; if (L >= nunits) return false; const int t = (int)L / nsplit, ks = (int)L % nsplit; u.pm = t / nN; u.pn = t % nN; u.kofs = ks * kloop; return true; }
    __device__ __forceinline__ void a_ready(const Unit&) const {}
    __device__ __forceinline__ void done(const Unit&) const {}
};
typedef __bf16 bf16x2_hw __attribute__((ext_vector_type(2)));
typedef float f32x2_hw __attribute__((ext_vector_type(2)));
__device__ __forceinline__ unsigned cvt_pk_bf16(float lo, float hi) { const f32x2_hw v = {lo, hi}; return __builtin_bit_cast(unsigned, __builtin_convertvector(v, bf16x2_hw)); }
typedef float f32x2 __attribute__((ext_vector_type(2)));

struct EpiStoreBf16 {
    static constexpr bool PERM = true, AFTER_DRAIN = false;
    bf16_t* O; int ldc; int zcol0; float* Z;
    __device__ __forceinline__ void operator()(const f32x4 (&acc)[2][2][4][2], const Unit& u, int wr, int wc, int fr, int fq) const {
        const int row0 = u.pm * BM + wr * 64 + fr; const int colt = u.pn * BM;
        if (colt >= zcol0) {
            if (wc == 0) {
#pragma unroll
                for (int ai = 0; ai < 2; ++ai)
#pragma unroll
                    for (int m = 0; m < 4; ++m) { float* zp = Z + (size_t)(row0 + ai * HALF + m * 16) * 32 + 8 * fq;
                        *(f32x4*)(zp) = acc[ai][0][m][0]; *(f32x4*)(zp + 4) = acc[ai][0][m][1]; }
            }
            return;
        }
        const int col0 = colt + wc * 32 + 8 * fq;
#pragma unroll
        for (int ai = 0; ai < 2; ++ai)
#pragma unroll
            for (int m = 0; m < 4; ++m) { bf16_t* rowp = O + (size_t)(row0 + ai * HALF + m * 16) * ldc + col0;
#pragma unroll
                for (int bj = 0; bj < 2; ++bj) { const f32x4 v0 = acc[ai][bj][m][0], v1 = acc[ai][bj][m][1];
                    u32x4 w; w.x = cvt_pk_bf16(v0[0], v0[1]); w.y = cvt_pk_bf16(v0[2], v0[3]); w.z = cvt_pk_bf16(v1[0], v1[1]); w.w = cvt_pk_bf16(v1[2], v1[3]);
                    *(u32x4*)(rowp + bj * HALF) = w; } }
    }
};
struct EpiResid {
    static constexpr bool PERM = false, AFTER_DRAIN = false;
    float* X; int ldc; const float* gate;
    __device__ __forceinline__ void operator()(const f32x4 (&acc)[2][2][4][2], const Unit& u, int wr, int wc, int fr, int fq) const {
        const int row0 = u.pm * BM + wr * 64 + fr, col0 = u.pn * BM + wc * 32 + 4 * fq;
        const int vec = u.pm < 64 ? (u.pm >> 4) : 4;
        const float* g = gate + (size_t)vec * 12288 + col0;
        f32x4 gv[2][2];
#pragma unroll
        for (int bj = 0; bj < 2; ++bj)
#pragma unroll
            for (int n = 0; n < 2; ++n) gv[bj][n] = *(const f32x4*)(g + bj * HALF + n * 16);
#pragma unroll
        for (int ai = 0; ai < 2; ++ai)
#pragma unroll
            for (int m = 0; m < 4; ++m) { float* rowp = X + (size_t)(row0 + ai * HALF + m * 16) * ldc + col0;
#pragma unroll
                for (int bj = 0; bj < 2; ++bj)
#pragma unroll
                    for (int n = 0; n < 2; ++n) { float* p = rowp + bj * HALF + n * 16; *(f32x4*)p = *(const f32x4*)p + gv[bj][n] * acc[ai][bj][m][n]; } }
    }
};
struct EpiPartial {
    static constexpr bool PERM = false, AFTER_DRAIN = false;
    float* PART; int ldc; int kloop; size_t slab;
    __device__ __forceinline__ void operator()(const f32x4 (&acc)[2][2][4][2], const Unit& u, int wr, int wc, int fr, int fq) const {
        const int row0 = u.pm * BM + wr * 64 + fr, col0 = u.pn * BM + wc * 32 + 4 * fq;
        float* base = PART + (size_t)(u.kofs / kloop) * slab;
#pragma unroll
        for (int ai = 0; ai < 2; ++ai)
#pragma unroll
            for (int m = 0; m < 4; ++m) { float* rowp = base + (size_t)(row0 + ai * HALF + m * 16) * ldc + col0;
#pragma unroll
                for (int bj = 0; bj < 2; ++bj)
#pragma unroll
                    for (int n = 0; n < 2; ++n) *(f32x4*)(rowp + bj * HALF + n * 16) = acc[ai][bj][m][n]; }
    }
};

__device__ __forceinline__ float dpp_prev(float v) { return __builtin_bit_cast(float, __builtin_amdgcn_update_dpp(0, __builtin_bit_cast(int, v), 0x121, 0xf, 0xf, false)); }
__device__ __forceinline__ float dpp_next(float v) { return __builtin_bit_cast(float, __builtin_amdgcn_update_dpp(0, __builtin_bit_cast(int, v), 0x12F, 0xf, 0xf, false)); }
struct EpiConv {
    static constexpr bool PERM = true, AFTER_DRAIN = false;
    bf16_t* ACT; const float* cw; const float* cb; float* UB; PG8_LAS float* xb; int dff;
    __device__ __forceinline__ void operator()(const f32x4 (&acc)[2][2][4][2], const Unit& u, int wr, int wc, int fr, int fq) const {
        const int cl = 32 * wc + 8 * fq, F = 128 * u.pn + cl, dff2 = 2 * dff;
        if (fr == 0 || fr == 15) { const int which = fr == 0 ? 0 : 1, m = fr == 0 ? 0 : 3;
#pragma unroll
            for (int ai = 0; ai < 2; ++ai)
#pragma unroll
                for (int bj = 0; bj < 2; ++bj)
#pragma unroll
                    for (int n = 0; n < 2; ++n) *(PG8_LAS f32x4*)(xb + ((((2 * ai + wr) * 2 + which) * 2 + bj) * 128 + cl + 4 * n)) = acc[ai][bj][m][n]; }
        asm volatile("s_waitcnt lgkmcnt(0)" ::: "memory"); __builtin_amdgcn_s_barrier(); asm volatile("" ::: "memory");
#pragma unroll
        for (int n = 0; n < 2; ++n) {
            f32x4 wgt[2][3], bia[2];
#pragma unroll
            for (int bj = 0; bj < 2; ++bj) { bia[bj] = *(const f32x4*)(cb + bj * dff + F + 4 * n);
#pragma unroll
                for (int j = 0; j < 3; ++j) wgt[bj][j] = *(const f32x4*)(cw + j * dff2 + bj * dff + F + 4 * n); }
#pragma unroll
            for (int ai = 0; ai < 2; ++ai) { const int B = 2 * ai + wr;
#pragma unroll
                for (int m = 0; m < 4; ++m) { f32x4 o[2];
#pragma unroll
                    for (int bj = 0; bj < 2; ++bj) { const f32x4 cur = acc[ai][bj][m][n]; f32x4 sp = cur, sn = cur;
                        if (m > 0) { const f32x4 up = acc[ai][bj][m > 0 ? m - 1 : 0][n]; sp = fr == 15 ? up : cur; }
                        if (m < 3) { const f32x4 dn = acc[ai][bj][m < 3 ? m + 1 : 3][n]; sn = fr == 0 ? dn : cur; }
                        f32x4 pv, nx; pv.x = dpp_prev(sp.x); pv.y = dpp_prev(sp.y); pv.z = dpp_prev(sp.z); pv.w = dpp_prev(sp.w);
                        nx.x = dpp_next(sn.x); nx.y = dpp_next(sn.y); nx.z = dpp_next(sn.z); nx.w = dpp_next(sn.w);
                        if (m == 0) { if (fr == 0 && B > 0) pv = *(const PG8_LAS f32x4*)(xb + (((B - 1) * 2 + 1) * 2 + bj) * 128 + cl + 4 * n); }
                        if (m == 3) { if (fr == 15 && B < 3) nx = *(const PG8_LAS f32x4*)(xb + (((B + 1) * 2 + 0) * 2 + bj) * 128 + cl + 4 * n); }
                        o[bj] = bia[bj] + wgt[bj][0] * pv + wgt[bj][1] * cur + wgt[bj][2] * nx; }
                    f32x4 a;
                    a.x = o[0].x * __builtin_amdgcn_rcpf(1.0f + __builtin_amdgcn_exp2f(-1.4426950408889634f * o[0].x)) * o[1].x;
                    a.y = o[0].y * __builtin_amdgcn_rcpf(1.0f + __builtin_amdgcn_exp2f(-1.4426950408889634f * o[0].y)) * o[1].y;
                    a.z = o[0].z * __builtin_amdgcn_rcpf(1.0f + __builtin_amdgcn_exp2f(-1.4426950408889634f * o[0].z)) * o[1].z;
                    a.w = o[0].w * __builtin_amdgcn_rcpf(1.0f + __builtin_amdgcn_exp2f(-1.4426950408889634f * o[0].w)) * o[1].w;
                    const int rl = 128 * ai + 64 * wr + 16 * m + fr;
                    if (rl != 0 && rl != 255) { typedef unsigned u32x2 __attribute__((ext_vector_type(2))); u32x2 w2; w2.x = cvt_pk_bf16(a.x, a.y); w2.y = cvt_pk_bf16(a.z, a.w);
                        *(u32x2*)(ACT + (size_t)(u.pm * BM + rl) * dff + F + 4 * n) = w2; } } }
            asm volatile("" ::: "memory"); }
        if (wr == 0 && fr < 2) {
#pragma unroll
            for (int bj = 0; bj < 2; ++bj)
#pragma unroll
                for (int n = 0; n < 2; ++n) *(f32x4*)(UB + (size_t)(u.pm * 4 + fr) * dff2 + bj * dff + F + 4 * n) = acc[0][bj][0][n]; }
        if (wr == 1 && fr >= 14) {
#pragma unroll
            for (int bj = 0; bj < 2; ++bj)
#pragma unroll
                for (int n = 0; n < 2; ++n) *(f32x4*)(UB + (size_t)(u.pm * 4 + fr - 12) * dff2 + bj * dff + F + 4 * n) = acc[1][bj][3][n]; }
    }
};
template <class Epi, class Sched, bool ALIGN_EPI = false, bool SP2 = false>
__device__ __forceinline__ void gemm_phase(PG8_LAS unsigned char* lds, const Gemm g, const Sched& S, const Epi& E) {
    int tid_l = threadIdx.x; asm volatile("" : "+v"(tid_l));
    const int tid = tid_l, wid = __builtin_amdgcn_readfirstlane(tid >> 6), lane = tid & 63, wr = wid >> 2, wc = wid & 3, fr = lane & 15, fq = lane >> 4;
    const int K = g.K, nt = g.kloop / BK;
    unsigned voffA[2], voffB[2];
#pragma unroll
    for (int i = 0; i < 2; ++i) { int R, C; stage_rc(tid * 16 + i * 8192, R, C); const int Rb = Epi::PERM ? ((R & ~31) + perm32(R & 31)) : R;
        voffA[i] = (unsigned)(R * K + C) * 2u; voffB[i] = (unsigned)(Rb * K + C) * 2u; }
    const size_t kstep = (size_t)(BK * 2);
    const size_t hstep = (size_t)HALF * K * 2;
    const size_t tstep = 2 * hstep;
    const unsigned ldsw = (unsigned)wid * 1024u;
    const int aoff = lds_byte(wr * 64 + fr, fq * 8), boff = lds_byte(wc * 32 + fr, fq * 8);
#define PG8_SA(b, h) (((b) * 2 + (h)) * HTB)
#define PG8_SB(b, h) ((4 + (b) * 2 + (h)) * HTB)
#define PG8_STAGE(bufoff, gbase, voff) do { _Pragma("unroll") for (int _i = 0; _i < 2; ++_i) \
        __builtin_amdgcn_global_load_lds((const unsigned*)((const char*)(gbase) + (voff)[_i]), (PG8_LAS unsigned*)(lds + (bufoff) + ldsw + _i * 8192), 16, 0, 0); } while (0)
#define PG8_LDA(dst, b, h) do { _Pragma("unroll") for (int m = 0; m < 4; ++m) _Pragma("unroll") for (int k = 0; k < 2; ++k) dst[m][k] = *(const PG8_LAS bf16x8*)(lds + PG8_SA(b, h) + aoff + m * 2048 + k * 1024); } while (0)
#define PG8_LDB(dst, b, h) do { _Pragma("unroll") for (int n = 0; n < 2; ++n) _Pragma("unroll") for (int k = 0; k < 2; ++k) dst[n][k] = *(const PG8_LAS bf16x8*)(lds + PG8_SB(b, h) + boff + n * 2048 + k * 1024); } while (0)
#define PG8_MMA(ai, bj, At, Bt) do { __builtin_amdgcn_s_setprio(1); _Pragma("unroll") for (int m = 0; m < 4; ++m) _Pragma("unroll") for (int n = 0; n < 2; ++n) _Pragma("unroll") for (int k = 0; k < 2; ++k) \
        acc[ai][bj][m][n] = __builtin_amdgcn_mfma_f32_16x16x32_bf16(Bt[n][k], At[m][k], acc[ai][bj][m][n], 0, 0, 0); __builtin_amdgcn_s_setprio(0); } while (0)
#define PG8_WAIT_V(n) asm volatile("s_waitcnt vmcnt(" #n ")" ::: "memory")
#define PG8_WAIT_L(n) asm volatile("s_waitcnt lgkmcnt(" #n ")" ::: "memory")
#define PG8_BAR __builtin_amdgcn_s_barrier()
#define PG8_SCHED __builtin_amdgcn_sched_barrier(0)
    Unit cur, nxt; int ui = 0;
    if (!S.next(0, cur)) return;
    f32x4 acc[2][2][4][2];
#pragma unroll
    for (int a = 0; a < 2; ++a)
#pragma unroll
        for (int b = 0; b < 2; ++b)
#pragma unroll
            for (int m = 0; m < 4; ++m)
#pragma unroll
                for (int n = 0; n < 2; ++n) acc[a][b][m][n] = (f32x4){0.f, 0.f, 0.f, 0.f};
    bf16x8 At[4][2], B0[2][2], B1[2][2];
    const char* cA = (const char*)g.A + (size_t)cur.pm * tstep + (size_t)cur.kofs * 2; const char* cB = (const char*)g.Bt + (size_t)cur.pn * tstep + (size_t)cur.kofs * 2;
    S.a_ready(cur);
    if constexpr (SP2) {
        PG8_STAGE(PG8_SB(0, 0), cB, voffB); PG8_STAGE(PG8_SB(0, 1), cB + hstep, voffB); PG8_STAGE(PG8_SA(0, 0), cA, voffA); PG8_STAGE(PG8_SA(0, 1), cA + hstep, voffA);
        if (wr == 1) PG8_BAR;
        PG8_WAIT_V(2); PG8_BAR;
        PG8_STAGE(PG8_SB(1, 0), cB + kstep, voffB); PG8_STAGE(PG8_SA(1, 0), cA + kstep, voffA); PG8_STAGE(PG8_SB(1, 1), cB + hstep + kstep, voffB);
        PG8_WAIT_V(6); PG8_BAR;
    } else {
        PG8_STAGE(PG8_SB(0, 0), cB, voffB); PG8_STAGE(PG8_SA(0, 0), cA, voffA); PG8_STAGE(PG8_SB(0, 1), cB + hstep, voffB); PG8_STAGE(PG8_SA(0, 1), cA + hstep, voffA);
        if (wr == 1) PG8_BAR;
        PG8_WAIT_V(4); PG8_BAR;
        PG8_STAGE(PG8_SB(1, 0), cB + kstep, voffB); PG8_STAGE(PG8_SA(1, 0), cA + kstep, voffA); PG8_STAGE(PG8_SB(1, 1), cB + hstep + kstep, voffB);
        PG8_WAIT_V(6); PG8_BAR;
    }
    for (;;) {
        const bool has_next = S.next(ui + 1, nxt);
        const char* nA = has_next ? (const char*)g.A + (size_t)nxt.pm * tstep + (size_t)nxt.kofs * 2 : cA; const char* nB = has_next ? (const char*)g.Bt + (size_t)nxt.pn * tstep + (size_t)nxt.kofs * 2 : cB;
        for (int t = 0; t < nt; t += 2) {
            const bool last = (t == nt - 2);
            const char* a1 = cA + (size_t)(t + 1) * kstep;
            const char* a2 = last ? nA : cA + (size_t)(t + 2) * kstep; const char* b2 = last ? nB : cB + (size_t)(t + 2) * kstep;
            const char* a3 = a2 + kstep; const char* b3 = b2 + kstep;
            if (last && has_next) S.a_ready(nxt);
            if constexpr (SP2) {
            PG8_LDB(B0, 0, 0); PG8_LDB(B1, 0, 1); PG8_SCHED; PG8_LDA(At, 0, 0); PG8_STAGE(PG8_SA(1, 1), a1 + hstep, voffA);
            PG8_WAIT_V(8); PG8_WAIT_L(0); PG8_BAR; PG8_MMA(0, 0, At, B0); PG8_MMA(0, 1, At, B1); PG8_BAR; PG8_SCHED;
            PG8_LDA(At, 0, 1); PG8_STAGE(PG8_SB(0, 0), b2, voffB); PG8_STAGE(PG8_SB(0, 1), b2 + hstep, voffB); PG8_STAGE(PG8_SA(0, 0), a2, voffA);
            PG8_WAIT_V(8); PG8_WAIT_L(0); PG8_BAR; PG8_MMA(1, 0, At, B0); PG8_MMA(1, 1, At, B1); PG8_BAR; PG8_SCHED;
            PG8_LDB(B0, 1, 0); PG8_LDB(B1, 1, 1); PG8_SCHED; PG8_LDA(At, 1, 0); PG8_STAGE(PG8_SA(0, 1), a2 + hstep, voffA);
            PG8_WAIT_V(8); PG8_WAIT_L(0); PG8_BAR; PG8_MMA(0, 0, At, B0); PG8_MMA(0, 1, At, B1); PG8_BAR; PG8_SCHED;
            PG8_LDA(At, 1, 1); PG8_STAGE(PG8_SB(1, 0), b3, voffB); PG8_STAGE(PG8_SB(1, 1), b3 + hstep, voffB); PG8_STAGE(PG8_SA(1, 0), a3, voffA);
            PG8_WAIT_V(8); PG8_WAIT_L(0); PG8_BAR; PG8_MMA(1, 0, At, B0); PG8_MMA(1, 1, At, B1); PG8_BAR; PG8_SCHED;
            } else {
            PG8_LDB(B0, 0, 0); PG8_SCHED; PG8_LDA(At, 0, 0); PG8_STAGE(PG8_SA(1, 1), a1 + hstep, voffA);
            PG8_WAIT_L(8); PG8_BAR; PG8_WAIT_L(0); PG8_MMA(0, 0, At, B0); PG8_BAR; PG8_SCHED;
            PG8_LDB(B1, 0, 1); PG8_STAGE(PG8_SB(0, 0), b2, voffB);
            PG8_BAR; PG8_WAIT_L(0); PG8_MMA(0, 1, At, B1); PG8_BAR;
            PG8_LDA(At, 0, 1); PG8_STAGE(PG8_SA(0, 0), a2, voffA);
            PG8_BAR; PG8_WAIT_L(0); PG8_MMA(1, 0, At, B0); PG8_BAR; PG8_SCHED;
            PG8_STAGE(PG8_SB(0, 1), b2 + hstep, voffB);
            PG8_WAIT_V(6); PG8_BAR; PG8_MMA(1, 1, At, B1); PG8_BAR;
            PG8_LDB(B0, 1, 0); PG8_SCHED; PG8_LDA(At, 1, 0); PG8_STAGE(PG8_SA(0, 1), a2 + hstep, voffA);
            PG8_WAIT_L(8); PG8_BAR; PG8_WAIT_L(0); PG8_MMA(0, 0, At, B0); PG8_BAR; PG8_SCHED;
            PG8_LDB(B1, 1, 1); PG8_STAGE(PG8_SB(1, 0), b3, voffB);
            PG8_BAR; PG8_WAIT_L(0); PG8_MMA(0, 1, At, B1); PG8_BAR;
            PG8_LDA(At, 1, 1); PG8_STAGE(PG8_SA(1, 0), a3, voffA);
            PG8_BAR; PG8_WAIT_L(0); PG8_MMA(1, 0, At, B0); PG8_BAR; PG8_SCHED;
            PG8_STAGE(PG8_SB(1, 1), b3 + hstep, voffB);
            PG8_WAIT_V(6); PG8_BAR; PG8_MMA(1, 1, At, B1); PG8_BAR;
            }
        }
        if constexpr (ALIGN_EPI) { if (wr == 0) PG8_BAR; }
        if constexpr (!Epi::AFTER_DRAIN) { E(acc, cur, wr, wc, fr, fq); S.done(cur); }
        if (!has_next) break;
#pragma unroll
        for (int a = 0; a < 2; ++a)
#pragma unroll
            for (int b = 0; b < 2; ++b)
#pragma unroll
                for (int m = 0; m < 4; ++m)
#pragma unroll
                    for (int n = 0; n < 2; ++n) acc[a][b][m][n] = (f32x4){0.f, 0.f, 0.f, 0.f};
        cur = nxt; cA = nA; cB = nB; ++ui;
        if constexpr (ALIGN_EPI) { if (wr == 1) PG8_BAR; }
    }
    PG8_WAIT_V(0);
    if constexpr (!ALIGN_EPI) { if (wr == 0) PG8_BAR; }
    PG8_BAR;
    if constexpr (Epi::AFTER_DRAIN) { E.fused(acc, cur, wr, wc, fr, fq, lds, wid, lane); S.done(cur); }
#undef PG8_SA
#undef PG8_SB
#undef PG8_STAGE
#undef PG8_LDA
#undef PG8_LDB
#undef PG8_MMA
#undef PG8_WAIT_V
#undef PG8_WAIT_L
#undef PG8_BAR
#undef PG8_SCHED
}
}
#define LAS __attribute__((address_space(3)))
#define XB_TMO      128
#define XB_XCNT(j)  (256  + 64 * (j))
#define XB_XSUB(j)  (1280 + 64 * (j))
#define XB_XGEN(j)  (2304 + 64 * (j))
#define XB_TOP      3328
#define XB_TOPGEN   3392
#define XCD_BAR_WORDS 3456
#define XB_SPIN_CAP (1u << 18)

__device__ __forceinline__ unsigned xb_ld(unsigned* p)              { return __hip_atomic_load(p, __ATOMIC_RELAXED, __HIP_MEMORY_SCOPE_AGENT); }
__device__ __forceinline__ unsigned xb_add(unsigned* p, unsigned v) { return __hip_atomic_fetch_add(p, v, __ATOMIC_RELAXED, __HIP_MEMORY_SCOPE_AGENT); }
__device__ __forceinline__ unsigned xb_xcc_id() { return (unsigned)__builtin_amdgcn_s_getreg((3 << 11) | 20) & 0xFu; }
#define XB_SPIN(cond, bar) do { unsigned _sp = 0; while (cond) { __builtin_amdgcn_s_sleep(1); \
    if ((++_sp & 255u) == 0u) { if (xb_ld(&(bar)[XB_TMO])) break; if (_sp > XB_SPIN_CAP) { atomicAdd(&(bar)[XB_TMO], 1u); break; } } } } while (0)

struct XcdBarrier {
    unsigned* bar; unsigned x;
    volatile LAS unsigned* st;
};

__device__ __forceinline__ XcdBarrier xcd_barrier_post(unsigned* bar, volatile LAS unsigned* st) {
    XcdBarrier b; b.bar = bar; b.x = xb_xcc_id(); b.st = st;
    if (threadIdx.x == 0) (void)xb_add(&bar[XB_XCNT(b.x)], 1u);
    return b;
}
__device__ __forceinline__ void xcd_barrier_complete(unsigned* bar, unsigned x, unsigned& nloc, unsigned& nx) {
    const unsigned G = gridDim.x * gridDim.y * gridDim.z;
    unsigned sum, cnt, mine, sp = 0u;
    for (;;) {
        sum = 0u; cnt = 0u; mine = 0u;
#pragma unroll
        for (unsigned j = 0; j < 16; ++j) { const unsigned c = xb_ld(&bar[XB_XCNT(j)]); sum += c; cnt += (c > 0u) ? 1u : 0u; mine = (j == x) ? c : mine; }
        if (sum == G) break;
        __builtin_amdgcn_s_sleep(1);
        if ((++sp & 255u) == 0u) { if (xb_ld(&bar[XB_TMO])) break; if (sp > XB_SPIN_CAP) { atomicAdd(&bar[XB_TMO], 1u); break; } }
    }
    nloc = mine > 0u ? mine : 1u; nx = cnt > 0u ? cnt : 1u;
}

__device__ __forceinline__ void xcd_barrier(const XcdBarrier& b) {
    asm volatile("s_waitcnt vmcnt(0)" ::: "memory");
    __syncthreads();
    if (threadIdx.x == 0) {
        unsigned* bar = b.bar;
        __builtin_amdgcn_s_waitcnt(0);
        unsigned nloc = b.st[0], nx = b.st[1];
        if (nloc == 0u) { xcd_barrier_complete(bar, b.x, nloc, nx); b.st[0] = nloc; b.st[1] = nx; }
        const unsigned old = xb_add(&bar[XB_XSUB(b.x)], 1u);
        const unsigned gen = old / nloc;
        if (old + 1u == (gen + 1u) * nloc) {
            __builtin_amdgcn_fence(__ATOMIC_RELEASE, "agent");
            asm volatile("s_waitcnt vmcnt(0)" ::: "memory");
            const unsigned og = xb_add(&bar[XB_TOP], 1u);
            const unsigned tg = og / nx;
            if (og + 1u == (tg + 1u) * nx) xb_add(&bar[XB_TOPGEN], 1u);
            else XB_SPIN(xb_ld(&bar[XB_TOPGEN]) == tg, bar);
            __builtin_amdgcn_fence(__ATOMIC_ACQUIRE, "agent");
            xb_add(&bar[XB_XGEN(b.x)], 1u);
            asm volatile("s_waitcnt vmcnt(0)" ::: "memory");
        } else {
            XB_SPIN(xb_ld(&bar[XB_XGEN(b.x)]) == gen, bar);
            __builtin_amdgcn_fence(__ATOMIC_ACQUIRE, "agent");
            asm volatile("s_waitcnt vmcnt(0)" ::: "memory");
        }
    }
    __syncthreads();
}

constexpr int DM = 2048, NB = 4, SEQ = 4096, CTXL = 256, DEPTH = 4;
constexpr int M_LAT = NB * SEQ, M_CTX = NB * CTXL, M_ALL = M_LAT + M_CTX;
constexpr int DFF = 5632, DFF2 = 2 * DFF, NQKV = 3072, NGLA = 6144, NGLA_EXT = 6400, NMOD = 6 * DM;
constexpr float EPS = 1e-6f;
#ifndef MK_ONE_LAUNCH
#define MK_ONE_LAUNCH 1
#endif
#ifndef NAIVE_ATTN
#define NAIVE_ATTN 0
#endif
#ifndef NAIVE_GLA
#define NAIVE_GLA 0
#endif
#ifndef RPT_PRO
#define RPT_PRO 1
#endif
#ifndef RPT_NORM
#define RPT_NORM 1
#endif
#ifndef RPT_ATT
#define RPT_ATT 1
#endif
#ifndef RPT_GPRE
#define RPT_GPRE 1
#endif
#ifndef RPT_SCAN
#define RPT_SCAN 1
#endif
#ifndef RPT_COMB
#define RPT_COMB 1
#endif
#ifndef RPT_UP
#define RPT_UP 1
#endif
#ifndef RPT_CONV
#define RPT_CONV 1
#endif
#ifndef RPT_PROJ
#define RPT_PROJ 1
#endif
#ifndef RPT_WO
#define RPT_WO 0
#endif
#ifndef RPT_DN
#define RPT_DN 0
#endif
#ifndef EXTRA_BAR
#define EXTRA_BAR 0
#endif
#ifndef RPT_AVT
#define RPT_AVT 1
#endif
#ifndef DIAG_SCAN
#define DIAG_SCAN 0
#endif
#ifndef SPLITK_WO
#define SPLITK_WO 0
#endif
#ifndef SPLITK_DN
#define SPLITK_DN 1
#endif
#ifndef FUSE_CONV
#define FUSE_CONV 1
#endif
constexpr int NPH = 42;

constexpr size_t MiB = 1u << 20;
constexpr size_t WS_CTL = 0, CTL_ZERO_BYTES = 1 * MiB;
constexpr size_t WS_MODS = 1 * MiB;
constexpr size_t WS_X = 2 * MiB;
constexpr size_t WS_H = 138 * MiB;
constexpr size_t WS_P = 206 * MiB;
constexpr size_t WS_Z1 = 410 * MiB;
constexpr size_t WS_OMIX = 413 * MiB;
constexpr size_t WS_U = 481 * MiB;
constexpr size_t WS_OF = WS_U, WS_OB = WS_U + 136 * MiB;
constexpr size_t WS_UB = WS_U + 64 * MiB;
constexpr size_t WS_PART = WS_U;
constexpr size_t WS_VTA = WS_U;
constexpr size_t WS_QT = WS_U;
constexpr size_t WS_KHT = WS_U + 68 * MiB;
constexpr size_t WS_AIN = WS_U + 136 * MiB;
constexpr size_t WS_DEC = WS_U + 153 * MiB;
constexpr size_t WS_VT = WS_U + 156 * MiB;
constexpr size_t WS_OFB = WS_U + 224 * MiB, WS_OBB = WS_U + 292 * MiB;
constexpr size_t WS_ACT = 855 * MiB;
constexpr size_t WS_WUP = 1042 * MiB, WUP_STRIDE = 44 * MiB;
constexpr size_t WS_WDN = 1218 * MiB, WDN_STRIDE = 22 * MiB;
constexpr size_t WS_WQKV = 1306 * MiB, WQKV_STRIDE = 12 * MiB;
constexpr size_t WS_WAO = 1330 * MiB, WO_STRIDE = 8 * MiB;
constexpr size_t WS_WGIN = 1346 * MiB, WGIN_STRIDE = 25 * MiB;
constexpr size_t WS_WGO = 1396 * MiB;
constexpr size_t WS_END = 1412 * MiB;
constexpr int CW_BAR = 4096;

constexpr int RING_BYTES = 131072, LDSCTL_OFF = RING_BYTES, LDS_BYTES = 147456;

#define GAS __attribute__((address_space(1)))
#define LAS __attribute__((address_space(3)))
typedef unsigned short bf16;
typedef unsigned v4u __attribute__((ext_vector_type(4)));
typedef unsigned v2u __attribute__((ext_vector_type(2)));
typedef float f32x4 __attribute__((ext_vector_type(4)));
#define LDS_WAIT() asm volatile("s_waitcnt lgkmcnt(0)" ::: "memory")
__device__ __forceinline__ unsigned pk2(float lo, float hi) { return pg8::cvt_pk_bf16(lo, hi); }
__device__ __forceinline__ unsigned f2bf(float f) { return pk2(f, 0.f) & 0xffffu; }
__device__ __forceinline__ float bf_lo(unsigned w) { return __builtin_bit_cast(float, w << 16); }
__device__ __forceinline__ float bf_hi(unsigned w) { return __builtin_bit_cast(float, w & 0xffff0000u); }
__device__ __forceinline__ float bf2f(bf16 h) { return __builtin_bit_cast(float, ((unsigned)h) << 16); }
__device__ __forceinline__ float silu_f(float v) { return v / (1.0f + __expf(-v)); }
__device__ __forceinline__ float wave_sum(float v) {
#pragma unroll
    for (int o = 1; o < 64; o <<= 1) v += __shfl_xor(v, o);
    return v;
}

__device__ __forceinline__ void unpack8(const v4u a, float (&x)[8]) { x[0] = bf_lo(a.x); x[1] = bf_hi(a.x); x[2] = bf_lo(a.y); x[3] = bf_hi(a.y); x[4] = bf_lo(a.z); x[5] = bf_hi(a.z); x[6] = bf_lo(a.w); x[7] = bf_hi(a.w); }

struct Args { const float* in[25]; float* out; unsigned char* ws; int ph_lo, ph_hi; };
struct WV { int tid, lane, wave, G, vcu, gw, NGW; LAS unsigned char* lds; };

__device__ __forceinline__ void p0_transpose_item(const float* W, int K, int N, bf16* WT, int row_off, LAS float* scr, int item, int lane, bool remap_up) {
    const int nblk = N / 32, kb = item / nblk, nb = item % nblk, k0 = 64 * kb, n0 = 32 * nb;
    const int r0 = remap_up ? ((n0 < DFF ? 0 : 128) + 256 * ((n0 < DFF ? n0 : n0 - DFF) >> 7) + ((n0 < DFF ? n0 : n0 - DFF) & 127)) : n0;
#pragma unroll 8
    for (int i = 0; i < 32; ++i) { const int kk = 2 * i + (lane >> 5); scr[kk * 33 + (lane & 31)] = W[(size_t)(k0 + kk) * N + n0 + (lane & 31)]; }
    LDS_WAIT(); asm volatile("" ::: "memory");
    const int c = lane & 7;
#pragma unroll
    for (int j = 0; j < 4; ++j) { const int n = (lane >> 3) + 8 * j; const LAS float* s = scr + (8 * c) * 33 + n;
        v4u o; o.x = pk2(s[0 * 33], s[1 * 33]); o.y = pk2(s[2 * 33], s[3 * 33]); o.z = pk2(s[4 * 33], s[5 * 33]); o.w = pk2(s[6 * 33], s[7 * 33]);
        *(v4u*)(WT + (size_t)(row_off + r0 + n) * K + k0 + 8 * c) = o; }
    LDS_WAIT(); asm volatile("" ::: "memory");
}
__device__ __forceinline__ void transpose_matrix(const WV& w, const float* W, int K, int N, bf16* WT, int row_off, bool remap_up = false) {
    LAS float* scr = (LAS float*)(w.lds + w.wave * 16384);
    const int nitems = (K / 64) * (N / 32);
    for (int it = w.gw; it < nitems; it += w.NGW) p0_transpose_item(W, K, N, WT, row_off, scr, it, w.lane, remap_up);
}
__device__ __forceinline__ void mods_item(const WV& w, const float* c, const float* c_ctx, const float* ada_w, const float* ada_b, float* mods, int it) {
    const int layer = it / 48, n0 = (it % 48) * 256;
    LAS float* sl = (LAS float*)w.lds;
    LAS float* red = (LAS float*)(w.lds + 40960);
    for (int i = w.tid; i < 5 * DM; i += 512) { const int vec = i >> 11, k = i & 2047; const float v = vec < 4 ? c[vec * DM + k] : c_ctx[k]; sl[i] = silu_f(v); }
    __syncthreads();
    const float* Wp = ada_w + (size_t)layer * DM * NMOD + n0 + 4 * w.lane;
    f32x4 acc[5];
#pragma unroll
    for (int v = 0; v < 5; ++v) acc[v] = (f32x4){0.f, 0.f, 0.f, 0.f};
    const int kbeg = w.wave * 256;
    for (int k = kbeg; k < kbeg + 256; k += 4) {
        f32x4 wv[4];
#pragma unroll
        for (int kk = 0; kk < 4; ++kk) wv[kk] = *(const f32x4*)(Wp + (size_t)(k + kk) * NMOD);
#pragma unroll
        for (int kk = 0; kk < 4; ++kk)
#pragma unroll
            for (int v = 0; v < 5; ++v) acc[v] += wv[kk] * sl[v * DM + k + kk];
    }
#pragma unroll
    for (int v = 0; v < 5; ++v) *(LAS f32x4*)(red + (w.wave * 5 + v) * 256 + 4 * w.lane) = acc[v];
    __syncthreads();
    for (int i = w.tid; i < 5 * 256; i += 512) { const int vec = i >> 8, col = i & 255; float s = 0.f;
#pragma unroll
        for (int ww = 0; ww < 8; ++ww) s += red[(ww * 5 + vec) * 256 + col];
        mods[((size_t)layer * 5 + vec) * NMOD + n0 + col] = s + ada_b[(size_t)layer * NMOD + n0 + col]; }
    __syncthreads();
}

__device__ __forceinline__ void norm_rows(const WV& w, float* X, bf16* H, const float* g, const float* shift, const float* scale, int nrows, const float* part, int nsplit, const float* pgate) {
    for (int row = w.gw; row < nrows; row += w.NGW) {
        const int vec = row < M_LAT ? (row >> 12) : 4;
        f32x4* xr = (f32x4*)(X + (size_t)row * DM) + w.lane;
        f32x4 v[8]; float ss = 0.f;
#pragma unroll
        for (int j = 0; j < 8; ++j) v[j] = xr[64 * j];
        if (nsplit > 0 && row >= M_LAT) {
            const f32x4* pr = (const f32x4*)(part + (size_t)(row - M_LAT) * DM) + w.lane;
#pragma unroll
            for (int j = 0; j < 8; ++j) { f32x4 sum = pr[64 * j];
                for (int sl = 1; sl < nsplit; ++sl) sum += pr[(size_t)sl * (M_CTX * DM / 4) + 64 * j];
                v[j] += *(const f32x4*)(pgate + 4 * (64 * j + w.lane)) * sum; xr[64 * j] = v[j]; }
        }
#pragma unroll
        for (int j = 0; j < 8; ++j) ss += (v[j].x * v[j].x + v[j].y * v[j].y) + (v[j].z * v[j].z + v[j].w * v[j].w);
        const float r = 1.0f / sqrtf(wave_sum(ss) * (1.0f / DM) + EPS);
        const float* sh = shift + (size_t)vec * NMOD; const float* sc = scale + (size_t)vec * NMOD;
        v2u* o8 = (v2u*)(H + (size_t)row * DM) + w.lane;
#pragma unroll
        for (int j = 0; j < 8; ++j) { const int col = 4 * (64 * j + w.lane);
            const f32x4 gv = *(const f32x4*)(g + col), s = *(const f32x4*)(sc + col), t = *(const f32x4*)(sh + col);
            const f32x4 y = v[j] * r * gv * (s + 1.0f) + t;
            v2u o; o.x = pk2(y.x, y.y); o.y = pk2(y.z, y.w); o8[64 * j] = o; }
    }
}
__device__ __forceinline__ void final_norm(const WV& w, const float* X, float* out, const float* g) {
    for (int row = w.gw; row < M_LAT; row += w.NGW) {
        const f32x4* xr = (const f32x4*)(X + (size_t)row * DM) + w.lane;
        f32x4 v[8]; float ss = 0.f;
#pragma unroll
        for (int j = 0; j < 8; ++j) { v[j] = xr[64 * j]; ss += (v[j].x * v[j].x + v[j].y * v[j].y) + (v[j].z * v[j].z + v[j].w * v[j].w); }
        const float r = 1.0f / sqrtf(wave_sum(ss) * (1.0f / DM) + EPS);
        f32x4* o = (f32x4*)(out + (size_t)row * DM) + w.lane;
#pragma unroll
        for (int j = 0; j < 8; ++j) { const int col = 4 * (64 * j + w.lane); o[64 * j] = v[j] * r * *(const f32x4*)(g + col); }
    }
}

__device__ __forceinline__ void rope_rows(const WV& w, bf16* P) {
    const int half = (w.lane >> 2) & 1, oct = w.lane & 3;
    float inv[8];
#pragma unroll
    for (int e = 0; e < 8; ++e) inv[e] = exp2f(-(float)(2 * (8 * oct + e)) * (13.287712379549449f / 64.0f));
    for (int row = w.gw; row < M_LAT; row += w.NGW) {
        const int t = row & (SEQ - 1); const float pos = (float)(half ? (t & 63) : (t >> 6));
        float cs[8], sn[8];
#pragma unroll
        for (int e = 0; e < 8; ++e) { const float ang = pos * inv[e]; cs[e] = __cosf(ang); sn[e] = __sinf(ang); }
        bf16* base = P + (size_t)row * NQKV + half * 64 + 8 * oct;
#pragma unroll
        for (int rnd = 0; rnd < 3; ++rnd) { const int hd = (w.lane >> 3) + 8 * rnd;
            if (hd < 20) { bf16* p = base + hd * 128; float x1[8], x2[8]; unpack8(*(const v4u*)p, x1); unpack8(*(const v4u*)(p + 32), x2);
                float y1[8], y2[8];
#pragma unroll
                for (int e = 0; e < 8; ++e) { y1[e] = x1[e] * cs[e] - x2[e] * sn[e]; y2[e] = x2[e] * cs[e] + x1[e] * sn[e]; }
                *(v4u*)p = (v4u){pk2(y1[0], y1[1]), pk2(y1[2], y1[3]), pk2(y1[4], y1[5]), pk2(y1[6], y1[7])};
                *(v4u*)(p + 32) = (v4u){pk2(y2[0], y2[1]), pk2(y2[2], y2[3]), pk2(y2[4], y2[5]), pk2(y2[6], y2[7])}; } }
    }
}

__device__ __forceinline__ void attn_naive(const WV& w, const bf16* P, const float* sink, bf16* O) {
    const int g = w.lane >> 4, li = w.lane & 15;
    const float scale = 0.08838834764831845f;
    for (int task = w.gw; task < M_ALL * 16; task += w.NGW) {
        const int row = task >> 4, hq = task & 15, kvh = hq >> 2;
        float q[8];
        { const v4u qq = *(const v4u*)(P + (size_t)row * NQKV + hq * 128 + 8 * li);
          q[0] = bf_lo(qq.x) * scale; q[1] = bf_hi(qq.x) * scale; q[2] = bf_lo(qq.y) * scale; q[3] = bf_hi(qq.y) * scale;
          q[4] = bf_lo(qq.z) * scale; q[5] = bf_hi(qq.z) * scale; q[6] = bf_lo(qq.w) * scale; q[7] = bf_hi(qq.w) * scale; }
        int b, wbase = 0, nwin = 0;
        if (row < M_LAT) { b = row >> 12; const int t = row & (SEQ - 1); const int j0 = t - 128 < 0 ? 0 : t - 128, j1 = t + 128 > SEQ - 1 ? SEQ - 1 : t + 128; wbase = b * SEQ + j0; nwin = j1 - j0 + 1; }
        else b = (row - M_LAT) >> 8;
        const int cbase = M_LAT + b * CTXL, nk = nwin + CTXL;
        float m = sink[hq], l = (g == 0) ? 1.0f : 0.0f, o[8];
#pragma unroll
        for (int d = 0; d < 8; ++d) o[d] = 0.f;
        for (int i = g; i < nk; i += 4) {
            const int krow = i < nwin ? wbase + i : cbase + (i - nwin);
            const bf16* kp = P + (size_t)krow * NQKV + 2048 + kvh * 128 + 8 * li;
            const v4u kk = *(const v4u*)kp, vv = *(const v4u*)(kp + 512);
            float s = q[0] * bf_lo(kk.x) + q[1] * bf_hi(kk.x) + q[2] * bf_lo(kk.y) + q[3] * bf_hi(kk.y) + q[4] * bf_lo(kk.z) + q[5] * bf_hi(kk.z) + q[6] * bf_lo(kk.w) + q[7] * bf_hi(kk.w);
            s += __shfl_xor(s, 1); s += __shfl_xor(s, 2); s += __shfl_xor(s, 4); s += __shfl_xor(s, 8);
            const float mn = fmaxf(m, s), a = __expf(m - mn), p = __expf(s - mn);
            l = l * a + p; m = mn;
            o[0] = o[0] * a + p * bf_lo(vv.x); o[1] = o[1] * a + p * bf_hi(vv.x); o[2] = o[2] * a + p * bf_lo(vv.y); o[3] = o[3] * a + p * bf_hi(vv.y);
            o[4] = o[4] * a + p * bf_lo(vv.z); o[5] = o[5] * a + p * bf_hi(vv.z); o[6] = o[6] * a + p * bf_lo(vv.w); o[7] = o[7] * a + p * bf_hi(vv.w);
        }
        float ma = fmaxf(m, __shfl_xor(m, 16)); ma = fmaxf(ma, __shfl_xor(ma, 32));
        const float fsc = __expf(m - ma); l *= fsc; l += __shfl_xor(l, 16); l += __shfl_xor(l, 32);
        const float rl = 1.0f / l;
#pragma unroll
        for (int d = 0; d < 8; ++d) { float x = o[d] * fsc; x += __shfl_xor(x, 16); x += __shfl_xor(x, 32); o[d] = x * rl; }
        if (g == 0) { v4u ov; ov.x = pk2(o[0], o[1]); ov.y = pk2(o[2], o[3]); ov.z = pk2(o[4], o[5]); ov.w = pk2(o[6], o[7]);
            *(v4u*)(O + (size_t)row * DM + hq * 128 + 8 * li) = ov; }
    }
}

__device__ __forceinline__ void gla_naive(const WV& w, const bf16* P, const float* Z1, const float* w2f, const float* bf, const float* w2b, const float* bb, float* OF, float* OB) {
    LAS float* buf = (LAS float*)w.lds;
    const int vc = w.tid >> 2, dq = w.tid & 3;
    for (int it = w.vcu; it < 128; it += w.G) {
        const int vs = it & 3, dir = (it >> 2) & 1, h = (it >> 3) & 3, b = it >> 5;
        const float* w2 = dir ? w2b : w2f; const float* bias = dir ? bb : bf; float* OUT = dir ? OB : OF;
        float w2c[16], bz = 0.f;
        if (w.tid < 256) { bz = bias[h * 256 + w.tid];
#pragma unroll
            for (int r = 0; r < 16; ++r) w2c[r] = w2[r * 1024 + h * 256 + w.tid]; }
        else {
#pragma unroll
            for (int r = 0; r < 16; ++r) w2c[r] = 0.f; }
        float S[64];
#pragma unroll
        for (int i = 0; i < 64; ++i) S[i] = 0.f;
        const int cbase = M_LAT + b * CTXL, lbase = b * SEQ;
#define GLA_ROW(step) ((step) < CTXL ? (dir ? cbase + CTXL - 1 - (step) : cbase + (step)) : (dir ? lbase + SEQ - 1 - ((step) - CTXL) : lbase + ((step) - CTXL)))
#define GLA_FILL(step, par) do { if (w.tid < 256) { const int r_ = GLA_ROW(step); const float* z_ = Z1 + (size_t)r_ * 32 + dir * 16; float zz = bz; \
            _Pragma("unroll") for (int r = 0; r < 16; ++r) zz += z_[r] * w2c[r]; \
            const float ls_ = fminf(zz, 0.f) - log1pf(__expf(-fabsf(zz))); \
            LAS float* bp_ = buf + (par) * 768; bp_[w.tid] = __expf(ls_ * (1.0f / 16.0f)); \
            bp_[256 + w.tid] = bf2f(P[(size_t)r_ * NGLA + 1024 + h * 256 + w.tid]); bp_[512 + w.tid] = bf2f(P[(size_t)r_ * NGLA + h * 256 + w.tid]) * 0.0625f; } } while (0)
        __syncthreads();
        GLA_FILL(0, 0);
        __syncthreads();
        for (int step = 0; step < CTXL + SEQ; ++step) {
            const int row = GLA_ROW(step);
            if (step + 1 < CTXL + SEQ) GLA_FILL(step + 1, (step + 1) & 1);
            const float v = bf2f(P[(size_t)row * NGLA + 2048 + h * 512 + vs * 128 + vc]);
            const LAS float* bp = buf + (step & 1) * 768 + 64 * dq;
            float acc = 0.f;
#pragma unroll
            for (int i = 0; i < 64; i += 4) {
                const f32x4 e4 = *(const LAS f32x4*)(bp + i), k4 = *(const LAS f32x4*)(bp + 256 + i), q4 = *(const LAS f32x4*)(bp + 512 + i);
                S[i] = S[i] * e4.x + k4.x * v; acc += q4.x * S[i];
                S[i + 1] = S[i + 1] * e4.y + k4.y * v; acc += q4.y * S[i + 1];
                S[i + 2] = S[i + 2] * e4.z + k4.z * v; acc += q4.z * S[i + 2];
                S[i + 3] = S[i + 3] * e4.w + k4.w * v; acc += q4.w * S[i + 3];
            }
            acc += __shfl_xor(acc, 1); acc += __shfl_xor(acc, 2);
            if (dq == 0) OUT[(size_t)row * DM + h * 512 + vs * 128 + vc] = acc;
            __syncthreads();
        }
#undef GLA_ROW
#undef GLA_FILL
    }
}
__device__ __forceinline__ void gla_combine(const WV& w, const float* OF, const float* OB, const bf16* P, const float* og, bf16* O, int nrows) {
    for (int task = w.gw; task < nrows * 4; task += w.NGW) {
        const int row = task >> 2, h = task & 3; const size_t off = (size_t)row * DM + h * 512 + 8 * w.lane;
        const f32x4 a0 = *(const f32x4*)(OF + off), a1 = *(const f32x4*)(OF + off + 4), b0 = *(const f32x4*)(OB + off), b1 = *(const f32x4*)(OB + off + 4);
        const f32x4 o0 = a0 + b0, o1 = a1 + b1;
        float ss = (o0.x * o0.x + o0.y * o0.y) + (o0.z * o0.z + o0.w * o0.w) + (o1.x * o1.x + o1.y * o1.y) + (o1.z * o1.z + o1.w * o1.w);
        const float r = 1.0f / sqrtf(wave_sum(ss) * (1.0f / 512.0f) + EPS);
        const f32x4 g0 = *(const f32x4*)(og + 8 * w.lane), g1 = *(const f32x4*)(og + 8 * w.lane + 4);
        const v4u rr = *(const v4u*)(P + (size_t)row * NGLA + 4096 + h * 512 + 8 * w.lane);
        v4u ov;
        ov.x = pk2(o0.x * r * g0.x * silu_f(bf_lo(rr.x)), o0.y * r * g0.y * silu_f(bf_hi(rr.x)));
        ov.y = pk2(o0.z * r * g0.z * silu_f(bf_lo(rr.y)), o0.w * r * g0.w * silu_f(bf_hi(rr.y)));
        ov.z = pk2(o1.x * r * g1.x * silu_f(bf_lo(rr.z)), o1.y * r * g1.y * silu_f(bf_hi(rr.z)));
        ov.w = pk2(o1.z * r * g1.z * silu_f(bf_lo(rr.w)), o1.w * r * g1.w * silu_f(bf_hi(rr.w)));
        *(v4u*)(O + off) = ov;
    }
}

typedef short bf16x8 __attribute__((ext_vector_type(8)));
typedef float f32x16 __attribute__((ext_vector_type(16)));
__device__ __forceinline__ int gla_row(int b, int cc, int i) { return cc < 64 ? b * SEQ + cc * 64 + i : M_LAT + b * CTXL + (cc - 64) * 64 + i; }
__device__ __forceinline__ void gla_pre(const WV& w, const bf16* P, const float* Z1, const float* w2f, const float* bf_, const float* w2b, const float* bb_, bf16* QT, bf16* KHT, bf16* AIN, float* DEC) {
    LAS bf16* QS = (LAS bf16*)w.lds;
    LAS bf16* KS = (LAS bf16*)(w.lds + 33792);
    LAS bf16* KH = (LAS bf16*)(w.lds + 67584);
    LAS float* z1s = (LAS float*)(w.lds + 104448);
    LAS float* tot = (LAS float*)(w.lds + 108544);
    LAS bf16* AS = (LAS bf16*)(w.lds + 110592);
    const int d = w.tid & 255, hf = w.tid >> 8;
    float w2c[16], bias = 0.f; int cur_dh = -1;
    for (int it = w.vcu; it < 2 * 4 * 4 * 68; it += w.G) {
        const int dir = it & 1, h = (it >> 1) & 3, b = (it >> 3) & 3, cc = it >> 5;
        const size_t item = ((size_t)(dir * 4 + b) * 4 + h) * 68 + cc;
        if (cur_dh != (dir * 4 + h)) { cur_dh = dir * 4 + h; const float* w2 = dir ? w2b : w2f; bias = (dir ? bb_ : bf_)[h * 256 + d];
#pragma unroll
            for (int r = 0; r < 16; ++r) w2c[r] = w2[r * 1024 + h * 256 + d]; }
        const int row0 = gla_row(b, cc, 0);
#pragma unroll
        for (int i = 0; i < 4; ++i) { const int p = w.tid + 512 * i, r = p >> 5, c = p & 31; const bf16* src = P + (size_t)(row0 + r) * NGLA + h * 256 + 8 * c;
            *(LAS v4u*)(QS + r * 264 + 8 * c) = *(const v4u*)src; *(LAS v4u*)(KS + r * 264 + 8 * c) = *(const v4u*)(src + 1024); }
        if (w.tid < 256) *(LAS f32x4*)(z1s + 4 * w.tid) = *(const f32x4*)(Z1 + (size_t)(row0 + (w.tid >> 2)) * 32 + dir * 16 + 4 * (w.tid & 3));
        __syncthreads();
        float g[32];
#pragma unroll
        for (int ii = 0; ii < 32; ++ii) { const LAS f32x4* zp = (const LAS f32x4*)(z1s + (32 * hf + ii) * 16); float zz = bias;
#pragma unroll
            for (int q4 = 0; q4 < 4; ++q4) { const f32x4 z = zp[q4]; zz += z.x * w2c[4 * q4] + z.y * w2c[4 * q4 + 1] + z.z * w2c[4 * q4 + 2] + z.w * w2c[4 * q4 + 3]; }
            g[ii] = (fminf(zz, 0.f) * 1.4426950408889634f - __builtin_amdgcn_logf(1.0f + __builtin_amdgcn_exp2f(-fabsf(zz) * 1.4426950408889634f))) * 0.0625f; }
        float run = 0.f;
        if (!dir) {
#pragma unroll
            for (int ii = 0; ii < 32; ++ii) { run += g[ii]; g[ii] = run; } }
        else {
#pragma unroll
            for (int ii = 31; ii >= 0; --ii) { run += g[ii]; g[ii] = run; } }
        tot[hf * 256 + d] = run;
        __syncthreads();
        const float t0 = tot[d], t1 = tot[256 + d], blast = t0 + t1;
        const float off = dir ? (hf == 0 ? t1 : 0.f) : (hf == 1 ? t0 : 0.f);
        unsigned khat[16];
#pragma unroll
        for (int ii = 0; ii < 32; ++ii) { const int i = 32 * hf + ii; const float bbv = g[ii] + off;
            const float qv = bf2f(QS[i * 264 + d]) * 0.0625f, kv = bf2f(KS[i * 264 + d]);
            const unsigned qk = pk2(qv * __builtin_amdgcn_exp2f(bbv), kv * __builtin_amdgcn_exp2f(-bbv)); const unsigned kh = f2bf(kv * __builtin_amdgcn_exp2f(blast - bbv));
            QS[i * 264 + d] = (bf16)(qk & 0xffffu); KS[i * 264 + d] = (bf16)(qk >> 16);
            if (ii & 1) khat[ii >> 1] |= kh << 16; else khat[ii >> 1] = kh; }
        { LAS v4u* kp = (LAS v4u*)(KH + d * 72 + 32 * hf);
#pragma unroll
          for (int q4 = 0; q4 < 4; ++q4) kp[q4] = (v4u){khat[4 * q4], khat[4 * q4 + 1], khat[4 * q4 + 2], khat[4 * q4 + 3]}; }
        if (hf == 0) DEC[item * 256 + d] = __builtin_amdgcn_exp2f(blast);
        __syncthreads();
#pragma unroll
        for (int i = 0; i < 4; ++i) { const int p = w.tid + 512 * i, r = p >> 5, c = p & 31;
            *(v4u*)(QT + ((size_t)dir * M_ALL + row0 + r) * 1024 + h * 256 + 8 * c) = *(const LAS v4u*)(QS + r * 264 + 8 * c); }
#pragma unroll
        for (int i = 0; i < 4; ++i) { const int p = w.tid + 512 * i, dd = p >> 3, c = p & 7;
            *(v4u*)(KHT + (item * 256 + dd) * 64 + 8 * c) = *(const LAS v4u*)(KH + dd * 72 + 8 * c); }
        { const int rb = w.wave >> 1, ch = w.wave & 1, c16 = w.lane & 15, kg = w.lane >> 4;
          f32x4 acc[2]; acc[0] = (f32x4){0.f, 0.f, 0.f, 0.f}; acc[1] = acc[0];
#pragma unroll
          for (int k8 = 0; k8 < 8; ++k8) { const bf16x8 a = *(const LAS bf16x8*)(QS + (rb * 16 + c16) * 264 + 32 * k8 + 8 * kg);
#pragma unroll
              for (int n = 0; n < 2; ++n) { const bf16x8 bq = *(const LAS bf16x8*)(KS + ((2 * ch + n) * 16 + c16) * 264 + 32 * k8 + 8 * kg); acc[n] = __builtin_amdgcn_mfma_f32_16x16x32_bf16(a, bq, acc[n], 0, 0, 0); } }
#pragma unroll
          for (int n = 0; n < 2; ++n)
#pragma unroll
              for (int r = 0; r < 4; ++r) { const int i = rb * 16 + 4 * kg + r, jj = (2 * ch + n) * 16 + c16; const bool keep = dir ? (jj >= i) : (jj <= i);
                  AS[i * 72 + jj] = (bf16)f2bf(keep ? acc[n][r] : 0.f); } }
        __syncthreads();
        { const int r = w.tid >> 3, c = w.tid & 7; *(v4u*)(AIN + (item * 64 + r) * 64 + 8 * c) = *(const LAS v4u*)(AS + r * 72 + 8 * c); }
        __syncthreads();
    }
}
__device__ __forceinline__ void gla_vt(const WV& w, const bf16* P, bf16* VT) {
    LAS bf16* vt = (LAS bf16*)w.lds;
    for (int it = w.vcu; it < 4 * 4 * 68; it += w.G) {
        const int cc = it % 68, bh = it / 68, h = bh & 3, b = bh >> 2;
        const int row0 = gla_row(b, cc, 0);
#pragma unroll
        for (int rr = 0; rr < 8; ++rr) { const int i = rr * 8 + (w.tid >> 6), piece = w.tid & 63;
            *(LAS v4u*)(vt + i * 520 + 8 * (piece ^ (i >> 3))) = *(const v4u*)(P + (size_t)(row0 + i) * NGLA + 2048 + h * 512 + 8 * piece); }
        __syncthreads();
#pragma unroll
        for (int i = 0; i < 8; ++i) { const int p = w.tid + 512 * i, dv = p >> 3, c = p & 7; unsigned u[8];
#pragma unroll
            for (int e = 0; e < 8; ++e) u[e] = vt[(8 * c + e) * 520 + 8 * ((dv >> 3) ^ c) + (dv & 7)];
            *(v4u*)(VT + ((size_t)it * 512 + dv) * 64 + 8 * c) = (v4u){u[0] | (u[1] << 16), u[2] | (u[3] << 16), u[4] | (u[5] << 16), u[6] | (u[7] << 16)}; }
        __syncthreads();
    }
}
__device__ __forceinline__ void gla_scan(const WV& w, const bf16* QT, const bf16* KHT, const bf16* AIN, const float* DEC, const bf16* VT, bf16* OFB, bf16* OBB) {
    LAS bf16* ST = (LAS bf16*)w.lds;
    LAS bf16* QS = (LAS bf16*)(w.lds + 33792);
    LAS bf16* VS = (LAS bf16*)(w.lds + 67584);
    LAS bf16* AS = (LAS bf16*)(w.lds + 76800);
    LAS float* DS = (LAS float*)(w.lds + 86016);
    LAS bf16* OS = (LAS bf16*)(w.lds + 87040);
    const int wv = w.wave, r32 = w.lane & 31, hh = w.lane >> 5, c16 = w.lane & 15, kg = w.lane >> 4, tb = wv >> 1, dh = wv & 1;
    for (int it = w.vcu; it < 256; it += w.G) {
        const int vs = it & 7, dir = (it >> 3) & 1, h = (it >> 4) & 3, b = it >> 6;
        bf16* O = dir ? OBB : OFB;
        f32x16 S[2];
#pragma unroll
        for (int n = 0; n < 2; ++n)
#pragma unroll
            for (int r = 0; r < 16; ++r) S[n][r] = 0.f;
        v4u sq[4], sv, sa; f32x4 sd = (f32x4){0.f, 0.f, 0.f, 0.f}; bf16x8 kn[4];
#define SC_CC(s_) ((s_) < 4 ? (dir ? 67 - (s_) : 64 + (s_)) : (dir ? 67 - (s_) : (s_) - 4))
#define SC_LOAD(s_) do { const int cc_ = SC_CC(s_); const size_t item_ = ((size_t)(dir * 4 + b) * 4 + h) * 68 + cc_, vitem_ = ((size_t)b * 4 + h) * 68 + cc_; const int row0_ = gla_row(b, cc_, 0); \
            _Pragma("unroll") for (int i_ = 0; i_ < 4; ++i_) { const int p_ = w.tid + 512 * i_; sq[i_] = *(const v4u*)(QT + ((size_t)dir * M_ALL + row0_ + (p_ >> 5)) * 1024 + h * 256 + 8 * (p_ & 31)); } \
            sv = *(const v4u*)(VT + (vitem_ * 512 + vs * 64 + (w.tid >> 3)) * 64 + 8 * (w.tid & 7)); \
            sa = *(const v4u*)(AIN + (item_ * 64 + (w.tid >> 3)) * 64 + 8 * (w.tid & 7)); \
            if (w.tid < 64) sd = *(const f32x4*)(DEC + item_ * 256 + 4 * w.tid); \
            const bf16* krow_ = KHT + (item_ * 256 + 32 * wv + r32) * 64 + 8 * hh; \
            _Pragma("unroll") for (int k4 = 0; k4 < 4; ++k4) kn[k4] = *(const bf16x8*)(krow_ + 16 * k4); } while (0)
        SC_LOAD(0);
        for (int s = 0; s < 68; ++s) {
            const int row0 = gla_row(b, SC_CC(s), 0);
#pragma unroll
            for (int n = 0; n < 2; ++n)
#pragma unroll
                for (int g4 = 0; g4 < 4; ++g4) { v2u pk; pk.x = pk2(S[n][4 * g4], S[n][4 * g4 + 1]); pk.y = pk2(S[n][4 * g4 + 2], S[n][4 * g4 + 3]);
                    *(LAS v2u*)(ST + (32 * n + r32) * 264 + 32 * wv + 8 * g4 + 4 * hh) = pk; }
#pragma unroll
            for (int i = 0; i < 4; ++i) { const int p = w.tid + 512 * i; *(LAS v4u*)(QS + (p >> 5) * 264 + 8 * (p & 31)) = sq[i]; }
            *(LAS v4u*)(VS + (w.tid >> 3) * 72 + 8 * (w.tid & 7)) = sv;
            *(LAS v4u*)(AS + (w.tid >> 3) * 72 + 8 * (w.tid & 7)) = sa;
            if (w.tid < 64) *(LAS f32x4*)(DS + 4 * w.tid) = sd;
            bf16x8 ka[4];
#pragma unroll
            for (int k4 = 0; k4 < 4; ++k4) ka[k4] = kn[k4];
            if (s + 1 < 68) SC_LOAD(s + 1);
            asm volatile("s_waitcnt lgkmcnt(0)" ::: "memory"); __builtin_amdgcn_s_barrier(); asm volatile("" ::: "memory");
            f32x4 oacc[2]; oacc[0] = (f32x4){0.f, 0.f, 0.f, 0.f}; oacc[1] = oacc[0];
#pragma unroll
            for (int k8 = 0; k8 < 8; ++k8) { const bf16x8 qa = *(const LAS bf16x8*)(QS + (tb * 16 + c16) * 264 + 32 * k8 + 8 * kg);
#pragma unroll
                for (int n = 0; n < 2; ++n) { const bf16x8 sb = *(const LAS bf16x8*)(ST + (32 * dh + 16 * n + c16) * 264 + 32 * k8 + 8 * kg); oacc[n] = __builtin_amdgcn_mfma_f32_16x16x32_bf16(qa, sb, oacc[n], 0, 0, 0); } }
#pragma unroll
            for (int k2 = 0; k2 < 2; ++k2) { const bf16x8 aa = *(const LAS bf16x8*)(AS + (tb * 16 + c16) * 72 + 32 * k2 + 8 * kg);
#pragma unroll
                for (int n = 0; n < 2; ++n) { const bf16x8 vb = *(const LAS bf16x8*)(VS + (32 * dh + 16 * n + c16) * 72 + 32 * k2 + 8 * kg); oacc[n] = __builtin_amdgcn_mfma_f32_16x16x32_bf16(aa, vb, oacc[n], 0, 0, 0); } }
#pragma unroll
            for (int n = 0; n < 2; ++n)
#pragma unroll
                for (int r = 0; r < 4; ++r) OS[(tb * 16 + 4 * kg + r) * 72 + 32 * dh + 16 * n + c16] = (bf16)f2bf(oacc[n][r]);
            { float dec[16];
#pragma unroll
              for (int q4 = 0; q4 < 4; ++q4) { const f32x4 dq = *(const LAS f32x4*)(DS + 32 * wv + 4 * hh + 8 * q4); dec[4 * q4] = dq.x; dec[4 * q4 + 1] = dq.y; dec[4 * q4 + 2] = dq.z; dec[4 * q4 + 3] = dq.w; }
#pragma unroll
              for (int n = 0; n < 2; ++n) {
#pragma unroll
                  for (int r = 0; r < 16; ++r) S[n][r] *= dec[r];
#pragma unroll
                  for (int k4 = 0; k4 < 4; ++k4) { const bf16x8 vb = *(const LAS bf16x8*)(VS + (32 * n + r32) * 72 + 16 * k4 + 8 * hh); S[n] = __builtin_amdgcn_mfma_f32_32x32x16_bf16(ka[k4], vb, S[n], 0, 0, 0); } } }
            asm volatile("s_waitcnt lgkmcnt(0)" ::: "memory"); __builtin_amdgcn_s_barrier(); asm volatile("" ::: "memory");
            *(v4u*)(O + (size_t)(row0 + (w.tid >> 3)) * DM + h * 512 + vs * 64 + 8 * (w.tid & 7)) = *(const LAS v4u*)(OS + (w.tid >> 3) * 72 + 8 * (w.tid & 7));
        }
#undef SC_CC
#undef SC_LOAD
        __syncthreads();
    }
}
__device__ __forceinline__ void gla_combine_bf(const WV& w, const bf16* OFB, const bf16* OBB, const bf16* P, const float* og, bf16* O, int nrows) {
    for (int task = w.gw; task < nrows * 4; task += w.NGW) {
        const int row = task >> 2, h = task & 3; const size_t off = (size_t)row * DM + h * 512 + 8 * w.lane;
        float a[8], c[8], o[8], rv[8]; unpack8(*(const v4u*)(OFB + off), a); unpack8(*(const v4u*)(OBB + off), c);
        float ss = 0.f;
#pragma unroll
        for (int e = 0; e < 8; ++e) { o[e] = a[e] + c[e]; ss += o[e] * o[e]; }
        const float r = 1.0f / sqrtf(wave_sum(ss) * (1.0f / 512.0f) + EPS);
        const f32x4 g0 = *(const f32x4*)(og + 8 * w.lane), g1 = *(const f32x4*)(og + 8 * w.lane + 4);
        const float gg[8] = {g0.x, g0.y, g0.z, g0.w, g1.x, g1.y, g1.z, g1.w};
        unpack8(*(const v4u*)(P + (size_t)row * NGLA + 4096 + h * 512 + 8 * w.lane), rv);
#pragma unroll
        for (int e = 0; e < 8; ++e) o[e] = o[e] * r * gg[e] * silu_f(rv[e]);
        *(v4u*)(O + off) = (v4u){pk2(o[0], o[1]), pk2(o[2], o[3]), pk2(o[4], o[5]), pk2(o[6], o[7])};
    }
}


__device__ __forceinline__ void attn_vt(const WV& w, const bf16* P, bf16* VTA) {
    LAS bf16* tl = (LAS bf16*)w.lds;
    for (int it = w.vcu; it < 16 * 68; it += w.G) {
        const int blk = it % 68, bk = it / 68, b = bk >> 2, kvh = bk & 3;
        const size_t row0 = blk < 64 ? (size_t)b * SEQ + 64 * blk : (size_t)M_LAT + b * CTXL + 64 * (blk - 64);
        const int col0 = blk < 64 ? 64 * blk : SEQ + 64 * (blk - 64);
#pragma unroll
        for (int i = 0; i < 2; ++i) { const int p = w.tid + 512 * i, r = p >> 4, c8 = p & 15;
            *(LAS v4u*)(tl + r * 136 + 8 * c8) = *(const v4u*)(P + (row0 + r) * NQKV + 2560 + kvh * 128 + 8 * c8); }
        __syncthreads();
        const int d = w.tid & 127, tg = w.tid >> 7;
        unsigned u[16];
#pragma unroll
        for (int e = 0; e < 16; ++e) u[e] = tl[(16 * tg + e) * 136 + d];
        v4u* dst = (v4u*)(VTA + ((size_t)bk * 128 + d) * 4352 + col0 + 16 * tg);
        dst[0] = (v4u){u[0] | (u[1] << 16), u[2] | (u[3] << 16), u[4] | (u[5] << 16), u[6] | (u[7] << 16)};
        dst[1] = (v4u){u[8] | (u[9] << 16), u[10] | (u[11] << 16), u[12] | (u[13] << 16), u[14] | (u[15] << 16)};
        __syncthreads();
    }
}
__device__ __forceinline__ void attn_fast(const WV& w, const bf16* P, const bf16* VTA, const float* sink, bf16* O) {
    LAS bf16* KL = (LAS bf16*)w.lds;
    LAS bf16* VL = (LAS bf16*)(w.lds + 2 * 17408);
    const int wv = w.wave, r32 = w.lane & 31, hh = w.lane >> 5, g = wv >> 1, th = wv & 1;
    const float C2 = 0.08838834764831845f * 1.4426950408889634f, L2E = 1.4426950408889634f;
    for (int u = w.vcu; u < 1088; u += w.G) {
        int b, kvh, qb; bool isctx;
        if (u < 1024) { b = u >> 8; kvh = (u >> 6) & 3; qb = u & 63; isctx = false; } else { const int v = u - 1024; b = v >> 4; kvh = (v >> 2) & 3; qb = v & 3; isctx = true; }
        const int hq = kvh * 4 + g, tq = qb * 64 + 32 * th + r32;
        const size_t qrow = isctx ? (size_t)M_LAT + b * CTXL + tq : (size_t)b * SEQ + tq;
        int i_lo = 0, nwin = 0;
        if (!isctx) { i_lo = 2 - qb > 0 ? 2 - qb : 0; const int i_hi = 65 - qb < 4 ? 65 - qb : 4; nwin = i_hi - i_lo + 1; }
        const int T = nwin + 4;
        bf16x8 qf[8];
#pragma unroll
        for (int k8 = 0; k8 < 8; ++k8) qf[k8] = *(const bf16x8*)(P + qrow * NQKV + hq * 128 + 16 * k8 + 8 * hh);
        f32x16 OT[4];
#pragma unroll
        for (int db = 0; db < 4; ++db)
#pragma unroll
            for (int r = 0; r < 16; ++r) OT[db][r] = 0.f;
        float m = sink[hq] * L2E, lsum = hh == 0 ? 1.0f : 0.0f;
        v4u kreg[2], vreg[2];
#define ATT_LOAD(t_) do { const int t__ = (t_); const bool wt_ = t__ < nwin; const int kp0_ = qb * 64 - 128 + 64 * (i_lo + t__), ct_ = t__ - nwin; \
            const size_t krow0_ = wt_ ? (size_t)b * SEQ + kp0_ : (size_t)M_LAT + b * CTXL + 64 * ct_; const int vcol0_ = wt_ ? kp0_ : SEQ + 64 * ct_; \
            _Pragma("unroll") for (int i_ = 0; i_ < 2; ++i_) { const int p_ = w.tid + 512 * i_; \
                kreg[i_] = *(const v4u*)(P + (krow0_ + (p_ >> 4)) * NQKV + 2048 + kvh * 128 + 8 * (p_ & 15)); \
                vreg[i_] = *(const v4u*)(VTA + ((size_t)(b * 4 + kvh) * 128 + (p_ >> 3)) * 4352 + vcol0_ + 8 * (p_ & 7)); } } while (0)
#define ATT_STORE(buf_) do { _Pragma("unroll") for (int i_ = 0; i_ < 2; ++i_) { const int p_ = w.tid + 512 * i_; \
                *(LAS v4u*)(KL + (buf_) * (64 * 136) + (p_ >> 4) * 136 + 8 * (p_ & 15)) = kreg[i_]; \
                LAS v2u* vp_ = (LAS v2u*)(VL + (buf_) * (128 * 68) + (p_ >> 3) * 68 + 8 * (p_ & 7)); vp_[0] = (v2u){vreg[i_].x, vreg[i_].y}; vp_[1] = (v2u){vreg[i_].z, vreg[i_].w}; } } while (0)
        __syncthreads();
        ATT_LOAD(0); ATT_STORE(0);
        __syncthreads();
        for (int t = 0; t < T; ++t) {
            if (t + 1 < T) ATT_LOAD(t + 1);
            const LAS bf16* kl = KL + (t & 1) * (64 * 136); const LAS bf16* vl = VL + (t & 1) * (128 * 68);
            f32x16 sacc[2];
#pragma unroll
            for (int kb = 0; kb < 2; ++kb) {
#pragma unroll
                for (int r = 0; r < 16; ++r) sacc[kb][r] = 0.f;
#pragma unroll
                for (int k8 = 0; k8 < 8; ++k8) { const bf16x8 a = *(const LAS bf16x8*)(kl + (32 * kb + r32) * 136 + 16 * k8 + 8 * hh); sacc[kb] = __builtin_amdgcn_mfma_f32_32x32x16_bf16(a, qf[k8], sacc[kb], 0, 0, 0); } }
            const bool wt = t < nwin; const int kp0 = qb * 64 - 128 + 64 * (i_lo + t);
            float mx = -INFINITY;
#pragma unroll
            for (int kb = 0; kb < 2; ++kb)
#pragma unroll
                for (int r = 0; r < 16; ++r) { float sv = sacc[kb][r] * C2;
                    if (wt) { const int dlt = kp0 + 32 * kb + (r & 3) + 8 * (r >> 2) + 4 * hh - tq; if (dlt > 128 || dlt < -128) sv = -INFINITY; }
                    sacc[kb][r] = sv; mx = fmaxf(mx, sv); }
            mx = fmaxf(mx, __shfl_xor(mx, 32));
            const float mn = fmaxf(m, mx), alpha = __builtin_amdgcn_exp2f(m - mn); m = mn;
            float ps = 0.f;
#pragma unroll
            for (int kb = 0; kb < 2; ++kb)
#pragma unroll
                for (int r = 0; r < 16; ++r) { const float pv = __builtin_amdgcn_exp2f(sacc[kb][r] - mn); ps += pv; sacc[kb][r] = pv; }
            lsum = lsum * alpha + ps;
#pragma unroll
            for (int db = 0; db < 4; ++db)
#pragma unroll
                for (int r = 0; r < 16; ++r) OT[db][r] *= alpha;
#pragma unroll
            for (int kb = 0; kb < 2; ++kb)
#pragma unroll
                for (int sh = 0; sh < 2; ++sh) {
                    v4u pw; pw.x = pk2(sacc[kb][8 * sh], sacc[kb][8 * sh + 1]); pw.y = pk2(sacc[kb][8 * sh + 2], sacc[kb][8 * sh + 3]);
                    pw.z = pk2(sacc[kb][8 * sh + 4], sacc[kb][8 * sh + 5]); pw.w = pk2(sacc[kb][8 * sh + 6], sacc[kb][8 * sh + 7]);
                    const bf16x8 pf = __builtin_bit_cast(bf16x8, pw);
#pragma unroll
                    for (int db = 0; db < 4; ++db) { const LAS bf16* vp = vl + (32 * db + r32) * 68 + 32 * kb + 16 * sh + 4 * hh;
                        const v2u lo = *(const LAS v2u*)vp, hi = *(const LAS v2u*)(vp + 8);
                        const bf16x8 vf = __builtin_bit_cast(bf16x8, ((v4u){lo.x, lo.y, hi.x, hi.y}));
                        OT[db] = __builtin_amdgcn_mfma_f32_32x32x16_bf16(vf, pf, OT[db], 0, 0, 0); } }
            if (t + 1 < T) ATT_STORE((t + 1) & 1);
            __syncthreads();
        }
#undef ATT_LOAD
#undef ATT_STORE
        const float l = lsum + __shfl_xor(lsum, 32), rl = 1.0f / l;
        bf16* op = O + qrow * DM + hq * 128 + 4 * hh;
#pragma unroll
        for (int db = 0; db < 4; ++db)
#pragma unroll
            for (int g4 = 0; g4 < 4; ++g4) { v2u o; o.x = pk2(OT[db][4 * g4] * rl, OT[db][4 * g4 + 1] * rl); o.y = pk2(OT[db][4 * g4 + 2] * rl, OT[db][4 * g4 + 3] * rl);
                *(v2u*)(op + 32 * db + 8 * g4) = o; }
    }
}

__device__ __forceinline__ void conv_rows(const WV& w, const bf16* U, const float* cw, const float* cb, bf16* ACT, int nrows) {
    const int nseg = nrows / 32;
    for (int wi = w.gw; wi < nseg * 11; wi += w.NGW) {
        const int seg = wi / 11, cg = wi % 11, r0 = seg * 32, f = (cg * 64 + w.lane) * 8;
        float wg[3][8], wv[3][8], bg[8], bv[8];
#pragma unroll
        for (int j = 0; j < 3; ++j)
#pragma unroll
            for (int e = 0; e < 8; ++e) { wg[j][e] = cw[j * DFF2 + f + e]; wv[j][e] = cw[j * DFF2 + DFF + f + e]; }
#pragma unroll
        for (int e = 0; e < 8; ++e) { bg[e] = cb[f + e]; bv[e] = cb[DFF + f + e]; }
        const bool s_start = r0 < M_LAT ? ((r0 & (SEQ - 1)) == 0) : (((r0 - M_LAT) & (CTXL - 1)) == 0);
        const bool s_end = r0 < M_LAT ? (((r0 + 32) & (SEQ - 1)) == 0) : (((r0 + 32 - M_LAT) & (CTXL - 1)) == 0);
        const v4u zero4 = (v4u){0u, 0u, 0u, 0u};
        v4u pg = s_start ? zero4 : *(const v4u*)(U + (size_t)(r0 - 1) * DFF2 + f), pv = s_start ? zero4 : *(const v4u*)(U + (size_t)(r0 - 1) * DFF2 + DFF + f);
        v4u cg4 = *(const v4u*)(U + (size_t)r0 * DFF2 + f), cv4 = *(const v4u*)(U + (size_t)r0 * DFF2 + DFF + f);
        for (int r = 0; r < 32; ++r) {
            const bool nz = (r == 31) && s_end;
            const v4u ng = nz ? zero4 : *(const v4u*)(U + (size_t)(r0 + r + 1) * DFF2 + f), nv = nz ? zero4 : *(const v4u*)(U + (size_t)(r0 + r + 1) * DFF2 + DFF + f);
            float a[8], c[8], n[8], gate[8], val[8];
            unpack8(pg, a); unpack8(cg4, c); unpack8(ng, n);
#pragma unroll
            for (int e = 0; e < 8; ++e) gate[e] = bg[e] + wg[0][e] * a[e] + wg[1][e] * c[e] + wg[2][e] * n[e];
            unpack8(pv, a); unpack8(cv4, c); unpack8(nv, n);
#pragma unroll
            for (int e = 0; e < 8; ++e) val[e] = bv[e] + wv[0][e] * a[e] + wv[1][e] * c[e] + wv[2][e] * n[e];
            v4u ov; ov.x = pk2(silu_f(gate[0]) * val[0], silu_f(gate[1]) * val[1]); ov.y = pk2(silu_f(gate[2]) * val[2], silu_f(gate[3]) * val[3]);
            ov.z = pk2(silu_f(gate[4]) * val[4], silu_f(gate[5]) * val[5]); ov.w = pk2(silu_f(gate[6]) * val[6], silu_f(gate[7]) * val[7]);
            *(v4u*)(ACT + (size_t)(r0 + r) * DFF + f) = ov;
            pg = cg4; pv = cv4; cg4 = ng; cv4 = nv;
        }
    }
}

__device__ __forceinline__ void conv_fixup(const WV& w, const float* UB, const float* cw, const float* cb, bf16* ACT, int npanels) {
    const int ntask = npanels * 2 * (DFF / 4);
    for (int task = w.gw * 64 + w.lane; task < ntask; task += w.NGW * 64) {
        const int f4 = task % (DFF / 4), pe = task / (DFF / 4), edge = pe & 1, pm = pe >> 1, F = 4 * f4;
        const bool first = pm >= 64 || (pm & 15) == 0, lastp = pm >= 64 || (pm & 15) == 15;
        f32x4 o[2];
#pragma unroll
        for (int bj = 0; bj < 2; ++bj) { const size_t col = (size_t)bj * DFF + F; const float* U0 = UB + (size_t)(pm * 4) * DFF2 + col; const f32x4 z = (f32x4){0.f, 0.f, 0.f, 0.f};
            const f32x4 cur = *(const f32x4*)(U0 + (edge ? 3 : 0) * (size_t)DFF2);
            const f32x4 pv = edge ? *(const f32x4*)(U0 + 2 * (size_t)DFF2) : (first ? z : *(const f32x4*)(UB + (size_t)((pm - 1) * 4 + 3) * DFF2 + col));
            const f32x4 nx = edge ? (lastp ? z : *(const f32x4*)(UB + (size_t)((pm + 1) * 4) * DFF2 + col)) : *(const f32x4*)(U0 + (size_t)DFF2);
            o[bj] = *(const f32x4*)(cb + col) + *(const f32x4*)(cw + col) * pv + *(const f32x4*)(cw + DFF2 + col) * cur + *(const f32x4*)(cw + 2 * DFF2 + col) * nx; }
        v2u ov; ov.x = pk2(silu_f(o[0].x) * o[1].x, silu_f(o[0].y) * o[1].y); ov.y = pk2(silu_f(o[0].z) * o[1].z, silu_f(o[0].w) * o[1].w);
        *(v2u*)(ACT + (size_t)(pm * 256 + (edge ? 255 : 0)) * DFF + F) = ov;
    }
}

__global__ void __launch_bounds__(512, 2) mega(Args args) {
    extern __shared__ __attribute__((aligned(16))) unsigned char lds_raw[];
    LAS unsigned char* const lds0 = (LAS unsigned char*)lds_raw;
    for (int u = threadIdx.x; u < (LDS_BYTES - LDSCTL_OFF) / 4; u += 512) ((LAS unsigned*)(lds0 + LDSCTL_OFF))[u] = 0u;
    __syncthreads();
    XcdBarrier bar; bar.bar = (unsigned*)(args.ws + WS_CTL) + CW_BAR; bar.x = 0; bar.st = nullptr;
    if (MK_ONE_LAUNCH) bar = xcd_barrier_post((unsigned*)(args.ws + WS_CTL) + CW_BAR, (volatile LAS unsigned*)(lds0 + LDSCTL_OFF + 32));
#define PHASE_ENTER() int tid_l = threadIdx.x; asm volatile("" : "+v"(tid_l)); unsigned char* ws = args.ws; asm volatile("" : "+s"(ws)); WV w; w.lds = lds0; w.tid = tid_l; w.lane = tid_l & 63; \
    w.wave = __builtin_amdgcn_readfirstlane(tid_l >> 6); w.G = gridDim.x; { const int bx = blockIdx.x; w.vcu = (w.G % 8 == 0) ? (bx % 8) * (w.G / 8) + bx / 8 : bx; } w.gw = w.vcu * 8 + w.wave; w.NGW = w.G * 8; \
    float* X = (float*)(ws + WS_X); bf16* H = (bf16*)(ws + WS_H); bf16* P = (bf16*)(ws + WS_P); float* Z1 = (float*)(ws + WS_Z1); bf16* OMIX = (bf16*)(ws + WS_OMIX); bf16* U = (bf16*)(ws + WS_U); \
    bf16* ACT = (bf16*)(ws + WS_ACT); float* MODS = (float*)(ws + WS_MODS); float* OF = (float*)(ws + WS_OF); float* OB = (float*)(ws + WS_OB); \
    (void)X; (void)H; (void)P; (void)Z1; (void)OMIX; (void)U; (void)ACT; (void)MODS; (void)OF; (void)OB; (void)w
    const int lo = args.ph_lo, hi = args.ph_hi;
#define RUN(k) (lo <= (k) && (k) < hi)
#define SEAM(k) do { if (MK_ONE_LAUNCH && RUN(k) && RUN((k) + 1)) xcd_barrier(bar); } while (0)

    for (int rep = 0; rep < RPT_PRO; ++rep) if (RUN(0)) {
        PHASE_ENTER();
        for (int it = w.vcu; it < 4 * 48; it += w.G) mods_item(w, args.in[1], args.in[3], args.in[4], args.in[5], MODS, it);
        for (int l = 0; l < DEPTH; ++l) {
            transpose_matrix(w, args.in[8] + (size_t)l * DM * DFF2, DM, DFF2, (bf16*)(ws + WS_WUP + l * WUP_STRIDE), 0, FUSE_CONV != 0);
            transpose_matrix(w, args.in[11] + (size_t)l * DFF * DM, DFF, DM, (bf16*)(ws + WS_WDN + l * WDN_STRIDE), 0);
        }
        for (int j = 0; j < 2; ++j) {
            transpose_matrix(w, args.in[12] + (size_t)j * DM * NQKV, DM, NQKV, (bf16*)(ws + WS_WQKV + j * WQKV_STRIDE), 0);
            transpose_matrix(w, args.in[14] + (size_t)j * DM * DM, DM, DM, (bf16*)(ws + WS_WAO + j * WO_STRIDE), 0);
            transpose_matrix(w, args.in[15] + (size_t)j * DM * NGLA, DM, NGLA, (bf16*)(ws + WS_WGIN + j * WGIN_STRIDE), 0);
            transpose_matrix(w, args.in[23] + (size_t)j * DM * DM, DM, DM, (bf16*)(ws + WS_WGO + j * WO_STRIDE), 0);
            bf16* wg = (bf16*)(ws + WS_WGIN + j * WGIN_STRIDE) + (size_t)NGLA * DM;
            const float* f1 = args.in[16] + (size_t)j * DM * 16; const float* b1 = args.in[19] + (size_t)j * DM * 16;
            for (int idx = w.gw * 64 + w.lane; idx < 256 * DM; idx += w.NGW * 64) { const int n = idx >> 11, k = idx & 2047;
                const float v = n < 16 ? f1[k * 16 + n] : (n < 32 ? b1[k * 16 + (n - 16)] : 0.f); wg[idx] = (bf16)f2bf(v); }
        }
        { const f32x4* xs = (const f32x4*)args.in[0]; const f32x4* cs = (const f32x4*)args.in[2]; f32x4* xd = (f32x4*)X;
          const size_t nl = (size_t)M_LAT * DM / 4, nc = (size_t)M_CTX * DM / 4, gt = (size_t)w.gw * 64 + w.lane, gn = (size_t)w.NGW * 64;
          for (size_t i = gt; i < nl; i += gn) xd[i] = xs[i];
          for (size_t i = gt; i < nc; i += gn) xd[nl + i] = cs[i]; }
    }
    SEAM(0);
    if (MK_ONE_LAUNCH && RUN(0) && RUN(1)) for (int eb = 0; eb < EXTRA_BAR; ++eb) xcd_barrier(bar);

    for (int l = 0; l < DEPTH; ++l) {
        const int base = 1 + 10 * l, j = l >> 1; const bool gla = (l & 1) != 0, last = (l == DEPTH - 1);
        const size_t mods_off = (size_t)l * 5 * NMOD;
        const int mrows = last ? M_LAT : M_ALL;
        for (int rep = 0; rep < RPT_NORM; ++rep) if (RUN(base + 0)) { PHASE_ENTER(); const float* mods_l = MODS + mods_off; norm_rows(w, X, H, args.in[6] + l * DM, mods_l + 0 * DM, mods_l + 1 * DM, M_ALL, (const float*)(ws + WS_PART), (SPLITK_DN && l > 0) ? 4 : 0, MODS + (mods_off - 5 * NMOD) + 4 * NMOD + 5 * DM); }
        SEAM(base + 0);
        for (int rep = 0; rep < RPT_PROJ; ++rep) if (RUN(base + 1)) {
            PHASE_ENTER();
            pg8::Gemm g{H, gla ? (const bf16*)(ws + WS_WGIN + j * WGIN_STRIDE) : (const bf16*)(ws + WS_WQKV + j * WQKV_STRIDE), M_ALL, gla ? NGLA_EXT : NQKV, DM, DM};
            pg8::StaticOrder S; S.init(g.M, g.N, w.G, (int)blockIdx.x);
            pg8::EpiStoreBf16 E{P, gla ? NGLA : NQKV, gla ? NGLA : (1 << 30), Z1};
            pg8::gemm_phase<pg8::EpiStoreBf16, pg8::StaticOrder, true, true>(w.lds, g, S, E);
        }
        SEAM(base + 1);
        if (RUN(base + 2)) {
            PHASE_ENTER();
            if (!gla) { rope_rows(w, P);
#if !NAIVE_ATTN
                for (int rep3 = 0; rep3 < RPT_AVT; ++rep3) attn_vt(w, P, (bf16*)(ws + WS_VTA));
#endif
            }
#if !NAIVE_GLA
            else for (int rep2 = 0; rep2 < RPT_GPRE; ++rep2) { gla_pre(w, P, Z1, args.in[17] + (size_t)j * 16 * 1024, args.in[18] + j * 1024, args.in[20] + (size_t)j * 16 * 1024, args.in[21] + j * 1024,
                           (bf16*)(ws + WS_QT), (bf16*)(ws + WS_KHT), (bf16*)(ws + WS_AIN), (float*)(ws + WS_DEC));
                   gla_vt(w, P, (bf16*)(ws + WS_VT)); }
#endif
        }
        if (!gla || !NAIVE_GLA) SEAM(base + 2);
        for (int rep = 0; rep < (gla ? RPT_SCAN : RPT_ATT); ++rep) if (RUN(base + 3)) {
            PHASE_ENTER();
#if NAIVE_ATTN
            if (!gla) attn_naive(w, P, args.in[13] + j * 16, OMIX);
#else
            if (!gla) attn_fast(w, P, (const bf16*)(ws + WS_VTA), args.in[13] + j * 16, OMIX);
#endif
#if NAIVE_GLA
            else gla_naive(w, P, Z1, args.in[17] + (size_t)j * 16 * 1024, args.in[18] + j * 1024, args.in[20] + (size_t)j * 16 * 1024, args.in[21] + j * 1024, OF, OB);
#else
            else gla_scan(w, (const bf16*)(ws + WS_QT), (const bf16*)(ws + WS_KHT), (const bf16*)(ws + WS_AIN), (const float*)(ws + WS_DEC), (const bf16*)(ws + WS_VT), (bf16*)(ws + WS_OFB), (bf16*)(ws + WS_OBB));
#endif
        }
        SEAM(base + 3);
#if NAIVE_GLA
        if (RUN(base + 4)) { if (gla) { PHASE_ENTER(); gla_combine(w, OF, OB, P, args.in[22] + j * 512, OMIX, mrows); } }
#else
        for (int rep = 0; rep < RPT_COMB; ++rep) if (RUN(base + 4)) { if (gla) { PHASE_ENTER(); gla_combine_bf(w, (const bf16*)(ws + WS_OFB), (const bf16*)(ws + WS_OBB), P, args.in[22] + j * 512, OMIX, mrows); } }
#endif
        if (gla) SEAM(base + 4);
        if (RUN(base + 5)) {
            PHASE_ENTER();
            pg8::Gemm g{OMIX, gla ? (const bf16*)(ws + WS_WGO + j * WO_STRIDE) : (const bf16*)(ws + WS_WAO + j * WO_STRIDE), SPLITK_WO ? M_LAT : mrows, DM, DM, DM};
            pg8::StaticOrder S; S.init(g.M, g.N, w.G, (int)blockIdx.x);
            pg8::EpiResid E{X, DM, MODS + mods_off + 2 * DM};
            if (RPT_WO) { pg8::EpiResid Ed{(float*)(ws + WS_U), DM, MODS + mods_off + 2 * DM}; pg8::gemm_phase<pg8::EpiResid, pg8::StaticOrder, true, true>(w.lds, g, S, Ed); }
            pg8::gemm_phase<pg8::EpiResid, pg8::StaticOrder, true, true>(w.lds, g, S, E);
            if (SPLITK_WO && !last) {
                pg8::Gemm g2{OMIX + (size_t)M_LAT * DM, g.Bt, M_CTX, DM, DM, 256};
                pg8::SplitKOrder S2; S2.init(M_CTX, DM, 8, 256, w.G, (int)blockIdx.x);
                pg8::EpiPartial E2{(float*)(ws + WS_PART), DM, 256, (size_t)M_CTX * DM};
                pg8::gemm_phase<pg8::EpiPartial, pg8::SplitKOrder, true, true>(w.lds, g2, S2, E2);
            }
        }
        SEAM(base + 5);
        for (int rep = 0; rep < RPT_NORM; ++rep) if (RUN(base + 6)) { PHASE_ENTER(); const float* mods_l = MODS + mods_off; norm_rows(w, X, H, args.in[7] + l * DM, mods_l + 3 * DM, mods_l + 4 * DM, mrows, (const float*)(ws + WS_PART), (!SPLITK_WO || last) ? 0 : 8, mods_l + 4 * NMOD + 2 * DM); }
        SEAM(base + 6);
        for (int rep = 0; rep < RPT_UP; ++rep) if (RUN(base + 7)) {
            PHASE_ENTER();
            pg8::Gemm g{H, (const bf16*)(ws + WS_WUP + l * WUP_STRIDE), mrows, DFF2, DM, DM};
            pg8::StaticOrder S; S.init(g.M, g.N, w.G, (int)blockIdx.x);
#if FUSE_CONV
            pg8::EpiConv E{ACT, args.in[9] + (size_t)l * 3 * DFF2, args.in[10] + (size_t)l * DFF2, (float*)(ws + WS_UB), (PG8_LAS float*)(w.lds + LDSCTL_OFF + 1024), DFF};
            pg8::gemm_phase<pg8::EpiConv, pg8::StaticOrder, true, true>(w.lds, g, S, E);
#else
            pg8::EpiStoreBf16 E{U, DFF2, 1 << 30, Z1};
            pg8::gemm_phase<pg8::EpiStoreBf16, pg8::StaticOrder, true, true>(w.lds, g, S, E);
#endif
        }
        SEAM(base + 7);
        for (int rep = 0; rep < RPT_CONV; ++rep) if (RUN(base + 8)) { PHASE_ENTER();
#if FUSE_CONV
            conv_fixup(w, (const float*)(ws + WS_UB), args.in[9] + (size_t)l * 3 * DFF2, args.in[10] + (size_t)l * DFF2, ACT, mrows / 256);
#else
            conv_rows(w, U, args.in[9] + (size_t)l * 3 * DFF2, args.in[10] + (size_t)l * DFF2, ACT, mrows);
#endif
        }
        SEAM(base + 8);
        if (RUN(base + 9)) {
            PHASE_ENTER();
            pg8::Gemm g{ACT, (const bf16*)(ws + WS_WDN + l * WDN_STRIDE), SPLITK_DN ? M_LAT : mrows, DM, DFF, DFF};
            pg8::StaticOrder S; S.init(g.M, g.N, w.G, (int)blockIdx.x);
            pg8::EpiResid E{X, DM, MODS + mods_off + 5 * DM};
            if (RPT_DN) { pg8::EpiResid Ed{(float*)(ws + WS_U), DM, MODS + mods_off + 5 * DM}; pg8::gemm_phase<pg8::EpiResid, pg8::StaticOrder, true, true>(w.lds, g, S, Ed); }
            pg8::gemm_phase<pg8::EpiResid, pg8::StaticOrder, true, true>(w.lds, g, S, E);
            if (SPLITK_DN && !last) {
                pg8::Gemm g2{ACT + (size_t)M_LAT * DFF, g.Bt, M_CTX, DM, DFF, 1408};
                pg8::SplitKOrder S2; S2.init(M_CTX, DM, 4, 1408, w.G, (int)blockIdx.x);
                pg8::EpiPartial E2{(float*)(ws + WS_PART), DM, 1408, (size_t)M_CTX * DM};
                pg8::gemm_phase<pg8::EpiPartial, pg8::SplitKOrder, true, true>(w.lds, g2, S2, E2);
            }
        }
        SEAM(base + 9);
    }
    if (RUN(41)) { PHASE_ENTER(); final_norm(w, X, args.out, args.in[24]);
        if (DIAG_SCAN && blockIdx.x == 0 && w.tid == 0) { asm volatile("s_waitcnt vmcnt(0)" ::: "memory"); const unsigned long long* dg = (const unsigned long long*)(ws + WS_CTL + 65536);
            const double a = (double)dg[0], b = (double)dg[1], c = (double)dg[2], tot = a + b + c; int d1 = (int)(10.0 * a / tot), d2 = (int)(10.0 * b / tot); if (d1 < 1) d1 = 1; if (d2 < 0) d2 = 0;
            args.out[0] = (float)(DIAG_SCAN == 1 ? 10 * d1 + d2 : (DIAG_SCAN == 2 ? tot / 68.0 / 2.0 / 10.0 : 0)); } }
#undef RUN
#undef SEAM
}

extern "C" void kernel_launch(void* const* d_in, const int* in_sizes, int n_in, void* d_out, int out_size, void* d_ws, size_t ws_size, hipStream_t stream) {
    static int grid = 0;
    if (grid == 0) {
        if (n_in != 25 || out_size != M_LAT * DM || ws_size < WS_END) { fprintf(stderr, "kernel_launch: unexpected shapes (n_in %d, out %d, ws %zu < %zu); nothing launched\n", n_in, out_size, ws_size, (size_t)WS_END); grid = -1; return; }
        int dev = 0, cus = 0, per_cu = 0;
        if (hipGetDevice(&dev) != hipSuccess || hipDeviceGetAttribute(&cus, hipDeviceAttributeMultiprocessorCount, dev) != hipSuccess) { grid = -1; return; }
        if (hipFuncSetAttribute((const void*)mega, hipFuncAttributeMaxDynamicSharedMemorySize, LDS_BYTES) != hipSuccess) { fprintf(stderr, "kernel_launch: hipFuncSetAttribute failed\n"); grid = -1; return; }
        if (hipOccupancyMaxActiveBlocksPerMultiprocessor(&per_cu, (const void*)mega, 512, LDS_BYTES) != hipSuccess || per_cu < 1)
            fprintf(stderr, "kernel_launch: occupancy query reports %d workgroups per CU\n", per_cu);
        (void)hipGetLastError();
        grid = cus;
    }
    if (grid < 0) return;
    if (hipMemsetAsync((char*)d_ws + WS_CTL, 0, CTL_ZERO_BYTES, stream) != hipSuccess) return;
    Args a{};
    for (int i = 0; i < 25; ++i) a.in[i] = (const float*)d_in[i];
    a.out = (float*)d_out; a.ws = (unsigned char*)d_ws;
#if MK_ONE_LAUNCH
    a.ph_lo = 0; a.ph_hi = NPH;
    hipLaunchKernelGGL(mega, dim3(grid), dim3(512), LDS_BYTES, stream, a);
#else
    for (int ph = 0; ph < NPH; ++ph) {
        if (ph >= 1 && ph <= 40) { const int l = (ph - 1) / 10, s = (ph - 1) % 10; if ((s == 2 && (l & 1) && NAIVE_GLA) || (s == 4 && !(l & 1))) continue; }
        a.ph_lo = ph; a.ph_hi = ph + 1;
        hipLaunchKernelGGL(mega, dim3(grid), dim3(512), LDS_BYTES, stream, a);
    }
#endif
}
```

```cpp
#include <hip/hip_runtime.h>
#include <cstdio>
#include <cstdint>
namespace pg8 {
#define PG8_LAS __attribute__((address_space(3)))
typedef unsigned short bf16_t;
typedef short bf16x8 __attribute__((ext_vector_type(8)));
typedef float f32x4 __attribute__((ext_vector_type(4)));
typedef unsigned u32x4 __attribute__((ext_vector_type(4)));
constexpr int BM = 256, BK = 64, HALF = 128, HTB = HALF * BK * 2  , STAGE_BYTES = 8 * HTB, NXCD = 8, WGM = 8;

__host__ __device__ __forceinline__ int lds_byte(int r, int c) { const int st = (r >> 4) * 2 + (c >> 5), rr = r & 15, cc = c & 31, ob = rr * 64 + cc * 2; return st * 1024 + (ob ^ (((ob >> 9) & 1) << 5)); }
__host__ __device__ __forceinline__ void stage_rc(int b, int& R, int& C) { const int st = b / 1024, sb = b % 1024, swz = sb ^ (((sb >> 9) & 1) << 5); R = (st >> 1) * 16 + swz / 64; C = (st & 1) * 32 + (swz % 64) / 2; }
__host__ __device__ __forceinline__ int perm32(int rho) { const int n = rho >> 4, i = rho & 15; return 8 * (i >> 2) + 4 * n + (i & 3); }

struct Unit { int pm, pn, kofs; };
struct Gemm { const bf16_t* A; const bf16_t* Bt; int M, N, K, kloop; };

struct StaticOrder {
    int nM, nN, nwg, G, c;
    __host__ __device__ void init(int M, int N, int G_, int c_) { nM = M / BM; nN = N / BM; nwg = nM * nN; G = G_; c = c_; }
    __host__ __device__ bool next(int i, Unit& u) const {
        const long L = (long)i * G + c; if (L >= nwg) return false;
        int wgid = (int)L; { const int q = nwg / NXCD, r = nwg % NXCD, xcd = wgid % NXCD, off = wgid / NXCD; wgid = (xcd < r ? xcd * (q + 1) : r * (q + 1) + (xcd - r) * q) + off; }
        const int nig = WGM * nN, gid = wgid / nig, fm = gid * WGM, gsz = (nM - fm) < WGM ? (nM - fm) : WGM;
        u.pm = fm + ((wgid % nig) % gsz); u.pn = (wgid % nig) / gsz; u.kofs = 0; return true;
    }
    __device__ __forceinline__ void a_ready(const Unit&) const {}
    __device__ __forceinline__ void done(const Unit&) const {}
};

struct SplitKOrder {
    int nN, nunits, nsplit, kloop, G, c;
    __host__ __device__ void init(int M, int N, int nsplit_, int kloop_, int G_, int c_) { nN = N / BM; nunits = (M / BM) * nN * nsplit_; nsplit = nsplit_; kloop = kloop_; G = G_; c = c_; }
    __host__ __device__ bool next(int i, Unit& u) const { const long L = (long)i * G + c; if (L >= nunits) return false; const int t = (int)L / nsplit, ks = (int)L % nsplit; u.pm = t / nN; u.pn = t % nN; u.kofs = ks * kloop; return true; }
    __device__ __forceinline__ void a_ready(const Unit&) const {}
    __device__ __forceinline__ void done(const Unit&) const {}
};
typedef __bf16 bf16x2_hw __attribute__((ext_vector_type(2)));
typedef float f32x2_hw __attribute__((ext_vector_type(2)));
__device__ __forceinline__ unsigned cvt_pk_bf16(float lo, float hi) { const f32x2_hw v = {lo, hi}; return __builtin_bit_cast(unsigned, __builtin_convertvector(v, bf16x2_hw)); }
typedef float f32x2 __attribute__((ext_vector_type(2)));

struct EpiStoreBf16 {
    static constexpr bool PERM = true, AFTER_DRAIN = false;
    bf16_t* O; int ldc; int zcol0; float* Z;
    __device__ __forceinline__ void operator()(const f32x4 (&acc)[2][2][4][2], const Unit& u, int wr, int wc, int fr, int fq) const {
        const int row0 = u.pm * BM + wr * 64 + fr; const int colt = u.pn * BM;
        if (colt >= zcol0) {
            if (wc == 0) {
#pragma unroll
                for (int ai = 0; ai < 2; ++ai)
#pragma unroll
                    for (int m = 0; m < 4; ++m) { float* zp = Z + (size_t)(row0 + ai * HALF + m * 16) * 32 + 8 * fq;
                        *(f32x4*)(zp) = acc[ai][0][m][0]; *(f32x4*)(zp + 4) = acc[ai][0][m][1]; }
            }
            return;
        }
        const int col0 = colt + wc * 32 + 8 * fq;
#pragma unroll
        for (int ai = 0; ai < 2; ++ai)
#pragma unroll
            for (int m = 0; m < 4; ++m) { bf16_t* rowp = O + (size_t)(row0 + ai * HALF + m * 16) * ldc + col0;
#pragma unroll
                for (int bj = 0; bj < 2; ++bj) { const f32x4 v0 = acc[ai][bj][m][0], v1 = acc[ai][bj][m][1];
                    u32x4 w; w.x = cvt_pk_bf16(v0[0], v0[1]); w.y = cvt_pk_bf16(v0[2], v0[3]); w.z = cvt_pk_bf16(v1[0], v1[1]); w.w = cvt_pk_bf16(v1[2], v1[3]);
                    *(u32x4*)(rowp + bj * HALF) = w; } }
    }
};
struct EpiResid {
    static constexpr bool PERM = false, AFTER_DRAIN = false;
    float* X; int ldc; const float* gate;
    const float* in_lat; const float* in_ctx;
    bf16_t* XB;
    __device__ __forceinline__ void operator()(const f32x4 (&acc)[2][2][4][2], const Unit& u, int wr, int wc, int fr, int fq) const {
        const int row0 = u.pm * BM + wr * 64 + fr, col0 = u.pn * BM + wc * 32 + 4 * fq;
        const int vec = u.pm < 64 ? (u.pm >> 4) : 4;
        const float* g = gate + (size_t)vec * 12288 + col0;
        f32x4 gv[2][2];
#pragma unroll
        for (int bj = 0; bj < 2; ++bj)
#pragma unroll
            for (int n = 0; n < 2; ++n) gv[bj][n] = *(const f32x4*)(g + bj * HALF + n * 16);
#pragma unroll
        for (int ai = 0; ai < 2; ++ai)
#pragma unroll
            for (int m = 0; m < 4; ++m) { const size_t r = (size_t)(row0 + ai * HALF + m * 16); float* rowp = X + r * ldc + col0;
                const float* srcp = in_lat ? (u.pm < 64 ? in_lat + r * ldc + col0 : in_ctx + (r - 16384) * ldc + col0) : rowp;
#pragma unroll
                for (int bj = 0; bj < 2; ++bj)
#pragma unroll
                    for (int n = 0; n < 2; ++n) { const int o = bj * HALF + n * 16; const f32x4 xn = *(const f32x4*)(srcp + o) + gv[bj][n] * acc[ai][bj][m][n]; *(f32x4*)(rowp + o) = xn;
#ifdef PROBE_EPI3
                        asm volatile("" ::: "memory"); *(f32x4*)(rowp + o) = xn;
#endif
                        if (XB) { typedef unsigned u32x2 __attribute__((ext_vector_type(2))); u32x2 pb; pb.x = cvt_pk_bf16(xn[0], xn[1]); pb.y = cvt_pk_bf16(xn[2], xn[3]); *(u32x2*)(XB + r * ldc + col0 + o) = pb; } } }
    }
};
struct EpiPartial {
    static constexpr bool PERM = false, AFTER_DRAIN = false;
    float* PART; int ldc; int kloop; size_t slab;
    __device__ __forceinline__ void operator()(const f32x4 (&acc)[2][2][4][2], const Unit& u, int wr, int wc, int fr, int fq) const {
        const int row0 = u.pm * BM + wr * 64 + fr, col0 = u.pn * BM + wc * 32 + 4 * fq;
        float* base = PART + (size_t)(u.kofs / kloop) * slab;
#pragma unroll
        for (int ai = 0; ai < 2; ++ai)
#pragma unroll
            for (int m = 0; m < 4; ++m) { float* rowp = base + (size_t)(row0 + ai * HALF + m * 16) * ldc + col0;
#pragma unroll
                for (int bj = 0; bj < 2; ++bj)
#pragma unroll
                    for (int n = 0; n < 2; ++n) *(f32x4*)(rowp + bj * HALF + n * 16) = acc[ai][bj][m][n]; }
    }
};

__device__ __forceinline__ float dpp_prev(float v) { return __builtin_bit_cast(float, __builtin_amdgcn_update_dpp(0, __builtin_bit_cast(int, v), 0x121, 0xf, 0xf, false)); }
__device__ __forceinline__ float dpp_next(float v) { return __builtin_bit_cast(float, __builtin_amdgcn_update_dpp(0, __builtin_bit_cast(int, v), 0x12F, 0xf, 0xf, false)); }
struct EpiConv {
    static constexpr bool PERM = true, AFTER_DRAIN = false;
    bf16_t* ACT; const float* cw; const float* cb; float* UB; PG8_LAS float* xb; int dff;
    __device__ __forceinline__ void operator()(const f32x4 (&acc)[2][2][4][2], const Unit& u, int wr, int wc, int fr, int fq) const {
        const int cl = 32 * wc + 8 * fq, F = 128 * u.pn + cl, dff2 = 2 * dff;
        if (fr == 0 || fr == 15) { const int which = fr == 0 ? 0 : 1, m = fr == 0 ? 0 : 3;
#pragma unroll
            for (int ai = 0; ai < 2; ++ai)
#pragma unroll
                for (int bj = 0; bj < 2; ++bj)
#pragma unroll
                    for (int n = 0; n < 2; ++n) *(PG8_LAS f32x4*)(xb + ((((2 * ai + wr) * 2 + which) * 2 + bj) * 128 + cl + 4 * n)) = acc[ai][bj][m][n]; }
        asm volatile("s_waitcnt lgkmcnt(0)" ::: "memory"); __builtin_amdgcn_s_barrier(); asm volatile("" ::: "memory");
#pragma unroll
        for (int n = 0; n < 2; ++n) {
            f32x4 wgt[2][3], bia[2];
#pragma unroll
            for (int bj = 0; bj < 2; ++bj) { bia[bj] = *(const f32x4*)(cb + bj * dff + F + 4 * n);
#pragma unroll
                for (int j = 0; j < 3; ++j) wgt[bj][j] = *(const f32x4*)(cw + j * dff2 + bj * dff + F + 4 * n); }
#pragma unroll
            for (int ai = 0; ai < 2; ++ai) { const int B = 2 * ai + wr;
#pragma unroll
                for (int m = 0; m < 4; ++m) { f32x4 o[2];
#pragma unroll
                    for (int bj = 0; bj < 2; ++bj) { const f32x4 cur = acc[ai][bj][m][n]; f32x4 sp = cur, sn = cur;
                        if (m > 0) { const f32x4 up = acc[ai][bj][m > 0 ? m - 1 : 0][n]; sp = fr == 15 ? up : cur; }
                        if (m < 3) { const f32x4 dn = acc[ai][bj][m < 3 ? m + 1 : 3][n]; sn = fr == 0 ? dn : cur; }
                        f32x4 pv, nx; pv.x = dpp_prev(sp.x); pv.y = dpp_prev(sp.y); pv.z = dpp_prev(sp.z); pv.w = dpp_prev(sp.w);
                        nx.x = dpp_next(sn.x); nx.y = dpp_next(sn.y); nx.z = dpp_next(sn.z); nx.w = dpp_next(sn.w);
                        if (m == 0) { if (fr == 0 && B > 0) pv = *(const PG8_LAS f32x4*)(xb + (((B - 1) * 2 + 1) * 2 + bj) * 128 + cl + 4 * n); }
                        if (m == 3) { if (fr == 15 && B < 3) nx = *(const PG8_LAS f32x4*)(xb + (((B + 1) * 2 + 0) * 2 + bj) * 128 + cl + 4 * n); }
                        o[bj] = bia[bj] + wgt[bj][0] * pv + wgt[bj][1] * cur + wgt[bj][2] * nx; }
                    f32x4 a;
                    a.x = o[0].x * __builtin_amdgcn_rcpf(1.0f + __builtin_amdgcn_exp2f(-1.4426950408889634f * o[0].x)) * o[1].x;
                    a.y = o[0].y * __builtin_amdgcn_rcpf(1.0f + __builtin_amdgcn_exp2f(-1.4426950408889634f * o[0].y)) * o[1].y;
                    a.z = o[0].z * __builtin_amdgcn_rcpf(1.0f + __builtin_amdgcn_exp2f(-1.4426950408889634f * o[0].z)) * o[1].z;
                    a.w = o[0].w * __builtin_amdgcn_rcpf(1.0f + __builtin_amdgcn_exp2f(-1.4426950408889634f * o[0].w)) * o[1].w;
                    const int rl = 128 * ai + 64 * wr + 16 * m + fr;
                    if (rl != 0 && rl != 255) { typedef unsigned u32x2 __attribute__((ext_vector_type(2))); u32x2 w2; w2.x = cvt_pk_bf16(a.x, a.y); w2.y = cvt_pk_bf16(a.z, a.w);
                        *(u32x2*)(ACT + (size_t)(u.pm * BM + rl) * dff + F + 4 * n) = w2; } } }
            asm volatile("" ::: "memory"); }
        if (wr == 0 && fr < 2) {
#pragma unroll
            for (int bj = 0; bj < 2; ++bj)
#pragma unroll
                for (int n = 0; n < 2; ++n) *(f32x4*)(UB + (size_t)(u.pm * 4 + fr) * dff2 + bj * dff + F + 4 * n) = acc[0][bj][0][n]; }
        if (wr == 1 && fr >= 14) {
#pragma unroll
            for (int bj = 0; bj < 2; ++bj)
#pragma unroll
                for (int n = 0; n < 2; ++n) *(f32x4*)(UB + (size_t)(u.pm * 4 + fr - 12) * dff2 + bj * dff + F + 4 * n) = acc[1][bj][3][n]; }
    }
};
template <class Epi, class Sched, bool ALIGN_EPI = false, bool SP2 = false>
__device__ __forceinline__ void gemm_phase(PG8_LAS unsigned char* lds, const Gemm g, const Sched& S, const Epi& E) {
    int tid_l = threadIdx.x; asm volatile("" : "+v"(tid_l));
    const int tid = tid_l, wid = __builtin_amdgcn_readfirstlane(tid >> 6), lane = tid & 63, wr = wid >> 2, wc = wid & 3, fr = lane & 15, fq = lane >> 4;
    const int K = g.K, nt = g.kloop / BK;
    unsigned voffA[2], voffB[2];
#pragma unroll
    for (int i = 0; i < 2; ++i) { int R, C; stage_rc(tid * 16 + i * 8192, R, C); const int Rb = Epi::PERM ? ((R & ~31) + perm32(R & 31)) : R;
        voffA[i] = (unsigned)(R * K + C) * 2u; voffB[i] = (unsigned)(Rb * K + C) * 2u; }
    const size_t kstep = (size_t)(BK * 2);
    const size_t hstep = (size_t)HALF * K * 2;
    const size_t tstep = 2 * hstep;
    const unsigned ldsw = (unsigned)wid * 1024u;
    const int aoff = lds_byte(wr * 64 + fr, fq * 8), boff = lds_byte(wc * 32 + fr, fq * 8);
#define PG8_SA(b, h) (((b) * 2 + (h)) * HTB)
#define PG8_SB(b, h) ((4 + (b) * 2 + (h)) * HTB)
#define PG8_STAGE(bufoff, gbase, voff) do { _Pragma("unroll") for (int _i = 0; _i < 2; ++_i) \
        __builtin_amdgcn_global_load_lds((const unsigned*)((const char*)(gbase) + (voff)[_i]), (PG8_LAS unsigned*)(lds + (bufoff) + ldsw + _i * 8192), 16, 0, 0); } while (0)
#define PG8_LDA(dst, b, h) do { _Pragma("unroll") for (int m = 0; m < 4; ++m) _Pragma("unroll") for (int k = 0; k < 2; ++k) dst[m][k] = *(const PG8_LAS bf16x8*)(lds + PG8_SA(b, h) + aoff + m * 2048 + k * 1024); } while (0)
#define PG8_LDB(dst, b, h) do { _Pragma("unroll") for (int n = 0; n < 2; ++n) _Pragma("unroll") for (int k = 0; k < 2; ++k) dst[n][k] = *(const PG8_LAS bf16x8*)(lds + PG8_SB(b, h) + boff + n * 2048 + k * 1024); } while (0)
#define PG8_MMA(ai, bj, At, Bt) do { __builtin_amdgcn_s_setprio(1); _Pragma("unroll") for (int m = 0; m < 4; ++m) _Pragma("unroll") for (int n = 0; n < 2; ++n) _Pragma("unroll") for (int k = 0; k < 2; ++k) \
        acc[ai][bj][m][n] = __builtin_amdgcn_mfma_f32_16x16x32_bf16(Bt[n][k], At[m][k], acc[ai][bj][m][n], 0, 0, 0); __builtin_amdgcn_s_setprio(0); } while (0)
#define PG8_WAIT_V(n) asm volatile("s_waitcnt vmcnt(" #n ")" ::: "memory")
#define PG8_WAIT_L(n) asm volatile("s_waitcnt lgkmcnt(" #n ")" ::: "memory")
#define PG8_BAR __builtin_amdgcn_s_barrier()
#define PG8_SCHED __builtin_amdgcn_sched_barrier(0)
    Unit cur, nxt; int ui = 0;
    if (!S.next(0, cur)) return;
    f32x4 acc[2][2][4][2];
#pragma unroll
    for (int a = 0; a < 2; ++a)
#pragma unroll
        for (int b = 0; b < 2; ++b)
#pragma unroll
            for (int m = 0; m < 4; ++m)
#pragma unroll
                for (int n = 0; n < 2; ++n) acc[a][b][m][n] = (f32x4){0.f, 0.f, 0.f, 0.f};
    bf16x8 At[4][2], B0[2][2], B1[2][2];
    const char* cA = (const char*)g.A + (size_t)cur.pm * tstep + (size_t)cur.kofs * 2; const char* cB = (const char*)g.Bt + (size_t)cur.pn * tstep + (size_t)cur.kofs * 2;
    S.a_ready(cur);
    if constexpr (SP2) {
        PG8_STAGE(PG8_SB(0, 0), cB, voffB); PG8_STAGE(PG8_SB(0, 1), cB + hstep, voffB); PG8_STAGE(PG8_SA(0, 0), cA, voffA); PG8_STAGE(PG8_SA(0, 1), cA + hstep, voffA);
        if (wr == 1) PG8_BAR;
        PG8_WAIT_V(2); PG8_BAR;
        PG8_STAGE(PG8_SB(1, 0), cB + kstep, voffB); PG8_STAGE(PG8_SA(1, 0), cA + kstep, voffA); PG8_STAGE(PG8_SB(1, 1), cB + hstep + kstep, voffB);
        PG8_WAIT_V(6); PG8_BAR;
    } else {
        PG8_STAGE(PG8_SB(0, 0), cB, voffB); PG8_STAGE(PG8_SA(0, 0), cA, voffA); PG8_STAGE(PG8_SB(0, 1), cB + hstep, voffB); PG8_STAGE(PG8_SA(0, 1), cA + hstep, voffA);
        if (wr == 1) PG8_BAR;
        PG8_WAIT_V(4); PG8_BAR;
        PG8_STAGE(PG8_SB(1, 0), cB + kstep, voffB); PG8_STAGE(PG8_SA(1, 0), cA + kstep, voffA); PG8_STAGE(PG8_SB(1, 1), cB + hstep + kstep, voffB);
        PG8_WAIT_V(6); PG8_BAR;
    }
    for (;;) {
        const bool has_next = S.next(ui + 1, nxt);
        const char* nA = has_next ? (const char*)g.A + (size_t)nxt.pm * tstep + (size_t)nxt.kofs * 2 : cA; const char* nB = has_next ? (const char*)g.Bt + (size_t)nxt.pn * tstep + (size_t)nxt.kofs * 2 : cB;
        for (int t = 0; t < nt; t += 2) {
            const bool last = (t == nt - 2);
            const char* a1 = cA + (size_t)(t + 1) * kstep;
            const char* a2 = last ? nA : cA + (size_t)(t + 2) * kstep; const char* b2 = last ? nB : cB + (size_t)(t + 2) * kstep;
            const char* a3 = a2 + kstep; const char* b3 = b2 + kstep;
            if (last && has_next) S.a_ready(nxt);
            if constexpr (SP2) {
            PG8_LDB(B0, 0, 0); PG8_LDB(B1, 0, 1); PG8_SCHED; PG8_LDA(At, 0, 0); PG8_STAGE(PG8_SA(1, 1), a1 + hstep, voffA);
            PG8_WAIT_V(8); PG8_WAIT_L(0); PG8_BAR; PG8_MMA(0, 0, At, B0); PG8_MMA(0, 1, At, B1); PG8_BAR; PG8_SCHED;
            PG8_LDA(At, 0, 1); PG8_STAGE(PG8_SB(0, 0), b2, voffB); PG8_STAGE(PG8_SB(0, 1), b2 + hstep, voffB); PG8_STAGE(PG8_SA(0, 0), a2, voffA);
            PG8_WAIT_V(8); PG8_WAIT_L(0); PG8_BAR; PG8_MMA(1, 0, At, B0); PG8_MMA(1, 1, At, B1); PG8_BAR; PG8_SCHED;
            PG8_LDB(B0, 1, 0); PG8_LDB(B1, 1, 1); PG8_SCHED; PG8_LDA(At, 1, 0); PG8_STAGE(PG8_SA(0, 1), a2 + hstep, voffA);
            PG8_WAIT_V(8); PG8_WAIT_L(0); PG8_BAR; PG8_MMA(0, 0, At, B0); PG8_MMA(0, 1, At, B1); PG8_BAR; PG8_SCHED;
            PG8_LDA(At, 1, 1); PG8_STAGE(PG8_SB(1, 0), b3, voffB); PG8_STAGE(PG8_SB(1, 1), b3 + hstep, voffB); PG8_STAGE(PG8_SA(1, 0), a3, voffA);
            PG8_WAIT_V(8); PG8_WAIT_L(0); PG8_BAR; PG8_MMA(1, 0, At, B0); PG8_MMA(1, 1, At, B1); PG8_BAR; PG8_SCHED;
            } else {
            PG8_LDB(B0, 0, 0); PG8_SCHED; PG8_LDA(At, 0, 0); PG8_STAGE(PG8_SA(1, 1), a1 + hstep, voffA);
            PG8_WAIT_L(8); PG8_BAR; PG8_WAIT_L(0); PG8_MMA(0, 0, At, B0); PG8_BAR; PG8_SCHED;
            PG8_LDB(B1, 0, 1); PG8_STAGE(PG8_SB(0, 0), b2, voffB);
            PG8_BAR; PG8_WAIT_L(0); PG8_MMA(0, 1, At, B1); PG8_BAR;
            PG8_LDA(At, 0, 1); PG8_STAGE(PG8_SA(0, 0), a2, voffA);
            PG8_BAR; PG8_WAIT_L(0); PG8_MMA(1, 0, At, B0); PG8_BAR; PG8_SCHED;
            PG8_STAGE(PG8_SB(0, 1), b2 + hstep, voffB);
            PG8_WAIT_V(6); PG8_BAR; PG8_MMA(1, 1, At, B1); PG8_BAR;
            PG8_LDB(B0, 1, 0); PG8_SCHED; PG8_LDA(At, 1, 0); PG8_STAGE(PG8_SA(0, 1), a2 + hstep, voffA);
            PG8_WAIT_L(8); PG8_BAR; PG8_WAIT_L(0); PG8_MMA(0, 0, At, B0); PG8_BAR; PG8_SCHED;
            PG8_LDB(B1, 1, 1); PG8_STAGE(PG8_SB(1, 0), b3, voffB);
            PG8_BAR; PG8_WAIT_L(0); PG8_MMA(0, 1, At, B1); PG8_BAR;
            PG8_LDA(At, 1, 1); PG8_STAGE(PG8_SA(1, 0), a3, voffA);
            PG8_BAR; PG8_WAIT_L(0); PG8_MMA(1, 0, At, B0); PG8_BAR; PG8_SCHED;
            PG8_STAGE(PG8_SB(1, 1), b3 + hstep, voffB);
            PG8_WAIT_V(6); PG8_BAR; PG8_MMA(1, 1, At, B1); PG8_BAR;
            }
        }
        if constexpr (ALIGN_EPI) { if (wr == 0) PG8_BAR; }
        if constexpr (!Epi::AFTER_DRAIN) { E(acc, cur, wr, wc, fr, fq); S.done(cur); }
        if (!has_next) break;
#pragma unroll
        for (int a = 0; a < 2; ++a)
#pragma unroll
            for (int b = 0; b < 2; ++b)
#pragma unroll
                for (int m = 0; m < 4; ++m)
#pragma unroll
                    for (int n = 0; n < 2; ++n) acc[a][b][m][n] = (f32x4){0.f, 0.f, 0.f, 0.f};
        cur = nxt; cA = nA; cB = nB; ++ui;
        if constexpr (ALIGN_EPI) { if (wr == 1) PG8_BAR; }
    }
    PG8_WAIT_V(0);
    if constexpr (!ALIGN_EPI) { if (wr == 0) PG8_BAR; }
    PG8_BAR;
    if constexpr (Epi::AFTER_DRAIN) { E.fused(acc, cur, wr, wc, fr, fq, lds, wid, lane); S.done(cur); }
#undef PG8_SA
#undef PG8_SB
#undef PG8_STAGE
#undef PG8_LDA
#undef PG8_LDB
#undef PG8_MMA
#undef PG8_WAIT_V
#undef PG8_WAIT_L
#undef PG8_BAR
#undef PG8_SCHED
}
}
#define LAS __attribute__((address_space(3)))
#define XB_TMO      128
#define XB_XCNT(j)  (256  + 64 * (j))
#define XB_XSUB(j)  (1280 + 64 * (j))
#define XB_XGEN(j)  (2304 + 64 * (j))
#define XB_TOP      3328
#define XB_TOPGEN   3392
#define XCD_BAR_WORDS 3456
#define XB_SPIN_CAP (1u << 18)

__device__ __forceinline__ unsigned xb_ld(unsigned* p)              { return __hip_atomic_load(p, __ATOMIC_RELAXED, __HIP_MEMORY_SCOPE_AGENT); }
__device__ __forceinline__ unsigned xb_add(unsigned* p, unsigned v) { return __hip_atomic_fetch_add(p, v, __ATOMIC_RELAXED, __HIP_MEMORY_SCOPE_AGENT); }
__device__ __forceinline__ unsigned xb_xcc_id() { return (unsigned)__builtin_amdgcn_s_getreg((3 << 11) | 20) & 0xFu; }
#define XB_SPIN(cond, bar) do { unsigned _sp = 0; while (cond) { __builtin_amdgcn_s_sleep(1); \
    if ((++_sp & 255u) == 0u) { if (xb_ld(&(bar)[XB_TMO])) break; if (_sp > XB_SPIN_CAP) { atomicAdd(&(bar)[XB_TMO], 1u); break; } } } } while (0)

struct XcdBarrier {
    unsigned* bar; unsigned x;
    volatile LAS unsigned* st;
};

__device__ __forceinline__ XcdBarrier xcd_barrier_post(unsigned* bar, volatile LAS unsigned* st) {
    XcdBarrier b; b.bar = bar; b.x = xb_xcc_id(); b.st = st;
    if (threadIdx.x == 0) (void)xb_add(&bar[XB_XCNT(b.x)], 1u);
    return b;
}
__device__ __forceinline__ void xcd_barrier_complete(unsigned* bar, unsigned x, unsigned& nloc, unsigned& nx) {
    const unsigned G = gridDim.x * gridDim.y * gridDim.z;
    unsigned sum, cnt, mine, sp = 0u;
    for (;;) {
        sum = 0u; cnt = 0u; mine = 0u;
#pragma unroll
        for (unsigned j = 0; j < 16; ++j) { const unsigned c = xb_ld(&bar[XB_XCNT(j)]); sum += c; cnt += (c > 0u) ? 1u : 0u; mine = (j == x) ? c : mine; }
        if (sum == G) break;
        __builtin_amdgcn_s_sleep(1);
        if ((++sp & 255u) == 0u) { if (xb_ld(&bar[XB_TMO])) break; if (sp > XB_SPIN_CAP) { atomicAdd(&bar[XB_TMO], 1u); break; } }
    }
    nloc = mine > 0u ? mine : 1u; nx = cnt > 0u ? cnt : 1u;
}

__device__ __forceinline__ void xcd_barrier(const XcdBarrier& b) {
    asm volatile("s_waitcnt vmcnt(0)" ::: "memory");
    __syncthreads();
    if (threadIdx.x == 0) {
        unsigned* bar = b.bar;
        __builtin_amdgcn_s_waitcnt(0);
        unsigned nloc = b.st[0], nx = b.st[1];
        if (nloc == 0u) { xcd_barrier_complete(bar, b.x, nloc, nx); b.st[0] = nloc; b.st[1] = nx; }
        const unsigned old = xb_add(&bar[XB_XSUB(b.x)], 1u);
        const unsigned gen = old / nloc;
        if (old + 1u == (gen + 1u) * nloc) {
            __builtin_amdgcn_fence(__ATOMIC_RELEASE, "agent");
            asm volatile("s_waitcnt vmcnt(0)" ::: "memory");
            const unsigned og = xb_add(&bar[XB_TOP], 1u);
            const unsigned tg = og / nx;
            if (og + 1u == (tg + 1u) * nx) xb_add(&bar[XB_TOPGEN], 1u);
            else XB_SPIN(xb_ld(&bar[XB_TOPGEN]) == tg, bar);
            __builtin_amdgcn_fence(__ATOMIC_ACQUIRE, "agent");
            xb_add(&bar[XB_XGEN(b.x)], 1u);
            asm volatile("s_waitcnt vmcnt(0)" ::: "memory");
        } else {
            XB_SPIN(xb_ld(&bar[XB_XGEN(b.x)]) == gen, bar);
            __builtin_amdgcn_fence(__ATOMIC_ACQUIRE, "agent");
            asm volatile("s_waitcnt vmcnt(0)" ::: "memory");
        }
    }
    __syncthreads();
}

constexpr int DM = 2048, NB = 4, SEQ = 4096, CTXL = 256, DEPTH = 4;
constexpr int M_LAT = NB * SEQ, M_CTX = NB * CTXL, M_ALL = M_LAT + M_CTX;
constexpr int DFF = 5632, DFF2 = 2 * DFF, NQKV = 3072, NGLA = 6144, NGLA_EXT = 6400, NMOD = 6 * DM;
constexpr float EPS = 1e-6f;
#ifndef MK_ONE_LAUNCH
#define MK_ONE_LAUNCH 1
#endif
#ifndef NAIVE_ATTN
#define NAIVE_ATTN 0
#endif
#ifndef NAIVE_GLA
#define NAIVE_GLA 0
#endif
#ifndef RPT_PRO
#define RPT_PRO 1
#endif
#ifndef RPT_NORM
#define RPT_NORM 1
#endif
#ifndef RPT_ATT
#define RPT_ATT 1
#endif
#ifndef RPT_GPRE
#define RPT_GPRE 1
#endif
#ifndef RPT_SCAN
#define RPT_SCAN 1
#endif
#ifndef RPT_COMB
#define RPT_COMB 1
#endif
#ifndef RPT_UP
#define RPT_UP 1
#endif
#ifndef RPT_CONV
#define RPT_CONV 1
#endif
#ifndef RPT_PROJ
#define RPT_PROJ 1
#endif
#ifndef RPT_WO
#define RPT_WO 0
#endif
#ifndef RPT_DN
#define RPT_DN 0
#endif
#ifndef EXTRA_BAR
#define EXTRA_BAR 0
#endif
#ifndef RPT_AVT
#define RPT_AVT 1
#endif
#ifndef RPT_ROPE
#define RPT_ROPE 0
#endif
#ifndef DIAG_BAR
#define DIAG_BAR 0
#endif
#ifndef DIAG_CLK
#define DIAG_CLK 0
#endif
#ifndef DIAG_SCAN
#define DIAG_SCAN 0
#endif
#ifndef SPLITK_WO
#define SPLITK_WO 0
#endif
#ifndef SPLITK_DN
#define SPLITK_DN 1
#endif
#ifndef TAIL_CONVERT
#define TAIL_CONVERT 1
#endif
#ifndef NORM_BF16_IN
#define NORM_BF16_IN 0
#endif
#ifndef TAIL_MODS
#define TAIL_MODS 0
#endif
#ifndef FUSE_CONV
#define FUSE_CONV 1
#endif
constexpr int NPH = 42;

constexpr size_t MiB = 1u << 20;
constexpr size_t WS_CTL = 0, CTL_ZERO_BYTES = 1 * MiB;
constexpr size_t WS_MODS = 1 * MiB;
constexpr size_t WS_X = 2 * MiB;
constexpr size_t WS_H = 138 * MiB;
constexpr size_t WS_P = 206 * MiB;
constexpr size_t WS_Z1 = 410 * MiB;
constexpr size_t WS_OMIX = 413 * MiB;
constexpr size_t WS_U = 481 * MiB;
constexpr size_t WS_OF = WS_U, WS_OB = WS_U + 136 * MiB;
constexpr size_t WS_XB = WS_U + 292 * MiB;
constexpr size_t WS_UB = WS_U + 64 * MiB;
constexpr size_t WS_PART = WS_U;
constexpr size_t WS_VTA = WS_U;
constexpr size_t WS_QT = WS_U;
constexpr size_t WS_KHT = WS_U + 68 * MiB;
constexpr size_t WS_AIN = WS_U + 136 * MiB;
constexpr size_t WS_DEC = WS_U + 153 * MiB;
constexpr size_t WS_VT = WS_U + 156 * MiB;
constexpr size_t WS_OFB = WS_U + 224 * MiB, WS_OBB = WS_U + 292 * MiB;
constexpr size_t WS_ACT = 855 * MiB;
constexpr size_t WS_WUP = 1042 * MiB, WUP_STRIDE = 44 * MiB;
constexpr size_t WS_WDN = 1218 * MiB, WDN_STRIDE = 22 * MiB;
constexpr size_t WS_WQKV = 1306 * MiB, WQKV_STRIDE = 12 * MiB;
constexpr size_t WS_WAO = 1330 * MiB, WO_STRIDE = 8 * MiB;
constexpr size_t WS_WGIN = 1346 * MiB, WGIN_STRIDE = 25 * MiB;
constexpr size_t WS_WGO = 1396 * MiB;
constexpr size_t WS_END = 1412 * MiB;
constexpr int CW_BAR = 4096;

constexpr int RING_BYTES = 131072, LDSCTL_OFF = RING_BYTES, LDS_BYTES = 147456;

#define GAS __attribute__((address_space(1)))
#define LAS __attribute__((address_space(3)))
typedef unsigned short bf16;
typedef unsigned v4u __attribute__((ext_vector_type(4)));
typedef unsigned v2u __attribute__((ext_vector_type(2)));
typedef float f32x4 __attribute__((ext_vector_type(4)));
#define LDS_WAIT() asm volatile("s_waitcnt lgkmcnt(0)" ::: "memory")
#define LDS_BARRIER() do { asm volatile("s_waitcnt lgkmcnt(0)" ::: "memory"); __builtin_amdgcn_s_barrier(); asm volatile("" ::: "memory"); } while (0)
__device__ __forceinline__ unsigned pk2(float lo, float hi) { return pg8::cvt_pk_bf16(lo, hi); }
__device__ __forceinline__ unsigned f2bf(float f) { return pk2(f, 0.f) & 0xffffu; }
__device__ __forceinline__ float bf_lo(unsigned w) { return __builtin_bit_cast(float, w << 16); }
__device__ __forceinline__ float bf_hi(unsigned w) { return __builtin_bit_cast(float, w & 0xffff0000u); }
__device__ __forceinline__ float bf2f(bf16 h) { return __builtin_bit_cast(float, ((unsigned)h) << 16); }
__device__ __forceinline__ float silu_f(float v) { return v / (1.0f + __expf(-v)); }
__device__ __forceinline__ float wave_sum(float v) {
#pragma unroll
    for (int o = 1; o < 64; o <<= 1) v += __shfl_xor(v, o);
    return v;
}

__device__ __forceinline__ void unpack8(const v4u a, float (&x)[8]) { x[0] = bf_lo(a.x); x[1] = bf_hi(a.x); x[2] = bf_lo(a.y); x[3] = bf_hi(a.y); x[4] = bf_lo(a.z); x[5] = bf_hi(a.z); x[6] = bf_lo(a.w); x[7] = bf_hi(a.w); }

struct Args { const float* in[25]; float* out; unsigned char* ws; int ph_lo, ph_hi; };
struct WV { int tid, lane, wave, G, vcu, gw, NGW; LAS unsigned char* lds; };

__device__ __forceinline__ void p0_transpose_item(const float* W, int K, int N, bf16* WT, int row_off, LAS float* scr, int item, int lane, bool remap_up) {
    const int nblk = N / 32, kb = item / nblk, nb = item % nblk, k0 = 64 * kb, n0 = 32 * nb;
    const int r0 = remap_up ? ((n0 < DFF ? 0 : 128) + 256 * ((n0 < DFF ? n0 : n0 - DFF) >> 7) + ((n0 < DFF ? n0 : n0 - DFF) & 127)) : n0;
    f32x4 ld[8];
#pragma unroll
    for (int i = 0; i < 8; ++i) ld[i] = *(const f32x4*)(W + (size_t)(k0 + 8 * i + (lane >> 3)) * N + n0 + 4 * (lane & 7));
#pragma unroll
    for (int i = 0; i < 8; ++i) { LAS float* sp = scr + (8 * i + (lane >> 3)) * 33 + 4 * (lane & 7); sp[0] = ld[i].x; sp[1] = ld[i].y; sp[2] = ld[i].z; sp[3] = ld[i].w; }
    LDS_WAIT(); asm volatile("" ::: "memory");
    const int c = lane & 7;
#pragma unroll
    for (int j = 0; j < 4; ++j) { const int n = (lane >> 3) + 8 * j; const LAS float* s = scr + (8 * c) * 33 + n;
        v4u o; o.x = pk2(s[0 * 33], s[1 * 33]); o.y = pk2(s[2 * 33], s[3 * 33]); o.z = pk2(s[4 * 33], s[5 * 33]); o.w = pk2(s[6 * 33], s[7 * 33]);
        *(v4u*)(WT + (size_t)(row_off + r0 + n) * K + k0 + 8 * c) = o; }
    LDS_WAIT(); asm volatile("" ::: "memory");
}
__device__ __forceinline__ void transpose_matrix(const WV& w, const float* W, int K, int N, bf16* WT, int row_off, bool remap_up = false) {
    LAS float* scr = (LAS float*)(w.lds + w.wave * 16384);
    const int nitems = (K / 64) * (N / 32);
    for (int it = w.gw; it < nitems; it += w.NGW) p0_transpose_item(W, K, N, WT, row_off, scr, it, w.lane, remap_up);
}
__device__ __forceinline__ void mods_item(const WV& w, const float* c, const float* c_ctx, const float* ada_w, const float* ada_b, float* mods, int it) {
    const int layer = it >> 6, n0 = (it & 63) * 192;
    LAS float* sl = (LAS float*)w.lds;
    LAS float* red = (LAS float*)(w.lds + 40960);
    for (int i = w.tid; i < 5 * DM; i += 512) { const int vec = i >> 11, k = i & 2047; const float v = vec < 4 ? c[vec * DM + k] : c_ctx[k]; sl[i] = silu_f(v); }
    __syncthreads();
    f32x4 acc[5];
#pragma unroll
    for (int v = 0; v < 5; ++v) acc[v] = (f32x4){0.f, 0.f, 0.f, 0.f};
    if (w.lane < 48) {
        const float* Wp = ada_w + (size_t)layer * DM * NMOD + n0 + 4 * w.lane;
        const int kbeg = w.wave * 256;
        for (int k = kbeg; k < kbeg + 256; k += 8) {
            f32x4 wv[8];
#pragma unroll
            for (int kk = 0; kk < 8; ++kk) wv[kk] = *(const f32x4*)(Wp + (size_t)(k + kk) * NMOD);
#pragma unroll
            for (int kk = 0; kk < 8; ++kk)
#pragma unroll
                for (int v = 0; v < 5; ++v) acc[v] += wv[kk] * sl[v * DM + k + kk];
        }
#pragma unroll
        for (int v = 0; v < 5; ++v) *(LAS f32x4*)(red + (w.wave * 5 + v) * 192 + 4 * w.lane) = acc[v];
    }
    __syncthreads();
    for (int i = w.tid; i < 5 * 192; i += 512) { const int vec = i / 192, col = i % 192; float s = 0.f;
#pragma unroll
        for (int ww = 0; ww < 8; ++ww) s += red[(ww * 5 + vec) * 192 + col];
        mods[((size_t)layer * 5 + vec) * NMOD + n0 + col] = s + ada_b[(size_t)layer * NMOD + n0 + col]; }
    __syncthreads();
}

__device__ __forceinline__ void norm_rows(const WV& w, float* X, bf16* H, const float* g, const float* shift, const float* scale, int nrows, const float* part, int nsplit, const float* pgate, const float* in_lat, const float* in_ctx, const bf16* xb) {
    for (int row = w.gw; row < nrows; row += w.NGW) {
        const int vec = row < M_LAT ? (row >> 12) : 4;
        f32x4* xr = (f32x4*)(X + (size_t)row * DM) + w.lane;
        const f32x4* xi = in_lat ? (const f32x4*)(row < M_LAT ? in_lat + (size_t)row * DM : in_ctx + (size_t)(row - M_LAT) * DM) + w.lane : xr;
        f32x4 v[8]; float ss = 0.f;
        const bool ctxfold = nsplit > 0 && row >= M_LAT;
        if (xb && !ctxfold) {
            const v2u* xbr = (const v2u*)(xb + (size_t)row * DM) + w.lane;
#pragma unroll
            for (int j = 0; j < 8; ++j) { const v2u q = xbr[64 * j]; v[j] = (f32x4){bf_lo(q.x), bf_hi(q.x), bf_lo(q.y), bf_hi(q.y)}; }
        } else {
#pragma unroll
            for (int j = 0; j < 8; ++j) v[j] = xi[64 * j];
        }
        if (ctxfold) {
            const f32x4* pr = (const f32x4*)(part + (size_t)(row - M_LAT) * DM) + w.lane;
#pragma unroll
            for (int j = 0; j < 8; ++j) { f32x4 sum = pr[64 * j];
                for (int sl = 1; sl < nsplit; ++sl) sum += pr[(size_t)sl * (M_CTX * DM / 4) + 64 * j];
                v[j] += *(const f32x4*)(pgate + 4 * (64 * j + w.lane)) * sum; xr[64 * j] = v[j]; }
        }
#pragma unroll
        for (int j = 0; j < 8; ++j) ss += (v[j].x * v[j].x + v[j].y * v[j].y) + (v[j].z * v[j].z + v[j].w * v[j].w);
        const float r = 1.0f / sqrtf(wave_sum(ss) * (1.0f / DM) + EPS);
        const float* sh = shift + (size_t)vec * NMOD; const float* sc = scale + (size_t)vec * NMOD;
        v2u* o8 = (v2u*)(H + (size_t)row * DM) + w.lane;
#pragma unroll
        for (int j = 0; j < 8; ++j) { const int col = 4 * (64 * j + w.lane);
            const f32x4 gv = *(const f32x4*)(g + col), s = *(const f32x4*)(sc + col), t = *(const f32x4*)(sh + col);
            const f32x4 y = v[j] * r * gv * (s + 1.0f) + t;
            v2u o; o.x = pk2(y.x, y.y); o.y = pk2(y.z, y.w); o8[64 * j] = o; }
    }
}
__device__ __forceinline__ void final_norm(const WV& w, const float* X, float* out, const float* g) {
    for (int row = w.gw; row < M_LAT; row += w.NGW) {
        const f32x4* xr = (const f32x4*)(X + (size_t)row * DM) + w.lane;
        f32x4 v[8]; float ss = 0.f;
#pragma unroll
        for (int j = 0; j < 8; ++j) { v[j] = xr[64 * j]; ss += (v[j].x * v[j].x + v[j].y * v[j].y) + (v[j].z * v[j].z + v[j].w * v[j].w); }
        const float r = 1.0f / sqrtf(wave_sum(ss) * (1.0f / DM) + EPS);
        f32x4* o = (f32x4*)(out + (size_t)row * DM) + w.lane;
#pragma unroll
        for (int j = 0; j < 8; ++j) { const int col = 4 * (64 * j + w.lane); o[64 * j] = v[j] * r * *(const f32x4*)(g + col); }
    }
}

__device__ __forceinline__ void rope_rows(const WV& w, bf16* P, float sgn = 1.0f) {
    const int half = (w.lane >> 2) & 1, oct = w.lane & 3;
    float inv[8];
#pragma unroll
    for (int e = 0; e < 8; ++e) inv[e] = exp2f(-(float)(2 * (8 * oct + e)) * (13.287712379549449f / 64.0f));
    for (int row = w.gw; row < M_LAT; row += w.NGW) {
        const int t = row & (SEQ - 1); const float pos = (float)(half ? (t & 63) : (t >> 6));
        float cs[8], sn[8];
#pragma unroll
        for (int e = 0; e < 8; ++e) { const float ang = pos * inv[e]; cs[e] = __cosf(ang); sn[e] = sgn * __sinf(ang); }
        bf16* base = P + (size_t)row * NQKV + half * 64 + 8 * oct;
#pragma unroll
        for (int rnd = 0; rnd < 3; ++rnd) { const int hd = (w.lane >> 3) + 8 * rnd;
            if (hd < 20) { bf16* p = base + hd * 128; float x1[8], x2[8]; unpack8(*(const v4u*)p, x1); unpack8(*(const v4u*)(p + 32), x2);
                float y1[8], y2[8];
#pragma unroll
                for (int e = 0; e < 8; ++e) { y1[e] = x1[e] * cs[e] - x2[e] * sn[e]; y2[e] = x2[e] * cs[e] + x1[e] * sn[e]; }
                *(v4u*)p = (v4u){pk2(y1[0], y1[1]), pk2(y1[2], y1[3]), pk2(y1[4], y1[5]), pk2(y1[6], y1[7])};
                *(v4u*)(p + 32) = (v4u){pk2(y2[0], y2[1]), pk2(y2[2], y2[3]), pk2(y2[4], y2[5]), pk2(y2[6], y2[7])}; } }
    }
}

__device__ __forceinline__ void attn_naive(const WV& w, const bf16* P, const float* sink, bf16* O) {
    const int g = w.lane >> 4, li = w.lane & 15;
    const float scale = 0.08838834764831845f;
    for (int task = w.gw; task < M_ALL * 16; task += w.NGW) {
        const int row = task >> 4, hq = task & 15, kvh = hq >> 2;
        float q[8];
        { const v4u qq = *(const v4u*)(P + (size_t)row * NQKV + hq * 128 + 8 * li);
          q[0] = bf_lo(qq.x) * scale; q[1] = bf_hi(qq.x) * scale; q[2] = bf_lo(qq.y) * scale; q[3] = bf_hi(qq.y) * scale;
          q[4] = bf_lo(qq.z) * scale; q[5] = bf_hi(qq.z) * scale; q[6] = bf_lo(qq.w) * scale; q[7] = bf_hi(qq.w) * scale; }
        int b, wbase = 0, nwin = 0;
        if (row < M_LAT) { b = row >> 12; const int t = row & (SEQ - 1); const int j0 = t - 128 < 0 ? 0 : t - 128, j1 = t + 128 > SEQ - 1 ? SEQ - 1 : t + 128; wbase = b * SEQ + j0; nwin = j1 - j0 + 1; }
        else b = (row - M_LAT) >> 8;
        const int cbase = M_LAT + b * CTXL, nk = nwin + CTXL;
        float m = sink[hq], l = (g == 0) ? 1.0f : 0.0f, o[8];
#pragma unroll
        for (int d = 0; d < 8; ++d) o[d] = 0.f;
        for (int i = g; i < nk; i += 4) {
            const int krow = i < nwin ? wbase + i : cbase + (i - nwin);
            const bf16* kp = P + (size_t)krow * NQKV + 2048 + kvh * 128 + 8 * li;
            const v4u kk = *(const v4u*)kp, vv = *(const v4u*)(kp + 512);
            float s = q[0] * bf_lo(kk.x) + q[1] * bf_hi(kk.x) + q[2] * bf_lo(kk.y) + q[3] * bf_hi(kk.y) + q[4] * bf_lo(kk.z) + q[5] * bf_hi(kk.z) + q[6] * bf_lo(kk.w) + q[7] * bf_hi(kk.w);
            s += __shfl_xor(s, 1); s += __shfl_xor(s, 2); s += __shfl_xor(s, 4); s += __shfl_xor(s, 8);
            const float mn = fmaxf(m, s), a = __expf(m - mn), p = __expf(s - mn);
            l = l * a + p; m = mn;
            o[0] = o[0] * a + p * bf_lo(vv.x); o[1] = o[1] * a + p * bf_hi(vv.x); o[2] = o[2] * a + p * bf_lo(vv.y); o[3] = o[3] * a + p * bf_hi(vv.y);
            o[4] = o[4] * a + p * bf_lo(vv.z); o[5] = o[5] * a + p * bf_hi(vv.z); o[6] = o[6] * a + p * bf_lo(vv.w); o[7] = o[7] * a + p * bf_hi(vv.w);
        }
        float ma = fmaxf(m, __shfl_xor(m, 16)); ma = fmaxf(ma, __shfl_xor(ma, 32));
        const float fsc = __expf(m - ma); l *= fsc; l += __shfl_xor(l, 16); l += __shfl_xor(l, 32);
        const float rl = 1.0f / l;
#pragma unroll
        for (int d = 0; d < 8; ++d) { float x = o[d] * fsc; x += __shfl_xor(x, 16); x += __shfl_xor(x, 32); o[d] = x * rl; }
        if (g == 0) { v4u ov; ov.x = pk2(o[0], o[1]); ov.y = pk2(o[2], o[3]); ov.z = pk2(o[4], o[5]); ov.w = pk2(o[6], o[7]);
            *(v4u*)(O + (size_t)row * DM + hq * 128 + 8 * li) = ov; }
    }
}

__device__ __forceinline__ void gla_naive(const WV& w, const bf16* P, const float* Z1, const float* w2f, const float* bf, const float* w2b, const float* bb, float* OF, float* OB) {
    LAS float* buf = (LAS float*)w.lds;
    const int vc = w.tid >> 2, dq = w.tid & 3;
    for (int it = w.vcu; it < 128; it += w.G) {
        const int vs = it & 3, dir = (it >> 2) & 1, h = (it >> 3) & 3, b = it >> 5;
        const float* w2 = dir ? w2b : w2f; const float* bias = dir ? bb : bf; float* OUT = dir ? OB : OF;
        float w2c[16], bz = 0.f;
        if (w.tid < 256) { bz = bias[h * 256 + w.tid];
#pragma unroll
            for (int r = 0; r < 16; ++r) w2c[r] = w2[r * 1024 + h * 256 + w.tid]; }
        else {
#pragma unroll
            for (int r = 0; r < 16; ++r) w2c[r] = 0.f; }
        float S[64];
#pragma unroll
        for (int i = 0; i < 64; ++i) S[i] = 0.f;
        const int cbase = M_LAT + b * CTXL, lbase = b * SEQ;
#define GLA_ROW(step) ((step) < CTXL ? (dir ? cbase + CTXL - 1 - (step) : cbase + (step)) : (dir ? lbase + SEQ - 1 - ((step) - CTXL) : lbase + ((step) - CTXL)))
#define GLA_FILL(step, par) do { if (w.tid < 256) { const int r_ = GLA_ROW(step); const float* z_ = Z1 + (size_t)r_ * 32 + dir * 16; float zz = bz; \
            _Pragma("unroll") for (int r = 0; r < 16; ++r) zz += z_[r] * w2c[r]; \
            const float ls_ = fminf(zz, 0.f) - log1pf(__expf(-fabsf(zz))); \
            LAS float* bp_ = buf + (par) * 768; bp_[w.tid] = __expf(ls_ * (1.0f / 16.0f)); \
            bp_[256 + w.tid] = bf2f(P[(size_t)r_ * NGLA + 1024 + h * 256 + w.tid]); bp_[512 + w.tid] = bf2f(P[(size_t)r_ * NGLA + h * 256 + w.tid]) * 0.0625f; } } while (0)
        __syncthreads();
        GLA_FILL(0, 0);
        __syncthreads();
        for (int step = 0; step < CTXL + SEQ; ++step) {
            const int row = GLA_ROW(step);
            if (step + 1 < CTXL + SEQ) GLA_FILL(step + 1, (step + 1) & 1);
            const float v = bf2f(P[(size_t)row * NGLA + 2048 + h * 512 + vs * 128 + vc]);
            const LAS float* bp = buf + (step & 1) * 768 + 64 * dq;
            float acc = 0.f;
#pragma unroll
            for (int i = 0; i < 64; i += 4) {
                const f32x4 e4 = *(const LAS f32x4*)(bp + i), k4 = *(const LAS f32x4*)(bp + 256 + i), q4 = *(const LAS f32x4*)(bp + 512 + i);
                S[i] = S[i] * e4.x + k4.x * v; acc += q4.x * S[i];
                S[i + 1] = S[i + 1] * e4.y + k4.y * v; acc += q4.y * S[i + 1];
                S[i + 2] = S[i + 2] * e4.z + k4.z * v; acc += q4.z * S[i + 2];
                S[i + 3] = S[i + 3] * e4.w + k4.w * v; acc += q4.w * S[i + 3];
            }
            acc += __shfl_xor(acc, 1); acc += __shfl_xor(acc, 2);
            if (dq == 0) OUT[(size_t)row * DM + h * 512 + vs * 128 + vc] = acc;
            __syncthreads();
        }
#undef GLA_ROW
#undef GLA_FILL
    }
}
__device__ __forceinline__ void gla_combine(const WV& w, const float* OF, const float* OB, const bf16* P, const float* og, bf16* O, int nrows) {
    for (int task = w.gw; task < nrows * 4; task += w.NGW) {
        const int row = task >> 2, h = task & 3; const size_t off = (size_t)row * DM + h * 512 + 8 * w.lane;
        const f32x4 a0 = *(const f32x4*)(OF + off), a1 = *(const f32x4*)(OF + off + 4), b0 = *(const f32x4*)(OB + off), b1 = *(const f32x4*)(OB + off + 4);
        const f32x4 o0 = a0 + b0, o1 = a1 + b1;
        float ss = (o0.x * o0.x + o0.y * o0.y) + (o0.z * o0.z + o0.w * o0.w) + (o1.x * o1.x + o1.y * o1.y) + (o1.z * o1.z + o1.w * o1.w);
        const float r = 1.0f / sqrtf(wave_sum(ss) * (1.0f / 512.0f) + EPS);
        const f32x4 g0 = *(const f32x4*)(og + 8 * w.lane), g1 = *(const f32x4*)(og + 8 * w.lane + 4);
        const v4u rr = *(const v4u*)(P + (size_t)row * NGLA + 4096 + h * 512 + 8 * w.lane);
        v4u ov;
        ov.x = pk2(o0.x * r * g0.x * silu_f(bf_lo(rr.x)), o0.y * r * g0.y * silu_f(bf_hi(rr.x)));
        ov.y = pk2(o0.z * r * g0.z * silu_f(bf_lo(rr.y)), o0.w * r * g0.w * silu_f(bf_hi(rr.y)));
        ov.z = pk2(o1.x * r * g1.x * silu_f(bf_lo(rr.z)), o1.y * r * g1.y * silu_f(bf_hi(rr.z)));
        ov.w = pk2(o1.z * r * g1.z * silu_f(bf_lo(rr.w)), o1.w * r * g1.w * silu_f(bf_hi(rr.w)));
        *(v4u*)(O + off) = ov;
    }
}

typedef short bf16x8 __attribute__((ext_vector_type(8)));
typedef float f32x16 __attribute__((ext_vector_type(16)));
__device__ __forceinline__ int gla_row(int b, int cc, int i) { return cc < 64 ? b * SEQ + cc * 64 + i : M_LAT + b * CTXL + (cc - 64) * 64 + i; }
__device__ __forceinline__ void gla_pre(const WV& w, const bf16* P, const float* Z1, const float* w2f, const float* bf_, const float* w2b, const float* bb_, bf16* QT, bf16* KHT, bf16* AIN, float* DEC) {
    LAS bf16* QS = (LAS bf16*)w.lds;
    LAS bf16* KS = (LAS bf16*)(w.lds + 33792);
    LAS bf16* KH = (LAS bf16*)(w.lds + 67584);
    LAS float* z1s = (LAS float*)(w.lds + 104448);
    LAS float* tot = (LAS float*)(w.lds + 108544);
    LAS bf16* AS = (LAS bf16*)(w.lds + 110592);
    const int d = w.tid & 255, hf = w.tid >> 8;
    float w2c[16], bias = 0.f; int cur_dh = -1;
    v4u pq[4], pkk[4]; f32x4 pz = (f32x4){0.f, 0.f, 0.f, 0.f};
#define PRE_FETCH(it_) do { const int b_ = ((it_) >> 3) & 3, h_ = ((it_) >> 1) & 3, dir_ = (it_) & 1, row0_ = gla_row(b_, (it_) >> 5, 0); \
        _Pragma("unroll") for (int i = 0; i < 4; ++i) { const int p = w.tid + 512 * i; const bf16* src = P + (size_t)(row0_ + (p >> 5)) * NGLA + h_ * 256 + 8 * (p & 31); pq[i] = *(const v4u*)src; pkk[i] = *(const v4u*)(src + 1024); } \
        if (w.tid < 256) pz = *(const f32x4*)(Z1 + (size_t)(row0_ + (w.tid >> 2)) * 32 + dir_ * 16 + 4 * (w.tid & 3)); } while (0)
    if (w.vcu < 2 * 4 * 4 * 68) PRE_FETCH(w.vcu);
    LDS_BARRIER();
    for (int it = w.vcu; it < 2 * 4 * 4 * 68; it += w.G) {
        const int dir = it & 1, h = (it >> 1) & 3, b = (it >> 3) & 3, cc = it >> 5;
        const size_t item = ((size_t)(dir * 4 + b) * 4 + h) * 68 + cc;
        if (cur_dh != (dir * 4 + h)) { cur_dh = dir * 4 + h; const float* w2 = dir ? w2b : w2f; bias = (dir ? bb_ : bf_)[h * 256 + d];
#pragma unroll
            for (int r = 0; r < 16; ++r) w2c[r] = w2[r * 1024 + h * 256 + d]; }
        const int row0 = gla_row(b, cc, 0);
#pragma unroll
        for (int i = 0; i < 4; ++i) { const int p = w.tid + 512 * i, r = p >> 5, c = p & 31; *(LAS v4u*)(QS + r * 264 + 8 * c) = pq[i]; *(LAS v4u*)(KS + r * 264 + 8 * c) = pkk[i]; }
        if (w.tid < 256) *(LAS f32x4*)(z1s + 4 * w.tid) = pz;
        if (it + w.G < 2 * 4 * 4 * 68) PRE_FETCH(it + w.G);
        LDS_BARRIER();
        float g[32];
#pragma unroll
        for (int ii = 0; ii < 32; ++ii) { const LAS f32x4* zp = (const LAS f32x4*)(z1s + (32 * hf + ii) * 16); float zz = bias;
#pragma unroll
            for (int q4 = 0; q4 < 4; ++q4) { const f32x4 z = zp[q4]; zz += z.x * w2c[4 * q4] + z.y * w2c[4 * q4 + 1] + z.z * w2c[4 * q4 + 2] + z.w * w2c[4 * q4 + 3]; }
            g[ii] = (fminf(zz, 0.f) * 1.4426950408889634f - __builtin_amdgcn_logf(1.0f + __builtin_amdgcn_exp2f(-fabsf(zz) * 1.4426950408889634f))) * 0.0625f; }
        float run = 0.f;
        if (!dir) {
#pragma unroll
            for (int ii = 0; ii < 32; ++ii) { run += g[ii]; g[ii] = run; } }
        else {
#pragma unroll
            for (int ii = 31; ii >= 0; --ii) { run += g[ii]; g[ii] = run; } }
        tot[hf * 256 + d] = run;
        LDS_BARRIER();
        const float t0 = tot[d], t1 = tot[256 + d], blast = t0 + t1;
        const float off = dir ? (hf == 0 ? t1 : 0.f) : (hf == 1 ? t0 : 0.f);
        unsigned khat[16];
#pragma unroll
        for (int ii = 0; ii < 32; ++ii) { const int i = 32 * hf + ii; const float bbv = g[ii] + off;
            const float qv = bf2f(QS[i * 264 + d]) * 0.0625f, kv = bf2f(KS[i * 264 + d]);
            const unsigned qk = pk2(qv * __builtin_amdgcn_exp2f(bbv), kv * __builtin_amdgcn_exp2f(-bbv)); const unsigned kh = f2bf(kv * __builtin_amdgcn_exp2f(blast - bbv));
            QS[i * 264 + d] = (bf16)(qk & 0xffffu); KS[i * 264 + d] = (bf16)(qk >> 16);
            if (ii & 1) khat[ii >> 1] |= kh << 16; else khat[ii >> 1] = kh; }
        { LAS v4u* kp = (LAS v4u*)(KH + d * 72 + 32 * hf);
#pragma unroll
          for (int q4 = 0; q4 < 4; ++q4) kp[q4] = (v4u){khat[4 * q4], khat[4 * q4 + 1], khat[4 * q4 + 2], khat[4 * q4 + 3]}; }
        if (hf == 0) DEC[item * 256 + d] = __builtin_amdgcn_exp2f(blast);
        LDS_BARRIER();
#pragma unroll
        for (int i = 0; i < 4; ++i) { const int p = w.tid + 512 * i, r = p >> 5, c = p & 31;
            *(v4u*)(QT + ((size_t)dir * M_ALL + row0 + r) * 1024 + h * 256 + 8 * c) = *(const LAS v4u*)(QS + r * 264 + 8 * c); }
#pragma unroll
        for (int i = 0; i < 4; ++i) { const int p = w.tid + 512 * i, dd = p >> 3, c = p & 7;
            *(v4u*)(KHT + (item * 256 + dd) * 64 + 8 * c) = *(const LAS v4u*)(KH + dd * 72 + 8 * c); }
        { const int rb = w.wave >> 1, ch = w.wave & 1, c16 = w.lane & 15, kg = w.lane >> 4;
          f32x4 acc[2]; acc[0] = (f32x4){0.f, 0.f, 0.f, 0.f}; acc[1] = acc[0];
#pragma unroll
          for (int k8 = 0; k8 < 8; ++k8) { const bf16x8 a = *(const LAS bf16x8*)(QS + (rb * 16 + c16) * 264 + 32 * k8 + 8 * kg);
#pragma unroll
              for (int n = 0; n < 2; ++n) { const bf16x8 bq = *(const LAS bf16x8*)(KS + ((2 * ch + n) * 16 + c16) * 264 + 32 * k8 + 8 * kg); acc[n] = __builtin_amdgcn_mfma_f32_16x16x32_bf16(a, bq, acc[n], 0, 0, 0); } }
#pragma unroll
          for (int n = 0; n < 2; ++n)
#pragma unroll
              for (int r = 0; r < 4; ++r) { const int i = rb * 16 + 4 * kg + r, jj = (2 * ch + n) * 16 + c16; const bool keep = dir ? (jj >= i) : (jj <= i);
                  AS[i * 72 + jj] = (bf16)f2bf(keep ? acc[n][r] : 0.f); } }
        LDS_BARRIER();
        { const int r = w.tid >> 3, c = w.tid & 7; *(v4u*)(AIN + (item * 64 + r) * 64 + 8 * c) = *(const LAS v4u*)(AS + r * 72 + 8 * c); }
        LDS_BARRIER();
    }
#undef PRE_FETCH
    __syncthreads();
}
__device__ __forceinline__ void gla_vt(const WV& w, const bf16* P, bf16* VT) {
    LAS bf16* vt = (LAS bf16*)w.lds;
    for (int it = w.vcu; it < 4 * 4 * 68; it += w.G) {
        const int cc = it % 68, bh = it / 68, h = bh & 3, b = bh >> 2;
        const int row0 = gla_row(b, cc, 0);
#pragma unroll
        for (int rr = 0; rr < 8; ++rr) { const int i = rr * 8 + (w.tid >> 6), piece = w.tid & 63;
            *(LAS v4u*)(vt + i * 520 + 8 * (piece ^ (i >> 3))) = *(const v4u*)(P + (size_t)(row0 + i) * NGLA + 2048 + h * 512 + 8 * piece); }
        __syncthreads();
#pragma unroll
        for (int i = 0; i < 8; ++i) { const int p = w.tid + 512 * i, dv = p >> 3, c = p & 7; unsigned u[8];
#pragma unroll
            for (int e = 0; e < 8; ++e) u[e] = vt[(8 * c + e) * 520 + 8 * ((dv >> 3) ^ c) + (dv & 7)];
            *(v4u*)(VT + ((size_t)it * 512 + dv) * 64 + 8 * c) = (v4u){u[0] | (u[1] << 16), u[2] | (u[3] << 16), u[4] | (u[5] << 16), u[6] | (u[7] << 16)}; }
        __syncthreads();
    }
}
__device__ __forceinline__ void gla_scan(const WV& w, const bf16* QT, const bf16* KHT, const bf16* AIN, const float* DEC, const bf16* VT, bf16* OFB, bf16* OBB) {
    LAS bf16* ST = (LAS bf16*)w.lds;
    LAS bf16* QS = (LAS bf16*)(w.lds + 33792);
    LAS bf16* VS = (LAS bf16*)(w.lds + 67584);
    LAS bf16* AS = (LAS bf16*)(w.lds + 76800);
    LAS float* DS = (LAS float*)(w.lds + 86016);
    LAS bf16* OS = (LAS bf16*)(w.lds + 87040);
    const int wv = w.wave, r32 = w.lane & 31, hh = w.lane >> 5, c16 = w.lane & 15, kg = w.lane >> 4, tb = wv >> 1, dh = wv & 1;
    for (int it = w.vcu; it < 256; it += w.G) {
        const int vs = it & 7, dir = (it >> 3) & 1, h = (it >> 4) & 3, b = it >> 6;
        bf16* O = dir ? OBB : OFB;
        f32x16 S[2];
#pragma unroll
        for (int n = 0; n < 2; ++n)
#pragma unroll
            for (int r = 0; r < 16; ++r) S[n][r] = 0.f;
        v4u sq[4], sv, sa; f32x4 sd = (f32x4){0.f, 0.f, 0.f, 0.f}; bf16x8 kn[4];
#define SC_CC(s_) ((s_) < 4 ? (dir ? 67 - (s_) : 64 + (s_)) : (dir ? 67 - (s_) : (s_) - 4))
#define SC_LOAD(s_) do { const int cc_ = SC_CC(s_); const size_t item_ = ((size_t)(dir * 4 + b) * 4 + h) * 68 + cc_, vitem_ = ((size_t)b * 4 + h) * 68 + cc_; const int row0_ = gla_row(b, cc_, 0); \
            _Pragma("unroll") for (int i_ = 0; i_ < 4; ++i_) { const int p_ = w.tid + 512 * i_; sq[i_] = *(const v4u*)(QT + ((size_t)dir * M_ALL + row0_ + (p_ >> 5)) * 1024 + h * 256 + 8 * (p_ & 31)); } \
            sv = *(const v4u*)(VT + (vitem_ * 512 + vs * 64 + (w.tid >> 3)) * 64 + 8 * (w.tid & 7)); \
            sa = *(const v4u*)(AIN + (item_ * 64 + (w.tid >> 3)) * 64 + 8 * (w.tid & 7)); \
            if (w.tid < 64) sd = *(const f32x4*)(DEC + item_ * 256 + 4 * w.tid); \
            const bf16* krow_ = KHT + (item_ * 256 + 32 * wv + r32) * 64 + 8 * hh; \
            _Pragma("unroll") for (int k4 = 0; k4 < 4; ++k4) kn[k4] = *(const bf16x8*)(krow_ + 16 * k4); } while (0)
        SC_LOAD(0);
        for (int s = 0; s < 68; ++s) {
            const int row0 = gla_row(b, SC_CC(s), 0);
#pragma unroll
            for (int n = 0; n < 2; ++n)
#pragma unroll
                for (int g4 = 0; g4 < 4; ++g4) { v2u pk; pk.x = pk2(S[n][4 * g4], S[n][4 * g4 + 1]); pk.y = pk2(S[n][4 * g4 + 2], S[n][4 * g4 + 3]);
                    *(LAS v2u*)(ST + (32 * n + r32) * 264 + 32 * wv + 8 * g4 + 4 * hh) = pk; }
#pragma unroll
            for (int i = 0; i < 4; ++i) { const int p = w.tid + 512 * i; *(LAS v4u*)(QS + (p >> 5) * 264 + 8 * (p & 31)) = sq[i]; }
            *(LAS v4u*)(VS + (w.tid >> 3) * 72 + 8 * (w.tid & 7)) = sv;
            *(LAS v4u*)(AS + (w.tid >> 3) * 72 + 8 * (w.tid & 7)) = sa;
            if (w.tid < 64) *(LAS f32x4*)(DS + 4 * w.tid) = sd;
            bf16x8 ka[4];
#pragma unroll
            for (int k4 = 0; k4 < 4; ++k4) ka[k4] = kn[k4];
            if (s + 1 < 68) SC_LOAD(s + 1);
            asm volatile("s_waitcnt lgkmcnt(0)" ::: "memory"); __builtin_amdgcn_s_barrier(); asm volatile("" ::: "memory");
            f32x4 oacc[2]; oacc[0] = (f32x4){0.f, 0.f, 0.f, 0.f}; oacc[1] = oacc[0];
#pragma unroll
            for (int k8 = 0; k8 < 8; ++k8) { const bf16x8 qa = *(const LAS bf16x8*)(QS + (tb * 16 + c16) * 264 + 32 * k8 + 8 * kg);
#pragma unroll
                for (int n = 0; n < 2; ++n) { const bf16x8 sb = *(const LAS bf16x8*)(ST + (32 * dh + 16 * n + c16) * 264 + 32 * k8 + 8 * kg); oacc[n] = __builtin_amdgcn_mfma_f32_16x16x32_bf16(qa, sb, oacc[n], 0, 0, 0); } }
#pragma unroll
            for (int k2 = 0; k2 < 2; ++k2) { const bf16x8 aa = *(const LAS bf16x8*)(AS + (tb * 16 + c16) * 72 + 32 * k2 + 8 * kg);
#pragma unroll
                for (int n = 0; n < 2; ++n) { const bf16x8 vb = *(const LAS bf16x8*)(VS + (32 * dh + 16 * n + c16) * 72 + 32 * k2 + 8 * kg); oacc[n] = __builtin_amdgcn_mfma_f32_16x16x32_bf16(aa, vb, oacc[n], 0, 0, 0); } }
#pragma unroll
            for (int n = 0; n < 2; ++n)
#pragma unroll
                for (int r = 0; r < 4; ++r) OS[(tb * 16 + 4 * kg + r) * 72 + 32 * dh + 16 * n + c16] = (bf16)f2bf(oacc[n][r]);
            { float dec[16];
#pragma unroll
              for (int q4 = 0; q4 < 4; ++q4) { const f32x4 dq = *(const LAS f32x4*)(DS + 32 * wv + 4 * hh + 8 * q4); dec[4 * q4] = dq.x; dec[4 * q4 + 1] = dq.y; dec[4 * q4 + 2] = dq.z; dec[4 * q4 + 3] = dq.w; }
#pragma unroll
              for (int n = 0; n < 2; ++n) {
#pragma unroll
                  for (int r = 0; r < 16; ++r) S[n][r] *= dec[r];
#pragma unroll
                  for (int k4 = 0; k4 < 4; ++k4) { const bf16x8 vb = *(const LAS bf16x8*)(VS + (32 * n + r32) * 72 + 16 * k4 + 8 * hh); S[n] = __builtin_amdgcn_mfma_f32_32x32x16_bf16(ka[k4], vb, S[n], 0, 0, 0); } } }
            asm volatile("s_waitcnt lgkmcnt(0)" ::: "memory"); __builtin_amdgcn_s_barrier(); asm volatile("" ::: "memory");
            *(v4u*)(O + (size_t)(row0 + (w.tid >> 3)) * DM + h * 512 + vs * 64 + 8 * (w.tid & 7)) = *(const LAS v4u*)(OS + (w.tid >> 3) * 72 + 8 * (w.tid & 7));
        }
#undef SC_CC
#undef SC_LOAD
        __syncthreads();
    }
}
__device__ __forceinline__ void gla_combine_bf(const WV& w, const bf16* OFB, const bf16* OBB, const bf16* P, const float* og, bf16* O, int nrows) {
    for (int task = w.gw; task < nrows * 4; task += w.NGW) {
        const int row = task >> 2, h = task & 3; const size_t off = (size_t)row * DM + h * 512 + 8 * w.lane;
        float a[8], c[8], o[8], rv[8]; unpack8(*(const v4u*)(OFB + off), a); unpack8(*(const v4u*)(OBB + off), c);
        float ss = 0.f;
#pragma unroll
        for (int e = 0; e < 8; ++e) { o[e] = a[e] + c[e]; ss += o[e] * o[e]; }
        const float r = 1.0f / sqrtf(wave_sum(ss) * (1.0f / 512.0f) + EPS);
        const f32x4 g0 = *(const f32x4*)(og + 8 * w.lane), g1 = *(const f32x4*)(og + 8 * w.lane + 4);
        const float gg[8] = {g0.x, g0.y, g0.z, g0.w, g1.x, g1.y, g1.z, g1.w};
        unpack8(*(const v4u*)(P + (size_t)row * NGLA + 4096 + h * 512 + 8 * w.lane), rv);
#pragma unroll
        for (int e = 0; e < 8; ++e) o[e] = o[e] * r * gg[e] * silu_f(rv[e]);
        *(v4u*)(O + off) = (v4u){pk2(o[0], o[1]), pk2(o[2], o[3]), pk2(o[4], o[5]), pk2(o[6], o[7])};
    }
}


__device__ __forceinline__ void attn_vt(const WV& w, const bf16* P, bf16* VTA) {
    LAS bf16* tl = (LAS bf16*)w.lds;
    for (int it = w.vcu; it < 16 * 68; it += w.G) {
        const int blk = it % 68, bk = it / 68, b = bk >> 2, kvh = bk & 3;
        const size_t row0 = blk < 64 ? (size_t)b * SEQ + 64 * blk : (size_t)M_LAT + b * CTXL + 64 * (blk - 64);
        const int col0 = blk < 64 ? 64 * blk : SEQ + 64 * (blk - 64);
#pragma unroll
        for (int i = 0; i < 2; ++i) { const int p = w.tid + 512 * i, r = p >> 4, c8 = p & 15;
            *(LAS v4u*)(tl + r * 136 + 8 * c8) = *(const v4u*)(P + (row0 + r) * NQKV + 2560 + kvh * 128 + 8 * c8); }
        __syncthreads();
        const int d = w.tid & 127, tg = w.tid >> 7;
        unsigned u[16];
#pragma unroll
        for (int e = 0; e < 16; ++e) u[e] = tl[(16 * tg + e) * 136 + d];
        v4u* dst = (v4u*)(VTA + ((size_t)bk * 128 + d) * 4352 + col0 + 16 * tg);
        dst[0] = (v4u){u[0] | (u[1] << 16), u[2] | (u[3] << 16), u[4] | (u[5] << 16), u[6] | (u[7] << 16)};
        dst[1] = (v4u){u[8] | (u[9] << 16), u[10] | (u[11] << 16), u[12] | (u[13] << 16), u[14] | (u[15] << 16)};
        __syncthreads();
    }
}
__device__ __forceinline__ void attn_fast(const WV& w, const bf16* P, const bf16* VTA, const float* sink, bf16* O) {
    LAS bf16* KL = (LAS bf16*)w.lds;
    LAS bf16* VL = (LAS bf16*)(w.lds + 2 * 17408);
    const int wv = w.wave, r32 = w.lane & 31, hh = w.lane >> 5, g = wv >> 1, th = wv & 1;
    const float C2 = 0.08838834764831845f * 1.4426950408889634f, L2E = 1.4426950408889634f;
    for (int u = w.vcu; u < 1088; u += w.G) {
        int b, kvh, qb; bool isctx;
        if (u < 1024) { b = u >> 8; kvh = (u >> 6) & 3; qb = u & 63; isctx = false; } else { const int v = u - 1024; b = v >> 4; kvh = (v >> 2) & 3; qb = v & 3; isctx = true; }
        const int hq = kvh * 4 + g, tq = qb * 64 + 32 * th + r32;
        const size_t qrow = isctx ? (size_t)M_LAT + b * CTXL + tq : (size_t)b * SEQ + tq;
        int i_lo = 0, nwin = 0;
        if (!isctx) { i_lo = 2 - qb > 0 ? 2 - qb : 0; const int i_hi = 65 - qb < 4 ? 65 - qb : 4; nwin = i_hi - i_lo + 1; }
        const int T = nwin + 4;
        bf16x8 qf[8];
#pragma unroll
        for (int k8 = 0; k8 < 8; ++k8) qf[k8] = *(const bf16x8*)(P + qrow * NQKV + hq * 128 + 16 * k8 + 8 * hh);
        f32x16 OT[4];
#pragma unroll
        for (int db = 0; db < 4; ++db)
#pragma unroll
            for (int r = 0; r < 16; ++r) OT[db][r] = 0.f;
        float m = sink[hq] * L2E, lsum = hh == 0 ? 1.0f : 0.0f;
        v4u krA[2], vrA[2], krB[2], vrB[2];
#define ATT_LOAD(t_, kr_, vr_) do { const int t__ = (t_); const bool wt_ = t__ < nwin; const int kp0_ = qb * 64 - 128 + 64 * (i_lo + t__), ct_ = t__ - nwin; \
            const size_t krow0_ = wt_ ? (size_t)b * SEQ + kp0_ : (size_t)M_LAT + b * CTXL + 64 * ct_; const int vcol0_ = wt_ ? kp0_ : SEQ + 64 * ct_; \
            _Pragma("unroll") for (int i_ = 0; i_ < 2; ++i_) { const int p_ = w.tid + 512 * i_; \
                kr_[i_] = *(const v4u*)(P + (krow0_ + (p_ >> 4)) * NQKV + 2048 + kvh * 128 + 8 * (p_ & 15)); \
                vr_[i_] = *(const v4u*)(VTA + ((size_t)(b * 4 + kvh) * 128 + (p_ >> 3)) * 4352 + vcol0_ + 8 * (p_ & 7)); } } while (0)
#define ATT_STORE(buf_, kr_, vr_) do { _Pragma("unroll") for (int i_ = 0; i_ < 2; ++i_) { const int p_ = w.tid + 512 * i_; \
                *(LAS v4u*)(KL + (buf_) * (64 * 136) + (p_ >> 4) * 136 + 8 * (p_ & 15)) = kr_[i_]; \
                LAS v2u* vp_ = (LAS v2u*)(VL + (buf_) * (128 * 68) + (p_ >> 3) * 68 + 8 * (p_ & 7)); vp_[0] = (v2u){vr_[i_].x, vr_[i_].y}; vp_[1] = (v2u){vr_[i_].z, vr_[i_].w}; } } while (0)
#define ATT_BAR() do { asm volatile("s_waitcnt lgkmcnt(0)" ::: "memory"); __builtin_amdgcn_s_barrier(); asm volatile("" ::: "memory"); } while (0)
#define ATT_COMPUTE(t_) do { const int t = (t_); \
            const LAS bf16* kl = KL + (t & 1) * (64 * 136); const LAS bf16* vl = VL + (t & 1) * (128 * 68); \
            f32x16 sacc[2]; \
            _Pragma("unroll") for (int kb = 0; kb < 2; ++kb) { \
                _Pragma("unroll") for (int r = 0; r < 16; ++r) sacc[kb][r] = 0.f; \
                _Pragma("unroll") for (int k8 = 0; k8 < 8; ++k8) { const bf16x8 a = *(const LAS bf16x8*)(kl + (32 * kb + r32) * 136 + 16 * k8 + 8 * hh); sacc[kb] = __builtin_amdgcn_mfma_f32_32x32x16_bf16(a, qf[k8], sacc[kb], 0, 0, 0); } } \
            const bool wt = t < nwin; const int kp0 = qb * 64 - 128 + 64 * (i_lo + t); \
            float mx = -INFINITY; \
            _Pragma("unroll") for (int kb = 0; kb < 2; ++kb) \
                _Pragma("unroll") for (int r = 0; r < 16; ++r) { float sv = sacc[kb][r] * C2; \
                    if (wt) { const int dlt = kp0 + 32 * kb + (r & 3) + 8 * (r >> 2) + 4 * hh - tq; if (dlt > 128 || dlt < -128) sv = -INFINITY; } \
                    sacc[kb][r] = sv; mx = fmaxf(mx, sv); } \
            mx = fmaxf(mx, __shfl_xor(mx, 32)); \
            const float mn = fmaxf(m, mx), alpha = __builtin_amdgcn_exp2f(m - mn); m = mn; \
            float ps = 0.f; \
            _Pragma("unroll") for (int kb = 0; kb < 2; ++kb) \
                _Pragma("unroll") for (int r = 0; r < 16; ++r) { const float pv = __builtin_amdgcn_exp2f(sacc[kb][r] - mn); ps += pv; sacc[kb][r] = pv; } \
            lsum = lsum * alpha + ps; \
            _Pragma("unroll") for (int db = 0; db < 4; ++db) \
                _Pragma("unroll") for (int r = 0; r < 16; ++r) OT[db][r] *= alpha; \
            _Pragma("unroll") for (int kb = 0; kb < 2; ++kb) \
                _Pragma("unroll") for (int sh = 0; sh < 2; ++sh) { \
                    v4u pw; pw.x = pk2(sacc[kb][8 * sh], sacc[kb][8 * sh + 1]); pw.y = pk2(sacc[kb][8 * sh + 2], sacc[kb][8 * sh + 3]); \
                    pw.z = pk2(sacc[kb][8 * sh + 4], sacc[kb][8 * sh + 5]); pw.w = pk2(sacc[kb][8 * sh + 6], sacc[kb][8 * sh + 7]); \
                    const bf16x8 pf = __builtin_bit_cast(bf16x8, pw); \
                    _Pragma("unroll") for (int db = 0; db < 4; ++db) { const LAS bf16* vp = vl + (32 * db + r32) * 68 + 32 * kb + 16 * sh + 4 * hh; \
                        const v2u lo = *(const LAS v2u*)vp, hi = *(const LAS v2u*)(vp + 8); \
                        const bf16x8 vf = __builtin_bit_cast(bf16x8, ((v4u){lo.x, lo.y, hi.x, hi.y})); \
                        OT[db] = __builtin_amdgcn_mfma_f32_32x32x16_bf16(vf, pf, OT[db], 0, 0, 0); } } } while (0)
        __syncthreads();
        ATT_LOAD(0, krA, vrA); ATT_STORE(0, krA, vrA);
        ATT_LOAD(1, krB, vrB);
        ATT_BAR();
        for (int t2 = 0; t2 < T; t2 += 2) {
            if (t2 + 2 < T) ATT_LOAD(t2 + 2, krA, vrA);
            ATT_COMPUTE(t2);
            if (t2 + 1 < T) ATT_STORE(1, krB, vrB);
            ATT_BAR();
            if (t2 + 1 < T) {
                if (t2 + 3 < T) ATT_LOAD(t2 + 3, krB, vrB);
                ATT_COMPUTE(t2 + 1);
                if (t2 + 2 < T) ATT_STORE(0, krA, vrA);
                ATT_BAR();
            }
        }
#undef ATT_LOAD
#undef ATT_STORE
#undef ATT_BAR
#undef ATT_COMPUTE
        const float l = lsum + __shfl_xor(lsum, 32), rl = 1.0f / l;
        bf16* op = O + qrow * DM + hq * 128 + 4 * hh;
#pragma unroll
        for (int db = 0; db < 4; ++db)
#pragma unroll
            for (int g4 = 0; g4 < 4; ++g4) { v2u o; o.x = pk2(OT[db][4 * g4] * rl, OT[db][4 * g4 + 1] * rl); o.y = pk2(OT[db][4 * g4 + 2] * rl, OT[db][4 * g4 + 3] * rl);
                *(v2u*)(op + 32 * db + 8 * g4) = o; }
    }
}

__device__ __forceinline__ void conv_rows(const WV& w, const bf16* U, const float* cw, const float* cb, bf16* ACT, int nrows) {
    const int nseg = nrows / 32;
    for (int wi = w.gw; wi < nseg * 11; wi += w.NGW) {
        const int seg = wi / 11, cg = wi % 11, r0 = seg * 32, f = (cg * 64 + w.lane) * 8;
        float wg[3][8], wv[3][8], bg[8], bv[8];
#pragma unroll
        for (int j = 0; j < 3; ++j)
#pragma unroll
            for (int e = 0; e < 8; ++e) { wg[j][e] = cw[j * DFF2 + f + e]; wv[j][e] = cw[j * DFF2 + DFF + f + e]; }
#pragma unroll
        for (int e = 0; e < 8; ++e) { bg[e] = cb[f + e]; bv[e] = cb[DFF + f + e]; }
        const bool s_start = r0 < M_LAT ? ((r0 & (SEQ - 1)) == 0) : (((r0 - M_LAT) & (CTXL - 1)) == 0);
        const bool s_end = r0 < M_LAT ? (((r0 + 32) & (SEQ - 1)) == 0) : (((r0 + 32 - M_LAT) & (CTXL - 1)) == 0);
        const v4u zero4 = (v4u){0u, 0u, 0u, 0u};
        v4u pg = s_start ? zero4 : *(const v4u*)(U + (size_t)(r0 - 1) * DFF2 + f), pv = s_start ? zero4 : *(const v4u*)(U + (size_t)(r0 - 1) * DFF2 + DFF + f);
        v4u cg4 = *(const v4u*)(U + (size_t)r0 * DFF2 + f), cv4 = *(const v4u*)(U + (size_t)r0 * DFF2 + DFF + f);
        for (int r = 0; r < 32; ++r) {
            const bool nz = (r == 31) && s_end;
            const v4u ng = nz ? zero4 : *(const v4u*)(U + (size_t)(r0 + r + 1) * DFF2 + f), nv = nz ? zero4 : *(const v4u*)(U + (size_t)(r0 + r + 1) * DFF2 + DFF + f);
            float a[8], c[8], n[8], gate[8], val[8];
            unpack8(pg, a); unpack8(cg4, c); unpack8(ng, n);
#pragma unroll
            for (int e = 0; e < 8; ++e) gate[e] = bg[e] + wg[0][e] * a[e] + wg[1][e] * c[e] + wg[2][e] * n[e];
            unpack8(pv, a); unpack8(cv4, c); unpack8(nv, n);
#pragma unroll
            for (int e = 0; e < 8; ++e) val[e] = bv[e] + wv[0][e] * a[e] + wv[1][e] * c[e] + wv[2][e] * n[e];
            v4u ov; ov.x = pk2(silu_f(gate[0]) * val[0], silu_f(gate[1]) * val[1]); ov.y = pk2(silu_f(gate[2]) * val[2], silu_f(gate[3]) * val[3]);
            ov.z = pk2(silu_f(gate[4]) * val[4], silu_f(gate[5]) * val[5]); ov.w = pk2(silu_f(gate[6]) * val[6], silu_f(gate[7]) * val[7]);
            *(v4u*)(ACT + (size_t)(r0 + r) * DFF + f) = ov;
            pg = cg4; pv = cv4; cg4 = ng; cv4 = nv;
        }
    }
}

__device__ __forceinline__ void conv_fixup(const WV& w, const float* UB, const float* cw, const float* cb, bf16* ACT, int npanels) {
    const int ntask = npanels * 2 * (DFF / 4);
    for (int task = w.gw * 64 + w.lane; task < ntask; task += w.NGW * 64) {
        const int f4 = task % (DFF / 4), pe = task / (DFF / 4), edge = pe & 1, pm = pe >> 1, F = 4 * f4;
        const bool first = pm >= 64 || (pm & 15) == 0, lastp = pm >= 64 || (pm & 15) == 15;
        f32x4 o[2];
#pragma unroll
        for (int bj = 0; bj < 2; ++bj) { const size_t col = (size_t)bj * DFF + F; const float* U0 = UB + (size_t)(pm * 4) * DFF2 + col; const f32x4 z = (f32x4){0.f, 0.f, 0.f, 0.f};
            const f32x4 cur = *(const f32x4*)(U0 + (edge ? 3 : 0) * (size_t)DFF2);
            const f32x4 pv = edge ? *(const f32x4*)(U0 + 2 * (size_t)DFF2) : (first ? z : *(const f32x4*)(UB + (size_t)((pm - 1) * 4 + 3) * DFF2 + col));
            const f32x4 nx = edge ? (lastp ? z : *(const f32x4*)(UB + (size_t)((pm + 1) * 4) * DFF2 + col)) : *(const f32x4*)(U0 + (size_t)DFF2);
            o[bj] = *(const f32x4*)(cb + col) + *(const f32x4*)(cw + col) * pv + *(const f32x4*)(cw + DFF2 + col) * cur + *(const f32x4*)(cw + 2 * DFF2 + col) * nx; }
        v2u ov; ov.x = pk2(silu_f(o[0].x) * o[1].x, silu_f(o[0].y) * o[1].y); ov.y = pk2(silu_f(o[0].z) * o[1].z, silu_f(o[0].w) * o[1].w);
        *(v2u*)(ACT + (size_t)(pm * 256 + (edge ? 255 : 0)) * DFF + F) = ov;
    }
}

__device__ __forceinline__ int layer_items(int L) { return 11264 + 5632 + ((L & 1) ? 6144 + 2048 : 3072 + 2048); }
__device__ __forceinline__ void convert_layer_items(const WV& w, const Args& args, unsigned char* ws, int L, int i0, int i1, int rank, int nranks) {
    LAS float* scr = (LAS float*)(w.lds + w.wave * 16384);
    const int j = L >> 1;
    for (int it = i0 + rank * 8 + w.wave; it < i1; it += nranks * 8) {
        int r = it;
        if (r < 11264) { p0_transpose_item(args.in[8] + (size_t)L * DM * DFF2, DM, DFF2, (bf16*)(ws + WS_WUP + L * WUP_STRIDE), 0, scr, r, w.lane, FUSE_CONV != 0); continue; } r -= 11264;
        if (r < 5632) { p0_transpose_item(args.in[11] + (size_t)L * DFF * DM, DFF, DM, (bf16*)(ws + WS_WDN + L * WDN_STRIDE), 0, scr, r, w.lane, false); continue; } r -= 5632;
        if (L & 1) {
            if (r < 6144) { p0_transpose_item(args.in[15] + (size_t)j * DM * NGLA, DM, NGLA, (bf16*)(ws + WS_WGIN + j * WGIN_STRIDE), 0, scr, r, w.lane, false); continue; } r -= 6144;
            p0_transpose_item(args.in[23] + (size_t)j * DM * DM, DM, DM, (bf16*)(ws + WS_WGO + j * WO_STRIDE), 0, scr, r, w.lane, false);
        } else {
            if (r < 3072) { p0_transpose_item(args.in[12] + (size_t)j * DM * NQKV, DM, NQKV, (bf16*)(ws + WS_WQKV + j * WQKV_STRIDE), 0, scr, r, w.lane, false); continue; } r -= 3072;
            p0_transpose_item(args.in[14] + (size_t)j * DM * DM, DM, DM, (bf16*)(ws + WS_WAO + j * WO_STRIDE), 0, scr, r, w.lane, false);
        }
    }
}
__device__ __forceinline__ void tail_convert(const WV& w, const Args& args, unsigned char* ws, int nwg, int L, int i0, int i1) {
    const int c = (int)blockIdx.x, rem = nwg % w.G;
    if (rem == 0) convert_layer_items(w, args, ws, L, i0, i1, c, w.G);
    else if (c >= rem) convert_layer_items(w, args, ws, L, i0, i1, c - rem, w.G - rem);
}

__global__ void __launch_bounds__(512, 2) mega(Args args) {
    extern __shared__ __attribute__((aligned(16))) unsigned char lds_raw[];
    LAS unsigned char* const lds0 = (LAS unsigned char*)lds_raw;
    for (int u = threadIdx.x; u < (LDS_BYTES - LDSCTL_OFF) / 4; u += 512) ((LAS unsigned*)(lds0 + LDSCTL_OFF))[u] = 0u;
    __syncthreads();
    XcdBarrier bar; bar.bar = (unsigned*)(args.ws + WS_CTL) + CW_BAR; bar.x = 0; bar.st = nullptr;
    if (MK_ONE_LAUNCH) bar = xcd_barrier_post((unsigned*)(args.ws + WS_CTL) + CW_BAR, (volatile LAS unsigned*)(lds0 + LDSCTL_OFF + 32));
#define PHASE_ENTER() int tid_l = threadIdx.x; asm volatile("" : "+v"(tid_l)); unsigned char* ws = args.ws; asm volatile("" : "+s"(ws)); WV w; w.lds = lds0; w.tid = tid_l; w.lane = tid_l & 63; \
    w.wave = __builtin_amdgcn_readfirstlane(tid_l >> 6); w.G = gridDim.x; { const int bx = blockIdx.x; w.vcu = (w.G % 8 == 0) ? (bx % 8) * (w.G / 8) + bx / 8 : bx; } w.gw = w.vcu * 8 + w.wave; w.NGW = w.G * 8; \
    float* X = (float*)(ws + WS_X); bf16* H = (bf16*)(ws + WS_H); bf16* P = (bf16*)(ws + WS_P); float* Z1 = (float*)(ws + WS_Z1); bf16* OMIX = (bf16*)(ws + WS_OMIX); bf16* U = (bf16*)(ws + WS_U); \
    bf16* ACT = (bf16*)(ws + WS_ACT); float* MODS = (float*)(ws + WS_MODS); float* OF = (float*)(ws + WS_OF); float* OB = (float*)(ws + WS_OB); \
    (void)X; (void)H; (void)P; (void)Z1; (void)OMIX; (void)U; (void)ACT; (void)MODS; (void)OF; (void)OB; (void)w
    const int lo = args.ph_lo, hi = args.ph_hi;
#define RUN(k) (lo <= (k) && (k) < hi)
#define SEAM(k) do { if (MK_ONE_LAUNCH && RUN(k) && RUN((k) + 1)) { unsigned long long tb0_ = 0; if (DIAG_BAR) tb0_ = __builtin_amdgcn_s_memrealtime(); xcd_barrier(bar); \
        if (DIAG_BAR && blockIdx.x == (DIAG_BAR == 1 ? 0 : 100) && threadIdx.x == 0) { volatile LAS unsigned* dgl_ = (volatile LAS unsigned*)(lds0 + LDSCTL_OFF + 256); dgl_[4] += (unsigned)(__builtin_amdgcn_s_memrealtime() - tb0_); } } } while (0)

    for (int rep = 0; rep < RPT_PRO; ++rep) if (RUN(0)) {
        PHASE_ENTER();
        for (int it = w.vcu; it < ((TAIL_MODS && SPLITK_DN) ? 64 : 4 * 64); it += w.G) mods_item(w, args.in[1], args.in[3], args.in[4], args.in[5], MODS, it);
        for (int L = 0; L < (TAIL_CONVERT ? 1 : DEPTH); ++L) convert_layer_items(w, args, ws, L, 0, layer_items(L), w.vcu, w.G);
        for (int j = 0; j < 2; ++j) {
            bf16* wg = (bf16*)(ws + WS_WGIN + j * WGIN_STRIDE) + (size_t)NGLA * DM;
            const float* f1 = args.in[16] + (size_t)j * DM * 16; const float* b1 = args.in[19] + (size_t)j * DM * 16;
            for (int idx = w.gw * 64 + w.lane; idx < 256 * DM; idx += w.NGW * 64) { const int n = idx >> 11, k = idx & 2047;
                const float v = n < 16 ? f1[k * 16 + n] : (n < 32 ? b1[k * 16 + (n - 16)] : 0.f); wg[idx] = (bf16)f2bf(v); }
        }
    }
    SEAM(0);
    if (MK_ONE_LAUNCH && RUN(0) && RUN(1)) for (int eb = 0; eb < EXTRA_BAR; ++eb) xcd_barrier(bar);

    for (int l = 0; l < DEPTH; ++l) {
        const int base = 1 + 10 * l, j = l >> 1; const bool gla = (l & 1) != 0, last = (l == DEPTH - 1);
        const size_t mods_off = (size_t)l * 5 * NMOD;
        const int mrows = last ? M_LAT : M_ALL;
        for (int rep = 0; rep < RPT_NORM; ++rep) if (RUN(base + 0)) { PHASE_ENTER(); const float* mods_l = MODS + mods_off; norm_rows(w, X, H, args.in[6] + l * DM, mods_l + 0 * DM, mods_l + 1 * DM, M_ALL, (const float*)(ws + WS_PART), (SPLITK_DN && l > 0) ? 4 : 0, MODS + (mods_off - 5 * NMOD) + 4 * NMOD + 5 * DM, l == 0 ? args.in[0] : nullptr, l == 0 ? args.in[2] : nullptr, (NORM_BF16_IN && l > 0) ? (const bf16*)(ws + WS_XB) : nullptr); }
        SEAM(base + 0);
        for (int rep = 0; rep < RPT_PROJ; ++rep) if (RUN(base + 1)) {
            PHASE_ENTER();
            pg8::Gemm g{H, gla ? (const bf16*)(ws + WS_WGIN + j * WGIN_STRIDE) : (const bf16*)(ws + WS_WQKV + j * WQKV_STRIDE), M_ALL, gla ? NGLA_EXT : NQKV, DM, DM};
            pg8::StaticOrder S; S.init(g.M, g.N, w.G, (int)blockIdx.x);
            pg8::EpiStoreBf16 E{P, gla ? NGLA : NQKV, gla ? NGLA : (1 << 30), Z1};
            pg8::gemm_phase<pg8::EpiStoreBf16, pg8::StaticOrder, true, true>(w.lds, g, S, E);
            if (TAIL_CONVERT && !last) { const int NI = layer_items(l + 1), ia = gla ? (NI * 23) / 100 : (NI * 40) / 100; tail_convert(w, args, ws, S.nwg, l + 1, 0, ia); }
        }
        SEAM(base + 1);
        if (RUN(base + 2)) {
            PHASE_ENTER();
            if (!gla) { rope_rows(w, P); if (RPT_ROPE) { rope_rows(w, P, -1.0f); rope_rows(w, P); }
#if !NAIVE_ATTN
                for (int rep3 = 0; rep3 < RPT_AVT; ++rep3) attn_vt(w, P, (bf16*)(ws + WS_VTA));
#endif
            }
#if !NAIVE_GLA
            else for (int rep2 = 0; rep2 < RPT_GPRE; ++rep2) { gla_pre(w, P, Z1, args.in[17] + (size_t)j * 16 * 1024, args.in[18] + j * 1024, args.in[20] + (size_t)j * 16 * 1024, args.in[21] + j * 1024,
                           (bf16*)(ws + WS_QT), (bf16*)(ws + WS_KHT), (bf16*)(ws + WS_AIN), (float*)(ws + WS_DEC));
                   gla_vt(w, P, (bf16*)(ws + WS_VT)); }
#endif
        }
        if (!gla || !NAIVE_GLA) SEAM(base + 2);
        for (int rep = 0; rep < (gla ? RPT_SCAN : RPT_ATT); ++rep) if (RUN(base + 3)) {
            PHASE_ENTER();
#if NAIVE_ATTN
            if (!gla) attn_naive(w, P, args.in[13] + j * 16, OMIX);
#else
            if (!gla) attn_fast(w, P, (const bf16*)(ws + WS_VTA), args.in[13] + j * 16, OMIX);
#endif
#if NAIVE_GLA
            else gla_naive(w, P, Z1, args.in[17] + (size_t)j * 16 * 1024, args.in[18] + j * 1024, args.in[20] + (size_t)j * 16 * 1024, args.in[21] + j * 1024, OF, OB);
#else
            else gla_scan(w, (const bf16*)(ws + WS_QT), (const bf16*)(ws + WS_KHT), (const bf16*)(ws + WS_AIN), (const float*)(ws + WS_DEC), (const bf16*)(ws + WS_VT), (bf16*)(ws + WS_OFB), (bf16*)(ws + WS_OBB));
#endif
        }
        SEAM(base + 3);
#if NAIVE_GLA
        if (RUN(base + 4)) { if (gla) { PHASE_ENTER(); gla_combine(w, OF, OB, P, args.in[22] + j * 512, OMIX, mrows); } }
#else
        for (int rep = 0; rep < RPT_COMB; ++rep) if (RUN(base + 4)) { if (gla) { PHASE_ENTER(); gla_combine_bf(w, (const bf16*)(ws + WS_OFB), (const bf16*)(ws + WS_OBB), P, args.in[22] + j * 512, OMIX, mrows); } }
#endif
        if (gla) SEAM(base + 4);
        if (RUN(base + 5)) {
            PHASE_ENTER();
            pg8::Gemm g{OMIX, gla ? (const bf16*)(ws + WS_WGO + j * WO_STRIDE) : (const bf16*)(ws + WS_WAO + j * WO_STRIDE), SPLITK_WO ? M_LAT : mrows, DM, DM, DM};
            pg8::StaticOrder S; S.init(g.M, g.N, w.G, (int)blockIdx.x);
            pg8::EpiResid E{X, DM, MODS + mods_off + 2 * DM, l == 0 ? args.in[0] : nullptr, l == 0 ? args.in[2] : nullptr, NORM_BF16_IN ? (bf16*)(ws + WS_XB) : nullptr};
            if (RPT_WO) { pg8::EpiResid Ed{(float*)(ws + WS_U), DM, MODS + mods_off + 2 * DM, nullptr, nullptr, nullptr}; pg8::gemm_phase<pg8::EpiResid, pg8::StaticOrder, true, true>(w.lds, g, S, Ed); }
            pg8::gemm_phase<pg8::EpiResid, pg8::StaticOrder, true, true>(w.lds, g, S, E);
            if (TAIL_CONVERT && !last) { const int NI = layer_items(l + 1), ia = gla ? (NI * 23) / 100 : (NI * 40) / 100, ib = gla ? (NI * 80) / 100 : (NI * 84) / 100; tail_convert(w, args, ws, S.nwg, l + 1, ia, ib); }
            if (SPLITK_WO && !last) {
                pg8::Gemm g2{OMIX + (size_t)M_LAT * DM, g.Bt, M_CTX, DM, DM, 256};
                pg8::SplitKOrder S2; S2.init(M_CTX, DM, 8, 256, w.G, (int)blockIdx.x);
                pg8::EpiPartial E2{(float*)(ws + WS_PART), DM, 256, (size_t)M_CTX * DM};
                pg8::gemm_phase<pg8::EpiPartial, pg8::SplitKOrder, true, true>(w.lds, g2, S2, E2);
            }
        }
        SEAM(base + 5);
        for (int rep = 0; rep < RPT_NORM; ++rep) if (RUN(base + 6)) { PHASE_ENTER(); const float* mods_l = MODS + mods_off; norm_rows(w, X, H, args.in[7] + l * DM, mods_l + 3 * DM, mods_l + 4 * DM, mrows, (const float*)(ws + WS_PART), (!SPLITK_WO || last) ? 0 : 8, mods_l + 4 * NMOD + 2 * DM, nullptr, nullptr, NORM_BF16_IN ? (const bf16*)(ws + WS_XB) : nullptr); }
        SEAM(base + 6);
        for (int rep = 0; rep < RPT_UP; ++rep) if (RUN(base + 7)) {
            PHASE_ENTER();
            pg8::Gemm g{H, (const bf16*)(ws + WS_WUP + l * WUP_STRIDE), mrows, DFF2, DM, DM};
            pg8::StaticOrder S; S.init(g.M, g.N, w.G, (int)blockIdx.x);
            unsigned long long dc0 = 0, dr0 = 0; if (DIAG_CLK && l == 1) { dc0 = __builtin_readcyclecounter(); dr0 = __builtin_amdgcn_s_memrealtime(); }
#if FUSE_CONV
            pg8::EpiConv E{ACT, args.in[9] + (size_t)l * 3 * DFF2, args.in[10] + (size_t)l * DFF2, (float*)(ws + WS_UB), (PG8_LAS float*)(w.lds + LDSCTL_OFF + 1024), DFF};
            pg8::gemm_phase<pg8::EpiConv, pg8::StaticOrder, true, true>(w.lds, g, S, E);
            if (DIAG_CLK && l == 1 && blockIdx.x == 0 && w.tid == 0) { const unsigned long long dc1 = __builtin_readcyclecounter(), dr1 = __builtin_amdgcn_s_memrealtime(); unsigned long long* dg = (unsigned long long*)(ws + WS_CTL + 65536); dg[4] = dc1 - dc0; dg[5] = dr1 - dr0; }
            if (TAIL_CONVERT && !last) { const int NI = layer_items(l + 1), ib = gla ? (NI * 80) / 100 : (NI * 84) / 100; tail_convert(w, args, ws, S.nwg, l + 1, ib, NI); }
#else
            pg8::EpiStoreBf16 E{U, DFF2, 1 << 30, Z1};
            pg8::gemm_phase<pg8::EpiStoreBf16, pg8::StaticOrder, true, true>(w.lds, g, S, E);
#endif
        }
        SEAM(base + 7);
        for (int rep = 0; rep < RPT_CONV; ++rep) if (RUN(base + 8)) { PHASE_ENTER();
#if FUSE_CONV
            conv_fixup(w, (const float*)(ws + WS_UB), args.in[9] + (size_t)l * 3 * DFF2, args.in[10] + (size_t)l * DFF2, ACT, mrows / 256);
#else
            conv_rows(w, U, args.in[9] + (size_t)l * 3 * DFF2, args.in[10] + (size_t)l * DFF2, ACT, mrows);
#endif
        }
        SEAM(base + 8);
        if (RUN(base + 9)) {
            PHASE_ENTER();
            pg8::Gemm g{ACT, (const bf16*)(ws + WS_WDN + l * WDN_STRIDE), SPLITK_DN ? M_LAT : mrows, DM, DFF, DFF};
            pg8::StaticOrder S; S.init(g.M, g.N, w.G, (int)blockIdx.x);
            pg8::EpiResid E{X, DM, MODS + mods_off + 5 * DM, nullptr, nullptr, (NORM_BF16_IN && !last) ? (bf16*)(ws + WS_XB) : nullptr};
            if (RPT_DN) { pg8::EpiResid Ed{(float*)(ws + WS_U), DM, MODS + mods_off + 5 * DM, nullptr, nullptr, nullptr}; pg8::gemm_phase<pg8::EpiResid, pg8::StaticOrder, true, true>(w.lds, g, S, Ed); }
            pg8::gemm_phase<pg8::EpiResid, pg8::StaticOrder, true, true>(w.lds, g, S, E);
            if (SPLITK_DN && !last) {
                pg8::Gemm g2{ACT + (size_t)M_LAT * DFF, g.Bt, M_CTX, DM, DFF, 1408};
                pg8::SplitKOrder S2; S2.init(M_CTX, DM, 4, 1408, w.G, (int)blockIdx.x);
                pg8::EpiPartial E2{(float*)(ws + WS_PART), DM, 1408, (size_t)M_CTX * DM};
                pg8::gemm_phase<pg8::EpiPartial, pg8::SplitKOrder, true, true>(w.lds, g2, S2, E2);
                if (TAIL_MODS && (int)blockIdx.x >= 128) {
                    for (int it = (l + 1) * 64 + ((int)blockIdx.x - 128); it < (l + 2) * 64; it += w.G - 128) mods_item(w, args.in[1], args.in[3], args.in[4], args.in[5], MODS, it);
                }
            }
        }
        SEAM(base + 9);
    }
    if (DIAG_BAR && blockIdx.x == (DIAG_BAR == 1 ? 0 : 100) && threadIdx.x == 0) { *(unsigned*)(args.ws + WS_CTL + 65536 + 64) = ((volatile LAS unsigned*)(lds0 + LDSCTL_OFF + 256))[4]; }
    if (RUN(41)) { PHASE_ENTER(); final_norm(w, X, args.out, args.in[24]);
        if (DIAG_BAR && blockIdx.x == 0 && w.tid == 0) { asm volatile("s_waitcnt vmcnt(0)" ::: "memory"); args.out[0] = (float)(10 * (int)((double)__hip_atomic_load((unsigned*)(ws + WS_CTL + 65536 + 64), __ATOMIC_RELAXED, __HIP_MEMORY_SCOPE_AGENT) / 100.0 / 100.0 + 0.5)); }
        if (DIAG_CLK && blockIdx.x == 0 && w.tid == 0) { asm volatile("s_waitcnt vmcnt(0)" ::: "memory"); const unsigned long long* dg = (const unsigned long long*)(ws + WS_CTL + 65536); args.out[0] = DIAG_CLK == 1 ? (float)(int)((double)dg[4] / (double)dg[5] + 0.5) : (float)(10 * (int)((double)dg[5] / 100.0 / 12.0 / 10.0 + 0.5)); }
        if (DIAG_SCAN && blockIdx.x == 0 && w.tid == 0) { asm volatile("s_waitcnt vmcnt(0)" ::: "memory"); const unsigned long long* dg = (const unsigned long long*)(ws + WS_CTL + 65536);
            const double a = (double)dg[0], b = (double)dg[1], c = (double)dg[2], tot = a + b + c; int d1 = (int)(10.0 * a / tot), d2 = (int)(10.0 * b / tot); if (d1 < 1) d1 = 1; if (d2 < 0) d2 = 0;
            args.out[0] = (float)(DIAG_SCAN == 1 ? 10 * d1 + d2 : (DIAG_SCAN == 2 ? tot / 68.0 / 2.0 / 10.0 : 0)); } }
#undef RUN
#undef SEAM
}

extern "C" void kernel_launch(void* const* d_in, const int* in_sizes, int n_in, void* d_out, int out_size, void* d_ws, size_t ws_size, hipStream_t stream) {
    static int grid = 0;
    if (grid == 0) {
        if (n_in != 25 || out_size != M_LAT * DM || ws_size < WS_END) { fprintf(stderr, "kernel_launch: unexpected shapes (n_in %d, out %d, ws %zu < %zu); nothing launched\n", n_in, out_size, ws_size, (size_t)WS_END); grid = -1; return; }
        int dev = 0, cus = 0, per_cu = 0;
        if (hipGetDevice(&dev) != hipSuccess || hipDeviceGetAttribute(&cus, hipDeviceAttributeMultiprocessorCount, dev) != hipSuccess) { grid = -1; return; }
        if (hipFuncSetAttribute((const void*)mega, hipFuncAttributeMaxDynamicSharedMemorySize, LDS_BYTES) != hipSuccess) { fprintf(stderr, "kernel_launch: hipFuncSetAttribute failed\n"); grid = -1; return; }
        if (hipOccupancyMaxActiveBlocksPerMultiprocessor(&per_cu, (const void*)mega, 512, LDS_BYTES) != hipSuccess || per_cu < 1)
            fprintf(stderr, "kernel_launch: occupancy query reports %d workgroups per CU\n", per_cu);
        (void)hipGetLastError();
        grid = cus;
    }
    if (grid < 0) return;
    if (hipMemsetAsync((char*)d_ws + WS_CTL, 0, CTL_ZERO_BYTES, stream) != hipSuccess) return;
    Args a{};
    for (int i = 0; i < 25; ++i) a.in[i] = (const float*)d_in[i];
    a.out = (float*)d_out; a.ws = (unsigned char*)d_ws;
#if MK_ONE_LAUNCH
    a.ph_lo = 0; a.ph_hi = NPH;
    hipLaunchKernelGGL(mega, dim3(grid), dim3(512), LDS_BYTES, stream, a);
#else
    for (int ph = 0; ph < NPH; ++ph) {
        if (ph >= 1 && ph <= 40) { const int l = (ph - 1) / 10, s = (ph - 1) % 10; if ((s == 2 && (l & 1) && NAIVE_GLA) || (s == 4 && !(l & 1))) continue; }
        a.ph_lo = ph; a.ph_hi = ph + 1;
        hipLaunchKernelGGL(mega, dim3(grid), dim3(512), LDS_BYTES, stream, a);
    }
#endif
}
```

```cpp
#include <hip/hip_runtime.h>
#include <cstdio>
#include <cstdint>
namespace pg8 {
#define PG8_LAS __attribute__((address_space(3)))
typedef unsigned short bf16_t;
typedef short bf16x8 __attribute__((ext_vector_type(8)));
typedef float f32x4 __attribute__((ext_vector_type(4)));
typedef unsigned u32x4 __attribute__((ext_vector_type(4)));
constexpr int BM = 256, BK = 64, HALF = 128, HTB = HALF * BK * 2  , STAGE_BYTES = 8 * HTB, NXCD = 8, WGM = 8;

__host__ __device__ __forceinline__ int lds_byte(int r, int c) { const int st = (r >> 4) * 2 + (c >> 5), rr = r & 15, cc = c & 31, ob = rr * 64 + cc * 2; return st * 1024 + (ob ^ (((ob >> 9) & 1) << 5)); }
__host__ __device__ __forceinline__ void stage_rc(int b, int& R, int& C) { const int st = b / 1024, sb = b % 1024, swz = sb ^ (((sb >> 9) & 1) << 5); R = (st >> 1) * 16 + swz / 64; C = (st & 1) * 32 + (swz % 64) / 2; }
__host__ __device__ __forceinline__ int perm32(int rho) { const int n = rho >> 4, i = rho & 15; return 8 * (i >> 2) + 4 * n + (i & 3); }

struct Unit { int pm, pn, kofs; };
struct Gemm { const bf16_t* A; const bf16_t* Bt; int M, N, K, kloop; };

struct StaticOrder {
    int nM, nN, nwg, G, c;
    __host__ __device__ void init(int M, int N, int G_, int c_) { nM = M / BM; nN = N / BM; nwg = nM * nN; G = G_; c = c_; }
    __host__ __device__ bool next(int i, Unit& u) const {
        const long L = (long)i * G + c; if (L >= nwg) return false;
        int wgid = (int)L; { const int q = nwg / NXCD, r = nwg % NXCD, xcd = wgid % NXCD, off = wgid / NXCD; wgid = (xcd < r ? xcd * (q + 1) : r * (q + 1) + (xcd - r) * q) + off; }
        const int nig = WGM * nN, gid = wgid / nig, fm = gid * WGM, gsz = (nM - fm) < WGM ? (nM - fm) : WGM;
        u.pm = fm + ((wgid % nig) % gsz); u.pn = (wgid % nig) / gsz; u.kofs = 0; return true;
    }
    __device__ __forceinline__ void a_ready(const Unit&) const {}
    __device__ __forceinline__ void done(const Unit&) const {}
};

struct SplitKOrder {
    int nN, nunits, nsplit, kloop, G, c;
    __host__ __device__ void init(int M, int N, int nsplit_, int kloop_, int G_, int c_) { nN = N / BM; nunits = (M / BM) * nN * nsplit_; nsplit = nsplit_; kloop = kloop_; G = G_; c = c_; }
    __host__ __device__ bool next(int i, Unit& u) const { const long L = (long)i * G + c; if (L >= nunits) return false; const int t = (int)L / nsplit, ks = (int)L % nsplit; u.pm = t / nN; u.pn = t % nN; u.kofs = ks * kloop; return true; }
    __device__ __forceinline__ void a_ready(const Unit&) const {}
    __device__ __forceinline__ void done(const Unit&) const {}
};
typedef __bf16 bf16x2_hw __attribute__((ext_vector_type(2)));
typedef float f32x2_hw __attribute__((ext_vector_type(2)));
__device__ __forceinline__ unsigned cvt_pk_bf16(float lo, float hi) { const f32x2_hw v = {lo, hi}; return __builtin_bit_cast(unsigned, __builtin_convertvector(v, bf16x2_hw)); }
typedef float f32x2 __attribute__((ext_vector_type(2)));
typedef _Float16 f16x2_hw __attribute__((ext_vector_type(2)));
__device__ __forceinline__ unsigned cvt_pk_f16(float lo, float hi) { const f32x2_hw v = {lo, hi}; return __builtin_bit_cast(unsigned, __builtin_convertvector(v, f16x2_hw)); }
__device__ __forceinline__ float f16_lo(unsigned w) { return (float)__builtin_bit_cast(f16x2_hw, w)[0]; }
__device__ __forceinline__ float f16_hi(unsigned w) { return (float)__builtin_bit_cast(f16x2_hw, w)[1]; }

struct EpiStoreBf16 {
    static constexpr bool PERM = true, AFTER_DRAIN = false;
    bf16_t* O; int ldc; int zcol0; float* Z;
    __device__ __forceinline__ void operator()(const f32x4 (&acc)[2][2][4][2], const Unit& u, int wr, int wc, int fr, int fq) const {
        const int row0 = u.pm * BM + wr * 64 + fr; const int colt = u.pn * BM;
        if (colt >= zcol0) {
            if (wc == 0) {
#pragma unroll
                for (int ai = 0; ai < 2; ++ai)
#pragma unroll
                    for (int m = 0; m < 4; ++m) { float* zp = Z + (size_t)(row0 + ai * HALF + m * 16) * 32 + 8 * fq;
                        *(f32x4*)(zp) = acc[ai][0][m][0]; *(f32x4*)(zp + 4) = acc[ai][0][m][1]; }
            }
            return;
        }
        const int col0 = colt + wc * 32 + 8 * fq;
#pragma unroll
        for (int ai = 0; ai < 2; ++ai)
#pragma unroll
            for (int m = 0; m < 4; ++m) { bf16_t* rowp = O + (size_t)(row0 + ai * HALF + m * 16) * ldc + col0;
#pragma unroll
                for (int bj = 0; bj < 2; ++bj) { const f32x4 v0 = acc[ai][bj][m][0], v1 = acc[ai][bj][m][1];
                    u32x4 w; w.x = cvt_pk_bf16(v0[0], v0[1]); w.y = cvt_pk_bf16(v0[2], v0[3]); w.z = cvt_pk_bf16(v1[0], v1[1]); w.w = cvt_pk_bf16(v1[2], v1[3]);
                    *(u32x4*)(rowp + bj * HALF) = w; } }
    }
};
struct EpiResid {
    static constexpr bool PERM = true, AFTER_DRAIN = false;
    bf16_t* X; int ldc; const float* gate;
    const float* in_lat; const float* in_ctx;
    __device__ __forceinline__ void operator()(const f32x4 (&acc)[2][2][4][2], const Unit& u, int wr, int wc, int fr, int fq) const {
        const int row0 = u.pm * BM + wr * 64 + fr, col0 = u.pn * BM + wc * 32 + 8 * fq;
        const int vec = u.pm < 64 ? (u.pm >> 4) : 4;
        const float* g = gate + (size_t)vec * 12288 + col0;
        f32x4 gv[2][2];
#pragma unroll
        for (int bj = 0; bj < 2; ++bj)
#pragma unroll
            for (int n = 0; n < 2; ++n) gv[bj][n] = *(const f32x4*)(g + bj * HALF + 4 * n);
#pragma unroll
        for (int ai = 0; ai < 2; ++ai)
#pragma unroll
            for (int m = 0; m < 4; ++m) { const size_t r = (size_t)(row0 + ai * HALF + m * 16); bf16_t* rowp = X + r * ldc + col0;
#pragma unroll
                for (int bj = 0; bj < 2; ++bj) { f32x4 x0, x1;
                    if (in_lat) { const float* s = (u.pm < 64 ? in_lat + r * ldc : in_ctx + (r - 16384) * ldc) + col0 + bj * HALF; x0 = *(const f32x4*)s; x1 = *(const f32x4*)(s + 4); }
                    else { const u32x4 q = *(const u32x4*)(rowp + bj * HALF);
                        x0 = (f32x4){f16_lo(q.x), f16_hi(q.x), f16_lo(q.y), f16_hi(q.y)}; x1 = (f32x4){f16_lo(q.z), f16_hi(q.z), f16_lo(q.w), f16_hi(q.w)}; }
                    x0 += gv[bj][0] * acc[ai][bj][m][0]; x1 += gv[bj][1] * acc[ai][bj][m][1];
                    u32x4 w4; w4.x = cvt_pk_f16(x0[0], x0[1]); w4.y = cvt_pk_f16(x0[2], x0[3]); w4.z = cvt_pk_f16(x1[0], x1[1]); w4.w = cvt_pk_f16(x1[2], x1[3]);
                    *(u32x4*)(rowp + bj * HALF) = w4; } }
    }
};
struct EpiPartial {
    static constexpr bool PERM = false, AFTER_DRAIN = false;
    float* PART; int ldc; int kloop; size_t slab;
    __device__ __forceinline__ void operator()(const f32x4 (&acc)[2][2][4][2], const Unit& u, int wr, int wc, int fr, int fq) const {
        const int row0 = u.pm * BM + wr * 64 + fr, col0 = u.pn * BM + wc * 32 + 4 * fq;
        float* base = PART + (size_t)(u.kofs / kloop) * slab;
#pragma unroll
        for (int ai = 0; ai < 2; ++ai)
#pragma unroll
            for (int m = 0; m < 4; ++m) { float* rowp = base + (size_t)(row0 + ai * HALF + m * 16) * ldc + col0;
#pragma unroll
                for (int bj = 0; bj < 2; ++bj)
#pragma unroll
                    for (int n = 0; n < 2; ++n) *(f32x4*)(rowp + bj * HALF + n * 16) = acc[ai][bj][m][n]; }
    }
};

__device__ __forceinline__ float dpp_prev(float v) { return __builtin_bit_cast(float, __builtin_amdgcn_update_dpp(0, __builtin_bit_cast(int, v), 0x121, 0xf, 0xf, false)); }
__device__ __forceinline__ float dpp_next(float v) { return __builtin_bit_cast(float, __builtin_amdgcn_update_dpp(0, __builtin_bit_cast(int, v), 0x12F, 0xf, 0xf, false)); }
struct EpiConv {
    static constexpr bool PERM = true, AFTER_DRAIN = false;
    bf16_t* ACT; const float* cw; const float* cb; float* UB; PG8_LAS float* xb; int dff;
    __device__ __forceinline__ void operator()(const f32x4 (&acc)[2][2][4][2], const Unit& u, int wr, int wc, int fr, int fq) const {
        const int cl = 32 * wc + 8 * fq, F = 128 * u.pn + cl, dff2 = 2 * dff;
        if (fr == 0 || fr == 15) { const int which = fr == 0 ? 0 : 1, m = fr == 0 ? 0 : 3;
#pragma unroll
            for (int ai = 0; ai < 2; ++ai)
#pragma unroll
                for (int bj = 0; bj < 2; ++bj)
#pragma unroll
                    for (int n = 0; n < 2; ++n) *(PG8_LAS f32x4*)(xb + ((((2 * ai + wr) * 2 + which) * 2 + bj) * 128 + cl + 4 * n)) = acc[ai][bj][m][n]; }
        asm volatile("s_waitcnt lgkmcnt(0)" ::: "memory"); __builtin_amdgcn_s_barrier(); asm volatile("" ::: "memory");
#pragma unroll
        for (int n = 0; n < 2; ++n) {
            f32x4 wgt[2][3], bia[2];
#pragma unroll
            for (int bj = 0; bj < 2; ++bj) { bia[bj] = *(const f32x4*)(cb + bj * dff + F + 4 * n);
#pragma unroll
                for (int j = 0; j < 3; ++j) wgt[bj][j] = *(const f32x4*)(cw + j * dff2 + bj * dff + F + 4 * n); }
#pragma unroll
            for (int ai = 0; ai < 2; ++ai) { const int B = 2 * ai + wr;
#pragma unroll
                for (int m = 0; m < 4; ++m) { f32x4 o[2];
#pragma unroll
                    for (int bj = 0; bj < 2; ++bj) { const f32x4 cur = acc[ai][bj][m][n]; f32x4 sp = cur, sn = cur;
                        if (m > 0) { const f32x4 up = acc[ai][bj][m > 0 ? m - 1 : 0][n]; sp = fr == 15 ? up : cur; }
                        if (m < 3) { const f32x4 dn = acc[ai][bj][m < 3 ? m + 1 : 3][n]; sn = fr == 0 ? dn : cur; }
                        f32x4 pv, nx; pv.x = dpp_prev(sp.x); pv.y = dpp_prev(sp.y); pv.z = dpp_prev(sp.z); pv.w = dpp_prev(sp.w);
                        nx.x = dpp_next(sn.x); nx.y = dpp_next(sn.y); nx.z = dpp_next(sn.z); nx.w = dpp_next(sn.w);
                        if (m == 0) { if (fr == 0 && B > 0) pv = *(const PG8_LAS f32x4*)(xb + (((B - 1) * 2 + 1) * 2 + bj) * 128 + cl + 4 * n); }
                        if (m == 3) { if (fr == 15 && B < 3) nx = *(const PG8_LAS f32x4*)(xb + (((B + 1) * 2 + 0) * 2 + bj) * 128 + cl + 4 * n); }
                        o[bj] = bia[bj] + wgt[bj][0] * pv + wgt[bj][1] * cur + wgt[bj][2] * nx; }
                    f32x4 a;
                    a.x = o[0].x * __builtin_amdgcn_rcpf(1.0f + __builtin_amdgcn_exp2f(-1.4426950408889634f * o[0].x)) * o[1].x;
                    a.y = o[0].y * __builtin_amdgcn_rcpf(1.0f + __builtin_amdgcn_exp2f(-1.4426950408889634f * o[0].y)) * o[1].y;
                    a.z = o[0].z * __builtin_amdgcn_rcpf(1.0f + __builtin_amdgcn_exp2f(-1.4426950408889634f * o[0].z)) * o[1].z;
                    a.w = o[0].w * __builtin_amdgcn_rcpf(1.0f + __builtin_amdgcn_exp2f(-1.4426950408889634f * o[0].w)) * o[1].w;
                    const int rl = 128 * ai + 64 * wr + 16 * m + fr;
                    if (rl != 0 && rl != 255) { typedef unsigned u32x2 __attribute__((ext_vector_type(2))); u32x2 w2; w2.x = cvt_pk_bf16(a.x, a.y); w2.y = cvt_pk_bf16(a.z, a.w);
                        *(u32x2*)(ACT + (size_t)(u.pm * BM + rl) * dff + F + 4 * n) = w2; } } }
            asm volatile("" ::: "memory"); }
        if (wr == 0 && fr < 2) {
#pragma unroll
            for (int bj = 0; bj < 2; ++bj)
#pragma unroll
                for (int n = 0; n < 2; ++n) *(f32x4*)(UB + (size_t)(u.pm * 4 + fr) * dff2 + bj * dff + F + 4 * n) = acc[0][bj][0][n]; }
        if (wr == 1 && fr >= 14) {
#pragma unroll
            for (int bj = 0; bj < 2; ++bj)
#pragma unroll
                for (int n = 0; n < 2; ++n) *(f32x4*)(UB + (size_t)(u.pm * 4 + fr - 12) * dff2 + bj * dff + F + 4 * n) = acc[1][bj][3][n]; }
    }
};
template <class Epi, class Sched, bool ALIGN_EPI = false, bool SP2 = false>
__device__ __forceinline__ void gemm_phase(PG8_LAS unsigned char* lds, const Gemm g, const Sched& S, const Epi& E) {
    int tid_l = threadIdx.x; asm volatile("" : "+v"(tid_l));
    const int tid = tid_l, wid = __builtin_amdgcn_readfirstlane(tid >> 6), lane = tid & 63, wr = wid >> 2, wc = wid & 3, fr = lane & 15, fq = lane >> 4;
    const int K = g.K, nt = g.kloop / BK;
    unsigned voffA[2], voffB[2];
#pragma unroll
    for (int i = 0; i < 2; ++i) { int R, C; stage_rc(tid * 16 + i * 8192, R, C); const int Rb = Epi::PERM ? ((R & ~31) + perm32(R & 31)) : R;
        voffA[i] = (unsigned)(R * K + C) * 2u; voffB[i] = (unsigned)(Rb * K + C) * 2u; }
    const size_t kstep = (size_t)(BK * 2);
    const size_t hstep = (size_t)HALF * K * 2;
    const size_t tstep = 2 * hstep;
    const unsigned ldsw = (unsigned)wid * 1024u;
    const int aoff = lds_byte(wr * 64 + fr, fq * 8), boff = lds_byte(wc * 32 + fr, fq * 8);
#define PG8_SA(b, h) (((b) * 2 + (h)) * HTB)
#define PG8_SB(b, h) ((4 + (b) * 2 + (h)) * HTB)
#define PG8_STAGE(bufoff, gbase, voff) do { _Pragma("unroll") for (int _i = 0; _i < 2; ++_i) \
        __builtin_amdgcn_global_load_lds((const unsigned*)((const char*)(gbase) + (voff)[_i]), (PG8_LAS unsigned*)(lds + (bufoff) + ldsw + _i * 8192), 16, 0, 0); } while (0)
#define PG8_LDA(dst, b, h) do { _Pragma("unroll") for (int m = 0; m < 4; ++m) _Pragma("unroll") for (int k = 0; k < 2; ++k) dst[m][k] = *(const PG8_LAS bf16x8*)(lds + PG8_SA(b, h) + aoff + m * 2048 + k * 1024); } while (0)
#define PG8_LDB(dst, b, h) do { _Pragma("unroll") for (int n = 0; n < 2; ++n) _Pragma("unroll") for (int k = 0; k < 2; ++k) dst[n][k] = *(const PG8_LAS bf16x8*)(lds + PG8_SB(b, h) + boff + n * 2048 + k * 1024); } while (0)
#define PG8_MMA(ai, bj, At, Bt) do { __builtin_amdgcn_s_setprio(1); _Pragma("unroll") for (int m = 0; m < 4; ++m) _Pragma("unroll") for (int n = 0; n < 2; ++n) _Pragma("unroll") for (int k = 0; k < 2; ++k) \
        acc[ai][bj][m][n] = __builtin_amdgcn_mfma_f32_16x16x32_bf16(Bt[n][k], At[m][k], acc[ai][bj][m][n], 0, 0, 0); __builtin_amdgcn_s_setprio(0); } while (0)
#define PG8_WAIT_V(n) asm volatile("s_waitcnt vmcnt(" #n ")" ::: "memory")
#define PG8_WAIT_L(n) asm volatile("s_waitcnt lgkmcnt(" #n ")" ::: "memory")
#define PG8_BAR __builtin_amdgcn_s_barrier()
#define PG8_SCHED __builtin_amdgcn_sched_barrier(0)
    Unit cur, nxt; int ui = 0;
    if (!S.next(0, cur)) return;
    f32x4 acc[2][2][4][2];
#pragma unroll
    for (int a = 0; a < 2; ++a)
#pragma unroll
        for (int b = 0; b < 2; ++b)
#pragma unroll
            for (int m = 0; m < 4; ++m)
#pragma unroll
                for (int n = 0; n < 2; ++n) acc[a][b][m][n] = (f32x4){0.f, 0.f, 0.f, 0.f};
    bf16x8 At[4][2], B0[2][2], B1[2][2];
    const char* cA = (const char*)g.A + (size_t)cur.pm * tstep + (size_t)cur.kofs * 2; const char* cB = (const char*)g.Bt + (size_t)cur.pn * tstep + (size_t)cur.kofs * 2;
    S.a_ready(cur);
    if constexpr (SP2) {
        PG8_STAGE(PG8_SB(0, 0), cB, voffB); PG8_STAGE(PG8_SB(0, 1), cB + hstep, voffB); PG8_STAGE(PG8_SA(0, 0), cA, voffA); PG8_STAGE(PG8_SA(0, 1), cA + hstep, voffA);
        if (wr == 1) PG8_BAR;
        PG8_WAIT_V(2); PG8_BAR;
        PG8_STAGE(PG8_SB(1, 0), cB + kstep, voffB); PG8_STAGE(PG8_SA(1, 0), cA + kstep, voffA); PG8_STAGE(PG8_SB(1, 1), cB + hstep + kstep, voffB);
        PG8_WAIT_V(6); PG8_BAR;
    } else {
        PG8_STAGE(PG8_SB(0, 0), cB, voffB); PG8_STAGE(PG8_SA(0, 0), cA, voffA); PG8_STAGE(PG8_SB(0, 1), cB + hstep, voffB); PG8_STAGE(PG8_SA(0, 1), cA + hstep, voffA);
        if (wr == 1) PG8_BAR;
        PG8_WAIT_V(4); PG8_BAR;
        PG8_STAGE(PG8_SB(1, 0), cB + kstep, voffB); PG8_STAGE(PG8_SA(1, 0), cA + kstep, voffA); PG8_STAGE(PG8_SB(1, 1), cB + hstep + kstep, voffB);
        PG8_WAIT_V(6); PG8_BAR;
    }
    for (;;) {
        const bool has_next = S.next(ui + 1, nxt);
        const char* nA = has_next ? (const char*)g.A + (size_t)nxt.pm * tstep + (size_t)nxt.kofs * 2 : cA; const char* nB = has_next ? (const char*)g.Bt + (size_t)nxt.pn * tstep + (size_t)nxt.kofs * 2 : cB;
        for (int t = 0; t < nt; t += 2) {
            const bool last = (t == nt - 2);
            const char* a1 = cA + (size_t)(t + 1) * kstep;
            const char* a2 = last ? nA : cA + (size_t)(t + 2) * kstep; const char* b2 = last ? nB : cB + (size_t)(t + 2) * kstep;
            const char* a3 = a2 + kstep; const char* b3 = b2 + kstep;
            if (last && has_next) S.a_ready(nxt);
            if constexpr (SP2) {
            PG8_LDB(B0, 0, 0); PG8_LDB(B1, 0, 1); PG8_SCHED; PG8_LDA(At, 0, 0); PG8_STAGE(PG8_SA(1, 1), a1 + hstep, voffA);
            PG8_WAIT_V(8); PG8_WAIT_L(0); PG8_BAR; PG8_MMA(0, 0, At, B0); PG8_MMA(0, 1, At, B1); PG8_BAR; PG8_SCHED;
            PG8_LDA(At, 0, 1); PG8_STAGE(PG8_SB(0, 0), b2, voffB); PG8_STAGE(PG8_SB(0, 1), b2 + hstep, voffB); PG8_STAGE(PG8_SA(0, 0), a2, voffA);
            PG8_WAIT_V(8); PG8_WAIT_L(0); PG8_BAR; PG8_MMA(1, 0, At, B0); PG8_MMA(1, 1, At, B1); PG8_BAR; PG8_SCHED;
            PG8_LDB(B0, 1, 0); PG8_LDB(B1, 1, 1); PG8_SCHED; PG8_LDA(At, 1, 0); PG8_STAGE(PG8_SA(0, 1), a2 + hstep, voffA);
            PG8_WAIT_V(8); PG8_WAIT_L(0); PG8_BAR; PG8_MMA(0, 0, At, B0); PG8_MMA(0, 1, At, B1); PG8_BAR; PG8_SCHED;
            PG8_LDA(At, 1, 1); PG8_STAGE(PG8_SB(1, 0), b3, voffB); PG8_STAGE(PG8_SB(1, 1), b3 + hstep, voffB); PG8_STAGE(PG8_SA(1, 0), a3, voffA);
            PG8_WAIT_V(8); PG8_WAIT_L(0); PG8_BAR; PG8_MMA(1, 0, At, B0); PG8_MMA(1, 1, At, B1); PG8_BAR; PG8_SCHED;
            } else {
            PG8_LDB(B0, 0, 0); PG8_SCHED; PG8_LDA(At, 0, 0); PG8_STAGE(PG8_SA(1, 1), a1 + hstep, voffA);
            PG8_WAIT_L(8); PG8_BAR; PG8_WAIT_L(0); PG8_MMA(0, 0, At, B0); PG8_BAR; PG8_SCHED;
            PG8_LDB(B1, 0, 1); PG8_STAGE(PG8_SB(0, 0), b2, voffB);
            PG8_BAR; PG8_WAIT_L(0); PG8_MMA(0, 1, At, B1); PG8_BAR;
            PG8_LDA(At, 0, 1); PG8_STAGE(PG8_SA(0, 0), a2, voffA);
            PG8_BAR; PG8_WAIT_L(0); PG8_MMA(1, 0, At, B0); PG8_BAR; PG8_SCHED;
            PG8_STAGE(PG8_SB(0, 1), b2 + hstep, voffB);
            PG8_WAIT_V(6); PG8_BAR; PG8_MMA(1, 1, At, B1); PG8_BAR;
            PG8_LDB(B0, 1, 0); PG8_SCHED; PG8_LDA(At, 1, 0); PG8_STAGE(PG8_SA(0, 1), a2 + hstep, voffA);
            PG8_WAIT_L(8); PG8_BAR; PG8_WAIT_L(0); PG8_MMA(0, 0, At, B0); PG8_BAR; PG8_SCHED;
            PG8_LDB(B1, 1, 1); PG8_STAGE(PG8_SB(1, 0), b3, voffB);
            PG8_BAR; PG8_WAIT_L(0); PG8_MMA(0, 1, At, B1); PG8_BAR;
            PG8_LDA(At, 1, 1); PG8_STAGE(PG8_SA(1, 0), a3, voffA);
            PG8_BAR; PG8_WAIT_L(0); PG8_MMA(1, 0, At, B0); PG8_BAR; PG8_SCHED;
            PG8_STAGE(PG8_SB(1, 1), b3 + hstep, voffB);
            PG8_WAIT_V(6); PG8_BAR; PG8_MMA(1, 1, At, B1); PG8_BAR;
            }
        }
        if constexpr (ALIGN_EPI) { if (wr == 0) PG8_BAR; }
        if constexpr (!Epi::AFTER_DRAIN) { E(acc, cur, wr, wc, fr, fq); S.done(cur); }
        if (!has_next) break;
#pragma unroll
        for (int a = 0; a < 2; ++a)
#pragma unroll
            for (int b = 0; b < 2; ++b)
#pragma unroll
                for (int m = 0; m < 4; ++m)
#pragma unroll
                    for (int n = 0; n < 2; ++n) acc[a][b][m][n] = (f32x4){0.f, 0.f, 0.f, 0.f};
        cur = nxt; cA = nA; cB = nB; ++ui;
        if constexpr (ALIGN_EPI) { if (wr == 1) PG8_BAR; }
    }
    PG8_WAIT_V(0);
    if constexpr (!ALIGN_EPI) { if (wr == 0) PG8_BAR; }
    PG8_BAR;
    if constexpr (Epi::AFTER_DRAIN) { E.fused(acc, cur, wr, wc, fr, fq, lds, wid, lane); S.done(cur); }
#undef PG8_SA
#undef PG8_SB
#undef PG8_STAGE
#undef PG8_LDA
#undef PG8_LDB
#undef PG8_MMA
#undef PG8_WAIT_V
#undef PG8_WAIT_L
#undef PG8_BAR
#undef PG8_SCHED
}
}
#define LAS __attribute__((address_space(3)))
#define XB_TMO      128
#define XB_XCNT(j)  (256  + 64 * (j))
#define XB_XSUB(j)  (1280 + 64 * (j))
#define XB_XGEN(j)  (2304 + 64 * (j))
#define XB_TOP      3328
#define XB_TOPGEN   3392
#define XCD_BAR_WORDS 3456
#define XB_SPIN_CAP (1u << 18)

__device__ __forceinline__ unsigned xb_ld(unsigned* p)              { return __hip_atomic_load(p, __ATOMIC_RELAXED, __HIP_MEMORY_SCOPE_AGENT); }
__device__ __forceinline__ unsigned xb_add(unsigned* p, unsigned v) { return __hip_atomic_fetch_add(p, v, __ATOMIC_RELAXED, __HIP_MEMORY_SCOPE_AGENT); }
__device__ __forceinline__ unsigned xb_xcc_id() { return (unsigned)__builtin_amdgcn_s_getreg((3 << 11) | 20) & 0xFu; }
#define XB_SPIN(cond, bar) do { unsigned _sp = 0; while (cond) { __builtin_amdgcn_s_sleep(1); \
    if ((++_sp & 255u) == 0u) { if (xb_ld(&(bar)[XB_TMO])) break; if (_sp > XB_SPIN_CAP) { atomicAdd(&(bar)[XB_TMO], 1u); break; } } } } while (0)

struct XcdBarrier {
    unsigned* bar; unsigned x;
    volatile LAS unsigned* st;
};

__device__ __forceinline__ XcdBarrier xcd_barrier_post(unsigned* bar, volatile LAS unsigned* st) {
    XcdBarrier b; b.bar = bar; b.x = xb_xcc_id(); b.st = st;
    if (threadIdx.x == 0) (void)xb_add(&bar[XB_XCNT(b.x)], 1u);
    return b;
}
__device__ __forceinline__ void xcd_barrier_complete(unsigned* bar, unsigned x, unsigned& nloc, unsigned& nx) {
    const unsigned G = gridDim.x * gridDim.y * gridDim.z;
    unsigned sum, cnt, mine, sp = 0u;
    for (;;) {
        sum = 0u; cnt = 0u; mine = 0u;
#pragma unroll
        for (unsigned j = 0; j < 16; ++j) { const unsigned c = xb_ld(&bar[XB_XCNT(j)]); sum += c; cnt += (c > 0u) ? 1u : 0u; mine = (j == x) ? c : mine; }
        if (sum == G) break;
        __builtin_amdgcn_s_sleep(1);
        if ((++sp & 255u) == 0u) { if (xb_ld(&bar[XB_TMO])) break; if (sp > XB_SPIN_CAP) { atomicAdd(&bar[XB_TMO], 1u); break; } }
    }
    nloc = mine > 0u ? mine : 1u; nx = cnt > 0u ? cnt : 1u;
}

__device__ __forceinline__ void xcd_barrier(const XcdBarrier& b) {
    asm volatile("s_waitcnt vmcnt(0)" ::: "memory");
    __syncthreads();
    if (threadIdx.x == 0) {
        unsigned* bar = b.bar;
        __builtin_amdgcn_s_waitcnt(0);
        unsigned nloc = b.st[0], nx = b.st[1];
        if (nloc == 0u) { xcd_barrier_complete(bar, b.x, nloc, nx); b.st[0] = nloc; b.st[1] = nx; }
        const unsigned old = xb_add(&bar[XB_XSUB(b.x)], 1u);
        const unsigned gen = old / nloc;
        if (old + 1u == (gen + 1u) * nloc) {
            __builtin_amdgcn_fence(__ATOMIC_RELEASE, "agent");
            asm volatile("s_waitcnt vmcnt(0)" ::: "memory");
            const unsigned og = xb_add(&bar[XB_TOP], 1u);
            const unsigned tg = og / nx;
            if (og + 1u == (tg + 1u) * nx) xb_add(&bar[XB_TOPGEN], 1u);
            else XB_SPIN(xb_ld(&bar[XB_TOPGEN]) == tg, bar);
            __builtin_amdgcn_fence(__ATOMIC_ACQUIRE, "agent");
            xb_add(&bar[XB_XGEN(b.x)], 1u);
            asm volatile("s_waitcnt vmcnt(0)" ::: "memory");
        } else {
            XB_SPIN(xb_ld(&bar[XB_XGEN(b.x)]) == gen, bar);
            __builtin_amdgcn_fence(__ATOMIC_ACQUIRE, "agent");
            asm volatile("s_waitcnt vmcnt(0)" ::: "memory");
        }
    }
    __syncthreads();
}

constexpr int DM = 2048, NB = 4, SEQ = 4096, CTXL = 256, DEPTH = 4;
constexpr int M_LAT = NB * SEQ, M_CTX = NB * CTXL, M_ALL = M_LAT + M_CTX;
constexpr int DFF = 5632, DFF2 = 2 * DFF, NQKV = 3072, NGLA = 6144, NGLA_EXT = 6400, NMOD = 6 * DM;
constexpr float EPS = 1e-6f;
#ifndef MK_ONE_LAUNCH
#define MK_ONE_LAUNCH 1
#endif
#ifndef NAIVE_ATTN
#define NAIVE_ATTN 0
#endif
#ifndef NAIVE_GLA
#define NAIVE_GLA 0
#endif
#ifndef RPT_PRO
#define RPT_PRO 1
#endif
#ifndef RPT_NORM
#define RPT_NORM 1
#endif
#ifndef RPT_ATT
#define RPT_ATT 1
#endif
#ifndef RPT_GPRE
#define RPT_GPRE 1
#endif
#ifndef RPT_SCAN
#define RPT_SCAN 1
#endif
#ifndef RPT_COMB
#define RPT_COMB 1
#endif
#ifndef RPT_UP
#define RPT_UP 1
#endif
#ifndef RPT_CONV
#define RPT_CONV 1
#endif
#ifndef RPT_PROJ
#define RPT_PROJ 1
#endif
#ifndef RPT_WO
#define RPT_WO 0
#endif
#ifndef RPT_DN
#define RPT_DN 0
#endif
#ifndef EXTRA_BAR
#define EXTRA_BAR 0
#endif
#ifndef RPT_AVT
#define RPT_AVT 1
#endif
#ifndef RPT_ROPE
#define RPT_ROPE 0
#endif
#ifndef DIAG_BAR
#define DIAG_BAR 0
#endif
#ifndef DIAG_CLK
#define DIAG_CLK 0
#endif
#ifndef DIAG_SCAN
#define DIAG_SCAN 0
#endif
#ifndef SPLITK_WO
#define SPLITK_WO 0
#endif
#ifndef SPLITK_DN
#define SPLITK_DN 1
#endif
#ifndef TAIL_CONVERT
#define TAIL_CONVERT 1
#endif
#ifndef NORM_BF16_IN
#define NORM_BF16_IN 0
#endif
#ifndef TAIL_MODS
#define TAIL_MODS 0
#endif
#ifndef FUSE_CONV
#define FUSE_CONV 1
#endif
constexpr int NPH = 42;

constexpr size_t MiB = 1u << 20;
constexpr size_t WS_CTL = 0, CTL_ZERO_BYTES = 1 * MiB;
constexpr size_t WS_MODS = 1 * MiB;
constexpr size_t WS_X = 2 * MiB;
constexpr size_t WS_H = 138 * MiB;
constexpr size_t WS_P = 206 * MiB;
constexpr size_t WS_Z1 = 410 * MiB;
constexpr size_t WS_OMIX = 413 * MiB;
constexpr size_t WS_U = 481 * MiB;
constexpr size_t WS_OF = WS_U, WS_OB = WS_U + 136 * MiB;
constexpr size_t WS_XB = WS_U + 292 * MiB;
constexpr size_t WS_UB = WS_U + 64 * MiB;
constexpr size_t WS_PART = WS_U;
constexpr size_t WS_VTA = WS_U;
constexpr size_t WS_QT = WS_U;
constexpr size_t WS_KHT = WS_U + 68 * MiB;
constexpr size_t WS_AIN = WS_U + 136 * MiB;
constexpr size_t WS_DEC = WS_U + 153 * MiB;
constexpr size_t WS_VT = WS_U + 156 * MiB;
constexpr size_t WS_OFB = WS_U + 224 * MiB, WS_OBB = WS_U + 292 * MiB;
constexpr size_t WS_ACT = 855 * MiB;
constexpr size_t WS_WUP = 1042 * MiB, WUP_STRIDE = 44 * MiB;
constexpr size_t WS_WDN = 1218 * MiB, WDN_STRIDE = 22 * MiB;
constexpr size_t WS_WQKV = 1306 * MiB, WQKV_STRIDE = 12 * MiB;
constexpr size_t WS_WAO = 1330 * MiB, WO_STRIDE = 8 * MiB;
constexpr size_t WS_WGIN = 1346 * MiB, WGIN_STRIDE = 25 * MiB;
constexpr size_t WS_WGO = 1396 * MiB;
constexpr size_t WS_END = 1412 * MiB;
constexpr int CW_BAR = 4096;

constexpr int RING_BYTES = 131072, LDSCTL_OFF = RING_BYTES, LDS_BYTES = 147456;

#define GAS __attribute__((address_space(1)))
#define LAS __attribute__((address_space(3)))
typedef unsigned short bf16;
typedef unsigned v4u __attribute__((ext_vector_type(4)));
typedef unsigned v2u __attribute__((ext_vector_type(2)));
typedef float f32x4 __attribute__((ext_vector_type(4)));
#define LDS_WAIT() asm volatile("s_waitcnt lgkmcnt(0)" ::: "memory")
#define LDS_BARRIER() do { asm volatile("s_waitcnt lgkmcnt(0)" ::: "memory"); __builtin_amdgcn_s_barrier(); asm volatile("" ::: "memory"); } while (0)
__device__ __forceinline__ unsigned pk2(float lo, float hi) { return pg8::cvt_pk_bf16(lo, hi); }
__device__ __forceinline__ unsigned f2bf(float f) { return pk2(f, 0.f) & 0xffffu; }
__device__ __forceinline__ float bf_lo(unsigned w) { return __builtin_bit_cast(float, w << 16); }
__device__ __forceinline__ float bf_hi(unsigned w) { return __builtin_bit_cast(float, w & 0xffff0000u); }
__device__ __forceinline__ float bf2f(bf16 h) { return __builtin_bit_cast(float, ((unsigned)h) << 16); }
__device__ __forceinline__ float silu_f(float v) { return v / (1.0f + __expf(-v)); }
__device__ __forceinline__ float wave_sum(float v) {
#pragma unroll
    for (int o = 1; o < 64; o <<= 1) v += __shfl_xor(v, o);
    return v;
}

__device__ __forceinline__ void unpack8h(const v4u a, float (&x)[8]) { x[0] = pg8::f16_lo(a.x); x[1] = pg8::f16_hi(a.x); x[2] = pg8::f16_lo(a.y); x[3] = pg8::f16_hi(a.y); x[4] = pg8::f16_lo(a.z); x[5] = pg8::f16_hi(a.z); x[6] = pg8::f16_lo(a.w); x[7] = pg8::f16_hi(a.w); }
__device__ __forceinline__ void unpack8(const v4u a, float (&x)[8]) { x[0] = bf_lo(a.x); x[1] = bf_hi(a.x); x[2] = bf_lo(a.y); x[3] = bf_hi(a.y); x[4] = bf_lo(a.z); x[5] = bf_hi(a.z); x[6] = bf_lo(a.w); x[7] = bf_hi(a.w); }

struct Args { const float* in[25]; float* out; unsigned char* ws; int ph_lo, ph_hi; };
struct WV { int tid, lane, wave, G, vcu, gw, NGW; LAS unsigned char* lds; };

__device__ __forceinline__ void p0_transpose_item(const float* W, int K, int N, bf16* WT, int row_off, LAS float* scr, int item, int lane, bool remap_up) {
    const int nblk = N / 32, kb = item / nblk, nb = item % nblk, k0 = 64 * kb, n0 = 32 * nb;
    const int r0 = remap_up ? ((n0 < DFF ? 0 : 128) + 256 * ((n0 < DFF ? n0 : n0 - DFF) >> 7) + ((n0 < DFF ? n0 : n0 - DFF) & 127)) : n0;
    f32x4 ld[8];
#pragma unroll
    for (int i = 0; i < 8; ++i) ld[i] = *(const f32x4*)(W + (size_t)(k0 + 8 * i + (lane >> 3)) * N + n0 + 4 * (lane & 7));
#pragma unroll
    for (int i = 0; i < 8; ++i) { LAS float* sp = scr + (8 * i + (lane >> 3)) * 33 + 4 * (lane & 7); sp[0] = ld[i].x; sp[1] = ld[i].y; sp[2] = ld[i].z; sp[3] = ld[i].w; }
    LDS_WAIT(); asm volatile("" ::: "memory");
    const int c = lane & 7;
#pragma unroll
    for (int j = 0; j < 4; ++j) { const int n = (lane >> 3) + 8 * j; const LAS float* s = scr + (8 * c) * 33 + n;
        v4u o; o.x = pk2(s[0 * 33], s[1 * 33]); o.y = pk2(s[2 * 33], s[3 * 33]); o.z = pk2(s[4 * 33], s[5 * 33]); o.w = pk2(s[6 * 33], s[7 * 33]);
        *(v4u*)(WT + (size_t)(row_off + r0 + n) * K + k0 + 8 * c) = o; }
    LDS_WAIT(); asm volatile("" ::: "memory");
}
__device__ __forceinline__ void transpose_matrix(const WV& w, const float* W, int K, int N, bf16* WT, int row_off, bool remap_up = false) {
    LAS float* scr = (LAS float*)(w.lds + w.wave * 16384);
    const int nitems = (K / 64) * (N / 32);
    for (int it = w.gw; it < nitems; it += w.NGW) p0_transpose_item(W, K, N, WT, row_off, scr, it, w.lane, remap_up);
}
__device__ __forceinline__ void mods_item(const WV& w, const float* c, const float* c_ctx, const float* ada_w, const float* ada_b, float* mods, int it) {
    const int layer = it >> 6, n0 = (it & 63) * 192;
    LAS float* sl = (LAS float*)w.lds;
    LAS float* red = (LAS float*)(w.lds + 40960);
    for (int i = w.tid; i < 5 * DM; i += 512) { const int vec = i >> 11, k = i & 2047; const float v = vec < 4 ? c[vec * DM + k] : c_ctx[k]; sl[i] = silu_f(v); }
    __syncthreads();
    f32x4 acc[5];
#pragma unroll
    for (int v = 0; v < 5; ++v) acc[v] = (f32x4){0.f, 0.f, 0.f, 0.f};
    if (w.lane < 48) {
        const float* Wp = ada_w + (size_t)layer * DM * NMOD + n0 + 4 * w.lane;
        const int kbeg = w.wave * 256;
        for (int k = kbeg; k < kbeg + 256; k += 8) {
            f32x4 wv[8];
#pragma unroll
            for (int kk = 0; kk < 8; ++kk) wv[kk] = *(const f32x4*)(Wp + (size_t)(k + kk) * NMOD);
#pragma unroll
            for (int kk = 0; kk < 8; ++kk)
#pragma unroll
                for (int v = 0; v < 5; ++v) acc[v] += wv[kk] * sl[v * DM + k + kk];
        }
#pragma unroll
        for (int v = 0; v < 5; ++v) *(LAS f32x4*)(red + (w.wave * 5 + v) * 192 + 4 * w.lane) = acc[v];
    }
    __syncthreads();
    for (int i = w.tid; i < 5 * 192; i += 512) { const int vec = i / 192, col = i % 192; float s = 0.f;
#pragma unroll
        for (int ww = 0; ww < 8; ++ww) s += red[(ww * 5 + vec) * 192 + col];
        mods[((size_t)layer * 5 + vec) * NMOD + n0 + col] = s + ada_b[(size_t)layer * NMOD + n0 + col]; }
    __syncthreads();
}

__device__ __forceinline__ void norm_rows(const WV& w, bf16* X, bf16* H, const float* g, const float* shift, const float* scale, int nrows, const float* part, int nsplit, const float* pgate, const float* in_lat, const float* in_ctx) {
    for (int row = w.gw; row < nrows; row += w.NGW) {
        const int vec = row < M_LAT ? (row >> 12) : 4;
        float v[4][8];
        v4u* xr = (v4u*)(X + (size_t)row * DM) + w.lane;
        if (in_lat) { const float* xi = (row < M_LAT ? in_lat + (size_t)row * DM : in_ctx + (size_t)(row - M_LAT) * DM) + 8 * w.lane;
#pragma unroll
            for (int j = 0; j < 4; ++j) { const f32x4 a = *(const f32x4*)(xi + 512 * j), c = *(const f32x4*)(xi + 512 * j + 4);
                v[j][0] = a.x; v[j][1] = a.y; v[j][2] = a.z; v[j][3] = a.w; v[j][4] = c.x; v[j][5] = c.y; v[j][6] = c.z; v[j][7] = c.w; } }
        else {
#pragma unroll
            for (int j = 0; j < 4; ++j) unpack8h(xr[64 * j], v[j]); }
        if (nsplit > 0 && row >= M_LAT) {
            const float* pr = part + (size_t)(row - M_LAT) * DM + 8 * w.lane;
#pragma unroll
            for (int j = 0; j < 4; ++j) { f32x4 s0 = *(const f32x4*)(pr + 512 * j), s1 = *(const f32x4*)(pr + 512 * j + 4);
                for (int sl = 1; sl < nsplit; ++sl) { s0 += *(const f32x4*)(pr + (size_t)sl * (M_CTX * DM) + 512 * j); s1 += *(const f32x4*)(pr + (size_t)sl * (M_CTX * DM) + 512 * j + 4); }
                const f32x4 g0 = *(const f32x4*)(pgate + 8 * (64 * j + w.lane)), g1 = *(const f32x4*)(pgate + 8 * (64 * j + w.lane) + 4);
                v[j][0] += g0.x * s0.x; v[j][1] += g0.y * s0.y; v[j][2] += g0.z * s0.z; v[j][3] += g0.w * s0.w; v[j][4] += g1.x * s1.x; v[j][5] += g1.y * s1.y; v[j][6] += g1.z * s1.z; v[j][7] += g1.w * s1.w;
                const v4u o = (v4u){pg8::cvt_pk_f16(v[j][0], v[j][1]), pg8::cvt_pk_f16(v[j][2], v[j][3]), pg8::cvt_pk_f16(v[j][4], v[j][5]), pg8::cvt_pk_f16(v[j][6], v[j][7])}; xr[64 * j] = o;
                unpack8h(o, v[j]); }
        }
        float ss = 0.f;
#pragma unroll
        for (int j = 0; j < 4; ++j)
#pragma unroll
            for (int e = 0; e < 8; ++e) ss += v[j][e] * v[j][e];
        const float r = 1.0f / sqrtf(wave_sum(ss) * (1.0f / DM) + EPS);
        const float* sh = shift + (size_t)vec * NMOD; const float* sc = scale + (size_t)vec * NMOD;
        v4u* o16 = (v4u*)(H + (size_t)row * DM) + w.lane;
#pragma unroll
        for (int j = 0; j < 4; ++j) { const int col = 8 * (64 * j + w.lane); float y[8];
#pragma unroll
            for (int hq = 0; hq < 2; ++hq) { const f32x4 gv = *(const f32x4*)(g + col + 4 * hq), s = *(const f32x4*)(sc + col + 4 * hq), t = *(const f32x4*)(sh + col + 4 * hq);
                y[4 * hq] = v[j][4 * hq] * r * gv.x * (s.x + 1.0f) + t.x; y[4 * hq + 1] = v[j][4 * hq + 1] * r * gv.y * (s.y + 1.0f) + t.y;
                y[4 * hq + 2] = v[j][4 * hq + 2] * r * gv.z * (s.z + 1.0f) + t.z; y[4 * hq + 3] = v[j][4 * hq + 3] * r * gv.w * (s.w + 1.0f) + t.w; }
            o16[64 * j] = (v4u){pk2(y[0], y[1]), pk2(y[2], y[3]), pk2(y[4], y[5]), pk2(y[6], y[7])}; }
    }
}
__device__ __forceinline__ void final_norm(const WV& w, const bf16* X, float* out, const float* g) {
    for (int row = w.gw; row < M_LAT; row += w.NGW) {
        const v4u* xr = (const v4u*)(X + (size_t)row * DM) + w.lane;
        float v[4][8]; float ss = 0.f;
#pragma unroll
        for (int j = 0; j < 4; ++j) { unpack8h(xr[64 * j], v[j]);
#pragma unroll
            for (int e = 0; e < 8; ++e) ss += v[j][e] * v[j][e]; }
        const float r = 1.0f / sqrtf(wave_sum(ss) * (1.0f / DM) + EPS);
        float* o = out + (size_t)row * DM + 8 * w.lane;
#pragma unroll
        for (int j = 0; j < 4; ++j) { const int col = 8 * (64 * j + w.lane); const f32x4 g0 = *(const f32x4*)(g + col), g1 = *(const f32x4*)(g + col + 4);
            *(f32x4*)(o + 512 * j) = (f32x4){v[j][0] * r * g0.x, v[j][1] * r * g0.y, v[j][2] * r * g0.z, v[j][3] * r * g0.w};
            *(f32x4*)(o + 512 * j + 4) = (f32x4){v[j][4] * r * g1.x, v[j][5] * r * g1.y, v[j][6] * r * g1.z, v[j][7] * r * g1.w}; }
    }
}

__device__ __forceinline__ void rope_rows(const WV& w, bf16* P, float sgn = 1.0f) {
    const int half = (w.lane >> 2) & 1, oct = w.lane & 3;
    float inv[8];
#pragma unroll
    for (int e = 0; e < 8; ++e) inv[e] = exp2f(-(float)(2 * (8 * oct + e)) * (13.287712379549449f / 64.0f));
    for (int row = w.gw; row < M_LAT; row += w.NGW) {
        const int t = row & (SEQ - 1); const float pos = (float)(half ? (t & 63) : (t >> 6));
        float cs[8], sn[8];
#pragma unroll
        for (int e = 0; e < 8; ++e) { const float ang = pos * inv[e]; cs[e] = __cosf(ang); sn[e] = sgn * __sinf(ang); }
        bf16* base = P + (size_t)row * NQKV + half * 64 + 8 * oct;
#pragma unroll
        for (int rnd = 0; rnd < 3; ++rnd) { const int hd = (w.lane >> 3) + 8 * rnd;
            if (hd < 20) { bf16* p = base + hd * 128; float x1[8], x2[8]; unpack8(*(const v4u*)p, x1); unpack8(*(const v4u*)(p + 32), x2);
                float y1[8], y2[8];
#pragma unroll
                for (int e = 0; e < 8; ++e) { y1[e] = x1[e] * cs[e] - x2[e] * sn[e]; y2[e] = x2[e] * cs[e] + x1[e] * sn[e]; }
                *(v4u*)p = (v4u){pk2(y1[0], y1[1]), pk2(y1[2], y1[3]), pk2(y1[4], y1[5]), pk2(y1[6], y1[7])};
                *(v4u*)(p + 32) = (v4u){pk2(y2[0], y2[1]), pk2(y2[2], y2[3]), pk2(y2[4], y2[5]), pk2(y2[6], y2[7])}; } }
    }
}

__device__ __forceinline__ void attn_naive(const WV& w, const bf16* P, const float* sink, bf16* O) {
    const int g = w.lane >> 4, li = w.lane & 15;
    const float scale = 0.08838834764831845f;
    for (int task = w.gw; task < M_ALL * 16; task += w.NGW) {
        const int row = task >> 4, hq = task & 15, kvh = hq >> 2;
        float q[8];
        { const v4u qq = *(const v4u*)(P + (size_t)row * NQKV + hq * 128 + 8 * li);
          q[0] = bf_lo(qq.x) * scale; q[1] = bf_hi(qq.x) * scale; q[2] = bf_lo(qq.y) * scale; q[3] = bf_hi(qq.y) * scale;
          q[4] = bf_lo(qq.z) * scale; q[5] = bf_hi(qq.z) * scale; q[6] = bf_lo(qq.w) * scale; q[7] = bf_hi(qq.w) * scale; }
        int b, wbase = 0, nwin = 0;
        if (row < M_LAT) { b = row >> 12; const int t = row & (SEQ - 1); const int j0 = t - 128 < 0 ? 0 : t - 128, j1 = t + 128 > SEQ - 1 ? SEQ - 1 : t + 128; wbase = b * SEQ + j0; nwin = j1 - j0 + 1; }
        else b = (row - M_LAT) >> 8;
        const int cbase = M_LAT + b * CTXL, nk = nwin + CTXL;
        float m = sink[hq], l = (g == 0) ? 1.0f : 0.0f, o[8];
#pragma unroll
        for (int d = 0; d < 8; ++d) o[d] = 0.f;
        for (int i = g; i < nk; i += 4) {
            const int krow = i < nwin ? wbase + i : cbase + (i - nwin);
            const bf16* kp = P + (size_t)krow * NQKV + 2048 + kvh * 128 + 8 * li;
            const v4u kk = *(const v4u*)kp, vv = *(const v4u*)(kp + 512);
            float s = q[0] * bf_lo(kk.x) + q[1] * bf_hi(kk.x) + q[2] * bf_lo(kk.y) + q[3] * bf_hi(kk.y) + q[4] * bf_lo(kk.z) + q[5] * bf_hi(kk.z) + q[6] * bf_lo(kk.w) + q[7] * bf_hi(kk.w);
            s += __shfl_xor(s, 1); s += __shfl_xor(s, 2); s += __shfl_xor(s, 4); s += __shfl_xor(s, 8);
            const float mn = fmaxf(m, s), a = __expf(m - mn), p = __expf(s - mn);
            l = l * a + p; m = mn;
            o[0] = o[0] * a + p * bf_lo(vv.x); o[1] = o[1] * a + p * bf_hi(vv.x); o[2] = o[2] * a + p * bf_lo(vv.y); o[3] = o[3] * a + p * bf_hi(vv.y);
            o[4] = o[4] * a + p * bf_lo(vv.z); o[5] = o[5] * a + p * bf_hi(vv.z); o[6] = o[6] * a + p * bf_lo(vv.w); o[7] = o[7] * a + p * bf_hi(vv.w);
        }
        float ma = fmaxf(m, __shfl_xor(m, 16)); ma = fmaxf(ma, __shfl_xor(ma, 32));
        const float fsc = __expf(m - ma); l *= fsc; l += __shfl_xor(l, 16); l += __shfl_xor(l, 32);
        const float rl = 1.0f / l;
#pragma unroll
        for (int d = 0; d < 8; ++d) { float x = o[d] * fsc; x += __shfl_xor(x, 16); x += __shfl_xor(x, 32); o[d] = x * rl; }
        if (g == 0) { v4u ov; ov.x = pk2(o[0], o[1]); ov.y = pk2(o[2], o[3]); ov.z = pk2(o[4], o[5]); ov.w = pk2(o[6], o[7]);
            *(v4u*)(O + (size_t)row * DM + hq * 128 + 8 * li) = ov; }
    }
}

__device__ __forceinline__ void gla_naive(const WV& w, const bf16* P, const float* Z1, const float* w2f, const float* bf, const float* w2b, const float* bb, float* OF, float* OB) {
    LAS float* buf = (LAS float*)w.lds;
    const int vc = w.tid >> 2, dq = w.tid & 3;
    for (int it = w.vcu; it < 128; it += w.G) {
        const int vs = it & 3, dir = (it >> 2) & 1, h = (it >> 3) & 3, b = it >> 5;
        const float* w2 = dir ? w2b : w2f; const float* bias = dir ? bb : bf; float* OUT = dir ? OB : OF;
        float w2c[16], bz = 0.f;
        if (w.tid < 256) { bz = bias[h * 256 + w.tid];
#pragma unroll
            for (int r = 0; r < 16; ++r) w2c[r] = w2[r * 1024 + h * 256 + w.tid]; }
        else {
#pragma unroll
            for (int r = 0; r < 16; ++r) w2c[r] = 0.f; }
        float S[64];
#pragma unroll
        for (int i = 0; i < 64; ++i) S[i] = 0.f;
        const int cbase = M_LAT + b * CTXL, lbase = b * SEQ;
#define GLA_ROW(step) ((step) < CTXL ? (dir ? cbase + CTXL - 1 - (step) : cbase + (step)) : (dir ? lbase + SEQ - 1 - ((step) - CTXL) : lbase + ((step) - CTXL)))
#define GLA_FILL(step, par) do { if (w.tid < 256) { const int r_ = GLA_ROW(step); const float* z_ = Z1 + (size_t)r_ * 32 + dir * 16; float zz = bz; \
            _Pragma("unroll") for (int r = 0; r < 16; ++r) zz += z_[r] * w2c[r]; \
            const float ls_ = fminf(zz, 0.f) - log1pf(__expf(-fabsf(zz))); \
            LAS float* bp_ = buf + (par) * 768; bp_[w.tid] = __expf(ls_ * (1.0f / 16.0f)); \
            bp_[256 + w.tid] = bf2f(P[(size_t)r_ * NGLA + 1024 + h * 256 + w.tid]); bp_[512 + w.tid] = bf2f(P[(size_t)r_ * NGLA + h * 256 + w.tid]) * 0.0625f; } } while (0)
        __syncthreads();
        GLA_FILL(0, 0);
        __syncthreads();
        for (int step = 0; step < CTXL + SEQ; ++step) {
            const int row = GLA_ROW(step);
            if (step + 1 < CTXL + SEQ) GLA_FILL(step + 1, (step + 1) & 1);
            const float v = bf2f(P[(size_t)row * NGLA + 2048 + h * 512 + vs * 128 + vc]);
            const LAS float* bp = buf + (step & 1) * 768 + 64 * dq;
            float acc = 0.f;
#pragma unroll
            for (int i = 0; i < 64; i += 4) {
                const f32x4 e4 = *(const LAS f32x4*)(bp + i), k4 = *(const LAS f32x4*)(bp + 256 + i), q4 = *(const LAS f32x4*)(bp + 512 + i);
                S[i] = S[i] * e4.x + k4.x * v; acc += q4.x * S[i];
                S[i + 1] = S[i + 1] * e4.y + k4.y * v; acc += q4.y * S[i + 1];
                S[i + 2] = S[i + 2] * e4.z + k4.z * v; acc += q4.z * S[i + 2];
                S[i + 3] = S[i + 3] * e4.w + k4.w * v; acc += q4.w * S[i + 3];
            }
            acc += __shfl_xor(acc, 1); acc += __shfl_xor(acc, 2);
            if (dq == 0) OUT[(size_t)row * DM + h * 512 + vs * 128 + vc] = acc;
            __syncthreads();
        }
#undef GLA_ROW
#undef GLA_FILL
    }
}
__device__ __forceinline__ void gla_combine(const WV& w, const float* OF, const float* OB, const bf16* P, const float* og, bf16* O, int nrows) {
    for (int task = w.gw; task < nrows * 4; task += w.NGW) {
        const int row = task >> 2, h = task & 3; const size_t off = (size_t)row * DM + h * 512 + 8 * w.lane;
        const f32x4 a0 = *(const f32x4*)(OF + off), a1 = *(const f32x4*)(OF + off + 4), b0 = *(const f32x4*)(OB + off), b1 = *(const f32x4*)(OB + off + 4);
        const f32x4 o0 = a0 + b0, o1 = a1 + b1;
        float ss = (o0.x * o0.x + o0.y * o0.y) + (o0.z * o0.z + o0.w * o0.w) + (o1.x * o1.x + o1.y * o1.y) + (o1.z * o1.z + o1.w * o1.w);
        const float r = 1.0f / sqrtf(wave_sum(ss) * (1.0f / 512.0f) + EPS);
        const f32x4 g0 = *(const f32x4*)(og + 8 * w.lane), g1 = *(const f32x4*)(og + 8 * w.lane + 4);
        const v4u rr = *(const v4u*)(P + (size_t)row * NGLA + 4096 + h * 512 + 8 * w.lane);
        v4u ov;
        ov.x = pk2(o0.x * r * g0.x * silu_f(bf_lo(rr.x)), o0.y * r * g0.y * silu_f(bf_hi(rr.x)));
        ov.y = pk2(o0.z * r * g0.z * silu_f(bf_lo(rr.y)), o0.w * r * g0.w * silu_f(bf_hi(rr.y)));
        ov.z = pk2(o1.x * r * g1.x * silu_f(bf_lo(rr.z)), o1.y * r * g1.y * silu_f(bf_hi(rr.z)));
        ov.w = pk2(o1.z * r * g1.z * silu_f(bf_lo(rr.w)), o1.w * r * g1.w * silu_f(bf_hi(rr.w)));
        *(v4u*)(O + off) = ov;
    }
}

typedef short bf16x8 __attribute__((ext_vector_type(8)));
typedef float f32x16 __attribute__((ext_vector_type(16)));
__device__ __forceinline__ int gla_row(int b, int cc, int i) { return cc < 64 ? b * SEQ + cc * 64 + i : M_LAT + b * CTXL + (cc - 64) * 64 + i; }
__device__ __forceinline__ void gla_pre(const WV& w, const bf16* P, const float* Z1, const float* w2f, const float* bf_, const float* w2b, const float* bb_, bf16* QT, bf16* KHT, bf16* AIN, float* DEC) {
    LAS bf16* QS = (LAS bf16*)w.lds;
    LAS bf16* KS = (LAS bf16*)(w.lds + 33792);
    LAS bf16* KH = (LAS bf16*)(w.lds + 67584);
    LAS float* z1s = (LAS float*)(w.lds + 104448);
    LAS float* tot = (LAS float*)(w.lds + 108544);
    LAS bf16* AS = (LAS bf16*)(w.lds + 110592);
    const int d = w.tid & 255, hf = w.tid >> 8;
    float w2c[16], bias = 0.f; int cur_dh = -1;
    v4u pq[4], pkk[4]; f32x4 pz = (f32x4){0.f, 0.f, 0.f, 0.f};
#define PRE_FETCH(it_) do { const int b_ = ((it_) >> 3) & 3, h_ = ((it_) >> 1) & 3, dir_ = (it_) & 1, row0_ = gla_row(b_, (it_) >> 5, 0); \
        _Pragma("unroll") for (int i = 0; i < 4; ++i) { const int p = w.tid + 512 * i; const bf16* src = P + (size_t)(row0_ + (p >> 5)) * NGLA + h_ * 256 + 8 * (p & 31); pq[i] = *(const v4u*)src; pkk[i] = *(const v4u*)(src + 1024); } \
        if (w.tid < 256) pz = *(const f32x4*)(Z1 + (size_t)(row0_ + (w.tid >> 2)) * 32 + dir_ * 16 + 4 * (w.tid & 3)); } while (0)
    if (w.vcu < 2 * 4 * 4 * 68) PRE_FETCH(w.vcu);
    LDS_BARRIER();
    for (int it = w.vcu; it < 2 * 4 * 4 * 68; it += w.G) {
        const int dir = it & 1, h = (it >> 1) & 3, b = (it >> 3) & 3, cc = it >> 5;
        const size_t item = ((size_t)(dir * 4 + b) * 4 + h) * 68 + cc;
        if (cur_dh != (dir * 4 + h)) { cur_dh = dir * 4 + h; const float* w2 = dir ? w2b : w2f; bias = (dir ? bb_ : bf_)[h * 256 + d];
#pragma unroll
            for (int r = 0; r < 16; ++r) w2c[r] = w2[r * 1024 + h * 256 + d]; }
        const int row0 = gla_row(b, cc, 0);
#pragma unroll
        for (int i = 0; i < 4; ++i) { const int p = w.tid + 512 * i, r = p >> 5, c = p & 31; *(LAS v4u*)(QS + r * 264 + 8 * c) = pq[i]; *(LAS v4u*)(KS + r * 264 + 8 * c) = pkk[i]; }
        if (w.tid < 256) *(LAS f32x4*)(z1s + 4 * w.tid) = pz;
        if (it + w.G < 2 * 4 * 4 * 68) PRE_FETCH(it + w.G);
        LDS_BARRIER();
        float g[32];
#pragma unroll
        for (int ii = 0; ii < 32; ++ii) { const LAS f32x4* zp = (const LAS f32x4*)(z1s + (32 * hf + ii) * 16); float zz = bias;
#pragma unroll
            for (int q4 = 0; q4 < 4; ++q4) { const f32x4 z = zp[q4]; zz += z.x * w2c[4 * q4] + z.y * w2c[4 * q4 + 1] + z.z * w2c[4 * q4 + 2] + z.w * w2c[4 * q4 + 3]; }
            g[ii] = (fminf(zz, 0.f) * 1.4426950408889634f - __builtin_amdgcn_logf(1.0f + __builtin_amdgcn_exp2f(-fabsf(zz) * 1.4426950408889634f))) * 0.0625f; }
        float run = 0.f;
        if (!dir) {
#pragma unroll
            for (int ii = 0; ii < 32; ++ii) { run += g[ii]; g[ii] = run; } }
        else {
#pragma unroll
            for (int ii = 31; ii >= 0; --ii) { run += g[ii]; g[ii] = run; } }
        tot[hf * 256 + d] = run;
        LDS_BARRIER();
        const float t0 = tot[d], t1 = tot[256 + d], blast = t0 + t1;
        const float off = dir ? (hf == 0 ? t1 : 0.f) : (hf == 1 ? t0 : 0.f);
        unsigned khat[16];
#pragma unroll
        for (int ii = 0; ii < 32; ++ii) { const int i = 32 * hf + ii; const float bbv = g[ii] + off;
            const float qv = bf2f(QS[i * 264 + d]) * 0.0625f, kv = bf2f(KS[i * 264 + d]);
            const unsigned qk = pk2(qv * __builtin_amdgcn_exp2f(bbv), kv * __builtin_amdgcn_exp2f(-bbv)); const unsigned kh = f2bf(kv * __builtin_amdgcn_exp2f(blast - bbv));
            QS[i * 264 + d] = (bf16)(qk & 0xffffu); KS[i * 264 + d] = (bf16)(qk >> 16);
            if (ii & 1) khat[ii >> 1] |= kh << 16; else khat[ii >> 1] = kh; }
        { LAS v4u* kp = (LAS v4u*)(KH + d * 72 + 32 * hf);
#pragma unroll
          for (int q4 = 0; q4 < 4; ++q4) kp[q4] = (v4u){khat[4 * q4], khat[4 * q4 + 1], khat[4 * q4 + 2], khat[4 * q4 + 3]}; }
        if (hf == 0) DEC[item * 256 + d] = __builtin_amdgcn_exp2f(blast);
        LDS_BARRIER();
#pragma unroll
        for (int i = 0; i < 4; ++i) { const int p = w.tid + 512 * i, r = p >> 5, c = p & 31;
            *(v4u*)(QT + ((size_t)dir * M_ALL + row0 + r) * 1024 + h * 256 + 8 * c) = *(const LAS v4u*)(QS + r * 264 + 8 * c); }
#pragma unroll
        for (int i = 0; i < 4; ++i) { const int p = w.tid + 512 * i, dd = p >> 3, c = p & 7;
            *(v4u*)(KHT + (item * 256 + dd) * 64 + 8 * c) = *(const LAS v4u*)(KH + dd * 72 + 8 * c); }
        { const int rb = w.wave >> 1, ch = w.wave & 1, c16 = w.lane & 15, kg = w.lane >> 4;
          f32x4 acc[2]; acc[0] = (f32x4){0.f, 0.f, 0.f, 0.f}; acc[1] = acc[0];
#pragma unroll
          for (int k8 = 0; k8 < 8; ++k8) { const bf16x8 a = *(const LAS bf16x8*)(QS + (rb * 16 + c16) * 264 + 32 * k8 + 8 * kg);
#pragma unroll
              for (int n = 0; n < 2; ++n) { const bf16x8 bq = *(const LAS bf16x8*)(KS + ((2 * ch + n) * 16 + c16) * 264 + 32 * k8 + 8 * kg); acc[n] = __builtin_amdgcn_mfma_f32_16x16x32_bf16(a, bq, acc[n], 0, 0, 0); } }
#pragma unroll
          for (int n = 0; n < 2; ++n)
#pragma unroll
              for (int r = 0; r < 4; ++r) { const int i = rb * 16 + 4 * kg + r, jj = (2 * ch + n) * 16 + c16; const bool keep = dir ? (jj >= i) : (jj <= i);
                  AS[i * 72 + jj] = (bf16)f2bf(keep ? acc[n][r] : 0.f); } }
        LDS_BARRIER();
        { const int r = w.tid >> 3, c = w.tid & 7; *(v4u*)(AIN + (item * 64 + r) * 64 + 8 * c) = *(const LAS v4u*)(AS + r * 72 + 8 * c); }
        LDS_BARRIER();
    }
#undef PRE_FETCH
    __syncthreads();
}
__device__ __forceinline__ void gla_vt(const WV& w, const bf16* P, bf16* VT) {
    LAS bf16* vt = (LAS bf16*)w.lds;
    for (int it = w.vcu; it < 4 * 4 * 68; it += w.G) {
        const int cc = it % 68, bh = it / 68, h = bh & 3, b = bh >> 2;
        const int row0 = gla_row(b, cc, 0);
#pragma unroll
        for (int rr = 0; rr < 8; ++rr) { const int i = rr * 8 + (w.tid >> 6), piece = w.tid & 63;
            *(LAS v4u*)(vt + i * 520 + 8 * (piece ^ (i >> 3))) = *(const v4u*)(P + (size_t)(row0 + i) * NGLA + 2048 + h * 512 + 8 * piece); }
        __syncthreads();
#pragma unroll
        for (int i = 0; i < 8; ++i) { const int p = w.tid + 512 * i, dv = p >> 3, c = p & 7; unsigned u[8];
#pragma unroll
            for (int e = 0; e < 8; ++e) u[e] = vt[(8 * c + e) * 520 + 8 * ((dv >> 3) ^ c) + (dv & 7)];
            *(v4u*)(VT + ((size_t)it * 512 + dv) * 64 + 8 * c) = (v4u){u[0] | (u[1] << 16), u[2] | (u[3] << 16), u[4] | (u[5] << 16), u[6] | (u[7] << 16)}; }
        __syncthreads();
    }
}
__device__ __forceinline__ void gla_scan(const WV& w, const bf16* QT, const bf16* KHT, const bf16* AIN, const float* DEC, const bf16* VT, bf16* OFB, bf16* OBB) {
    LAS bf16* ST = (LAS bf16*)w.lds;
    LAS bf16* QS = (LAS bf16*)(w.lds + 33792);
    LAS bf16* VS = (LAS bf16*)(w.lds + 67584);
    LAS bf16* AS = (LAS bf16*)(w.lds + 76800);
    LAS float* DS = (LAS float*)(w.lds + 86016);
    LAS bf16* OS = (LAS bf16*)(w.lds + 87040);
    const int wv = w.wave, r32 = w.lane & 31, hh = w.lane >> 5, c16 = w.lane & 15, kg = w.lane >> 4, tb = wv >> 1, dh = wv & 1;
    for (int it = w.vcu; it < 256; it += w.G) {
        const int vs = it & 7, dir = (it >> 3) & 1, h = (it >> 4) & 3, b = it >> 6;
        bf16* O = dir ? OBB : OFB;
        f32x16 S[2];
#pragma unroll
        for (int n = 0; n < 2; ++n)
#pragma unroll
            for (int r = 0; r < 16; ++r) S[n][r] = 0.f;
        v4u sq[4], sv, sa; f32x4 sd = (f32x4){0.f, 0.f, 0.f, 0.f}; bf16x8 kn[4];
#define SC_CC(s_) ((s_) < 4 ? (dir ? 67 - (s_) : 64 + (s_)) : (dir ? 67 - (s_) : (s_) - 4))
#define SC_LOAD(s_) do { const int cc_ = SC_CC(s_); const size_t item_ = ((size_t)(dir * 4 + b) * 4 + h) * 68 + cc_, vitem_ = ((size_t)b * 4 + h) * 68 + cc_; const int row0_ = gla_row(b, cc_, 0); \
            _Pragma("unroll") for (int i_ = 0; i_ < 4; ++i_) { const int p_ = w.tid + 512 * i_; sq[i_] = *(const v4u*)(QT + ((size_t)dir * M_ALL + row0_ + (p_ >> 5)) * 1024 + h * 256 + 8 * (p_ & 31)); } \
            sv = *(const v4u*)(VT + (vitem_ * 512 + vs * 64 + (w.tid >> 3)) * 64 + 8 * (w.tid & 7)); \
            sa = *(const v4u*)(AIN + (item_ * 64 + (w.tid >> 3)) * 64 + 8 * (w.tid & 7)); \
            if (w.tid < 64) sd = *(const f32x4*)(DEC + item_ * 256 + 4 * w.tid); \
            const bf16* krow_ = KHT + (item_ * 256 + 32 * wv + r32) * 64 + 8 * hh; \
            _Pragma("unroll") for (int k4 = 0; k4 < 4; ++k4) kn[k4] = *(const bf16x8*)(krow_ + 16 * k4); } while (0)
        SC_LOAD(0);
        for (int s = 0; s < 68; ++s) {
            const int row0 = gla_row(b, SC_CC(s), 0);
#pragma unroll
            for (int n = 0; n < 2; ++n)
#pragma unroll
                for (int g4 = 0; g4 < 4; ++g4) { v2u pk; pk.x = pk2(S[n][4 * g4], S[n][4 * g4 + 1]); pk.y = pk2(S[n][4 * g4 + 2], S[n][4 * g4 + 3]);
                    *(LAS v2u*)(ST + (32 * n + r32) * 264 + 32 * wv + 8 * g4 + 4 * hh) = pk; }
#pragma unroll
            for (int i = 0; i < 4; ++i) { const int p = w.tid + 512 * i; *(LAS v4u*)(QS + (p >> 5) * 264 + 8 * (p & 31)) = sq[i]; }
            *(LAS v4u*)(VS + (w.tid >> 3) * 72 + 8 * (w.tid & 7)) = sv;
            *(LAS v4u*)(AS + (w.tid >> 3) * 72 + 8 * (w.tid & 7)) = sa;
            if (w.tid < 64) *(LAS f32x4*)(DS + 4 * w.tid) = sd;
            bf16x8 ka[4];
#pragma unroll
            for (int k4 = 0; k4 < 4; ++k4) ka[k4] = kn[k4];
            if (s + 1 < 68) SC_LOAD(s + 1);
            asm volatile("s_waitcnt lgkmcnt(0)" ::: "memory"); __builtin_amdgcn_s_barrier(); asm volatile("" ::: "memory");
            f32x4 oacc[2]; oacc[0] = (f32x4){0.f, 0.f, 0.f, 0.f}; oacc[1] = oacc[0];
#pragma unroll
            for (int k8 = 0; k8 < 8; ++k8) { const bf16x8 qa = *(const LAS bf16x8*)(QS + (tb * 16 + c16) * 264 + 32 * k8 + 8 * kg);
#pragma unroll
                for (int n = 0; n < 2; ++n) { const bf16x8 sb = *(const LAS bf16x8*)(ST + (32 * dh + 16 * n + c16) * 264 + 32 * k8 + 8 * kg); oacc[n] = __builtin_amdgcn_mfma_f32_16x16x32_bf16(qa, sb, oacc[n], 0, 0, 0); } }
#pragma unroll
            for (int k2 = 0; k2 < 2; ++k2) { const bf16x8 aa = *(const LAS bf16x8*)(AS + (tb * 16 + c16) * 72 + 32 * k2 + 8 * kg);
#pragma unroll
                for (int n = 0; n < 2; ++n) { const bf16x8 vb = *(const LAS bf16x8*)(VS + (32 * dh + 16 * n + c16) * 72 + 32 * k2 + 8 * kg); oacc[n] = __builtin_amdgcn_mfma_f32_16x16x32_bf16(aa, vb, oacc[n], 0, 0, 0); } }
#pragma unroll
            for (int n = 0; n < 2; ++n)
#pragma unroll
                for (int r = 0; r < 4; ++r) OS[(tb * 16 + 4 * kg + r) * 72 + 32 * dh + 16 * n + c16] = (bf16)f2bf(oacc[n][r]);
            { float dec[16];
#pragma unroll
              for (int q4 = 0; q4 < 4; ++q4) { const f32x4 dq = *(const LAS f32x4*)(DS + 32 * wv + 4 * hh + 8 * q4); dec[4 * q4] = dq.x; dec[4 * q4 + 1] = dq.y; dec[4 * q4 + 2] = dq.z; dec[4 * q4 + 3] = dq.w; }
#pragma unroll
              for (int n = 0; n < 2; ++n) {
#pragma unroll
                  for (int r = 0; r < 16; ++r) S[n][r] *= dec[r];
#pragma unroll
                  for (int k4 = 0; k4 < 4; ++k4) { const bf16x8 vb = *(const LAS bf16x8*)(VS + (32 * n + r32) * 72 + 16 * k4 + 8 * hh); S[n] = __builtin_amdgcn_mfma_f32_32x32x16_bf16(ka[k4], vb, S[n], 0, 0, 0); } } }
            asm volatile("s_waitcnt lgkmcnt(0)" ::: "memory"); __builtin_amdgcn_s_barrier(); asm volatile("" ::: "memory");
            *(v4u*)(O + (size_t)(row0 + (w.tid >> 3)) * DM + h * 512 + vs * 64 + 8 * (w.tid & 7)) = *(const LAS v4u*)(OS + (w.tid >> 3) * 72 + 8 * (w.tid & 7));
        }
#undef SC_CC
#undef SC_LOAD
        __syncthreads();
    }
}
__device__ __forceinline__ void gla_combine_bf(const WV& w, const bf16* OFB, const bf16* OBB, const bf16* P, const float* og, bf16* O, int nrows) {
    for (int task = w.gw; task < nrows * 4; task += w.NGW) {
        const int row = task >> 2, h = task & 3; const size_t off = (size_t)row * DM + h * 512 + 8 * w.lane;
        float a[8], c[8], o[8], rv[8]; unpack8(*(const v4u*)(OFB + off), a); unpack8(*(const v4u*)(OBB + off), c);
        float ss = 0.f;
#pragma unroll
        for (int e = 0; e < 8; ++e) { o[e] = a[e] + c[e]; ss += o[e] * o[e]; }
        const float r = 1.0f / sqrtf(wave_sum(ss) * (1.0f / 512.0f) + EPS);
        const f32x4 g0 = *(const f32x4*)(og + 8 * w.lane), g1 = *(const f32x4*)(og + 8 * w.lane + 4);
        const float gg[8] = {g0.x, g0.y, g0.z, g0.w, g1.x, g1.y, g1.z, g1.w};
        unpack8(*(const v4u*)(P + (size_t)row * NGLA + 4096 + h * 512 + 8 * w.lane), rv);
#pragma unroll
        for (int e = 0; e < 8; ++e) o[e] = o[e] * r * gg[e] * silu_f(rv[e]);
        *(v4u*)(O + off) = (v4u){pk2(o[0], o[1]), pk2(o[2], o[3]), pk2(o[4], o[5]), pk2(o[6], o[7])};
    }
}


__device__ __forceinline__ void attn_vt(const WV& w, const bf16* P, bf16* VTA) {
    LAS bf16* tl = (LAS bf16*)w.lds;
    for (int it = w.vcu; it < 16 * 68; it += w.G) {
        const int blk = it % 68, bk = it / 68, b = bk >> 2, kvh = bk & 3;
        const size_t row0 = blk < 64 ? (size_t)b * SEQ + 64 * blk : (size_t)M_LAT + b * CTXL + 64 * (blk - 64);
        const int col0 = blk < 64 ? 64 * blk : SEQ + 64 * (blk - 64);
#pragma unroll
        for (int i = 0; i < 2; ++i) { const int p = w.tid + 512 * i, r = p >> 4, c8 = p & 15;
            *(LAS v4u*)(tl + r * 136 + 8 * c8) = *(const v4u*)(P + (row0 + r) * NQKV + 2560 + kvh * 128 + 8 * c8); }
        __syncthreads();
        const int d = w.tid & 127, tg = w.tid >> 7;
        unsigned u[16];
#pragma unroll
        for (int e = 0; e < 16; ++e) u[e] = tl[(16 * tg + e) * 136 + d];
        v4u* dst = (v4u*)(VTA + ((size_t)bk * 128 + d) * 4352 + col0 + 16 * tg);
        dst[0] = (v4u){u[0] | (u[1] << 16), u[2] | (u[3] << 16), u[4] | (u[5] << 16), u[6] | (u[7] << 16)};
        dst[1] = (v4u){u[8] | (u[9] << 16), u[10] | (u[11] << 16), u[12] | (u[13] << 16), u[14] | (u[15] << 16)};
        __syncthreads();
    }
}
__device__ __forceinline__ void attn_fast(const WV& w, const bf16* P, const bf16* VTA, const float* sink, bf16* O) {
    LAS bf16* KL = (LAS bf16*)w.lds;
    LAS bf16* VL = (LAS bf16*)(w.lds + 2 * 17408);
    const int wv = w.wave, r32 = w.lane & 31, hh = w.lane >> 5, g = wv >> 1, th = wv & 1;
    const float C2 = 0.08838834764831845f * 1.4426950408889634f, L2E = 1.4426950408889634f;
    for (int u = w.vcu; u < 1088; u += w.G) {
        int b, kvh, qb; bool isctx;
        if (u < 1024) { b = u >> 8; kvh = (u >> 6) & 3; qb = u & 63; isctx = false; } else { const int v = u - 1024; b = v >> 4; kvh = (v >> 2) & 3; qb = v & 3; isctx = true; }
        const int hq = kvh * 4 + g, tq = qb * 64 + 32 * th + r32;
        const size_t qrow = isctx ? (size_t)M_LAT + b * CTXL + tq : (size_t)b * SEQ + tq;
        int i_lo = 0, nwin = 0;
        if (!isctx) { i_lo = 2 - qb > 0 ? 2 - qb : 0; const int i_hi = 65 - qb < 4 ? 65 - qb : 4; nwin = i_hi - i_lo + 1; }
        const int T = nwin + 4;
        bf16x8 qf[8];
#pragma unroll
        for (int k8 = 0; k8 < 8; ++k8) qf[k8] = *(const bf16x8*)(P + qrow * NQKV + hq * 128 + 16 * k8 + 8 * hh);
        f32x16 OT[4];
#pragma unroll
        for (int db = 0; db < 4; ++db)
#pragma unroll
            for (int r = 0; r < 16; ++r) OT[db][r] = 0.f;
        float m = sink[hq] * L2E, lsum = hh == 0 ? 1.0f : 0.0f;
        v4u krA[2], vrA[2], krB[2], vrB[2];
#define ATT_LOAD(t_, kr_, vr_) do { const int t__ = (t_); const bool wt_ = t__ < nwin; const int kp0_ = qb * 64 - 128 + 64 * (i_lo + t__), ct_ = t__ - nwin; \
            const size_t krow0_ = wt_ ? (size_t)b * SEQ + kp0_ : (size_t)M_LAT + b * CTXL + 64 * ct_; const int vcol0_ = wt_ ? kp0_ : SEQ + 64 * ct_; \
            _Pragma("unroll") for (int i_ = 0; i_ < 2; ++i_) { const int p_ = w.tid + 512 * i_; \
                kr_[i_] = *(const v4u*)(P + (krow0_ + (p_ >> 4)) * NQKV + 2048 + kvh * 128 + 8 * (p_ & 15)); \
                vr_[i_] = *(const v4u*)(VTA + ((size_t)(b * 4 + kvh) * 128 + (p_ >> 3)) * 4352 + vcol0_ + 8 * (p_ & 7)); } } while (0)
#define ATT_STORE(buf_, kr_, vr_) do { _Pragma("unroll") for (int i_ = 0; i_ < 2; ++i_) { const int p_ = w.tid + 512 * i_; \
                *(LAS v4u*)(KL + (buf_) * (64 * 136) + (p_ >> 4) * 136 + 8 * (p_ & 15)) = kr_[i_]; \
                LAS v2u* vp_ = (LAS v2u*)(VL + (buf_) * (128 * 68) + (p_ >> 3) * 68 + 8 * (p_ & 7)); vp_[0] = (v2u){vr_[i_].x, vr_[i_].y}; vp_[1] = (v2u){vr_[i_].z, vr_[i_].w}; } } while (0)
#define ATT_BAR() do { asm volatile("s_waitcnt lgkmcnt(0)" ::: "memory"); __builtin_amdgcn_s_barrier(); asm volatile("" ::: "memory"); } while (0)
#define ATT_COMPUTE(t_) do { const int t = (t_); \
            const LAS bf16* kl = KL + (t & 1) * (64 * 136); const LAS bf16* vl = VL + (t & 1) * (128 * 68); \
            f32x16 sacc[2]; \
            _Pragma("unroll") for (int kb = 0; kb < 2; ++kb) { \
                _Pragma("unroll") for (int r = 0; r < 16; ++r) sacc[kb][r] = 0.f; \
                _Pragma("unroll") for (int k8 = 0; k8 < 8; ++k8) { const bf16x8 a = *(const LAS bf16x8*)(kl + (32 * kb + r32) * 136 + 16 * k8 + 8 * hh); sacc[kb] = __builtin_amdgcn_mfma_f32_32x32x16_bf16(a, qf[k8], sacc[kb], 0, 0, 0); } } \
            const bool wt = t < nwin; const int kp0 = qb * 64 - 128 + 64 * (i_lo + t); \
            float mx = -INFINITY; \
            _Pragma("unroll") for (int kb = 0; kb < 2; ++kb) \
                _Pragma("unroll") for (int r = 0; r < 16; ++r) { float sv = sacc[kb][r] * C2; \
                    if (wt) { const int dlt = kp0 + 32 * kb + (r & 3) + 8 * (r >> 2) + 4 * hh - tq; if (dlt > 128 || dlt < -128) sv = -INFINITY; } \
                    sacc[kb][r] = sv; mx = fmaxf(mx, sv); } \
            mx = fmaxf(mx, __shfl_xor(mx, 32)); \
            const float mn = fmaxf(m, mx), alpha = __builtin_amdgcn_exp2f(m - mn); m = mn; \
            float ps = 0.f; \
            _Pragma("unroll") for (int kb = 0; kb < 2; ++kb) \
                _Pragma("unroll") for (int r = 0; r < 16; ++r) { const float pv = __builtin_amdgcn_exp2f(sacc[kb][r] - mn); ps += pv; sacc[kb][r] = pv; } \
            lsum = lsum * alpha + ps; \
            _Pragma("unroll") for (int db = 0; db < 4; ++db) \
                _Pragma("unroll") for (int r = 0; r < 16; ++r) OT[db][r] *= alpha; \
            _Pragma("unroll") for (int kb = 0; kb < 2; ++kb) \
                _Pragma("unroll") for (int sh = 0; sh < 2; ++sh) { \
                    v4u pw; pw.x = pk2(sacc[kb][8 * sh], sacc[kb][8 * sh + 1]); pw.y = pk2(sacc[kb][8 * sh + 2], sacc[kb][8 * sh + 3]); \
                    pw.z = pk2(sacc[kb][8 * sh + 4], sacc[kb][8 * sh + 5]); pw.w = pk2(sacc[kb][8 * sh + 6], sacc[kb][8 * sh + 7]); \
                    const bf16x8 pf = __builtin_bit_cast(bf16x8, pw); \
                    _Pragma("unroll") for (int db = 0; db < 4; ++db) { const LAS bf16* vp = vl + (32 * db + r32) * 68 + 32 * kb + 16 * sh + 4 * hh; \
                        const v2u lo = *(const LAS v2u*)vp, hi = *(const LAS v2u*)(vp + 8); \
                        const bf16x8 vf = __builtin_bit_cast(bf16x8, ((v4u){lo.x, lo.y, hi.x, hi.y})); \
                        OT[db] = __builtin_amdgcn_mfma_f32_32x32x16_bf16(vf, pf, OT[db], 0, 0, 0); } } } while (0)
        __syncthreads();
        ATT_LOAD(0, krA, vrA); ATT_STORE(0, krA, vrA);
        ATT_LOAD(1, krB, vrB);
        ATT_BAR();
        for (int t2 = 0; t2 < T; t2 += 2) {
            if (t2 + 2 < T) ATT_LOAD(t2 + 2, krA, vrA);
            ATT_COMPUTE(t2);
            if (t2 + 1 < T) ATT_STORE(1, krB, vrB);
            ATT_BAR();
            if (t2 + 1 < T) {
                if (t2 + 3 < T) ATT_LOAD(t2 + 3, krB, vrB);
                ATT_COMPUTE(t2 + 1);
                if (t2 + 2 < T) ATT_STORE(0, krA, vrA);
                ATT_BAR();
            }
        }
#undef ATT_LOAD
#undef ATT_STORE
#undef ATT_BAR
#undef ATT_COMPUTE
        const float l = lsum + __shfl_xor(lsum, 32), rl = 1.0f / l;
        bf16* op = O + qrow * DM + hq * 128 + 4 * hh;
#pragma unroll
        for (int db = 0; db < 4; ++db)
#pragma unroll
            for (int g4 = 0; g4 < 4; ++g4) { v2u o; o.x = pk2(OT[db][4 * g4] * rl, OT[db][4 * g4 + 1] * rl); o.y = pk2(OT[db][4 * g4 + 2] * rl, OT[db][4 * g4 + 3] * rl);
                *(v2u*)(op + 32 * db + 8 * g4) = o; }
    }
}

__device__ __forceinline__ void conv_rows(const WV& w, const bf16* U, const float* cw, const float* cb, bf16* ACT, int nrows) {
    const int nseg = nrows / 32;
    for (int wi = w.gw; wi < nseg * 11; wi += w.NGW) {
        const int seg = wi / 11, cg = wi % 11, r0 = seg * 32, f = (cg * 64 + w.lane) * 8;
        float wg[3][8], wv[3][8], bg[8], bv[8];
#pragma unroll
        for (int j = 0; j < 3; ++j)
#pragma unroll
            for (int e = 0; e < 8; ++e) { wg[j][e] = cw[j * DFF2 + f + e]; wv[j][e] = cw[j * DFF2 + DFF + f + e]; }
#pragma unroll
        for (int e = 0; e < 8; ++e) { bg[e] = cb[f + e]; bv[e] = cb[DFF + f + e]; }
        const bool s_start = r0 < M_LAT ? ((r0 & (SEQ - 1)) == 0) : (((r0 - M_LAT) & (CTXL - 1)) == 0);
        const bool s_end = r0 < M_LAT ? (((r0 + 32) & (SEQ - 1)) == 0) : (((r0 + 32 - M_LAT) & (CTXL - 1)) == 0);
        const v4u zero4 = (v4u){0u, 0u, 0u, 0u};
        v4u pg = s_start ? zero4 : *(const v4u*)(U + (size_t)(r0 - 1) * DFF2 + f), pv = s_start ? zero4 : *(const v4u*)(U + (size_t)(r0 - 1) * DFF2 + DFF + f);
        v4u cg4 = *(const v4u*)(U + (size_t)r0 * DFF2 + f), cv4 = *(const v4u*)(U + (size_t)r0 * DFF2 + DFF + f);
        for (int r = 0; r < 32; ++r) {
            const bool nz = (r == 31) && s_end;
            const v4u ng = nz ? zero4 : *(const v4u*)(U + (size_t)(r0 + r + 1) * DFF2 + f), nv = nz ? zero4 : *(const v4u*)(U + (size_t)(r0 + r + 1) * DFF2 + DFF + f);
            float a[8], c[8], n[8], gate[8], val[8];
            unpack8(pg, a); unpack8(cg4, c); unpack8(ng, n);
#pragma unroll
            for (int e = 0; e < 8; ++e) gate[e] = bg[e] + wg[0][e] * a[e] + wg[1][e] * c[e] + wg[2][e] * n[e];
            unpack8(pv, a); unpack8(cv4, c); unpack8(nv, n);
#pragma unroll
            for (int e = 0; e < 8; ++e) val[e] = bv[e] + wv[0][e] * a[e] + wv[1][e] * c[e] + wv[2][e] * n[e];
            v4u ov; ov.x = pk2(silu_f(gate[0]) * val[0], silu_f(gate[1]) * val[1]); ov.y = pk2(silu_f(gate[2]) * val[2], silu_f(gate[3]) * val[3]);
            ov.z = pk2(silu_f(gate[4]) * val[4], silu_f(gate[5]) * val[5]); ov.w = pk2(silu_f(gate[6]) * val[6], silu_f(gate[7]) * val[7]);
            *(v4u*)(ACT + (size_t)(r0 + r) * DFF + f) = ov;
            pg = cg4; pv = cv4; cg4 = ng; cv4 = nv;
        }
    }
}

__device__ __forceinline__ void conv_fixup(const WV& w, const float* UB, const float* cw, const float* cb, bf16* ACT, int npanels) {
    const int ntask = npanels * 2 * (DFF / 4);
    for (int task = w.gw * 64 + w.lane; task < ntask; task += w.NGW * 64) {
        const int f4 = task % (DFF / 4), pe = task / (DFF / 4), edge = pe & 1, pm = pe >> 1, F = 4 * f4;
        const bool first = pm >= 64 || (pm & 15) == 0, lastp = pm >= 64 || (pm & 15) == 15;
        f32x4 o[2];
#pragma unroll
        for (int bj = 0; bj < 2; ++bj) { const size_t col = (size_t)bj * DFF + F; const float* U0 = UB + (size_t)(pm * 4) * DFF2 + col; const f32x4 z = (f32x4){0.f, 0.f, 0.f, 0.f};
            const f32x4 cur = *(const f32x4*)(U0 + (edge ? 3 : 0) * (size_t)DFF2);
            const f32x4 pv = edge ? *(const f32x4*)(U0 + 2 * (size_t)DFF2) : (first ? z : *(const f32x4*)(UB + (size_t)((pm - 1) * 4 + 3) * DFF2 + col));
            const f32x4 nx = edge ? (lastp ? z : *(const f32x4*)(UB + (size_t)((pm + 1) * 4) * DFF2 + col)) : *(const f32x4*)(U0 + (size_t)DFF2);
            o[bj] = *(const f32x4*)(cb + col) + *(const f32x4*)(cw + col) * pv + *(const f32x4*)(cw + DFF2 + col) * cur + *(const f32x4*)(cw + 2 * DFF2 + col) * nx; }
        v2u ov; ov.x = pk2(silu_f(o[0].x) * o[1].x, silu_f(o[0].y) * o[1].y); ov.y = pk2(silu_f(o[0].z) * o[1].z, silu_f(o[0].w) * o[1].w);
        *(v2u*)(ACT + (size_t)(pm * 256 + (edge ? 255 : 0)) * DFF + F) = ov;
    }
}

__device__ __forceinline__ int layer_items(int L) { return 11264 + 5632 + ((L & 1) ? 6144 + 2048 : 3072 + 2048); }
__device__ __forceinline__ void convert_layer_items(const WV& w, const Args& args, unsigned char* ws, int L, int i0, int i1, int rank, int nranks) {
    LAS float* scr = (LAS float*)(w.lds + w.wave * 16384);
    const int j = L >> 1;
    for (int it = i0 + rank * 8 + w.wave; it < i1; it += nranks * 8) {
        int r = it;
        if (r < 11264) { p0_transpose_item(args.in[8] + (size_t)L * DM * DFF2, DM, DFF2, (bf16*)(ws + WS_WUP + L * WUP_STRIDE), 0, scr, r, w.lane, FUSE_CONV != 0); continue; } r -= 11264;
        if (r < 5632) { p0_transpose_item(args.in[11] + (size_t)L * DFF * DM, DFF, DM, (bf16*)(ws + WS_WDN + L * WDN_STRIDE), 0, scr, r, w.lane, false); continue; } r -= 5632;
        if (L & 1) {
            if (r < 6144) { p0_transpose_item(args.in[15] + (size_t)j * DM * NGLA, DM, NGLA, (bf16*)(ws + WS_WGIN + j * WGIN_STRIDE), 0, scr, r, w.lane, false); continue; } r -= 6144;
            p0_transpose_item(args.in[23] + (size_t)j * DM * DM, DM, DM, (bf16*)(ws + WS_WGO + j * WO_STRIDE), 0, scr, r, w.lane, false);
        } else {
            if (r < 3072) { p0_transpose_item(args.in[12] + (size_t)j * DM * NQKV, DM, NQKV, (bf16*)(ws + WS_WQKV + j * WQKV_STRIDE), 0, scr, r, w.lane, false); continue; } r -= 3072;
            p0_transpose_item(args.in[14] + (size_t)j * DM * DM, DM, DM, (bf16*)(ws + WS_WAO + j * WO_STRIDE), 0, scr, r, w.lane, false);
        }
    }
}
__device__ __forceinline__ void tail_convert(const WV& w, const Args& args, unsigned char* ws, int nwg, int L, int i0, int i1) {
    const int c = (int)blockIdx.x, rem = nwg % w.G;
    if (rem == 0) convert_layer_items(w, args, ws, L, i0, i1, c, w.G);
    else if (c >= rem) convert_layer_items(w, args, ws, L, i0, i1, c - rem, w.G - rem);
}

__global__ void __launch_bounds__(512, 2) mega(Args args) {
    extern __shared__ __attribute__((aligned(16))) unsigned char lds_raw[];
    LAS unsigned char* const lds0 = (LAS unsigned char*)lds_raw;
    for (int u = threadIdx.x; u < (LDS_BYTES - LDSCTL_OFF) / 4; u += 512) ((LAS unsigned*)(lds0 + LDSCTL_OFF))[u] = 0u;
    __syncthreads();
    XcdBarrier bar; bar.bar = (unsigned*)(args.ws + WS_CTL) + CW_BAR; bar.x = 0; bar.st = nullptr;
    if (MK_ONE_LAUNCH) bar = xcd_barrier_post((unsigned*)(args.ws + WS_CTL) + CW_BAR, (volatile LAS unsigned*)(lds0 + LDSCTL_OFF + 32));
#define PHASE_ENTER() int tid_l = threadIdx.x; asm volatile("" : "+v"(tid_l)); unsigned char* ws = args.ws; asm volatile("" : "+s"(ws)); WV w; w.lds = lds0; w.tid = tid_l; w.lane = tid_l & 63; \
    w.wave = __builtin_amdgcn_readfirstlane(tid_l >> 6); w.G = gridDim.x; { const int bx = blockIdx.x; w.vcu = (w.G % 8 == 0) ? (bx % 8) * (w.G / 8) + bx / 8 : bx; } w.gw = w.vcu * 8 + w.wave; w.NGW = w.G * 8; \
    bf16* X = (bf16*)(ws + WS_X); bf16* H = (bf16*)(ws + WS_H); bf16* P = (bf16*)(ws + WS_P); float* Z1 = (float*)(ws + WS_Z1); bf16* OMIX = (bf16*)(ws + WS_OMIX); bf16* U = (bf16*)(ws + WS_U); \
    bf16* ACT = (bf16*)(ws + WS_ACT); float* MODS = (float*)(ws + WS_MODS); float* OF = (float*)(ws + WS_OF); float* OB = (float*)(ws + WS_OB); \
    (void)X; (void)H; (void)P; (void)Z1; (void)OMIX; (void)U; (void)ACT; (void)MODS; (void)OF; (void)OB; (void)w
    const int lo = args.ph_lo, hi = args.ph_hi;
#define RUN(k) (lo <= (k) && (k) < hi)
#define SEAM(k) do { if (MK_ONE_LAUNCH && RUN(k) && RUN((k) + 1)) { unsigned long long tb0_ = 0; if (DIAG_BAR) tb0_ = __builtin_amdgcn_s_memrealtime(); xcd_barrier(bar); \
        if (DIAG_BAR && blockIdx.x == (DIAG_BAR == 1 ? 0 : 100) && threadIdx.x == 0) { volatile LAS unsigned* dgl_ = (volatile LAS unsigned*)(lds0 + LDSCTL_OFF + 256); dgl_[4] += (unsigned)(__builtin_amdgcn_s_memrealtime() - tb0_); } } } while (0)

    for (int rep = 0; rep < RPT_PRO; ++rep) if (RUN(0)) {
        PHASE_ENTER();
        for (int it = w.vcu; it < ((TAIL_MODS && SPLITK_DN) ? 64 : 4 * 64); it += w.G) mods_item(w, args.in[1], args.in[3], args.in[4], args.in[5], MODS, it);
        for (int L = 0; L < (TAIL_CONVERT ? 1 : DEPTH); ++L) convert_layer_items(w, args, ws, L, 0, layer_items(L), w.vcu, w.G);
        for (int j = 0; j < 2; ++j) {
            bf16* wg = (bf16*)(ws + WS_WGIN + j * WGIN_STRIDE) + (size_t)NGLA * DM;
            const float* f1 = args.in[16] + (size_t)j * DM * 16; const float* b1 = args.in[19] + (size_t)j * DM * 16;
            for (int idx = w.gw * 64 + w.lane; idx < 256 * DM; idx += w.NGW * 64) { const int n = idx >> 11, k = idx & 2047;
                const float v = n < 16 ? f1[k * 16 + n] : (n < 32 ? b1[k * 16 + (n - 16)] : 0.f); wg[idx] = (bf16)f2bf(v); }
        }
    }
    SEAM(0);
    if (MK_ONE_LAUNCH && RUN(0) && RUN(1)) for (int eb = 0; eb < EXTRA_BAR; ++eb) xcd_barrier(bar);

    for (int l = 0; l < DEPTH; ++l) {
        const int base = 1 + 10 * l, j = l >> 1; const bool gla = (l & 1) != 0, last = (l == DEPTH - 1);
        const size_t mods_off = (size_t)l * 5 * NMOD;
        const int mrows = last ? M_LAT : M_ALL;
        for (int rep = 0; rep < RPT_NORM; ++rep) if (RUN(base + 0)) { PHASE_ENTER(); const float* mods_l = MODS + mods_off; norm_rows(w, X, H, args.in[6] + l * DM, mods_l + 0 * DM, mods_l + 1 * DM, M_ALL, (const float*)(ws + WS_PART), (SPLITK_DN && l > 0) ? 4 : 0, MODS + (mods_off - 5 * NMOD) + 4 * NMOD + 5 * DM, l == 0 ? args.in[0] : nullptr, l == 0 ? args.in[2] : nullptr); }
        SEAM(base + 0);
        for (int rep = 0; rep < RPT_PROJ; ++rep) if (RUN(base + 1)) {
            PHASE_ENTER();
            pg8::Gemm g{H, gla ? (const bf16*)(ws + WS_WGIN + j * WGIN_STRIDE) : (const bf16*)(ws + WS_WQKV + j * WQKV_STRIDE), M_ALL, gla ? NGLA_EXT : NQKV, DM, DM};
            pg8::StaticOrder S; S.init(g.M, g.N, w.G, (int)blockIdx.x);
            pg8::EpiStoreBf16 E{P, gla ? NGLA : NQKV, gla ? NGLA : (1 << 30), Z1};
            pg8::gemm_phase<pg8::EpiStoreBf16, pg8::StaticOrder, true, true>(w.lds, g, S, E);
            if (TAIL_CONVERT && !last) { const int NI = layer_items(l + 1), ia = gla ? (NI * 23) / 100 : (NI * 40) / 100; tail_convert(w, args, ws, S.nwg, l + 1, 0, ia); }
        }
        SEAM(base + 1);
        if (RUN(base + 2)) {
            PHASE_ENTER();
            if (!gla) { rope_rows(w, P); if (RPT_ROPE) { rope_rows(w, P, -1.0f); rope_rows(w, P); }
#if !NAIVE_ATTN
                for (int rep3 = 0; rep3 < RPT_AVT; ++rep3) attn_vt(w, P, (bf16*)(ws + WS_VTA));
#endif
            }
#if !NAIVE_GLA
            else for (int rep2 = 0; rep2 < RPT_GPRE; ++rep2) { gla_pre(w, P, Z1, args.in[17] + (size_t)j * 16 * 1024, args.in[18] + j * 1024, args.in[20] + (size_t)j * 16 * 1024, args.in[21] + j * 1024,
                           (bf16*)(ws + WS_QT), (bf16*)(ws + WS_KHT), (bf16*)(ws + WS_AIN), (float*)(ws + WS_DEC));
                   gla_vt(w, P, (bf16*)(ws + WS_VT)); }
#endif
        }
        if (!gla || !NAIVE_GLA) SEAM(base + 2);
        for (int rep = 0; rep < (gla ? RPT_SCAN : RPT_ATT); ++rep) if (RUN(base + 3)) {
            PHASE_ENTER();
#if NAIVE_ATTN
            if (!gla) attn_naive(w, P, args.in[13] + j * 16, OMIX);
#else
            if (!gla) attn_fast(w, P, (const bf16*)(ws + WS_VTA), args.in[13] + j * 16, OMIX);
#endif
#if NAIVE_GLA
            else gla_naive(w, P, Z1, args.in[17] + (size_t)j * 16 * 1024, args.in[18] + j * 1024, args.in[20] + (size_t)j * 16 * 1024, args.in[21] + j * 1024, OF, OB);
#else
            else gla_scan(w, (const bf16*)(ws + WS_QT), (const bf16*)(ws + WS_KHT), (const bf16*)(ws + WS_AIN), (const float*)(ws + WS_DEC), (const bf16*)(ws + WS_VT), (bf16*)(ws + WS_OFB), (bf16*)(ws + WS_OBB));
#endif
        }
        SEAM(base + 3);
#if NAIVE_GLA
        if (RUN(base + 4)) { if (gla) { PHASE_ENTER(); gla_combine(w, OF, OB, P, args.in[22] + j * 512, OMIX, mrows); } }
#else
        for (int rep = 0; rep < RPT_COMB; ++rep) if (RUN(base + 4)) { if (gla) { PHASE_ENTER(); gla_combine_bf(w, (const bf16*)(ws + WS_OFB), (const bf16*)(ws + WS_OBB), P, args.in[22] + j * 512, OMIX, mrows); } }
#endif
        if (gla) SEAM(base + 4);
        if (RUN(base + 5)) {
            PHASE_ENTER();
            pg8::Gemm g{OMIX, gla ? (const bf16*)(ws + WS_WGO + j * WO_STRIDE) : (const bf16*)(ws + WS_WAO + j * WO_STRIDE), SPLITK_WO ? M_LAT : mrows, DM, DM, DM};
            pg8::StaticOrder S; S.init(g.M, g.N, w.G, (int)blockIdx.x);
            pg8::EpiResid E{X, DM, MODS + mods_off + 2 * DM, l == 0 ? args.in[0] : nullptr, l == 0 ? args.in[2] : nullptr};
            pg8::gemm_phase<pg8::EpiResid, pg8::StaticOrder, true, true>(w.lds, g, S, E);
            if (TAIL_CONVERT && !last) { const int NI = layer_items(l + 1), ia = gla ? (NI * 23) / 100 : (NI * 40) / 100, ib = gla ? (NI * 80) / 100 : (NI * 84) / 100; tail_convert(w, args, ws, S.nwg, l + 1, ia, ib); }
            if (SPLITK_WO && !last) {
                pg8::Gemm g2{OMIX + (size_t)M_LAT * DM, g.Bt, M_CTX, DM, DM, 256};
                pg8::SplitKOrder S2; S2.init(M_CTX, DM, 8, 256, w.G, (int)blockIdx.x);
                pg8::EpiPartial E2{(float*)(ws + WS_PART), DM, 256, (size_t)M_CTX * DM};
                pg8::gemm_phase<pg8::EpiPartial, pg8::SplitKOrder, true, true>(w.lds, g2, S2, E2);
            }
        }
        SEAM(base + 5);
        for (int rep = 0; rep < RPT_NORM; ++rep) if (RUN(base + 6)) { PHASE_ENTER(); const float* mods_l = MODS + mods_off; norm_rows(w, X, H, args.in[7] + l * DM, mods_l + 3 * DM, mods_l + 4 * DM, mrows, (const float*)(ws + WS_PART), (!SPLITK_WO || last) ? 0 : 8, mods_l + 4 * NMOD + 2 * DM, nullptr, nullptr); }
        SEAM(base + 6);
        for (int rep = 0; rep < RPT_UP; ++rep) if (RUN(base + 7)) {
            PHASE_ENTER();
            pg8::Gemm g{H, (const bf16*)(ws + WS_WUP + l * WUP_STRIDE), mrows, DFF2, DM, DM};
            pg8::StaticOrder S; S.init(g.M, g.N, w.G, (int)blockIdx.x);
            unsigned long long dc0 = 0, dr0 = 0; if (DIAG_CLK && l == 1) { dc0 = __builtin_readcyclecounter(); dr0 = __builtin_amdgcn_s_memrealtime(); }
#if FUSE_CONV
            pg8::EpiConv E{ACT, args.in[9] + (size_t)l * 3 * DFF2, args.in[10] + (size_t)l * DFF2, (float*)(ws + WS_UB), (PG8_LAS float*)(w.lds + LDSCTL_OFF + 1024), DFF};
            pg8::gemm_phase<pg8::EpiConv, pg8::StaticOrder, true, true>(w.lds, g, S, E);
            if (DIAG_CLK && l == 1 && blockIdx.x == 0 && w.tid == 0) { const unsigned long long dc1 = __builtin_readcyclecounter(), dr1 = __builtin_amdgcn_s_memrealtime(); unsigned long long* dg = (unsigned long long*)(ws + WS_CTL + 65536); dg[4] = dc1 - dc0; dg[5] = dr1 - dr0; }
            if (TAIL_CONVERT && !last) { const int NI = layer_items(l + 1), ib = gla ? (NI * 80) / 100 : (NI * 84) / 100; tail_convert(w, args, ws, S.nwg, l + 1, ib, NI); }
#else
            pg8::EpiStoreBf16 E{U, DFF2, 1 << 30, Z1};
            pg8::gemm_phase<pg8::EpiStoreBf16, pg8::StaticOrder, true, true>(w.lds, g, S, E);
#endif
        }
        SEAM(base + 7);
        for (int rep = 0; rep < RPT_CONV; ++rep) if (RUN(base + 8)) { PHASE_ENTER();
#if FUSE_CONV
            conv_fixup(w, (const float*)(ws + WS_UB), args.in[9] + (size_t)l * 3 * DFF2, args.in[10] + (size_t)l * DFF2, ACT, mrows / 256);
#else
            conv_rows(w, U, args.in[9] + (size_t)l * 3 * DFF2, args.in[10] + (size_t)l * DFF2, ACT, mrows);
#endif
        }
        SEAM(base + 8);
        if (RUN(base + 9)) {
            PHASE_ENTER();
            pg8::Gemm g{ACT, (const bf16*)(ws + WS_WDN + l * WDN_STRIDE), SPLITK_DN ? M_LAT : mrows, DM, DFF, DFF};
            pg8::StaticOrder S; S.init(g.M, g.N, w.G, (int)blockIdx.x);
            pg8::EpiResid E{X, DM, MODS + mods_off + 5 * DM, nullptr, nullptr};
            pg8::gemm_phase<pg8::EpiResid, pg8::StaticOrder, true, true>(w.lds, g, S, E);
            if (SPLITK_DN && !last) {
                pg8::Gemm g2{ACT + (size_t)M_LAT * DFF, g.Bt, M_CTX, DM, DFF, 1408};
                pg8::SplitKOrder S2; S2.init(M_CTX, DM, 4, 1408, w.G, (int)blockIdx.x);
                pg8::EpiPartial E2{(float*)(ws + WS_PART), DM, 1408, (size_t)M_CTX * DM};
                pg8::gemm_phase<pg8::EpiPartial, pg8::SplitKOrder, true, true>(w.lds, g2, S2, E2);
                if (TAIL_MODS && (int)blockIdx.x >= 128) {
                    for (int it = (l + 1) * 64 + ((int)blockIdx.x - 128); it < (l + 2) * 64; it += w.G - 128) mods_item(w, args.in[1], args.in[3], args.in[4], args.in[5], MODS, it);
                }
            }
        }
        SEAM(base + 9);
    }
    if (DIAG_BAR && blockIdx.x == (DIAG_BAR == 1 ? 0 : 100) && threadIdx.x == 0) { *(unsigned*)(args.ws + WS_CTL + 65536 + 64) = ((volatile LAS unsigned*)(lds0 + LDSCTL_OFF + 256))[4]; }
    if (RUN(41)) { PHASE_ENTER(); final_norm(w, X, args.out, args.in[24]);
        if (DIAG_BAR && blockIdx.x == 0 && w.tid == 0) { asm volatile("s_waitcnt vmcnt(0)" ::: "memory"); args.out[0] = (float)(10 * (int)((double)__hip_atomic_load((unsigned*)(ws + WS_CTL + 65536 + 64), __ATOMIC_RELAXED, __HIP_MEMORY_SCOPE_AGENT) / 100.0 / 100.0 + 0.5)); }
        if (DIAG_CLK && blockIdx.x == 0 && w.tid == 0) { asm volatile("s_waitcnt vmcnt(0)" ::: "memory"); const unsigned long long* dg = (const unsigned long long*)(ws + WS_CTL + 65536); args.out[0] = DIAG_CLK == 1 ? (float)(int)((double)dg[4] / (double)dg[5] + 0.5) : (float)(10 * (int)((double)dg[5] / 100.0 / 12.0 / 10.0 + 0.5)); }
        if (DIAG_SCAN && blockIdx.x == 0 && w.tid == 0) { asm volatile("s_waitcnt vmcnt(0)" ::: "memory"); const unsigned long long* dg = (const unsigned long long*)(ws + WS_CTL + 65536);
            const double a = (double)dg[0], b = (double)dg[1], c = (double)dg[2], tot = a + b + c; int d1 = (int)(10.0 * a / tot), d2 = (int)(10.0 * b / tot); if (d1 < 1) d1 = 1; if (d2 < 0) d2 = 0;
            args.out[0] = (float)(DIAG_SCAN == 1 ? 10 * d1 + d2 : (DIAG_SCAN == 2 ? tot / 68.0 / 2.0 / 10.0 : 0)); } }
#undef RUN
#undef SEAM
}

extern "C" void kernel_launch(void* const* d_in, const int* in_sizes, int n_in, void* d_out, int out_size, void* d_ws, size_t ws_size, hipStream_t stream) {
    static int grid = 0;
    if (grid == 0) {
        if (n_in != 25 || out_size != M_LAT * DM || ws_size < WS_END) { fprintf(stderr, "kernel_launch: unexpected shapes (n_in %d, out %d, ws %zu < %zu); nothing launched\n", n_in, out_size, ws_size, (size_t)WS_END); grid = -1; return; }
        int dev = 0, cus = 0, per_cu = 0;
        if (hipGetDevice(&dev) != hipSuccess || hipDeviceGetAttribute(&cus, hipDeviceAttributeMultiprocessorCount, dev) != hipSuccess) { grid = -1; return; }
        if (hipFuncSetAttribute((const void*)mega, hipFuncAttributeMaxDynamicSharedMemorySize, LDS_BYTES) != hipSuccess) { fprintf(stderr, "kernel_launch: hipFuncSetAttribute failed\n"); grid = -1; return; }
        if (hipOccupancyMaxActiveBlocksPerMultiprocessor(&per_cu, (const void*)mega, 512, LDS_BYTES) != hipSuccess || per_cu < 1)
            fprintf(stderr, "kernel_launch: occupancy query reports %d workgroups per CU\n", per_cu);
        (void)hipGetLastError();
        grid = cus;
    }
    if (grid < 0) return;
    if (hipMemsetAsync((char*)d_ws + WS_CTL, 0, CTL_ZERO_BYTES, stream) != hipSuccess) return;
    Args a{};
    for (int i = 0; i < 25; ++i) a.in[i] = (const float*)d_in[i];
    a.out = (float*)d_out; a.ws = (unsigned char*)d_ws;
#if MK_ONE_LAUNCH
    a.ph_lo = 0; a.ph_hi = NPH;
    hipLaunchKernelGGL(mega, dim3(grid), dim3(512), LDS_BYTES, stream, a);
#else
    for (int ph = 0; ph < NPH; ++ph) {
        if (ph >= 1 && ph <= 40) { const int l = (ph - 1) / 10, s = (ph - 1) % 10; if ((s == 2 && (l & 1) && NAIVE_GLA) || (s == 4 && !(l & 1))) continue; }
        a.ph_lo = ph; a.ph_hi = ph + 1;
        hipLaunchKernelGGL(mega, dim3(grid), dim3(512), LDS_BYTES, stream, a);
    }
#endif
}
```

```cpp
#include <hip/hip_runtime.h>
#include <cstdio>
#include <cstdint>
namespace pg8 {
#define PG8_LAS __attribute__((address_space(3)))
typedef unsigned short bf16_t;
typedef short bf16x8 __attribute__((ext_vector_type(8)));
typedef float f32x4 __attribute__((ext_vector_type(4)));
typedef unsigned u32x4 __attribute__((ext_vector_type(4)));
constexpr int BM = 256, BK = 64, HALF = 128, HTB = HALF * BK * 2  , STAGE_BYTES = 8 * HTB, NXCD = 8, WGM = 8;

__host__ __device__ __forceinline__ int lds_byte(int r, int c) { const int st = (r >> 4) * 2 + (c >> 5), rr = r & 15, cc = c & 31, ob = rr * 64 + cc * 2; return st * 1024 + (ob ^ (((ob >> 9) & 1) << 5)); }
__host__ __device__ __forceinline__ void stage_rc(int b, int& R, int& C) { const int st = b / 1024, sb = b % 1024, swz = sb ^ (((sb >> 9) & 1) << 5); R = (st >> 1) * 16 + swz / 64; C = (st & 1) * 32 + (swz % 64) / 2; }
__host__ __device__ __forceinline__ int perm32(int rho) { const int n = rho >> 4, i = rho & 15; return 8 * (i >> 2) + 4 * n + (i & 3); }

struct Unit { int pm, pn, kofs; };
struct Gemm { const bf16_t* A; const bf16_t* Bt; int M, N, K, kloop; };

struct StaticOrder {
    int nM, nN, nwg, G, c;
    __host__ __device__ void init(int M, int N, int G_, int c_) { nM = M / BM; nN = N / BM; nwg = nM * nN; G = G_; c = c_; }
    __host__ __device__ bool next(int i, Unit& u) const {
        const long L = (long)i * G + c; if (L >= nwg) return false;
        int wgid = (int)L; { const int q = nwg / NXCD, r = nwg % NXCD, xcd = wgid % NXCD, off = wgid / NXCD; wgid = (xcd < r ? xcd * (q + 1) : r * (q + 1) + (xcd - r) * q) + off; }
        const int nig = WGM * nN, gid = wgid / nig, fm = gid * WGM, gsz = (nM - fm) < WGM ? (nM - fm) : WGM;
        u.pm = fm + ((wgid % nig) % gsz); u.pn = (wgid % nig) / gsz; u.kofs = 0; return true;
    }
    __device__ __forceinline__ void a_ready(const Unit&) const {}
    __device__ __forceinline__ void done(const Unit&) const {}
};

struct SplitKOrder {
    int nN, nunits, nsplit, kloop, G, c;
    __host__ __device__ void init(int M, int N, int nsplit_, int kloop_, int G_, int c_) { nN = N / BM; nunits = (M / BM) * nN * nsplit_; nsplit = nsplit_; kloop = kloop_; G = G_; c = c_; }
    __host__ __device__ bool next(int i, Unit& u) const { const long L = (long)i * G + c; if (L >= nunits) return false; const int t = (int)L / nsplit, ks = (int)L % nsplit; u.pm = t / nN; u.pn = t % nN; u.kofs = ks * kloop; return true; }
    __device__ __forceinline__ void a_ready(const Unit&) const {}
    __device__ __forceinline__ void done(const Unit&) const {}
};
typedef __bf16 bf16x2_hw __attribute__((ext_vector_type(2)));
typedef float f32x2_hw __attribute__((ext_vector_type(2)));
__device__ __forceinline__ unsigned cvt_pk_bf16(float lo, float hi) { const f32x2_hw v = {lo, hi}; return __builtin_bit_cast(unsigned, __builtin_convertvector(v, bf16x2_hw)); }
typedef float f32x2 __attribute__((ext_vector_type(2)));
typedef _Float16 f16x2_hw __attribute__((ext_vector_type(2)));
__device__ __forceinline__ unsigned cvt_pk_f16(float lo, float hi) { const f32x2_hw v = {lo, hi}; return __builtin_bit_cast(unsigned, __builtin_convertvector(v, f16x2_hw)); }
__device__ __forceinline__ float f16_lo(unsigned w) { return (float)__builtin_bit_cast(f16x2_hw, w)[0]; }
__device__ __forceinline__ float f16_hi(unsigned w) { return (float)__builtin_bit_cast(f16x2_hw, w)[1]; }

struct EpiStoreBf16 {
    static constexpr bool PERM = true, AFTER_DRAIN = false;
    bf16_t* O; int ldc; int zcol0; float* Z;
    __device__ __forceinline__ void operator()(const f32x4 (&acc)[2][2][4][2], const Unit& u, int wr, int wc, int fr, int fq) const {
        const int row0 = u.pm * BM + wr * 64 + fr; const int colt = u.pn * BM;
        if (colt >= zcol0) {
            if (wc == 0) {
#pragma unroll
                for (int ai = 0; ai < 2; ++ai)
#pragma unroll
                    for (int m = 0; m < 4; ++m) { float* zp = Z + (size_t)(row0 + ai * HALF + m * 16) * 32 + 8 * fq;
                        *(f32x4*)(zp) = acc[ai][0][m][0]; *(f32x4*)(zp + 4) = acc[ai][0][m][1]; }
            }
            return;
        }
        const int col0 = colt + wc * 32 + 8 * fq;
#pragma unroll
        for (int ai = 0; ai < 2; ++ai)
#pragma unroll
            for (int m = 0; m < 4; ++m) { bf16_t* rowp = O + (size_t)(row0 + ai * HALF + m * 16) * ldc + col0;
#pragma unroll
                for (int bj = 0; bj < 2; ++bj) { const f32x4 v0 = acc[ai][bj][m][0], v1 = acc[ai][bj][m][1];
                    u32x4 w; w.x = cvt_pk_bf16(v0[0], v0[1]); w.y = cvt_pk_bf16(v0[2], v0[3]); w.z = cvt_pk_bf16(v1[0], v1[1]); w.w = cvt_pk_bf16(v1[2], v1[3]);
                    *(u32x4*)(rowp + bj * HALF) = w; } }
    }
};
struct EpiResid {
    static constexpr bool PERM = true, AFTER_DRAIN = false;
    bf16_t* X; int ldc; const float* gate;
    const float* in_lat; const float* in_ctx;
    __device__ __forceinline__ void operator()(const f32x4 (&acc)[2][2][4][2], const Unit& u, int wr, int wc, int fr, int fq) const {
        const int row0 = u.pm * BM + wr * 64 + fr, col0 = u.pn * BM + wc * 32 + 8 * fq;
        const int vec = u.pm < 64 ? (u.pm >> 4) : 4;
        const float* g = gate + (size_t)vec * 12288 + col0;
        f32x4 gv[2][2];
#pragma unroll
        for (int bj = 0; bj < 2; ++bj)
#pragma unroll
            for (int n = 0; n < 2; ++n) gv[bj][n] = *(const f32x4*)(g + bj * HALF + 4 * n);
#pragma unroll
        for (int ai = 0; ai < 2; ++ai)
#pragma unroll
            for (int m = 0; m < 4; ++m) { const size_t r = (size_t)(row0 + ai * HALF + m * 16); bf16_t* rowp = X + r * ldc + col0;
#pragma unroll
                for (int bj = 0; bj < 2; ++bj) { f32x4 x0, x1;
                    if (in_lat) { const float* s = (u.pm < 64 ? in_lat + r * ldc : in_ctx + (r - 16384) * ldc) + col0 + bj * HALF; x0 = *(const f32x4*)s; x1 = *(const f32x4*)(s + 4); }
                    else { const u32x4 q = *(const u32x4*)(rowp + bj * HALF);
                        x0 = (f32x4){f16_lo(q.x), f16_hi(q.x), f16_lo(q.y), f16_hi(q.y)}; x1 = (f32x4){f16_lo(q.z), f16_hi(q.z), f16_lo(q.w), f16_hi(q.w)}; }
                    x0 += gv[bj][0] * acc[ai][bj][m][0]; x1 += gv[bj][1] * acc[ai][bj][m][1];
                    u32x4 w4; w4.x = cvt_pk_f16(x0[0], x0[1]); w4.y = cvt_pk_f16(x0[2], x0[3]); w4.z = cvt_pk_f16(x1[0], x1[1]); w4.w = cvt_pk_f16(x1[2], x1[3]);
                    *(u32x4*)(rowp + bj * HALF) = w4; } }
    }
};
struct EpiPartial {
    static constexpr bool PERM = false, AFTER_DRAIN = false;
    float* PART; int ldc; int kloop; size_t slab;
    __device__ __forceinline__ void operator()(const f32x4 (&acc)[2][2][4][2], const Unit& u, int wr, int wc, int fr, int fq) const {
        const int row0 = u.pm * BM + wr * 64 + fr, col0 = u.pn * BM + wc * 32 + 4 * fq;
        float* base = PART + (size_t)(u.kofs / kloop) * slab;
#pragma unroll
        for (int ai = 0; ai < 2; ++ai)
#pragma unroll
            for (int m = 0; m < 4; ++m) { float* rowp = base + (size_t)(row0 + ai * HALF + m * 16) * ldc + col0;
#pragma unroll
                for (int bj = 0; bj < 2; ++bj)
#pragma unroll
                    for (int n = 0; n < 2; ++n) *(f32x4*)(rowp + bj * HALF + n * 16) = acc[ai][bj][m][n]; }
    }
};

__device__ __forceinline__ float dpp_prev(float v) { return __builtin_bit_cast(float, __builtin_amdgcn_update_dpp(0, __builtin_bit_cast(int, v), 0x121, 0xf, 0xf, false)); }
__device__ __forceinline__ float dpp_next(float v) { return __builtin_bit_cast(float, __builtin_amdgcn_update_dpp(0, __builtin_bit_cast(int, v), 0x12F, 0xf, 0xf, false)); }
struct EpiConv {
    static constexpr bool PERM = true, AFTER_DRAIN = false;
    bf16_t* ACT; const float* cw; const float* cb; float* UB; PG8_LAS float* xb; int dff;
    __device__ __forceinline__ void operator()(const f32x4 (&acc)[2][2][4][2], const Unit& u, int wr, int wc, int fr, int fq) const {
        const int cl = 32 * wc + 8 * fq, F = 128 * u.pn + cl, dff2 = 2 * dff;
        if (fr == 0 || fr == 15) { const int which = fr == 0 ? 0 : 1, m = fr == 0 ? 0 : 3;
#pragma unroll
            for (int ai = 0; ai < 2; ++ai)
#pragma unroll
                for (int bj = 0; bj < 2; ++bj)
#pragma unroll
                    for (int n = 0; n < 2; ++n) *(PG8_LAS f32x4*)(xb + ((((2 * ai + wr) * 2 + which) * 2 + bj) * 128 + cl + 4 * n)) = acc[ai][bj][m][n]; }
        asm volatile("s_waitcnt lgkmcnt(0)" ::: "memory"); __builtin_amdgcn_s_barrier(); asm volatile("" ::: "memory");
#pragma unroll
        for (int n = 0; n < 2; ++n) {
            f32x4 wgt[2][3], bia[2];
#pragma unroll
            for (int bj = 0; bj < 2; ++bj) { bia[bj] = *(const f32x4*)(cb + bj * dff + F + 4 * n);
#pragma unroll
                for (int j = 0; j < 3; ++j) wgt[bj][j] = *(const f32x4*)(cw + j * dff2 + bj * dff + F + 4 * n); }
#pragma unroll
            for (int ai = 0; ai < 2; ++ai) { const int B = 2 * ai + wr;
#pragma unroll
                for (int m = 0; m < 4; ++m) { f32x4 o[2];
#pragma unroll
                    for (int bj = 0; bj < 2; ++bj) { const f32x4 cur = acc[ai][bj][m][n]; f32x4 sp = cur, sn = cur;
                        if (m > 0) { const f32x4 up = acc[ai][bj][m > 0 ? m - 1 : 0][n]; sp = fr == 15 ? up : cur; }
                        if (m < 3) { const f32x4 dn = acc[ai][bj][m < 3 ? m + 1 : 3][n]; sn = fr == 0 ? dn : cur; }
                        f32x4 pv, nx; pv.x = dpp_prev(sp.x); pv.y = dpp_prev(sp.y); pv.z = dpp_prev(sp.z); pv.w = dpp_prev(sp.w);
                        nx.x = dpp_next(sn.x); nx.y = dpp_next(sn.y); nx.z = dpp_next(sn.z); nx.w = dpp_next(sn.w);
                        if (m == 0) { if (fr == 0 && B > 0) pv = *(const PG8_LAS f32x4*)(xb + (((B - 1) * 2 + 1) * 2 + bj) * 128 + cl + 4 * n); }
                        if (m == 3) { if (fr == 15 && B < 3) nx = *(const PG8_LAS f32x4*)(xb + (((B + 1) * 2 + 0) * 2 + bj) * 128 + cl + 4 * n); }
                        o[bj] = bia[bj] + wgt[bj][0] * pv + wgt[bj][1] * cur + wgt[bj][2] * nx; }
                    f32x4 a;
                    a.x = o[0].x * __builtin_amdgcn_rcpf(1.0f + __builtin_amdgcn_exp2f(-1.4426950408889634f * o[0].x)) * o[1].x;
                    a.y = o[0].y * __builtin_amdgcn_rcpf(1.0f + __builtin_amdgcn_exp2f(-1.4426950408889634f * o[0].y)) * o[1].y;
                    a.z = o[0].z * __builtin_amdgcn_rcpf(1.0f + __builtin_amdgcn_exp2f(-1.4426950408889634f * o[0].z)) * o[1].z;
                    a.w = o[0].w * __builtin_amdgcn_rcpf(1.0f + __builtin_amdgcn_exp2f(-1.4426950408889634f * o[0].w)) * o[1].w;
                    const int rl = 128 * ai + 64 * wr + 16 * m + fr;
                    if (rl != 0 && rl != 255) { typedef unsigned u32x2 __attribute__((ext_vector_type(2))); u32x2 w2; w2.x = cvt_pk_bf16(a.x, a.y); w2.y = cvt_pk_bf16(a.z, a.w);
                        *(u32x2*)(ACT + (size_t)(u.pm * BM + rl) * dff + F + 4 * n) = w2; } } }
            asm volatile("" ::: "memory"); }
        if (wr == 0 && fr < 2) {
#pragma unroll
            for (int bj = 0; bj < 2; ++bj)
#pragma unroll
                for (int n = 0; n < 2; ++n) *(f32x4*)(UB + (size_t)(u.pm * 4 + fr) * dff2 + bj * dff + F + 4 * n) = acc[0][bj][0][n]; }
        if (wr == 1 && fr >= 14) {
#pragma unroll
            for (int bj = 0; bj < 2; ++bj)
#pragma unroll
                for (int n = 0; n < 2; ++n) *(f32x4*)(UB + (size_t)(u.pm * 4 + fr - 12) * dff2 + bj * dff + F + 4 * n) = acc[1][bj][3][n]; }
    }
};
template <class Epi, class Sched, bool ALIGN_EPI = false, bool SP2 = false>
__device__ __forceinline__ void gemm_phase(PG8_LAS unsigned char* lds, const Gemm g, const Sched& S, const Epi& E) {
    int tid_l = threadIdx.x; asm volatile("" : "+v"(tid_l));
    const int tid = tid_l, wid = __builtin_amdgcn_readfirstlane(tid >> 6), lane = tid & 63, wr = wid >> 2, wc = wid & 3, fr = lane & 15, fq = lane >> 4;
    const int K = g.K, nt = g.kloop / BK;
    unsigned voffA[2], voffB[2];
#pragma unroll
    for (int i = 0; i < 2; ++i) { int R, C; stage_rc(tid * 16 + i * 8192, R, C); const int Rb = Epi::PERM ? ((R & ~31) + perm32(R & 31)) : R;
        voffA[i] = (unsigned)(R * K + C) * 2u; voffB[i] = (unsigned)(Rb * K + C) * 2u; }
    const size_t kstep = (size_t)(BK * 2);
    const size_t hstep = (size_t)HALF * K * 2;
    const size_t tstep = 2 * hstep;
    const unsigned ldsw = (unsigned)wid * 1024u;
    const int aoff = lds_byte(wr * 64 + fr, fq * 8), boff = lds_byte(wc * 32 + fr, fq * 8);
#define PG8_SA(b, h) (((b) * 2 + (h)) * HTB)
#define PG8_SB(b, h) ((4 + (b) * 2 + (h)) * HTB)
#define PG8_STAGE(bufoff, gbase, voff) do { _Pragma("unroll") for (int _i = 0; _i < 2; ++_i) \
        __builtin_amdgcn_global_load_lds((const unsigned*)((const char*)(gbase) + (voff)[_i]), (PG8_LAS unsigned*)(lds + (bufoff) + ldsw + _i * 8192), 16, 0, 0); } while (0)
#define PG8_LDA(dst, b, h) do { _Pragma("unroll") for (int m = 0; m < 4; ++m) _Pragma("unroll") for (int k = 0; k < 2; ++k) dst[m][k] = *(const PG8_LAS bf16x8*)(lds + PG8_SA(b, h) + aoff + m * 2048 + k * 1024); } while (0)
#define PG8_LDB(dst, b, h) do { _Pragma("unroll") for (int n = 0; n < 2; ++n) _Pragma("unroll") for (int k = 0; k < 2; ++k) dst[n][k] = *(const PG8_LAS bf16x8*)(lds + PG8_SB(b, h) + boff + n * 2048 + k * 1024); } while (0)
#define PG8_MMA(ai, bj, At, Bt) do { __builtin_amdgcn_s_setprio(1); _Pragma("unroll") for (int m = 0; m < 4; ++m) _Pragma("unroll") for (int n = 0; n < 2; ++n) _Pragma("unroll") for (int k = 0; k < 2; ++k) \
        acc[ai][bj][m][n] = __builtin_amdgcn_mfma_f32_16x16x32_bf16(Bt[n][k], At[m][k], acc[ai][bj][m][n], 0, 0, 0); __builtin_amdgcn_s_setprio(0); } while (0)
#define PG8_WAIT_V(n) asm volatile("s_waitcnt vmcnt(" #n ")" ::: "memory")
#define PG8_WAIT_L(n) asm volatile("s_waitcnt lgkmcnt(" #n ")" ::: "memory")
#define PG8_BAR __builtin_amdgcn_s_barrier()
#define PG8_SCHED __builtin_amdgcn_sched_barrier(0)
    Unit cur, nxt; int ui = 0;
    if (!S.next(0, cur)) return;
    f32x4 acc[2][2][4][2];
#pragma unroll
    for (int a = 0; a < 2; ++a)
#pragma unroll
        for (int b = 0; b < 2; ++b)
#pragma unroll
            for (int m = 0; m < 4; ++m)
#pragma unroll
                for (int n = 0; n < 2; ++n) acc[a][b][m][n] = (f32x4){0.f, 0.f, 0.f, 0.f};
    bf16x8 At[4][2], B0[2][2], B1[2][2];
    const char* cA = (const char*)g.A + (size_t)cur.pm * tstep + (size_t)cur.kofs * 2; const char* cB = (const char*)g.Bt + (size_t)cur.pn * tstep + (size_t)cur.kofs * 2;
    S.a_ready(cur);
    if constexpr (SP2) {
        PG8_STAGE(PG8_SB(0, 0), cB, voffB); PG8_STAGE(PG8_SB(0, 1), cB + hstep, voffB); PG8_STAGE(PG8_SA(0, 0), cA, voffA); PG8_STAGE(PG8_SA(0, 1), cA + hstep, voffA);
        if (wr == 1) PG8_BAR;
        PG8_WAIT_V(2); PG8_BAR;
        PG8_STAGE(PG8_SB(1, 0), cB + kstep, voffB); PG8_STAGE(PG8_SA(1, 0), cA + kstep, voffA); PG8_STAGE(PG8_SB(1, 1), cB + hstep + kstep, voffB);
        PG8_WAIT_V(6); PG8_BAR;
    } else {
        PG8_STAGE(PG8_SB(0, 0), cB, voffB); PG8_STAGE(PG8_SA(0, 0), cA, voffA); PG8_STAGE(PG8_SB(0, 1), cB + hstep, voffB); PG8_STAGE(PG8_SA(0, 1), cA + hstep, voffA);
        if (wr == 1) PG8_BAR;
        PG8_WAIT_V(4); PG8_BAR;
        PG8_STAGE(PG8_SB(1, 0), cB + kstep, voffB); PG8_STAGE(PG8_SA(1, 0), cA + kstep, voffA); PG8_STAGE(PG8_SB(1, 1), cB + hstep + kstep, voffB);
        PG8_WAIT_V(6); PG8_BAR;
    }
    for (;;) {
        const bool has_next = S.next(ui + 1, nxt);
        const char* nA = has_next ? (const char*)g.A + (size_t)nxt.pm * tstep + (size_t)nxt.kofs * 2 : cA; const char* nB = has_next ? (const char*)g.Bt + (size_t)nxt.pn * tstep + (size_t)nxt.kofs * 2 : cB;
        for (int t = 0; t < nt; t += 2) {
            const bool last = (t == nt - 2);
            const char* a1 = cA + (size_t)(t + 1) * kstep;
            const char* a2 = last ? nA : cA + (size_t)(t + 2) * kstep; const char* b2 = last ? nB : cB + (size_t)(t + 2) * kstep;
            const char* a3 = a2 + kstep; const char* b3 = b2 + kstep;
            if (last && has_next) S.a_ready(nxt);
            if constexpr (SP2) {
            PG8_LDB(B0, 0, 0); PG8_LDB(B1, 0, 1); PG8_SCHED; PG8_LDA(At, 0, 0); PG8_STAGE(PG8_SA(1, 1), a1 + hstep, voffA);
            PG8_WAIT_V(8); PG8_WAIT_L(0); PG8_BAR; PG8_MMA(0, 0, At, B0); PG8_MMA(0, 1, At, B1); PG8_BAR; PG8_SCHED;
            PG8_LDA(At, 0, 1); PG8_STAGE(PG8_SB(0, 0), b2, voffB); PG8_STAGE(PG8_SB(0, 1), b2 + hstep, voffB); PG8_STAGE(PG8_SA(0, 0), a2, voffA);
            PG8_WAIT_V(8); PG8_WAIT_L(0); PG8_BAR; PG8_MMA(1, 0, At, B0); PG8_MMA(1, 1, At, B1); PG8_BAR; PG8_SCHED;
            PG8_LDB(B0, 1, 0); PG8_LDB(B1, 1, 1); PG8_SCHED; PG8_LDA(At, 1, 0); PG8_STAGE(PG8_SA(0, 1), a2 + hstep, voffA);
            PG8_WAIT_V(8); PG8_WAIT_L(0); PG8_BAR; PG8_MMA(0, 0, At, B0); PG8_MMA(0, 1, At, B1); PG8_BAR; PG8_SCHED;
            PG8_LDA(At, 1, 1); PG8_STAGE(PG8_SB(1, 0), b3, voffB); PG8_STAGE(PG8_SB(1, 1), b3 + hstep, voffB); PG8_STAGE(PG8_SA(1, 0), a3, voffA);
            PG8_WAIT_V(8); PG8_WAIT_L(0); PG8_BAR; PG8_MMA(1, 0, At, B0); PG8_MMA(1, 1, At, B1); PG8_BAR; PG8_SCHED;
            } else {
            PG8_LDB(B0, 0, 0); PG8_SCHED; PG8_LDA(At, 0, 0); PG8_STAGE(PG8_SA(1, 1), a1 + hstep, voffA);
            PG8_WAIT_L(8); PG8_BAR; PG8_WAIT_L(0); PG8_MMA(0, 0, At, B0); PG8_BAR; PG8_SCHED;
            PG8_LDB(B1, 0, 1); PG8_STAGE(PG8_SB(0, 0), b2, voffB);
            PG8_BAR; PG8_WAIT_L(0); PG8_MMA(0, 1, At, B1); PG8_BAR;
            PG8_LDA(At, 0, 1); PG8_STAGE(PG8_SA(0, 0), a2, voffA);
            PG8_BAR; PG8_WAIT_L(0); PG8_MMA(1, 0, At, B0); PG8_BAR; PG8_SCHED;
            PG8_STAGE(PG8_SB(0, 1), b2 + hstep, voffB);
            PG8_WAIT_V(6); PG8_BAR; PG8_MMA(1, 1, At, B1); PG8_BAR;
            PG8_LDB(B0, 1, 0); PG8_SCHED; PG8_LDA(At, 1, 0); PG8_STAGE(PG8_SA(0, 1), a2 + hstep, voffA);
            PG8_WAIT_L(8); PG8_BAR; PG8_WAIT_L(0); PG8_MMA(0, 0, At, B0); PG8_BAR; PG8_SCHED;
            PG8_LDB(B1, 1, 1); PG8_STAGE(PG8_SB(1, 0), b3, voffB);
            PG8_BAR; PG8_WAIT_L(0); PG8_MMA(0, 1, At, B1); PG8_BAR;
            PG8_LDA(At, 1, 1); PG8_STAGE(PG8_SA(1, 0), a3, voffA);
            PG8_BAR; PG8_WAIT_L(0); PG8_MMA(1, 0, At, B0); PG8_BAR; PG8_SCHED;
            PG8_STAGE(PG8_SB(1, 1), b3 + hstep, voffB);
            PG8_WAIT_V(6); PG8_BAR; PG8_MMA(1, 1, At, B1); PG8_BAR;
            }
        }
        if constexpr (ALIGN_EPI) { if (wr == 0) PG8_BAR; }
        if constexpr (!Epi::AFTER_DRAIN) { E(acc, cur, wr, wc, fr, fq); S.done(cur); }
        if (!has_next) break;
#pragma unroll
        for (int a = 0; a < 2; ++a)
#pragma unroll
            for (int b = 0; b < 2; ++b)
#pragma unroll
                for (int m = 0; m < 4; ++m)
#pragma unroll
                    for (int n = 0; n < 2; ++n) acc[a][b][m][n] = (f32x4){0.f, 0.f, 0.f, 0.f};
        cur = nxt; cA = nA; cB = nB; ++ui;
        if constexpr (ALIGN_EPI) { if (wr == 1) PG8_BAR; }
    }
    PG8_WAIT_V(0);
    if constexpr (!ALIGN_EPI) { if (wr == 0) PG8_BAR; }
    PG8_BAR;
    if constexpr (Epi::AFTER_DRAIN) { E.fused(acc, cur, wr, wc, fr, fq, lds, wid, lane); S.done(cur); }
#undef PG8_SA
#undef PG8_SB
#undef PG8_STAGE
#undef PG8_LDA
#undef PG8_LDB
#undef PG8_MMA
#undef PG8_WAIT_V
#undef PG8_WAIT_L
#undef PG8_BAR
#undef PG8_SCHED
}
}
#define LAS __attribute__((address_space(3)))
#define XB_TMO      128
#define XB_XCNT(j)  (256  + 64 * (j))
#define XB_XSUB(j)  (1280 + 64 * (j))
#define XB_XGEN(j)  (2304 + 64 * (j))
#define XB_TOP      3328
#define XB_TOPGEN   3392
#define XCD_BAR_WORDS 3456
#define XB_SPIN_CAP (1u << 18)

__device__ __forceinline__ unsigned xb_ld(unsigned* p)              { return __hip_atomic_load(p, __ATOMIC_RELAXED, __HIP_MEMORY_SCOPE_AGENT); }
__device__ __forceinline__ unsigned xb_add(unsigned* p, unsigned v) { return __hip_atomic_fetch_add(p, v, __ATOMIC_RELAXED, __HIP_MEMORY_SCOPE_AGENT); }
__device__ __forceinline__ unsigned xb_xcc_id() { return (unsigned)__builtin_amdgcn_s_getreg((3 << 11) | 20) & 0xFu; }
#define XB_SPIN(cond, bar) do { unsigned _sp = 0; while (cond) { __builtin_amdgcn_s_sleep(1); \
    if ((++_sp & 255u) == 0u) { if (xb_ld(&(bar)[XB_TMO])) break; if (_sp > XB_SPIN_CAP) { atomicAdd(&(bar)[XB_TMO], 1u); break; } } } } while (0)

struct XcdBarrier {
    unsigned* bar; unsigned x;
    volatile LAS unsigned* st;
};

__device__ __forceinline__ XcdBarrier xcd_barrier_post(unsigned* bar, volatile LAS unsigned* st) {
    XcdBarrier b; b.bar = bar; b.x = xb_xcc_id(); b.st = st;
    if (threadIdx.x == 0) (void)xb_add(&bar[XB_XCNT(b.x)], 1u);
    return b;
}
__device__ __forceinline__ void xcd_barrier_complete(unsigned* bar, unsigned x, unsigned& nloc, unsigned& nx) {
    const unsigned G = gridDim.x * gridDim.y * gridDim.z;
    unsigned sum, cnt, mine, sp = 0u;
    for (;;) {
        sum = 0u; cnt = 0u; mine = 0u;
#pragma unroll
        for (unsigned j = 0; j < 16; ++j) { const unsigned c = xb_ld(&bar[XB_XCNT(j)]); sum += c; cnt += (c > 0u) ? 1u : 0u; mine = (j == x) ? c : mine; }
        if (sum == G) break;
        __builtin_amdgcn_s_sleep(1);
        if ((++sp & 255u) == 0u) { if (xb_ld(&bar[XB_TMO])) break; if (sp > XB_SPIN_CAP) { atomicAdd(&bar[XB_TMO], 1u); break; } }
    }
    nloc = mine > 0u ? mine : 1u; nx = cnt > 0u ? cnt : 1u;
}

__device__ __forceinline__ void xcd_barrier(const XcdBarrier& b) {
    asm volatile("s_waitcnt vmcnt(0)" ::: "memory");
    __syncthreads();
    if (threadIdx.x == 0) {
        unsigned* bar = b.bar;
        __builtin_amdgcn_s_waitcnt(0);
        unsigned nloc = b.st[0], nx = b.st[1];
        if (nloc == 0u) { xcd_barrier_complete(bar, b.x, nloc, nx); b.st[0] = nloc; b.st[1] = nx; }
        const unsigned old = xb_add(&bar[XB_XSUB(b.x)], 1u);
        const unsigned gen = old / nloc;
        if (old + 1u == (gen + 1u) * nloc) {
            __builtin_amdgcn_fence(__ATOMIC_RELEASE, "agent");
            asm volatile("s_waitcnt vmcnt(0)" ::: "memory");
            const unsigned og = xb_add(&bar[XB_TOP], 1u);
            const unsigned tg = og / nx;
            if (og + 1u == (tg + 1u) * nx) xb_add(&bar[XB_TOPGEN], 1u);
            else XB_SPIN(xb_ld(&bar[XB_TOPGEN]) == tg, bar);
            __builtin_amdgcn_fence(__ATOMIC_ACQUIRE, "agent");
            xb_add(&bar[XB_XGEN(b.x)], 1u);
            asm volatile("s_waitcnt vmcnt(0)" ::: "memory");
        } else {
            XB_SPIN(xb_ld(&bar[XB_XGEN(b.x)]) == gen, bar);
            __builtin_amdgcn_fence(__ATOMIC_ACQUIRE, "agent");
            asm volatile("s_waitcnt vmcnt(0)" ::: "memory");
        }
    }
    __syncthreads();
}

constexpr int DM = 2048, NB = 4, SEQ = 4096, CTXL = 256, DEPTH = 4;
constexpr int M_LAT = NB * SEQ, M_CTX = NB * CTXL, M_ALL = M_LAT + M_CTX;
constexpr int DFF = 5632, DFF2 = 2 * DFF, NQKV = 3072, NGLA = 6144, NGLA_EXT = 6400, NMOD = 6 * DM;
constexpr float EPS = 1e-6f;
#ifndef MK_ONE_LAUNCH
#define MK_ONE_LAUNCH 1
#endif
#ifndef NAIVE_ATTN
#define NAIVE_ATTN 0
#endif
#ifndef NAIVE_GLA
#define NAIVE_GLA 0
#endif
#ifndef RPT_PRO
#define RPT_PRO 1
#endif
#ifndef RPT_NORM
#define RPT_NORM 1
#endif
#ifndef RPT_ATT
#define RPT_ATT 1
#endif
#ifndef RPT_GPRE
#define RPT_GPRE 1
#endif
#ifndef RPT_SCAN
#define RPT_SCAN 1
#endif
#ifndef RPT_COMB
#define RPT_COMB 1
#endif
#ifndef RPT_UP
#define RPT_UP 1
#endif
#ifndef RPT_CONV
#define RPT_CONV 1
#endif
#ifndef RPT_PROJ
#define RPT_PROJ 1
#endif
#ifndef RPT_WO
#define RPT_WO 0
#endif
#ifndef RPT_DN
#define RPT_DN 0
#endif
#ifndef EXTRA_BAR
#define EXTRA_BAR 0
#endif
#ifndef RPT_AVT
#define RPT_AVT 1
#endif
#ifndef RPT_ROPE
#define RPT_ROPE 0
#endif
#ifndef DIAG_BAR
#define DIAG_BAR 0
#endif
#ifndef DIAG_CLK
#define DIAG_CLK 0
#endif
#ifndef DIAG_SCAN
#define DIAG_SCAN 0
#endif
#ifndef SPLITK_WO
#define SPLITK_WO 0
#endif
#ifndef SPLITK_DN
#define SPLITK_DN 1
#endif
#ifndef TAIL_CONVERT
#define TAIL_CONVERT 1
#endif
#ifndef NORM_BF16_IN
#define NORM_BF16_IN 0
#endif
#ifndef TAIL_MODS
#define TAIL_MODS 0
#endif
#ifndef FUSE_CONV
#define FUSE_CONV 1
#endif
constexpr int NPH = 42;

constexpr size_t MiB = 1u << 20;
constexpr size_t WS_CTL = 0, CTL_ZERO_BYTES = 1 * MiB;
constexpr size_t WS_MODS = 1 * MiB;
constexpr size_t WS_X = 2 * MiB;
constexpr size_t WS_H = 138 * MiB;
constexpr size_t WS_P = 206 * MiB;
constexpr size_t WS_Z1 = 410 * MiB;
constexpr size_t WS_OMIX = 413 * MiB;
constexpr size_t WS_U = 481 * MiB;
constexpr size_t WS_OF = WS_U, WS_OB = WS_U + 136 * MiB;
constexpr size_t WS_XB = WS_U + 292 * MiB;
constexpr size_t WS_UB = WS_U + 64 * MiB;
constexpr size_t WS_PART = WS_U;
constexpr size_t WS_VTA = WS_U;
constexpr size_t WS_QT = WS_U;
constexpr size_t WS_KHT = WS_U + 68 * MiB;
constexpr size_t WS_AIN = WS_U + 136 * MiB;
constexpr size_t WS_DEC = WS_U + 153 * MiB;
constexpr size_t WS_VT = WS_U + 156 * MiB;
constexpr size_t WS_OFB = WS_U + 224 * MiB, WS_OBB = WS_U + 292 * MiB;
constexpr size_t WS_ACT = 855 * MiB;
constexpr size_t WS_WUP = 1042 * MiB, WUP_STRIDE = 44 * MiB;
constexpr size_t WS_WDN = 1218 * MiB, WDN_STRIDE = 22 * MiB;
constexpr size_t WS_WQKV = 1306 * MiB, WQKV_STRIDE = 12 * MiB;
constexpr size_t WS_WAO = 1330 * MiB, WO_STRIDE = 8 * MiB;
constexpr size_t WS_WGIN = 1346 * MiB, WGIN_STRIDE = 25 * MiB;
constexpr size_t WS_WGO = 1396 * MiB;
constexpr size_t WS_END = 1412 * MiB;
constexpr int CW_BAR = 4096;

constexpr int RING_BYTES = 131072, LDSCTL_OFF = RING_BYTES, LDS_BYTES = 147456;

#define GAS __attribute__((address_space(1)))
#define LAS __attribute__((address_space(3)))
typedef unsigned short bf16;
typedef unsigned v4u __attribute__((ext_vector_type(4)));
typedef unsigned v2u __attribute__((ext_vector_type(2)));
typedef float f32x4 __attribute__((ext_vector_type(4)));
#define LDS_WAIT() asm volatile("s_waitcnt lgkmcnt(0)" ::: "memory")
#define LDS_BARRIER() do { asm volatile("s_waitcnt lgkmcnt(0)" ::: "memory"); __builtin_amdgcn_s_barrier(); asm volatile("" ::: "memory"); } while (0)
__device__ __forceinline__ unsigned pk2(float lo, float hi) { return pg8::cvt_pk_bf16(lo, hi); }
__device__ __forceinline__ unsigned f2bf(float f) { return pk2(f, 0.f) & 0xffffu; }
__device__ __forceinline__ float bf_lo(unsigned w) { return __builtin_bit_cast(float, w << 16); }
__device__ __forceinline__ float bf_hi(unsigned w) { return __builtin_bit_cast(float, w & 0xffff0000u); }
__device__ __forceinline__ float bf2f(bf16 h) { return __builtin_bit_cast(float, ((unsigned)h) << 16); }
__device__ __forceinline__ float silu_f(float v) { return v / (1.0f + __expf(-v)); }
__device__ __forceinline__ float wave_sum(float v) {
#pragma unroll
    for (int o = 1; o < 64; o <<= 1) v += __shfl_xor(v, o);
    return v;
}

__device__ __forceinline__ void unpack8h(const v4u a, float (&x)[8]) { x[0] = pg8::f16_lo(a.x); x[1] = pg8::f16_hi(a.x); x[2] = pg8::f16_lo(a.y); x[3] = pg8::f16_hi(a.y); x[4] = pg8::f16_lo(a.z); x[5] = pg8::f16_hi(a.z); x[6] = pg8::f16_lo(a.w); x[7] = pg8::f16_hi(a.w); }
__device__ __forceinline__ void unpack8(const v4u a, float (&x)[8]) { x[0] = bf_lo(a.x); x[1] = bf_hi(a.x); x[2] = bf_lo(a.y); x[3] = bf_hi(a.y); x[4] = bf_lo(a.z); x[5] = bf_hi(a.z); x[6] = bf_lo(a.w); x[7] = bf_hi(a.w); }

struct Args { const float* in[25]; float* out; unsigned char* ws; int ph_lo, ph_hi; };
struct WV { int tid, lane, wave, G, vcu, gw, NGW; LAS unsigned char* lds; };

__device__ __forceinline__ void p0_transpose_item(const float* W, int K, int N, bf16* WT, int row_off, LAS float* scr, int item, int lane, bool remap_up) {
    const int nblk = N / 32, kb = item / nblk, nb = item % nblk, k0 = 64 * kb, n0 = 32 * nb;
    const int r0 = remap_up ? ((n0 < DFF ? 0 : 128) + 256 * ((n0 < DFF ? n0 : n0 - DFF) >> 7) + ((n0 < DFF ? n0 : n0 - DFF) & 127)) : n0;
    f32x4 ld[8];
#pragma unroll
    for (int i = 0; i < 8; ++i) ld[i] = __builtin_nontemporal_load((const f32x4*)(W + (size_t)(k0 + 8 * i + (lane >> 3)) * N + n0 + 4 * (lane & 7)));
#pragma unroll
    for (int i = 0; i < 8; ++i) { LAS float* sp = scr + (8 * i + (lane >> 3)) * 33 + 4 * (lane & 7); sp[0] = ld[i].x; sp[1] = ld[i].y; sp[2] = ld[i].z; sp[3] = ld[i].w; }
    LDS_WAIT(); asm volatile("" ::: "memory");
    const int c = lane & 7;
#pragma unroll
    for (int j = 0; j < 4; ++j) { const int n = (lane >> 3) + 8 * j; const LAS float* s = scr + (8 * c) * 33 + n;
        v4u o; o.x = pk2(s[0 * 33], s[1 * 33]); o.y = pk2(s[2 * 33], s[3 * 33]); o.z = pk2(s[4 * 33], s[5 * 33]); o.w = pk2(s[6 * 33], s[7 * 33]);
        *(v4u*)(WT + (size_t)(row_off + r0 + n) * K + k0 + 8 * c) = o; }
    LDS_WAIT(); asm volatile("" ::: "memory");
}
__device__ __forceinline__ void transpose_matrix(const WV& w, const float* W, int K, int N, bf16* WT, int row_off, bool remap_up = false) {
    LAS float* scr = (LAS float*)(w.lds + w.wave * 16384);
    const int nitems = (K / 64) * (N / 32);
    for (int it = w.gw; it < nitems; it += w.NGW) p0_transpose_item(W, K, N, WT, row_off, scr, it, w.lane, remap_up);
}
__device__ __forceinline__ void mods_item(const WV& w, const float* c, const float* c_ctx, const float* ada_w, const float* ada_b, float* mods, int it) {
    const int layer = it >> 6, n0 = (it & 63) * 192;
    LAS float* sl = (LAS float*)w.lds;
    LAS float* red = (LAS float*)(w.lds + 40960);
    for (int i = w.tid; i < 5 * DM; i += 512) { const int vec = i >> 11, k = i & 2047; const float v = vec < 4 ? c[vec * DM + k] : c_ctx[k]; sl[i] = silu_f(v); }
    __syncthreads();
    f32x4 acc[5];
#pragma unroll
    for (int v = 0; v < 5; ++v) acc[v] = (f32x4){0.f, 0.f, 0.f, 0.f};
    if (w.lane < 48) {
        const float* Wp = ada_w + (size_t)layer * DM * NMOD + n0 + 4 * w.lane;
        const int kbeg = w.wave * 256;
        for (int k = kbeg; k < kbeg + 256; k += 8) {
            f32x4 wv[8];
#pragma unroll
            for (int kk = 0; kk < 8; ++kk) wv[kk] = __builtin_nontemporal_load((const f32x4*)(Wp + (size_t)(k + kk) * NMOD));
#pragma unroll
            for (int kk = 0; kk < 8; ++kk)
#pragma unroll
                for (int v = 0; v < 5; ++v) acc[v] += wv[kk] * sl[v * DM + k + kk];
        }
#pragma unroll
        for (int v = 0; v < 5; ++v) *(LAS f32x4*)(red + (w.wave * 5 + v) * 192 + 4 * w.lane) = acc[v];
    }
    __syncthreads();
    for (int i = w.tid; i < 5 * 192; i += 512) { const int vec = i / 192, col = i % 192; float s = 0.f;
#pragma unroll
        for (int ww = 0; ww < 8; ++ww) s += red[(ww * 5 + vec) * 192 + col];
        mods[((size_t)layer * 5 + vec) * NMOD + n0 + col] = s + ada_b[(size_t)layer * NMOD + n0 + col]; }
    __syncthreads();
}

__device__ __forceinline__ void norm_rows(const WV& w, bf16* X, bf16* H, const float* g, const float* shift, const float* scale, int nrows, const float* part, int nsplit, const float* pgate, const float* in_lat, const float* in_ctx) {
    for (int row = w.gw; row < nrows; row += w.NGW) {
        const int vec = row < M_LAT ? (row >> 12) : 4;
        float v[4][8];
        v4u* xr = (v4u*)(X + (size_t)row * DM) + w.lane;
        if (in_lat) { const float* xi = (row < M_LAT ? in_lat + (size_t)row * DM : in_ctx + (size_t)(row - M_LAT) * DM) + 8 * w.lane;
#pragma unroll
            for (int j = 0; j < 4; ++j) { const f32x4 a = *(const f32x4*)(xi + 512 * j), c = *(const f32x4*)(xi + 512 * j + 4);
                v[j][0] = a.x; v[j][1] = a.y; v[j][2] = a.z; v[j][3] = a.w; v[j][4] = c.x; v[j][5] = c.y; v[j][6] = c.z; v[j][7] = c.w; } }
        else {
#pragma unroll
            for (int j = 0; j < 4; ++j) unpack8h(xr[64 * j], v[j]); }
        if (nsplit > 0 && row >= M_LAT) {
            const float* pr = part + (size_t)(row - M_LAT) * DM + 8 * w.lane;
#pragma unroll
            for (int j = 0; j < 4; ++j) { f32x4 s0 = *(const f32x4*)(pr + 512 * j), s1 = *(const f32x4*)(pr + 512 * j + 4);
                for (int sl = 1; sl < nsplit; ++sl) { s0 += *(const f32x4*)(pr + (size_t)sl * (M_CTX * DM) + 512 * j); s1 += *(const f32x4*)(pr + (size_t)sl * (M_CTX * DM) + 512 * j + 4); }
                const f32x4 g0 = *(const f32x4*)(pgate + 8 * (64 * j + w.lane)), g1 = *(const f32x4*)(pgate + 8 * (64 * j + w.lane) + 4);
                v[j][0] += g0.x * s0.x; v[j][1] += g0.y * s0.y; v[j][2] += g0.z * s0.z; v[j][3] += g0.w * s0.w; v[j][4] += g1.x * s1.x; v[j][5] += g1.y * s1.y; v[j][6] += g1.z * s1.z; v[j][7] += g1.w * s1.w;
                const v4u o = (v4u){pg8::cvt_pk_f16(v[j][0], v[j][1]), pg8::cvt_pk_f16(v[j][2], v[j][3]), pg8::cvt_pk_f16(v[j][4], v[j][5]), pg8::cvt_pk_f16(v[j][6], v[j][7])}; xr[64 * j] = o;
                unpack8h(o, v[j]); }
        }
        float ss = 0.f;
#pragma unroll
        for (int j = 0; j < 4; ++j)
#pragma unroll
            for (int e = 0; e < 8; ++e) ss += v[j][e] * v[j][e];
        const float r = 1.0f / sqrtf(wave_sum(ss) * (1.0f / DM) + EPS);
        const float* sh = shift + (size_t)vec * NMOD; const float* sc = scale + (size_t)vec * NMOD;
        v4u* o16 = (v4u*)(H + (size_t)row * DM) + w.lane;
#pragma unroll
        for (int j = 0; j < 4; ++j) { const int col = 8 * (64 * j + w.lane); float y[8];
#pragma unroll
            for (int hq = 0; hq < 2; ++hq) { const f32x4 gv = *(const f32x4*)(g + col + 4 * hq), s = *(const f32x4*)(sc + col + 4 * hq), t = *(const f32x4*)(sh + col + 4 * hq);
                y[4 * hq] = v[j][4 * hq] * r * gv.x * (s.x + 1.0f) + t.x; y[4 * hq + 1] = v[j][4 * hq + 1] * r * gv.y * (s.y + 1.0f) + t.y;
                y[4 * hq + 2] = v[j][4 * hq + 2] * r * gv.z * (s.z + 1.0f) + t.z; y[4 * hq + 3] = v[j][4 * hq + 3] * r * gv.w * (s.w + 1.0f) + t.w; }
            o16[64 * j] = (v4u){pk2(y[0], y[1]), pk2(y[2], y[3]), pk2(y[4], y[5]), pk2(y[6], y[7])}; }
    }
}
__device__ __forceinline__ void final_norm(const WV& w, const bf16* X, float* out, const float* g) {
    for (int row = w.gw; row < M_LAT; row += w.NGW) {
        const v4u* xr = (const v4u*)(X + (size_t)row * DM) + w.lane;
        float v[4][8]; float ss = 0.f;
#pragma unroll
        for (int j = 0; j < 4; ++j) { unpack8h(xr[64 * j], v[j]);
#pragma unroll
            for (int e = 0; e < 8; ++e) ss += v[j][e] * v[j][e]; }
        const float r = 1.0f / sqrtf(wave_sum(ss) * (1.0f / DM) + EPS);
        float* o = out + (size_t)row * DM + 8 * w.lane;
#pragma unroll
        for (int j = 0; j < 4; ++j) { const int col = 8 * (64 * j + w.lane); const f32x4 g0 = *(const f32x4*)(g + col), g1 = *(const f32x4*)(g + col + 4);
            __builtin_nontemporal_store((f32x4){v[j][0] * r * g0.x, v[j][1] * r * g0.y, v[j][2] * r * g0.z, v[j][3] * r * g0.w}, (f32x4*)(o + 512 * j));
            __builtin_nontemporal_store((f32x4){v[j][4] * r * g1.x, v[j][5] * r * g1.y, v[j][6] * r * g1.z, v[j][7] * r * g1.w}, (f32x4*)(o + 512 * j + 4)); }
    }
}

__device__ __forceinline__ void rope_rows(const WV& w, bf16* P, float sgn = 1.0f) {
    const int half = (w.lane >> 2) & 1, oct = w.lane & 3;
    float inv[8];
#pragma unroll
    for (int e = 0; e < 8; ++e) inv[e] = exp2f(-(float)(2 * (8 * oct + e)) * (13.287712379549449f / 64.0f));
    for (int row = w.gw; row < M_LAT; row += w.NGW) {
        const int t = row & (SEQ - 1); const float pos = (float)(half ? (t & 63) : (t >> 6));
        float cs[8], sn[8];
#pragma unroll
        for (int e = 0; e < 8; ++e) { const float ang = pos * inv[e]; cs[e] = __cosf(ang); sn[e] = sgn * __sinf(ang); }
        bf16* base = P + (size_t)row * NQKV + half * 64 + 8 * oct;
#pragma unroll
        for (int rnd = 0; rnd < 3; ++rnd) { const int hd = (w.lane >> 3) + 8 * rnd;
            if (hd < 20) { bf16* p = base + hd * 128; float x1[8], x2[8]; unpack8(*(const v4u*)p, x1); unpack8(*(const v4u*)(p + 32), x2);
                float y1[8], y2[8];
#pragma unroll
                for (int e = 0; e < 8; ++e) { y1[e] = x1[e] * cs[e] - x2[e] * sn[e]; y2[e] = x2[e] * cs[e] + x1[e] * sn[e]; }
                *(v4u*)p = (v4u){pk2(y1[0], y1[1]), pk2(y1[2], y1[3]), pk2(y1[4], y1[5]), pk2(y1[6], y1[7])};
                *(v4u*)(p + 32) = (v4u){pk2(y2[0], y2[1]), pk2(y2[2], y2[3]), pk2(y2[4], y2[5]), pk2(y2[6], y2[7])}; } }
    }
}

__device__ __forceinline__ void attn_naive(const WV& w, const bf16* P, const float* sink, bf16* O) {
    const int g = w.lane >> 4, li = w.lane & 15;
    const float scale = 0.08838834764831845f;
    for (int task = w.gw; task < M_ALL * 16; task += w.NGW) {
        const int row = task >> 4, hq = task & 15, kvh = hq >> 2;
        float q[8];
        { const v4u qq = *(const v4u*)(P + (size_t)row * NQKV + hq * 128 + 8 * li);
          q[0] = bf_lo(qq.x) * scale; q[1] = bf_hi(qq.x) * scale; q[2] = bf_lo(qq.y) * scale; q[3] = bf_hi(qq.y) * scale;
          q[4] = bf_lo(qq.z) * scale; q[5] = bf_hi(qq.z) * scale; q[6] = bf_lo(qq.w) * scale; q[7] = bf_hi(qq.w) * scale; }
        int b, wbase = 0, nwin = 0;
        if (row < M_LAT) { b = row >> 12; const int t = row & (SEQ - 1); const int j0 = t - 128 < 0 ? 0 : t - 128, j1 = t + 128 > SEQ - 1 ? SEQ - 1 : t + 128; wbase = b * SEQ + j0; nwin = j1 - j0 + 1; }
        else b = (row - M_LAT) >> 8;
        const int cbase = M_LAT + b * CTXL, nk = nwin + CTXL;
        float m = sink[hq], l = (g == 0) ? 1.0f : 0.0f, o[8];
#pragma unroll
        for (int d = 0; d < 8; ++d) o[d] = 0.f;
        for (int i = g; i < nk; i += 4) {
            const int krow = i < nwin ? wbase + i : cbase + (i - nwin);
            const bf16* kp = P + (size_t)krow * NQKV + 2048 + kvh * 128 + 8 * li;
            const v4u kk = *(const v4u*)kp, vv = *(const v4u*)(kp + 512);
            float s = q[0] * bf_lo(kk.x) + q[1] * bf_hi(kk.x) + q[2] * bf_lo(kk.y) + q[3] * bf_hi(kk.y) + q[4] * bf_lo(kk.z) + q[5] * bf_hi(kk.z) + q[6] * bf_lo(kk.w) + q[7] * bf_hi(kk.w);
            s += __shfl_xor(s, 1); s += __shfl_xor(s, 2); s += __shfl_xor(s, 4); s += __shfl_xor(s, 8);
            const float mn = fmaxf(m, s), a = __expf(m - mn), p = __expf(s - mn);
            l = l * a + p; m = mn;
            o[0] = o[0] * a + p * bf_lo(vv.x); o[1] = o[1] * a + p * bf_hi(vv.x); o[2] = o[2] * a + p * bf_lo(vv.y); o[3] = o[3] * a + p * bf_hi(vv.y);
            o[4] = o[4] * a + p * bf_lo(vv.z); o[5] = o[5] * a + p * bf_hi(vv.z); o[6] = o[6] * a + p * bf_lo(vv.w); o[7] = o[7] * a + p * bf_hi(vv.w);
        }
        float ma = fmaxf(m, __shfl_xor(m, 16)); ma = fmaxf(ma, __shfl_xor(ma, 32));
        const float fsc = __expf(m - ma); l *= fsc; l += __shfl_xor(l, 16); l += __shfl_xor(l, 32);
        const float rl = 1.0f / l;
#pragma unroll
        for (int d = 0; d < 8; ++d) { float x = o[d] * fsc; x += __shfl_xor(x, 16); x += __shfl_xor(x, 32); o[d] = x * rl; }
        if (g == 0) { v4u ov; ov.x = pk2(o[0], o[1]); ov.y = pk2(o[2], o[3]); ov.z = pk2(o[4], o[5]); ov.w = pk2(o[6], o[7]);
            *(v4u*)(O + (size_t)row * DM + hq * 128 + 8 * li) = ov; }
    }
}

__device__ __forceinline__ void gla_naive(const WV& w, const bf16* P, const float* Z1, const float* w2f, const float* bf, const float* w2b, const float* bb, float* OF, float* OB) {
    LAS float* buf = (LAS float*)w.lds;
    const int vc = w.tid >> 2, dq = w.tid & 3;
    for (int it = w.vcu; it < 128; it += w.G) {
        const int vs = it & 3, dir = (it >> 2) & 1, h = (it >> 3) & 3, b = it >> 5;
        const float* w2 = dir ? w2b : w2f; const float* bias = dir ? bb : bf; float* OUT = dir ? OB : OF;
        float w2c[16], bz = 0.f;
        if (w.tid < 256) { bz = bias[h * 256 + w.tid];
#pragma unroll
            for (int r = 0; r < 16; ++r) w2c[r] = w2[r * 1024 + h * 256 + w.tid]; }
        else {
#pragma unroll
            for (int r = 0; r < 16; ++r) w2c[r] = 0.f; }
        float S[64];
#pragma unroll
        for (int i = 0; i < 64; ++i) S[i] = 0.f;
        const int cbase = M_LAT + b * CTXL, lbase = b * SEQ;
#define GLA_ROW(step) ((step) < CTXL ? (dir ? cbase + CTXL - 1 - (step) : cbase + (step)) : (dir ? lbase + SEQ - 1 - ((step) - CTXL) : lbase + ((step) - CTXL)))
#define GLA_FILL(step, par) do { if (w.tid < 256) { const int r_ = GLA_ROW(step); const float* z_ = Z1 + (size_t)r_ * 32 + dir * 16; float zz = bz; \
            _Pragma("unroll") for (int r = 0; r < 16; ++r) zz += z_[r] * w2c[r]; \
            const float ls_ = fminf(zz, 0.f) - log1pf(__expf(-fabsf(zz))); \
            LAS float* bp_ = buf + (par) * 768; bp_[w.tid] = __expf(ls_ * (1.0f / 16.0f)); \
            bp_[256 + w.tid] = bf2f(P[(size_t)r_ * NGLA + 1024 + h * 256 + w.tid]); bp_[512 + w.tid] = bf2f(P[(size_t)r_ * NGLA + h * 256 + w.tid]) * 0.0625f; } } while (0)
        __syncthreads();
        GLA_FILL(0, 0);
        __syncthreads();
        for (int step = 0; step < CTXL + SEQ; ++step) {
            const int row = GLA_ROW(step);
            if (step + 1 < CTXL + SEQ) GLA_FILL(step + 1, (step + 1) & 1);
            const float v = bf2f(P[(size_t)row * NGLA + 2048 + h * 512 + vs * 128 + vc]);
            const LAS float* bp = buf + (step & 1) * 768 + 64 * dq;
            float acc = 0.f;
#pragma unroll
            for (int i = 0; i < 64; i += 4) {
                const f32x4 e4 = *(const LAS f32x4*)(bp + i), k4 = *(const LAS f32x4*)(bp + 256 + i), q4 = *(const LAS f32x4*)(bp + 512 + i);
                S[i] = S[i] * e4.x + k4.x * v; acc += q4.x * S[i];
                S[i + 1] = S[i + 1] * e4.y + k4.y * v; acc += q4.y * S[i + 1];
                S[i + 2] = S[i + 2] * e4.z + k4.z * v; acc += q4.z * S[i + 2];
                S[i + 3] = S[i + 3] * e4.w + k4.w * v; acc += q4.w * S[i + 3];
            }
            acc += __shfl_xor(acc, 1); acc += __shfl_xor(acc, 2);
            if (dq == 0) OUT[(size_t)row * DM + h * 512 + vs * 128 + vc] = acc;
            __syncthreads();
        }
#undef GLA_ROW
#undef GLA_FILL
    }
}
__device__ __forceinline__ void gla_combine(const WV& w, const float* OF, const float* OB, const bf16* P, const float* og, bf16* O, int nrows) {
    for (int task = w.gw; task < nrows * 4; task += w.NGW) {
        const int row = task >> 2, h = task & 3; const size_t off = (size_t)row * DM + h * 512 + 8 * w.lane;
        const f32x4 a0 = *(const f32x4*)(OF + off), a1 = *(const f32x4*)(OF + off + 4), b0 = *(const f32x4*)(OB + off), b1 = *(const f32x4*)(OB + off + 4);
        const f32x4 o0 = a0 + b0, o1 = a1 + b1;
        float ss = (o0.x * o0.x + o0.y * o0.y) + (o0.z * o0.z + o0.w * o0.w) + (o1.x * o1.x + o1.y * o1.y) + (o1.z * o1.z + o1.w * o1.w);
        const float r = 1.0f / sqrtf(wave_sum(ss) * (1.0f / 512.0f) + EPS);
        const f32x4 g0 = *(const f32x4*)(og + 8 * w.lane), g1 = *(const f32x4*)(og + 8 * w.lane + 4);
        const v4u rr = *(const v4u*)(P + (size_t)row * NGLA + 4096 + h * 512 + 8 * w.lane);
        v4u ov;
        ov.x = pk2(o0.x * r * g0.x * silu_f(bf_lo(rr.x)), o0.y * r * g0.y * silu_f(bf_hi(rr.x)));
        ov.y = pk2(o0.z * r * g0.z * silu_f(bf_lo(rr.y)), o0.w * r * g0.w * silu_f(bf_hi(rr.y)));
        ov.z = pk2(o1.x * r * g1.x * silu_f(bf_lo(rr.z)), o1.y * r * g1.y * silu_f(bf_hi(rr.z)));
        ov.w = pk2(o1.z * r * g1.z * silu_f(bf_lo(rr.w)), o1.w * r * g1.w * silu_f(bf_hi(rr.w)));
        *(v4u*)(O + off) = ov;
    }
}

typedef short bf16x8 __attribute__((ext_vector_type(8)));
typedef float f32x16 __attribute__((ext_vector_type(16)));
__device__ __forceinline__ int gla_row(int b, int cc, int i) { return cc < 64 ? b * SEQ + cc * 64 + i : M_LAT + b * CTXL + (cc - 64) * 64 + i; }
__device__ __forceinline__ void gla_pre(const WV& w, const bf16* P, const float* Z1, const float* w2f, const float* bf_, const float* w2b, const float* bb_, bf16* QT, bf16* KHT, bf16* AIN, float* DEC) {
    LAS bf16* QS = (LAS bf16*)w.lds;
    LAS bf16* KS = (LAS bf16*)(w.lds + 33792);
    LAS bf16* KH = (LAS bf16*)(w.lds + 67584);
    LAS float* z1s = (LAS float*)(w.lds + 104448);
    LAS float* tot = (LAS float*)(w.lds + 108544);
    LAS bf16* AS = (LAS bf16*)(w.lds + 110592);
    const int d = w.tid & 255, hf = w.tid >> 8;
    float w2c[16], bias = 0.f; int cur_dh = -1;
    v4u pq[4], pkk[4]; f32x4 pz = (f32x4){0.f, 0.f, 0.f, 0.f};
#define PRE_FETCH(it_) do { const int b_ = ((it_) >> 3) & 3, h_ = ((it_) >> 1) & 3, dir_ = (it_) & 1, row0_ = gla_row(b_, (it_) >> 5, 0); \
        _Pragma("unroll") for (int i = 0; i < 4; ++i) { const int p = w.tid + 512 * i; const bf16* src = P + (size_t)(row0_ + (p >> 5)) * NGLA + h_ * 256 + 8 * (p & 31); pq[i] = *(const v4u*)src; pkk[i] = *(const v4u*)(src + 1024); } \
        if (w.tid < 256) pz = *(const f32x4*)(Z1 + (size_t)(row0_ + (w.tid >> 2)) * 32 + dir_ * 16 + 4 * (w.tid & 3)); } while (0)
    if (w.vcu < 2 * 4 * 4 * 68) PRE_FETCH(w.vcu);
    LDS_BARRIER();
    for (int it = w.vcu; it < 2 * 4 * 4 * 68; it += w.G) {
        const int dir = it & 1, h = (it >> 1) & 3, b = (it >> 3) & 3, cc = it >> 5;
        const size_t item = ((size_t)(dir * 4 + b) * 4 + h) * 68 + cc;
        if (cur_dh != (dir * 4 + h)) { cur_dh = dir * 4 + h; const float* w2 = dir ? w2b : w2f; bias = (dir ? bb_ : bf_)[h * 256 + d];
#pragma unroll
            for (int r = 0; r < 16; ++r) w2c[r] = w2[r * 1024 + h * 256 + d]; }
        const int row0 = gla_row(b, cc, 0);
#pragma unroll
        for (int i = 0; i < 4; ++i) { const int p = w.tid + 512 * i, r = p >> 5, c = p & 31; *(LAS v4u*)(QS + r * 264 + 8 * c) = pq[i]; *(LAS v4u*)(KS + r * 264 + 8 * c) = pkk[i]; }
        if (w.tid < 256) *(LAS f32x4*)(z1s + 4 * w.tid) = pz;
        if (it + w.G < 2 * 4 * 4 * 68) PRE_FETCH(it + w.G);
        LDS_BARRIER();
        float g[32];
#pragma unroll
        for (int ii = 0; ii < 32; ++ii) { const LAS f32x4* zp = (const LAS f32x4*)(z1s + (32 * hf + ii) * 16); float zz = bias;
#pragma unroll
            for (int q4 = 0; q4 < 4; ++q4) { const f32x4 z = zp[q4]; zz += z.x * w2c[4 * q4] + z.y * w2c[4 * q4 + 1] + z.z * w2c[4 * q4 + 2] + z.w * w2c[4 * q4 + 3]; }
            g[ii] = (fminf(zz, 0.f) * 1.4426950408889634f - __builtin_amdgcn_logf(1.0f + __builtin_amdgcn_exp2f(-fabsf(zz) * 1.4426950408889634f))) * 0.0625f; }
        float run = 0.f;
        if (!dir) {
#pragma unroll
            for (int ii = 0; ii < 32; ++ii) { run += g[ii]; g[ii] = run; } }
        else {
#pragma unroll
            for (int ii = 31; ii >= 0; --ii) { run += g[ii]; g[ii] = run; } }
        tot[hf * 256 + d] = run;
        LDS_BARRIER();
        const float t0 = tot[d], t1 = tot[256 + d], blast = t0 + t1;
        const float off = dir ? (hf == 0 ? t1 : 0.f) : (hf == 1 ? t0 : 0.f);
        unsigned khat[16];
#pragma unroll
        for (int ii = 0; ii < 32; ++ii) { const int i = 32 * hf + ii; const float bbv = g[ii] + off;
            const float qv = bf2f(QS[i * 264 + d]) * 0.0625f, kv = bf2f(KS[i * 264 + d]);
            const unsigned qk = pk2(qv * __builtin_amdgcn_exp2f(bbv), kv * __builtin_amdgcn_exp2f(-bbv)); const unsigned kh = f2bf(kv * __builtin_amdgcn_exp2f(blast - bbv));
            QS[i * 264 + d] = (bf16)(qk & 0xffffu); KS[i * 264 + d] = (bf16)(qk >> 16);
            if (ii & 1) khat[ii >> 1] |= kh << 16; else khat[ii >> 1] = kh; }
        { LAS v4u* kp = (LAS v4u*)(KH + d * 72 + 32 * hf);
#pragma unroll
          for (int q4 = 0; q4 < 4; ++q4) kp[q4] = (v4u){khat[4 * q4], khat[4 * q4 + 1], khat[4 * q4 + 2], khat[4 * q4 + 3]}; }
        if (hf == 0) DEC[item * 256 + d] = __builtin_amdgcn_exp2f(blast);
        LDS_BARRIER();
#pragma unroll
        for (int i = 0; i < 4; ++i) { const int p = w.tid + 512 * i, r = p >> 5, c = p & 31;
            *(v4u*)(QT + ((size_t)dir * M_ALL + row0 + r) * 1024 + h * 256 + 8 * c) = *(const LAS v4u*)(QS + r * 264 + 8 * c); }
#pragma unroll
        for (int i = 0; i < 4; ++i) { const int p = w.tid + 512 * i, dd = p >> 3, c = p & 7;
            *(v4u*)(KHT + (item * 256 + dd) * 64 + 8 * c) = *(const LAS v4u*)(KH + dd * 72 + 8 * c); }
        { const int rb = w.wave >> 1, ch = w.wave & 1, c16 = w.lane & 15, kg = w.lane >> 4;
          f32x4 acc[2]; acc[0] = (f32x4){0.f, 0.f, 0.f, 0.f}; acc[1] = acc[0];
#pragma unroll
          for (int k8 = 0; k8 < 8; ++k8) { const bf16x8 a = *(const LAS bf16x8*)(QS + (rb * 16 + c16) * 264 + 32 * k8 + 8 * kg);
#pragma unroll
              for (int n = 0; n < 2; ++n) { const bf16x8 bq = *(const LAS bf16x8*)(KS + ((2 * ch + n) * 16 + c16) * 264 + 32 * k8 + 8 * kg); acc[n] = __builtin_amdgcn_mfma_f32_16x16x32_bf16(a, bq, acc[n], 0, 0, 0); } }
#pragma unroll
          for (int n = 0; n < 2; ++n)
#pragma unroll
              for (int r = 0; r < 4; ++r) { const int i = rb * 16 + 4 * kg + r, jj = (2 * ch + n) * 16 + c16; const bool keep = dir ? (jj >= i) : (jj <= i);
                  AS[i * 72 + jj] = (bf16)f2bf(keep ? acc[n][r] : 0.f); } }
        LDS_BARRIER();
        { const int r = w.tid >> 3, c = w.tid & 7; *(v4u*)(AIN + (item * 64 + r) * 64 + 8 * c) = *(const LAS v4u*)(AS + r * 72 + 8 * c); }
        LDS_BARRIER();
    }
#undef PRE_FETCH
    __syncthreads();
}
__device__ __forceinline__ void gla_vt(const WV& w, const bf16* P, bf16* VT) {
    LAS bf16* vt = (LAS bf16*)w.lds;
    for (int it = w.vcu; it < 4 * 4 * 68; it += w.G) {
        const int cc = it % 68, bh = it / 68, h = bh & 3, b = bh >> 2;
        const int row0 = gla_row(b, cc, 0);
#pragma unroll
        for (int rr = 0; rr < 8; ++rr) { const int i = rr * 8 + (w.tid >> 6), piece = w.tid & 63;
            *(LAS v4u*)(vt + i * 520 + 8 * (piece ^ (i >> 3))) = *(const v4u*)(P + (size_t)(row0 + i) * NGLA + 2048 + h * 512 + 8 * piece); }
        __syncthreads();
#pragma unroll
        for (int i = 0; i < 8; ++i) { const int p = w.tid + 512 * i, dv = p >> 3, c = p & 7; unsigned u[8];
#pragma unroll
            for (int e = 0; e < 8; ++e) u[e] = vt[(8 * c + e) * 520 + 8 * ((dv >> 3) ^ c) + (dv & 7)];
            *(v4u*)(VT + ((size_t)it * 512 + dv) * 64 + 8 * c) = (v4u){u[0] | (u[1] << 16), u[2] | (u[3] << 16), u[4] | (u[5] << 16), u[6] | (u[7] << 16)}; }
        __syncthreads();
    }
}
__device__ __forceinline__ void gla_scan(const WV& w, const bf16* QT, const bf16* KHT, const bf16* AIN, const float* DEC, const bf16* VT, bf16* OFB, bf16* OBB) {
    LAS bf16* ST = (LAS bf16*)w.lds;
    LAS bf16* QS = (LAS bf16*)(w.lds + 33792);
    LAS bf16* VS = (LAS bf16*)(w.lds + 67584);
    LAS bf16* AS = (LAS bf16*)(w.lds + 76800);
    LAS float* DS = (LAS float*)(w.lds + 86016);
    LAS bf16* OS = (LAS bf16*)(w.lds + 87040);
    const int wv = w.wave, r32 = w.lane & 31, hh = w.lane >> 5, c16 = w.lane & 15, kg = w.lane >> 4, tb = wv >> 1, dh = wv & 1;
    for (int it = w.vcu; it < 256; it += w.G) {
        const int vs = it & 7, dir = (it >> 3) & 1, h = (it >> 4) & 3, b = it >> 6;
        bf16* O = dir ? OBB : OFB;
        f32x16 S[2];
#pragma unroll
        for (int n = 0; n < 2; ++n)
#pragma unroll
            for (int r = 0; r < 16; ++r) S[n][r] = 0.f;
        v4u sq[4], sv, sa; f32x4 sd = (f32x4){0.f, 0.f, 0.f, 0.f}; bf16x8 kn[4];
#define SC_CC(s_) ((s_) < 4 ? (dir ? 67 - (s_) : 64 + (s_)) : (dir ? 67 - (s_) : (s_) - 4))
#define SC_LOAD(s_) do { const int cc_ = SC_CC(s_); const size_t item_ = ((size_t)(dir * 4 + b) * 4 + h) * 68 + cc_, vitem_ = ((size_t)b * 4 + h) * 68 + cc_; const int row0_ = gla_row(b, cc_, 0); \
            _Pragma("unroll") for (int i_ = 0; i_ < 4; ++i_) { const int p_ = w.tid + 512 * i_; sq[i_] = *(const v4u*)(QT + ((size_t)dir * M_ALL + row0_ + (p_ >> 5)) * 1024 + h * 256 + 8 * (p_ & 31)); } \
            sv = *(const v4u*)(VT + (vitem_ * 512 + vs * 64 + (w.tid >> 3)) * 64 + 8 * (w.tid & 7)); \
            sa = *(const v4u*)(AIN + (item_ * 64 + (w.tid >> 3)) * 64 + 8 * (w.tid & 7)); \
            if (w.tid < 64) sd = *(const f32x4*)(DEC + item_ * 256 + 4 * w.tid); \
            const bf16* krow_ = KHT + (item_ * 256 + 32 * wv + r32) * 64 + 8 * hh; \
            _Pragma("unroll") for (int k4 = 0; k4 < 4; ++k4) kn[k4] = *(const bf16x8*)(krow_ + 16 * k4); } while (0)
        SC_LOAD(0);
        for (int s = 0; s < 68; ++s) {
            const int row0 = gla_row(b, SC_CC(s), 0);
#pragma unroll
            for (int n = 0; n < 2; ++n)
#pragma unroll
                for (int g4 = 0; g4 < 4; ++g4) { v2u pk; pk.x = pk2(S[n][4 * g4], S[n][4 * g4 + 1]); pk.y = pk2(S[n][4 * g4 + 2], S[n][4 * g4 + 3]);
                    *(LAS v2u*)(ST + (32 * n + r32) * 264 + 32 * wv + 8 * g4 + 4 * hh) = pk; }
#pragma unroll
            for (int i = 0; i < 4; ++i) { const int p = w.tid + 512 * i; *(LAS v4u*)(QS + (p >> 5) * 264 + 8 * (p & 31)) = sq[i]; }
            *(LAS v4u*)(VS + (w.tid >> 3) * 72 + 8 * (w.tid & 7)) = sv;
            *(LAS v4u*)(AS + (w.tid >> 3) * 72 + 8 * (w.tid & 7)) = sa;
            if (w.tid < 64) *(LAS f32x4*)(DS + 4 * w.tid) = sd;
            bf16x8 ka[4];
#pragma unroll
            for (int k4 = 0; k4 < 4; ++k4) ka[k4] = kn[k4];
            if (s + 1 < 68) SC_LOAD(s + 1);
            asm volatile("s_waitcnt lgkmcnt(0)" ::: "memory"); __builtin_amdgcn_s_barrier(); asm volatile("" ::: "memory");
            f32x4 oacc[2]; oacc[0] = (f32x4){0.f, 0.f, 0.f, 0.f}; oacc[1] = oacc[0];
#pragma unroll
            for (int k8 = 0; k8 < 8; ++k8) { const bf16x8 qa = *(const LAS bf16x8*)(QS + (tb * 16 + c16) * 264 + 32 * k8 + 8 * kg);
#pragma unroll
                for (int n = 0; n < 2; ++n) { const bf16x8 sb = *(const LAS bf16x8*)(ST + (32 * dh + 16 * n + c16) * 264 + 32 * k8 + 8 * kg); oacc[n] = __builtin_amdgcn_mfma_f32_16x16x32_bf16(qa, sb, oacc[n], 0, 0, 0); } }
#pragma unroll
            for (int k2 = 0; k2 < 2; ++k2) { const bf16x8 aa = *(const LAS bf16x8*)(AS + (tb * 16 + c16) * 72 + 32 * k2 + 8 * kg);
#pragma unroll
                for (int n = 0; n < 2; ++n) { const bf16x8 vb = *(const LAS bf16x8*)(VS + (32 * dh + 16 * n + c16) * 72 + 32 * k2 + 8 * kg); oacc[n] = __builtin_amdgcn_mfma_f32_16x16x32_bf16(aa, vb, oacc[n], 0, 0, 0); } }
#pragma unroll
            for (int n = 0; n < 2; ++n)
#pragma unroll
                for (int r = 0; r < 4; ++r) OS[(tb * 16 + 4 * kg + r) * 72 + 32 * dh + 16 * n + c16] = (bf16)f2bf(oacc[n][r]);
            { float dec[16];
#pragma unroll
              for (int q4 = 0; q4 < 4; ++q4) { const f32x4 dq = *(const LAS f32x4*)(DS + 32 * wv + 4 * hh + 8 * q4); dec[4 * q4] = dq.x; dec[4 * q4 + 1] = dq.y; dec[4 * q4 + 2] = dq.z; dec[4 * q4 + 3] = dq.w; }
#pragma unroll
              for (int n = 0; n < 2; ++n) {
#pragma unroll
                  for (int r = 0; r < 16; ++r) S[n][r] *= dec[r];
#pragma unroll
                  for (int k4 = 0; k4 < 4; ++k4) { const bf16x8 vb = *(const LAS bf16x8*)(VS + (32 * n + r32) * 72 + 16 * k4 + 8 * hh); S[n] = __builtin_amdgcn_mfma_f32_32x32x16_bf16(ka[k4], vb, S[n], 0, 0, 0); } } }
            asm volatile("s_waitcnt lgkmcnt(0)" ::: "memory"); __builtin_amdgcn_s_barrier(); asm volatile("" ::: "memory");
            *(v4u*)(O + (size_t)(row0 + (w.tid >> 3)) * DM + h * 512 + vs * 64 + 8 * (w.tid & 7)) = *(const LAS v4u*)(OS + (w.tid >> 3) * 72 + 8 * (w.tid & 7));
        }
#undef SC_CC
#undef SC_LOAD
        __syncthreads();
    }
}
__device__ __forceinline__ void gla_combine_bf(const WV& w, const bf16* OFB, const bf16* OBB, const bf16* P, const float* og, bf16* O, int nrows) {
    for (int task = w.gw; task < nrows * 4; task += w.NGW) {
        const int row = task >> 2, h = task & 3; const size_t off = (size_t)row * DM + h * 512 + 8 * w.lane;
        float a[8], c[8], o[8], rv[8]; unpack8(*(const v4u*)(OFB + off), a); unpack8(*(const v4u*)(OBB + off), c);
        float ss = 0.f;
#pragma unroll
        for (int e = 0; e < 8; ++e) { o[e] = a[e] + c[e]; ss += o[e] * o[e]; }
        const float r = 1.0f / sqrtf(wave_sum(ss) * (1.0f / 512.0f) + EPS);
        const f32x4 g0 = *(const f32x4*)(og + 8 * w.lane), g1 = *(const f32x4*)(og + 8 * w.lane + 4);
        const float gg[8] = {g0.x, g0.y, g0.z, g0.w, g1.x, g1.y, g1.z, g1.w};
        unpack8(*(const v4u*)(P + (size_t)row * NGLA + 4096 + h * 512 + 8 * w.lane), rv);
#pragma unroll
        for (int e = 0; e < 8; ++e) o[e] = o[e] * r * gg[e] * silu_f(rv[e]);
        *(v4u*)(O + off) = (v4u){pk2(o[0], o[1]), pk2(o[2], o[3]), pk2(o[4], o[5]), pk2(o[6], o[7])};
    }
}


__device__ __forceinline__ void attn_vt(const WV& w, const bf16* P, bf16* VTA) {
    LAS bf16* tl = (LAS bf16*)w.lds;
    for (int it = w.vcu; it < 16 * 68; it += w.G) {
        const int blk = it % 68, bk = it / 68, b = bk >> 2, kvh = bk & 3;
        const size_t row0 = blk < 64 ? (size_t)b * SEQ + 64 * blk : (size_t)M_LAT + b * CTXL + 64 * (blk - 64);
        const int col0 = blk < 64 ? 64 * blk : SEQ + 64 * (blk - 64);
#pragma unroll
        for (int i = 0; i < 2; ++i) { const int p = w.tid + 512 * i, r = p >> 4, c8 = p & 15;
            *(LAS v4u*)(tl + r * 136 + 8 * c8) = *(const v4u*)(P + (row0 + r) * NQKV + 2560 + kvh * 128 + 8 * c8); }
        __syncthreads();
        const int d = w.tid & 127, tg = w.tid >> 7;
        unsigned u[16];
#pragma unroll
        for (int e = 0; e < 16; ++e) u[e] = tl[(16 * tg + e) * 136 + d];
        v4u* dst = (v4u*)(VTA + ((size_t)bk * 128 + d) * 4352 + col0 + 16 * tg);
        dst[0] = (v4u){u[0] | (u[1] << 16), u[2] | (u[3] << 16), u[4] | (u[5] << 16), u[6] | (u[7] << 16)};
        dst[1] = (v4u){u[8] | (u[9] << 16), u[10] | (u[11] << 16), u[12] | (u[13] << 16), u[14] | (u[15] << 16)};
        __syncthreads();
    }
}
__device__ __forceinline__ void attn_fast(const WV& w, const bf16* P, const bf16* VTA, const float* sink, bf16* O) {
    LAS bf16* KL = (LAS bf16*)w.lds;
    LAS bf16* VL = (LAS bf16*)(w.lds + 2 * 17408);
    const int wv = w.wave, r32 = w.lane & 31, hh = w.lane >> 5, g = wv >> 1, th = wv & 1;
    const float C2 = 0.08838834764831845f * 1.4426950408889634f, L2E = 1.4426950408889634f;
    for (int u = w.vcu; u < 1088; u += w.G) {
        int b, kvh, qb; bool isctx;
        if (u < 1024) { b = u >> 8; kvh = (u >> 6) & 3; qb = u & 63; isctx = false; } else { const int v = u - 1024; b = v >> 4; kvh = (v >> 2) & 3; qb = v & 3; isctx = true; }
        const int hq = kvh * 4 + g, tq = qb * 64 + 32 * th + r32;
        const size_t qrow = isctx ? (size_t)M_LAT + b * CTXL + tq : (size_t)b * SEQ + tq;
        int i_lo = 0, nwin = 0;
        if (!isctx) { i_lo = 2 - qb > 0 ? 2 - qb : 0; const int i_hi = 65 - qb < 4 ? 65 - qb : 4; nwin = i_hi - i_lo + 1; }
        const int T = nwin + 4;
        bf16x8 qf[8];
#pragma unroll
        for (int k8 = 0; k8 < 8; ++k8) qf[k8] = *(const bf16x8*)(P + qrow * NQKV + hq * 128 + 16 * k8 + 8 * hh);
        f32x16 OT[4];
#pragma unroll
        for (int db = 0; db < 4; ++db)
#pragma unroll
            for (int r = 0; r < 16; ++r) OT[db][r] = 0.f;
        float m = sink[hq] * L2E, lsum = hh == 0 ? 1.0f : 0.0f;
        v4u krA[2], vrA[2], krB[2], vrB[2];
#define ATT_LOAD(t_, kr_, vr_) do { const int t__ = (t_); const bool wt_ = t__ < nwin; const int kp0_ = qb * 64 - 128 + 64 * (i_lo + t__), ct_ = t__ - nwin; \
            const size_t krow0_ = wt_ ? (size_t)b * SEQ + kp0_ : (size_t)M_LAT + b * CTXL + 64 * ct_; const int vcol0_ = wt_ ? kp0_ : SEQ + 64 * ct_; \
            _Pragma("unroll") for (int i_ = 0; i_ < 2; ++i_) { const int p_ = w.tid + 512 * i_; \
                kr_[i_] = *(const v4u*)(P + (krow0_ + (p_ >> 4)) * NQKV + 2048 + kvh * 128 + 8 * (p_ & 15)); \
                vr_[i_] = *(const v4u*)(VTA + ((size_t)(b * 4 + kvh) * 128 + (p_ >> 3)) * 4352 + vcol0_ + 8 * (p_ & 7)); } } while (0)
#define ATT_STORE(buf_, kr_, vr_) do { _Pragma("unroll") for (int i_ = 0; i_ < 2; ++i_) { const int p_ = w.tid + 512 * i_; \
                *(LAS v4u*)(KL + (buf_) * (64 * 136) + (p_ >> 4) * 136 + 8 * (p_ & 15)) = kr_[i_]; \
                LAS v2u* vp_ = (LAS v2u*)(VL + (buf_) * (128 * 68) + (p_ >> 3) * 68 + 8 * (p_ & 7)); vp_[0] = (v2u){vr_[i_].x, vr_[i_].y}; vp_[1] = (v2u){vr_[i_].z, vr_[i_].w}; } } while (0)
#define ATT_BAR() do { asm volatile("s_waitcnt lgkmcnt(0)" ::: "memory"); __builtin_amdgcn_s_barrier(); asm volatile("" ::: "memory"); } while (0)
#define ATT_COMPUTE(t_) do { const int t = (t_); \
            const LAS bf16* kl = KL + (t & 1) * (64 * 136); const LAS bf16* vl = VL + (t & 1) * (128 * 68); \
            f32x16 sacc[2]; \
            _Pragma("unroll") for (int kb = 0; kb < 2; ++kb) { \
                _Pragma("unroll") for (int r = 0; r < 16; ++r) sacc[kb][r] = 0.f; \
                _Pragma("unroll") for (int k8 = 0; k8 < 8; ++k8) { const bf16x8 a = *(const LAS bf16x8*)(kl + (32 * kb + r32) * 136 + 16 * k8 + 8 * hh); sacc[kb] = __builtin_amdgcn_mfma_f32_32x32x16_bf16(a, qf[k8], sacc[kb], 0, 0, 0); } } \
            const bool wt = t < nwin; const int kp0 = qb * 64 - 128 + 64 * (i_lo + t); \
            float mx = -INFINITY; \
            _Pragma("unroll") for (int kb = 0; kb < 2; ++kb) \
                _Pragma("unroll") for (int r = 0; r < 16; ++r) { float sv = sacc[kb][r] * C2; \
                    if (wt) { const int dlt = kp0 + 32 * kb + (r & 3) + 8 * (r >> 2) + 4 * hh - tq; if (dlt > 128 || dlt < -128) sv = -INFINITY; } \
                    sacc[kb][r] = sv; mx = fmaxf(mx, sv); } \
            mx = fmaxf(mx, __shfl_xor(mx, 32)); \
            const float mn = fmaxf(m, mx), alpha = __builtin_amdgcn_exp2f(m - mn); m = mn; \
            float ps = 0.f; \
            _Pragma("unroll") for (int kb = 0; kb < 2; ++kb) \
                _Pragma("unroll") for (int r = 0; r < 16; ++r) { const float pv = __builtin_amdgcn_exp2f(sacc[kb][r] - mn); ps += pv; sacc[kb][r] = pv; } \
            lsum = lsum * alpha + ps; \
            _Pragma("unroll") for (int db = 0; db < 4; ++db) \
                _Pragma("unroll") for (int r = 0; r < 16; ++r) OT[db][r] *= alpha; \
            _Pragma("unroll") for (int kb = 0; kb < 2; ++kb) \
                _Pragma("unroll") for (int sh = 0; sh < 2; ++sh) { \
                    v4u pw; pw.x = pk2(sacc[kb][8 * sh], sacc[kb][8 * sh + 1]); pw.y = pk2(sacc[kb][8 * sh + 2], sacc[kb][8 * sh + 3]); \
                    pw.z = pk2(sacc[kb][8 * sh + 4], sacc[kb][8 * sh + 5]); pw.w = pk2(sacc[kb][8 * sh + 6], sacc[kb][8 * sh + 7]); \
                    const bf16x8 pf = __builtin_bit_cast(bf16x8, pw); \
                    _Pragma("unroll") for (int db = 0; db < 4; ++db) { const LAS bf16* vp = vl + (32 * db + r32) * 68 + 32 * kb + 16 * sh + 4 * hh; \
                        const v2u lo = *(const LAS v2u*)vp, hi = *(const LAS v2u*)(vp + 8); \
                        const bf16x8 vf = __builtin_bit_cast(bf16x8, ((v4u){lo.x, lo.y, hi.x, hi.y})); \
                        OT[db] = __builtin_amdgcn_mfma_f32_32x32x16_bf16(vf, pf, OT[db], 0, 0, 0); } } } while (0)
        __syncthreads();
        ATT_LOAD(0, krA, vrA); ATT_STORE(0, krA, vrA);
        ATT_LOAD(1, krB, vrB);
        ATT_BAR();
        for (int t2 = 0; t2 < T; t2 += 2) {
            if (t2 + 2 < T) ATT_LOAD(t2 + 2, krA, vrA);
            ATT_COMPUTE(t2);
            if (t2 + 1 < T) ATT_STORE(1, krB, vrB);
            ATT_BAR();
            if (t2 + 1 < T) {
                if (t2 + 3 < T) ATT_LOAD(t2 + 3, krB, vrB);
                ATT_COMPUTE(t2 + 1);
                if (t2 + 2 < T) ATT_STORE(0, krA, vrA);
                ATT_BAR();
            }
        }
#undef ATT_LOAD
#undef ATT_STORE
#undef ATT_BAR
#undef ATT_COMPUTE
        const float l = lsum + __shfl_xor(lsum, 32), rl = 1.0f / l;
        bf16* op = O + qrow * DM + hq * 128 + 4 * hh;
#pragma unroll
        for (int db = 0; db < 4; ++db)
#pragma unroll
            for (int g4 = 0; g4 < 4; ++g4) { v2u o; o.x = pk2(OT[db][4 * g4] * rl, OT[db][4 * g4 + 1] * rl); o.y = pk2(OT[db][4 * g4 + 2] * rl, OT[db][4 * g4 + 3] * rl);
                *(v2u*)(op + 32 * db + 8 * g4) = o; }
    }
}

__device__ __forceinline__ void conv_rows(const WV& w, const bf16* U, const float* cw, const float* cb, bf16* ACT, int nrows) {
    const int nseg = nrows / 32;
    for (int wi = w.gw; wi < nseg * 11; wi += w.NGW) {
        const int seg = wi / 11, cg = wi % 11, r0 = seg * 32, f = (cg * 64 + w.lane) * 8;
        float wg[3][8], wv[3][8], bg[8], bv[8];
#pragma unroll
        for (int j = 0; j < 3; ++j)
#pragma unroll
            for (int e = 0; e < 8; ++e) { wg[j][e] = cw[j * DFF2 + f + e]; wv[j][e] = cw[j * DFF2 + DFF + f + e]; }
#pragma unroll
        for (int e = 0; e < 8; ++e) { bg[e] = cb[f + e]; bv[e] = cb[DFF + f + e]; }
        const bool s_start = r0 < M_LAT ? ((r0 & (SEQ - 1)) == 0) : (((r0 - M_LAT) & (CTXL - 1)) == 0);
        const bool s_end = r0 < M_LAT ? (((r0 + 32) & (SEQ - 1)) == 0) : (((r0 + 32 - M_LAT) & (CTXL - 1)) == 0);
        const v4u zero4 = (v4u){0u, 0u, 0u, 0u};
        v4u pg = s_start ? zero4 : *(const v4u*)(U + (size_t)(r0 - 1) * DFF2 + f), pv = s_start ? zero4 : *(const v4u*)(U + (size_t)(r0 - 1) * DFF2 + DFF + f);
        v4u cg4 = *(const v4u*)(U + (size_t)r0 * DFF2 + f), cv4 = *(const v4u*)(U + (size_t)r0 * DFF2 + DFF + f);
        for (int r = 0; r < 32; ++r) {
            const bool nz = (r == 31) && s_end;
            const v4u ng = nz ? zero4 : *(const v4u*)(U + (size_t)(r0 + r + 1) * DFF2 + f), nv = nz ? zero4 : *(const v4u*)(U + (size_t)(r0 + r + 1) * DFF2 + DFF + f);
            float a[8], c[8], n[8], gate[8], val[8];
            unpack8(pg, a); unpack8(cg4, c); unpack8(ng, n);
#pragma unroll
            for (int e = 0; e < 8; ++e) gate[e] = bg[e] + wg[0][e] * a[e] + wg[1][e] * c[e] + wg[2][e] * n[e];
            unpack8(pv, a); unpack8(cv4, c); unpack8(nv, n);
#pragma unroll
            for (int e = 0; e < 8; ++e) val[e] = bv[e] + wv[0][e] * a[e] + wv[1][e] * c[e] + wv[2][e] * n[e];
            v4u ov; ov.x = pk2(silu_f(gate[0]) * val[0], silu_f(gate[1]) * val[1]); ov.y = pk2(silu_f(gate[2]) * val[2], silu_f(gate[3]) * val[3]);
            ov.z = pk2(silu_f(gate[4]) * val[4], silu_f(gate[5]) * val[5]); ov.w = pk2(silu_f(gate[6]) * val[6], silu_f(gate[7]) * val[7]);
            *(v4u*)(ACT + (size_t)(r0 + r) * DFF + f) = ov;
            pg = cg4; pv = cv4; cg4 = ng; cv4 = nv;
        }
    }
}

__device__ __forceinline__ void conv_fixup(const WV& w, const float* UB, const float* cw, const float* cb, bf16* ACT, int npanels) {
    const int ntask = npanels * 2 * (DFF / 4);
    for (int task = w.gw * 64 + w.lane; task < ntask; task += w.NGW * 64) {
        const int f4 = task % (DFF / 4), pe = task / (DFF / 4), edge = pe & 1, pm = pe >> 1, F = 4 * f4;
        const bool first = pm >= 64 || (pm & 15) == 0, lastp = pm >= 64 || (pm & 15) == 15;
        f32x4 o[2];
#pragma unroll
        for (int bj = 0; bj < 2; ++bj) { const size_t col = (size_t)bj * DFF + F; const float* U0 = UB + (size_t)(pm * 4) * DFF2 + col; const f32x4 z = (f32x4){0.f, 0.f, 0.f, 0.f};
            const f32x4 cur = *(const f32x4*)(U0 + (edge ? 3 : 0) * (size_t)DFF2);
            const f32x4 pv = edge ? *(const f32x4*)(U0 + 2 * (size_t)DFF2) : (first ? z : *(const f32x4*)(UB + (size_t)((pm - 1) * 4 + 3) * DFF2 + col));
            const f32x4 nx = edge ? (lastp ? z : *(const f32x4*)(UB + (size_t)((pm + 1) * 4) * DFF2 + col)) : *(const f32x4*)(U0 + (size_t)DFF2);
            o[bj] = *(const f32x4*)(cb + col) + *(const f32x4*)(cw + col) * pv + *(const f32x4*)(cw + DFF2 + col) * cur + *(const f32x4*)(cw + 2 * DFF2 + col) * nx; }
        v2u ov; ov.x = pk2(silu_f(o[0].x) * o[1].x, silu_f(o[0].y) * o[1].y); ov.y = pk2(silu_f(o[0].z) * o[1].z, silu_f(o[0].w) * o[1].w);
        *(v2u*)(ACT + (size_t)(pm * 256 + (edge ? 255 : 0)) * DFF + F) = ov;
    }
}

__device__ __forceinline__ int layer_items(int L) { return 11264 + 5632 + ((L & 1) ? 6144 + 2048 : 3072 + 2048); }
__device__ __forceinline__ void convert_layer_items(const WV& w, const Args& args, unsigned char* ws, int L, int i0, int i1, int rank, int nranks) {
    LAS float* scr = (LAS float*)(w.lds + w.wave * 16384);
    const int j = L >> 1;
    for (int it = i0 + rank * 8 + w.wave; it < i1; it += nranks * 8) {
        int r = it;
        if (r < 11264) { p0_transpose_item(args.in[8] + (size_t)L * DM * DFF2, DM, DFF2, (bf16*)(ws + WS_WUP + L * WUP_STRIDE), 0, scr, r, w.lane, FUSE_CONV != 0); continue; } r -= 11264;
        if (r < 5632) { p0_transpose_item(args.in[11] + (size_t)L * DFF * DM, DFF, DM, (bf16*)(ws + WS_WDN + L * WDN_STRIDE), 0, scr, r, w.lane, false); continue; } r -= 5632;
        if (L & 1) {
            if (r < 6144) { p0_transpose_item(args.in[15] + (size_t)j * DM * NGLA, DM, NGLA, (bf16*)(ws + WS_WGIN + j * WGIN_STRIDE), 0, scr, r, w.lane, false); continue; } r -= 6144;
            p0_transpose_item(args.in[23] + (size_t)j * DM * DM, DM, DM, (bf16*)(ws + WS_WGO + j * WO_STRIDE), 0, scr, r, w.lane, false);
        } else {
            if (r < 3072) { p0_transpose_item(args.in[12] + (size_t)j * DM * NQKV, DM, NQKV, (bf16*)(ws + WS_WQKV + j * WQKV_STRIDE), 0, scr, r, w.lane, false); continue; } r -= 3072;
            p0_transpose_item(args.in[14] + (size_t)j * DM * DM, DM, DM, (bf16*)(ws + WS_WAO + j * WO_STRIDE), 0, scr, r, w.lane, false);
        }
    }
}
__device__ __forceinline__ void tail_convert(const WV& w, const Args& args, unsigned char* ws, int nwg, int L, int i0, int i1) {
    const int c = (int)blockIdx.x, rem = nwg % w.G;
    if (rem == 0) convert_layer_items(w, args, ws, L, i0, i1, c, w.G);
    else if (c >= rem) convert_layer_items(w, args, ws, L, i0, i1, c - rem, w.G - rem);
}

__global__ void __launch_bounds__(512, 2) mega(Args args) {
    extern __shared__ __attribute__((aligned(16))) unsigned char lds_raw[];
    LAS unsigned char* const lds0 = (LAS unsigned char*)lds_raw;
    for (int u = threadIdx.x; u < (LDS_BYTES - LDSCTL_OFF) / 4; u += 512) ((LAS unsigned*)(lds0 + LDSCTL_OFF))[u] = 0u;
    __syncthreads();
    XcdBarrier bar; bar.bar = (unsigned*)(args.ws + WS_CTL) + CW_BAR; bar.x = 0; bar.st = nullptr;
    if (MK_ONE_LAUNCH) bar = xcd_barrier_post((unsigned*)(args.ws + WS_CTL) + CW_BAR, (volatile LAS unsigned*)(lds0 + LDSCTL_OFF + 32));
#define PHASE_ENTER() int tid_l = threadIdx.x; asm volatile("" : "+v"(tid_l)); unsigned char* ws = args.ws; asm volatile("" : "+s"(ws)); WV w; w.lds = lds0; w.tid = tid_l; w.lane = tid_l & 63; \
    w.wave = __builtin_amdgcn_readfirstlane(tid_l >> 6); w.G = gridDim.x; { const int bx = blockIdx.x; w.vcu = (w.G % 8 == 0) ? (bx % 8) * (w.G / 8) + bx / 8 : bx; } w.gw = w.vcu * 8 + w.wave; w.NGW = w.G * 8; \
    bf16* X = (bf16*)(ws + WS_X); bf16* H = (bf16*)(ws + WS_H); bf16* P = (bf16*)(ws + WS_P); float* Z1 = (float*)(ws + WS_Z1); bf16* OMIX = (bf16*)(ws + WS_OMIX); bf16* U = (bf16*)(ws + WS_U); \
    bf16* ACT = (bf16*)(ws + WS_ACT); float* MODS = (float*)(ws + WS_MODS); float* OF = (float*)(ws + WS_OF); float* OB = (float*)(ws + WS_OB); \
    (void)X; (void)H; (void)P; (void)Z1; (void)OMIX; (void)U; (void)ACT; (void)MODS; (void)OF; (void)OB; (void)w
    const int lo = args.ph_lo, hi = args.ph_hi;
#define RUN(k) (lo <= (k) && (k) < hi)
#define SEAM(k) do { if (MK_ONE_LAUNCH && RUN(k) && RUN((k) + 1)) { unsigned long long tb0_ = 0; if (DIAG_BAR) tb0_ = __builtin_amdgcn_s_memrealtime(); xcd_barrier(bar); \
        if (DIAG_BAR && blockIdx.x == (DIAG_BAR == 1 ? 0 : 100) && threadIdx.x == 0) { volatile LAS unsigned* dgl_ = (volatile LAS unsigned*)(lds0 + LDSCTL_OFF + 256); dgl_[4] += (unsigned)(__builtin_amdgcn_s_memrealtime() - tb0_); } } } while (0)

    for (int rep = 0; rep < RPT_PRO; ++rep) if (RUN(0)) {
        PHASE_ENTER();
        for (int it = w.vcu; it < ((TAIL_MODS && SPLITK_DN) ? 64 : 4 * 64); it += w.G) mods_item(w, args.in[1], args.in[3], args.in[4], args.in[5], MODS, it);
        for (int L = 0; L < (TAIL_CONVERT ? 1 : DEPTH); ++L) convert_layer_items(w, args, ws, L, 0, layer_items(L), w.vcu, w.G);
        for (int j = 0; j < 2; ++j) {
            bf16* wg = (bf16*)(ws + WS_WGIN + j * WGIN_STRIDE) + (size_t)NGLA * DM;
            const float* f1 = args.in[16] + (size_t)j * DM * 16; const float* b1 = args.in[19] + (size_t)j * DM * 16;
            for (int idx = w.gw * 64 + w.lane; idx < 256 * DM; idx += w.NGW * 64) { const int n = idx >> 11, k = idx & 2047;
                const float v = n < 16 ? f1[k * 16 + n] : (n < 32 ? b1[k * 16 + (n - 16)] : 0.f); wg[idx] = (bf16)f2bf(v); }
        }
    }
    SEAM(0);
    if (MK_ONE_LAUNCH && RUN(0) && RUN(1)) for (int eb = 0; eb < EXTRA_BAR; ++eb) xcd_barrier(bar);

    for (int l = 0; l < DEPTH; ++l) {
        const int base = 1 + 10 * l, j = l >> 1; const bool gla = (l & 1) != 0, last = (l == DEPTH - 1);
        const size_t mods_off = (size_t)l * 5 * NMOD;
        const int mrows = last ? M_LAT : M_ALL;
        for (int rep = 0; rep < RPT_NORM; ++rep) if (RUN(base + 0)) { PHASE_ENTER(); const float* mods_l = MODS + mods_off; norm_rows(w, X, H, args.in[6] + l * DM, mods_l + 0 * DM, mods_l + 1 * DM, M_ALL, (const float*)(ws + WS_PART), (SPLITK_DN && l > 0) ? 4 : 0, MODS + (mods_off - 5 * NMOD) + 4 * NMOD + 5 * DM, l == 0 ? args.in[0] : nullptr, l == 0 ? args.in[2] : nullptr); }
        SEAM(base + 0);
        for (int rep = 0; rep < RPT_PROJ; ++rep) if (RUN(base + 1)) {
            PHASE_ENTER();
            pg8::Gemm g{H, gla ? (const bf16*)(ws + WS_WGIN + j * WGIN_STRIDE) : (const bf16*)(ws + WS_WQKV + j * WQKV_STRIDE), M_ALL, gla ? NGLA_EXT : NQKV, DM, DM};
            pg8::StaticOrder S; S.init(g.M, g.N, w.G, (int)blockIdx.x);
            pg8::EpiStoreBf16 E{P, gla ? NGLA : NQKV, gla ? NGLA : (1 << 30), Z1};
            pg8::gemm_phase<pg8::EpiStoreBf16, pg8::StaticOrder, true, true>(w.lds, g, S, E);
            if (TAIL_CONVERT && !last) { const int NI = layer_items(l + 1), ia = gla ? (NI * 23) / 100 : (NI * 40) / 100; tail_convert(w, args, ws, S.nwg, l + 1, 0, ia); }
        }
        SEAM(base + 1);
        if (RUN(base + 2)) {
            PHASE_ENTER();
            if (!gla) { rope_rows(w, P); if (RPT_ROPE) { rope_rows(w, P, -1.0f); rope_rows(w, P); }
#if !NAIVE_ATTN
                for (int rep3 = 0; rep3 < RPT_AVT; ++rep3) attn_vt(w, P, (bf16*)(ws + WS_VTA));
#endif
            }
#if !NAIVE_GLA
            else for (int rep2 = 0; rep2 < RPT_GPRE; ++rep2) { gla_pre(w, P, Z1, args.in[17] + (size_t)j * 16 * 1024, args.in[18] + j * 1024, args.in[20] + (size_t)j * 16 * 1024, args.in[21] + j * 1024,
                           (bf16*)(ws + WS_QT), (bf16*)(ws + WS_KHT), (bf16*)(ws + WS_AIN), (float*)(ws + WS_DEC));
                   gla_vt(w, P, (bf16*)(ws + WS_VT)); }
#endif
        }
        if (!gla || !NAIVE_GLA) SEAM(base + 2);
        for (int rep = 0; rep < (gla ? RPT_SCAN : RPT_ATT); ++rep) if (RUN(base + 3)) {
            PHASE_ENTER();
#if NAIVE_ATTN
            if (!gla) attn_naive(w, P, args.in[13] + j * 16, OMIX);
#else
            if (!gla) attn_fast(w, P, (const bf16*)(ws + WS_VTA), args.in[13] + j * 16, OMIX);
#endif
#if NAIVE_GLA
            else gla_naive(w, P, Z1, args.in[17] + (size_t)j * 16 * 1024, args.in[18] + j * 1024, args.in[20] + (size_t)j * 16 * 1024, args.in[21] + j * 1024, OF, OB);
#else
            else gla_scan(w, (const bf16*)(ws + WS_QT), (const bf16*)(ws + WS_KHT), (const bf16*)(ws + WS_AIN), (const float*)(ws + WS_DEC), (const bf16*)(ws + WS_VT), (bf16*)(ws + WS_OFB), (bf16*)(ws + WS_OBB));
#endif
        }
        SEAM(base + 3);
#if NAIVE_GLA
        if (RUN(base + 4)) { if (gla) { PHASE_ENTER(); gla_combine(w, OF, OB, P, args.in[22] + j * 512, OMIX, mrows); } }
#else
        for (int rep = 0; rep < RPT_COMB; ++rep) if (RUN(base + 4)) { if (gla) { PHASE_ENTER(); gla_combine_bf(w, (const bf16*)(ws + WS_OFB), (const bf16*)(ws + WS_OBB), P, args.in[22] + j * 512, OMIX, mrows); } }
#endif
        if (gla) SEAM(base + 4);
        if (RUN(base + 5)) {
            PHASE_ENTER();
            pg8::Gemm g{OMIX, gla ? (const bf16*)(ws + WS_WGO + j * WO_STRIDE) : (const bf16*)(ws + WS_WAO + j * WO_STRIDE), SPLITK_WO ? M_LAT : mrows, DM, DM, DM};
            pg8::StaticOrder S; S.init(g.M, g.N, w.G, (int)blockIdx.x);
            pg8::EpiResid E{X, DM, MODS + mods_off + 2 * DM, l == 0 ? args.in[0] : nullptr, l == 0 ? args.in[2] : nullptr};
            pg8::gemm_phase<pg8::EpiResid, pg8::StaticOrder, true, true>(w.lds, g, S, E);
            if (TAIL_CONVERT && !last) { const int NI = layer_items(l + 1), ia = gla ? (NI * 23) / 100 : (NI * 40) / 100, ib = gla ? (NI * 80) / 100 : (NI * 84) / 100; tail_convert(w, args, ws, S.nwg, l + 1, ia, ib); }
            if (SPLITK_WO && !last) {
                pg8::Gemm g2{OMIX + (size_t)M_LAT * DM, g.Bt, M_CTX, DM, DM, 256};
                pg8::SplitKOrder S2; S2.init(M_CTX, DM, 8, 256, w.G, (int)blockIdx.x);
                pg8::EpiPartial E2{(float*)(ws + WS_PART), DM, 256, (size_t)M_CTX * DM};
                pg8::gemm_phase<pg8::EpiPartial, pg8::SplitKOrder, true, true>(w.lds, g2, S2, E2);
            }
        }
        SEAM(base + 5);
        for (int rep = 0; rep < RPT_NORM; ++rep) if (RUN(base + 6)) { PHASE_ENTER(); const float* mods_l = MODS + mods_off; norm_rows(w, X, H, args.in[7] + l * DM, mods_l + 3 * DM, mods_l + 4 * DM, mrows, (const float*)(ws + WS_PART), (!SPLITK_WO || last) ? 0 : 8, mods_l + 4 * NMOD + 2 * DM, nullptr, nullptr); }
        SEAM(base + 6);
        for (int rep = 0; rep < RPT_UP; ++rep) if (RUN(base + 7)) {
            PHASE_ENTER();
            pg8::Gemm g{H, (const bf16*)(ws + WS_WUP + l * WUP_STRIDE), mrows, DFF2, DM, DM};
            pg8::StaticOrder S; S.init(g.M, g.N, w.G, (int)blockIdx.x);
            unsigned long long dc0 = 0, dr0 = 0; if (DIAG_CLK && l == 1) { dc0 = __builtin_readcyclecounter(); dr0 = __builtin_amdgcn_s_memrealtime(); }
#if FUSE_CONV
            pg8::EpiConv E{ACT, args.in[9] + (size_t)l * 3 * DFF2, args.in[10] + (size_t)l * DFF2, (float*)(ws + WS_UB), (PG8_LAS float*)(w.lds + LDSCTL_OFF + 1024), DFF};
            pg8::gemm_phase<pg8::EpiConv, pg8::StaticOrder, true, true>(w.lds, g, S, E);
            if (DIAG_CLK && l == 1 && blockIdx.x == 0 && w.tid == 0) { const unsigned long long dc1 = __builtin_readcyclecounter(), dr1 = __builtin_amdgcn_s_memrealtime(); unsigned long long* dg = (unsigned long long*)(ws + WS_CTL + 65536); dg[4] = dc1 - dc0; dg[5] = dr1 - dr0; }
            if (TAIL_CONVERT && !last) { const int NI = layer_items(l + 1), ib = gla ? (NI * 80) / 100 : (NI * 84) / 100; tail_convert(w, args, ws, S.nwg, l + 1, ib, NI); }
#else
            pg8::EpiStoreBf16 E{U, DFF2, 1 << 30, Z1};
            pg8::gemm_phase<pg8::EpiStoreBf16, pg8::StaticOrder, true, true>(w.lds, g, S, E);
#endif
        }
        SEAM(base + 7);
        for (int rep = 0; rep < RPT_CONV; ++rep) if (RUN(base + 8)) { PHASE_ENTER();
#if FUSE_CONV
            conv_fixup(w, (const float*)(ws + WS_UB), args.in[9] + (size_t)l * 3 * DFF2, args.in[10] + (size_t)l * DFF2, ACT, mrows / 256);
#else
            conv_rows(w, U, args.in[9] + (size_t)l * 3 * DFF2, args.in[10] + (size_t)l * DFF2, ACT, mrows);
#endif
        }
        SEAM(base + 8);
        if (RUN(base + 9)) {
            PHASE_ENTER();
            pg8::Gemm g{ACT, (const bf16*)(ws + WS_WDN + l * WDN_STRIDE), SPLITK_DN ? M_LAT : mrows, DM, DFF, DFF};
            pg8::StaticOrder S; S.init(g.M, g.N, w.G, (int)blockIdx.x);
            pg8::EpiResid E{X, DM, MODS + mods_off + 5 * DM, nullptr, nullptr};
            pg8::gemm_phase<pg8::EpiResid, pg8::StaticOrder, true, true>(w.lds, g, S, E);
            if (SPLITK_DN && !last) {
                pg8::Gemm g2{ACT + (size_t)M_LAT * DFF, g.Bt, M_CTX, DM, DFF, 1408};
                pg8::SplitKOrder S2; S2.init(M_CTX, DM, 4, 1408, w.G, (int)blockIdx.x);
                pg8::EpiPartial E2{(float*)(ws + WS_PART), DM, 1408, (size_t)M_CTX * DM};
                pg8::gemm_phase<pg8::EpiPartial, pg8::SplitKOrder, true, true>(w.lds, g2, S2, E2);
                if (TAIL_MODS && (int)blockIdx.x >= 128) {
                    for (int it = (l + 1) * 64 + ((int)blockIdx.x - 128); it < (l + 2) * 64; it += w.G - 128) mods_item(w, args.in[1], args.in[3], args.in[4], args.in[5], MODS, it);
                }
            }
        }
        SEAM(base + 9);
    }
    if (DIAG_BAR && blockIdx.x == (DIAG_BAR == 1 ? 0 : 100) && threadIdx.x == 0) { *(unsigned*)(args.ws + WS_CTL + 65536 + 64) = ((volatile LAS unsigned*)(lds0 + LDSCTL_OFF + 256))[4]; }
    if (RUN(41)) { PHASE_ENTER(); final_norm(w, X, args.out, args.in[24]);
        if (DIAG_BAR && blockIdx.x == 0 && w.tid == 0) { asm volatile("s_waitcnt vmcnt(0)" ::: "memory"); args.out[0] = (float)(10 * (int)((double)__hip_atomic_load((unsigned*)(ws + WS_CTL + 65536 + 64), __ATOMIC_RELAXED, __HIP_MEMORY_SCOPE_AGENT) / 100.0 / 100.0 + 0.5)); }
        if (DIAG_CLK && blockIdx.x == 0 && w.tid == 0) { asm volatile("s_waitcnt vmcnt(0)" ::: "memory"); const unsigned long long* dg = (const unsigned long long*)(ws + WS_CTL + 65536); args.out[0] = DIAG_CLK == 1 ? (float)(int)((double)dg[4] / (double)dg[5] + 0.5) : (float)(10 * (int)((double)dg[5] / 100.0 / 12.0 / 10.0 + 0.5)); }
        if (DIAG_SCAN && blockIdx.x == 0 && w.tid == 0) { asm volatile("s_waitcnt vmcnt(0)" ::: "memory"); const unsigned long long* dg = (const unsigned long long*)(ws + WS_CTL + 65536);
            const double a = (double)dg[0], b = (double)dg[1], c = (double)dg[2], tot = a + b + c; int d1 = (int)(10.0 * a / tot), d2 = (int)(10.0 * b / tot); if (d1 < 1) d1 = 1; if (d2 < 0) d2 = 0;
            args.out[0] = (float)(DIAG_SCAN == 1 ? 10 * d1 + d2 : (DIAG_SCAN == 2 ? tot / 68.0 / 2.0 / 10.0 : 0)); } }
#undef RUN
#undef SEAM
}

extern "C" void kernel_launch(void* const* d_in, const int* in_sizes, int n_in, void* d_out, int out_size, void* d_ws, size_t ws_size, hipStream_t stream) {
    static int grid = 0;
    if (grid == 0) {
        if (n_in != 25 || out_size != M_LAT * DM || ws_size < WS_END) { fprintf(stderr, "kernel_launch: unexpected shapes (n_in %d, out %d, ws %zu < %zu); nothing launched\n", n_in, out_size, ws_size, (size_t)WS_END); grid = -1; return; }
        int dev = 0, cus = 0, per_cu = 0;
        if (hipGetDevice(&dev) != hipSuccess || hipDeviceGetAttribute(&cus, hipDeviceAttributeMultiprocessorCount, dev) != hipSuccess) { grid = -1; return; }
        if (hipFuncSetAttribute((const void*)mega, hipFuncAttributeMaxDynamicSharedMemorySize, LDS_BYTES) != hipSuccess) { fprintf(stderr, "kernel_launch: hipFuncSetAttribute failed\n"); grid = -1; return; }
        if (hipOccupancyMaxActiveBlocksPerMultiprocessor(&per_cu, (const void*)mega, 512, LDS_BYTES) != hipSuccess || per_cu < 1)
            fprintf(stderr, "kernel_launch: occupancy query reports %d workgroups per CU\n", per_cu);
        (void)hipGetLastError();
        grid = cus;
    }
    if (grid < 0) return;
    if (hipMemsetAsync((char*)d_ws + WS_CTL, 0, CTL_ZERO_BYTES, stream) != hipSuccess) return;
    Args a{};
    for (int i = 0; i < 25; ++i) a.in[i] = (const float*)d_in[i];
    a.out = (float*)d_out; a.ws = (unsigned char*)d_ws;
#if MK_ONE_LAUNCH
    a.ph_lo = 0; a.ph_hi = NPH;
    hipLaunchKernelGGL(mega, dim3(grid), dim3(512), LDS_BYTES, stream, a);
#else
    for (int ph = 0; ph < NPH; ++ph) {
        if (ph >= 1 && ph <= 40) { const int l = (ph - 1) / 10, s = (ph - 1) % 10; if ((s == 2 && (l & 1) && NAIVE_GLA) || (s == 4 && !(l & 1))) continue; }
        a.ph_lo = ph; a.ph_hi = ph + 1;
        hipLaunchKernelGGL(mega, dim3(grid), dim3(512), LDS_BYTES, stream, a);
    }
#endif
}
```
